# Optimizing an MI355X kernel written in HIP

```python
import jax, jax.numpy as jnp
from jax import lax
import numpy as np

D_MODEL = 2048
BATCH = 2
SEQ = 16384
DEPTH = 1

MEM_LEN = 256
EPS = 1e-6

SSD_INNER = 3 * D_MODEL // 4
SSD_HEAD_DIM = 64
SSD_HEADS = SSD_INNER // SSD_HEAD_DIM
SSD_GROUPS = 4
SSD_HEADS_PER_GROUP = SSD_HEADS // SSD_GROUPS
SSD_STATE = 128
SSD_CONV = 4
SSD_CHUNK = 128
SSD_BC = SSD_GROUPS * SSD_STATE
SSD_CONV_DIM = SSD_INNER + 2 * SSD_BC

SB_HEADS = 4
SB_HEAD_DIM = 128
SB_WIDTH = SB_HEADS * SB_HEAD_DIM
SB_BLOCK = 128

N_BRANCH = 2
COL_Z = SSD_INNER
COL_XBC = COL_Z + SSD_CONV_DIM
COL_DT = COL_XBC + SSD_HEADS
COL_QKV = COL_DT + 3 * SB_WIDTH
IN_COLS = COL_QKV + N_BRANCH * D_MODEL

XA_HEADS = 4
XA_HEAD_DIM = 128
XA_WIDTH = XA_HEADS * XA_HEAD_DIM

N_GROUPS = 4
EXPERTS_PER_GROUP = 8
N_EXPERTS = N_GROUPS * EXPERTS_PER_GROUP
TOP_K = 2
EXPERT_FF = D_MODEL // 4
MOE_BLOCK = 256

kernel_name = "hybrid_ssd_stickbreak_hiermoe"


def rms_norm(x, w):
    xf = x.astype(jnp.float32)
    y = xf * lax.rsqrt(jnp.mean(xf * xf, axis=-1, keepdims=True) + EPS)
    return (y * w.astype(jnp.float32)).astype(x.dtype)


def causal_dwconv(u, w, b):
    c = u.shape[-1]
    out = lax.conv_general_dilated(
        u, w[:, None, :].astype(u.dtype), window_strides=(1,),
        padding=[(SSD_CONV - 1, 0)], dimension_numbers=('NWC', 'WIO', 'NWC'),
        feature_group_count=c)
    return out + b.astype(u.dtype)


def ssd_mixer(z, xbc, dt_raw, conv_w, conv_b, dt_bias, a_log, d_skip, norm_w):
    bsz, s, _ = z.shape
    g, r, p, n, L = SSD_GROUPS, SSD_HEADS_PER_GROUP, SSD_HEAD_DIM, SSD_STATE, SSD_CHUNK
    xbc = jax.nn.silu(causal_dwconv(xbc, conv_w, conv_b))
    xs = xbc[..., :SSD_INNER].reshape(bsz, s, g, r, p)
    bm = xbc[..., SSD_INNER:SSD_INNER + SSD_BC].reshape(bsz, s, g, n).astype(jnp.float32)
    cm = xbc[..., SSD_INNER + SSD_BC:].reshape(bsz, s, g, n).astype(jnp.float32)
    dt = jax.nn.softplus(dt_raw.astype(jnp.float32) + dt_bias.astype(jnp.float32))
    a = -jnp.exp(a_log.astype(jnp.float32))
    da = (dt * a).reshape(bsz, s, g, r)
    xdt = xs.astype(jnp.float32) * dt.reshape(bsz, s, g, r)[..., None]
    nc = s // L

    def to_chunks(t):
        return jnp.moveaxis(t.reshape(bsz, nc, L, *t.shape[2:]), 1, 0)

    tri = jnp.arange(L)[:, None] >= jnp.arange(L)[None, :]

    def step(state, inp):
        x_c, a_c, b_c, c_c = inp
        a_cum = jnp.cumsum(a_c, axis=1)
        seg = a_cum[:, :, None] - a_cum[:, None, :]
        decay = jnp.exp(jnp.where(tri[None, :, :, None, None], seg, -jnp.inf))
        cb = jnp.einsum('btgn,bsgn->btsg', c_c, b_c)
        y_diag = jnp.einsum('btsgr,bsgrp->btgrp', cb[..., None] * decay, x_c)
        y_off = jnp.einsum('btgn,bgrpn->btgrp', c_c, state) * jnp.exp(a_cum)[..., None]
        a_last = a_cum[:, -1]
        w_s = jnp.exp(a_last[:, None] - a_cum)
        new_state = state * jnp.exp(a_last)[..., None, None] + jnp.einsum(
            'bsgn,bsgrp->bgrpn', b_c, x_c * w_s[..., None])
        return new_state, y_diag + y_off

    state0 = jnp.zeros((bsz, g, r, p, n), jnp.float32)
    _, ys = lax.scan(step, state0, (to_chunks(xdt), to_chunks(da), to_chunks(bm), to_chunks(cm)))
    y = jnp.moveaxis(ys, 0, 1).reshape(bsz, s, g, r, p)
    y = y + xs.astype(jnp.float32) * d_skip.astype(jnp.float32).reshape(g, r)[:, :, None]
    y = y.reshape(bsz, s, SSD_INNER) * jax.nn.silu(z.astype(jnp.float32))
    return rms_norm(y, norm_w).astype(z.dtype)


def stick_breaking_attention(q, k, v):
    bsz, s, h, dh = q.shape
    scale = dh ** -0.5
    qh = q.transpose(0, 2, 1, 3).astype(jnp.float32)
    kh = k.transpose(0, 2, 1, 3).astype(jnp.float32)
    vh = v.transpose(0, 2, 1, 3).astype(jnp.float32)
    nb = s // SB_BLOCK
    r = jnp.arange(SB_BLOCK)
    later = (r[:, None] > r[None, :]).astype(jnp.float32)
    outs = []
    for i in range(nb):
        n_keys = (i + 1) * SB_BLOCK
        qb = qh[:, :, i * SB_BLOCK:(i + 1) * SB_BLOCK]
        kb = kh[:, :, :n_keys]
        vb = vh[:, :, :n_keys]
        t_idx = i * SB_BLOCK + r
        causal = jnp.arange(n_keys)[None, :] < t_idx[:, None]
        zlog = jnp.einsum('bhtd,bhsd->bhts', qb, kb) * scale
        log_beta = jax.nn.log_sigmoid(zlog)
        log_keep = jnp.where(causal, log_beta - zlog, 0.0)
        lk = log_keep.reshape(bsz, h, SB_BLOCK, i + 1, SB_BLOCK)
        after_in = jnp.einsum('bhtcj,js->bhtcs', lk, later)
        blk_sum = jnp.sum(lk, axis=-1)
        carry = lax.cumsum(blk_sum, axis=3, reverse=True) - blk_sum
        after = (after_in + carry[..., None]).reshape(bsz, h, SB_BLOCK, n_keys)
        att = jnp.where(causal, jnp.exp(log_beta + after), 0.0)
        outs.append(jnp.einsum('bhts,bhsd->bhtd', att, vb))
    out = jnp.concatenate(outs, axis=2).transpose(0, 2, 1, 3)
    return out.reshape(bsz, s, h * dh).astype(q.dtype)


def memory_cross_attention(u, mem_n, wq, wk, wv, wo):
    bsz, s, _ = u.shape
    m = mem_n.shape[1]
    q = (u @ wq).reshape(bsz, s, XA_HEADS, XA_HEAD_DIM)
    k = (mem_n @ wk).reshape(bsz, m, XA_HEADS, XA_HEAD_DIM)
    v = (mem_n @ wv).reshape(bsz, m, XA_HEADS, XA_HEAD_DIM)
    sc = jnp.einsum('bshd,bmhd->bhsm', q, k).astype(jnp.float32) * (XA_HEAD_DIM ** -0.5)
    pr = jax.nn.softmax(sc, axis=-1).astype(v.dtype)
    o = jnp.einsum('bhsm,bmhd->bshd', pr, v).reshape(bsz, s, XA_WIDTH)
    return o @ wo


def hierarchical_moe(u, w_rg, w_re, w_gate, w_up, w_down):
    bsz, s, dm = u.shape
    t = bsz * s
    tok = u.reshape(t, dm)
    g_logits = (tok @ w_rg).astype(jnp.float32)
    g_prob = jax.nn.softmax(g_logits, axis=-1)
    g_sel = jnp.argmax(g_logits, axis=-1)
    g_gate = jnp.take_along_axis(g_prob, g_sel[:, None], axis=-1)[:, 0]
    e_logits = (tok @ w_re).astype(jnp.float32).reshape(t, N_GROUPS, EXPERTS_PER_GROUP)
    e_in_group = jnp.take_along_axis(e_logits, g_sel[:, None, None], axis=1)[:, 0]
    top_val, top_idx = lax.top_k(e_in_group, TOP_K)
    gate = jax.nn.softmax(top_val, axis=-1) * g_gate[:, None]
    expert_id = (g_sel[:, None] * EXPERTS_PER_GROUP + top_idx).astype(jnp.int32)
    flat_e = expert_id.reshape(-1)
    flat_t = jnp.repeat(jnp.arange(t, dtype=jnp.int32), TOP_K)
    flat_w = gate.reshape(-1)
    order = jnp.argsort(flat_e)
    se = flat_e[order]
    counts = jnp.bincount(flat_e, length=N_EXPERTS)
    offsets = jnp.cumsum(counts) - counts
    padded = (counts + MOE_BLOCK - 1) // MOE_BLOCK * MOE_BLOCK
    pad_end = jnp.cumsum(padded)
    pad_start = pad_end - padded
    dest = pad_start[se] + (jnp.arange(t * TOP_K) - offsets[se])
    n_slots = t * TOP_K + N_EXPERTS * MOE_BLOCK
    n_blocks = n_slots // MOE_BLOCK
    slot_tok = jnp.full((n_slots,), t, jnp.int32).at[dest].set(flat_t[order])
    slot_w = jnp.zeros((n_slots,), jnp.float32).at[dest].set(flat_w[order])
    block_e = jnp.minimum(
        jnp.searchsorted(pad_end, jnp.arange(n_blocks) * MOE_BLOCK, side='right'),
        N_EXPERTS - 1)
    tok_pad = jnp.concatenate([tok, jnp.zeros((1, dm), tok.dtype)], axis=0)

    def run_block(args):
        idx, e = args
        xb = tok_pad[idx]
        hid = jax.nn.silu(xb @ w_gate[e]) * (xb @ w_up[e])
        return hid @ w_down[e]

    yb = lax.map(run_block, (slot_tok.reshape(n_blocks, MOE_BLOCK), block_e))
    yb = yb.reshape(n_slots, dm).astype(jnp.float32) * slot_w[:, None]
    out = jnp.zeros((t + 1, dm), jnp.float32).at[slot_tok].add(yb)[:t]
    return out.reshape(bsz, s, dm).astype(u.dtype)


def setup_inputs(seed: int = 0) -> dict:
    key = jax.random.key(seed)
    ks = iter(jax.random.split(key, 40))
    f32 = jnp.float32

    def w(shape, fan_in):
        return jax.random.normal(next(ks), shape, f32) * (fan_in ** -0.5)

    def gain(shape):
        return 1.0 + 0.01 * jax.random.normal(next(ks), shape, f32)

    x = jax.random.normal(next(ks), (BATCH, SEQ, D_MODEL), f32)
    mem = jax.random.normal(next(ks), (BATCH, MEM_LEN, D_MODEL), f32)
    dt0 = jnp.exp(jax.random.uniform(next(ks), (DEPTH, SSD_HEADS), f32,
                                     np.log(1e-3), np.log(1e-1)))
    dt_bias = dt0 + jnp.log(-jnp.expm1(-dt0))
    a_log = jnp.log(jax.random.uniform(next(ks), (DEPTH, SSD_HEADS), f32, 1.0, 16.0))
    return {
        "x": x,
        "mem": mem,
        "norm_mix_w": gain((DEPTH, D_MODEL)),
        "w_in": w((DEPTH, D_MODEL, IN_COLS), D_MODEL),
        "conv_w": w((DEPTH, SSD_CONV, SSD_CONV_DIM), SSD_CONV),
        "conv_b": 0.01 * jax.random.normal(next(ks), (DEPTH, SSD_CONV_DIM), f32),
        "dt_bias": dt_bias,
        "a_log": a_log,
        "d_skip": 1.0 + 0.1 * jax.random.normal(next(ks), (DEPTH, SSD_HEADS), f32),
        "ssd_norm_w": gain((DEPTH, SSD_INNER)),
        "w_ssd_branch": w((DEPTH, SSD_INNER, D_MODEL), SSD_INNER),
        "w_sb_branch": w((DEPTH, SB_WIDTH, D_MODEL), SB_WIDTH),
        "w_mix_out": w((DEPTH, D_MODEL, D_MODEL), D_MODEL),
        "norm_xa_w": gain((DEPTH, D_MODEL)),
        "norm_mem_w": gain((DEPTH, D_MODEL)),
        "w_xq": w((DEPTH, D_MODEL, XA_WIDTH), D_MODEL),
        "w_xk": w((DEPTH, D_MODEL, XA_WIDTH), D_MODEL),
        "w_xv": w((DEPTH, D_MODEL, XA_WIDTH), D_MODEL),
        "w_xo": w((DEPTH, XA_WIDTH, D_MODEL), XA_WIDTH),
        "norm_moe_w": gain((DEPTH, D_MODEL)),
        "w_router_group": w((DEPTH, D_MODEL, N_GROUPS), D_MODEL),
        "w_router_expert": w((DEPTH, D_MODEL, N_EXPERTS), D_MODEL),
        "w_expert_gate": w((DEPTH, N_EXPERTS, D_MODEL, EXPERT_FF), D_MODEL),
        "w_expert_up": w((DEPTH, N_EXPERTS, D_MODEL, EXPERT_FF), D_MODEL),
        "w_expert_down": w((DEPTH, N_EXPERTS, EXPERT_FF, D_MODEL), EXPERT_FF),
        "norm_final_w": gain((D_MODEL,)),
    }


def reference(x, mem, norm_mix_w, w_in, conv_w, conv_b, dt_bias, a_log, d_skip,
              ssd_norm_w, w_ssd_branch, w_sb_branch, w_mix_out, norm_xa_w, norm_mem_w,
              w_xq, w_xk, w_xv, w_xo, norm_moe_w, w_router_group, w_router_expert,
              w_expert_gate, w_expert_up, w_expert_down, norm_final_w):
    bsz, s, _ = x.shape
    h = x
    for l in range(DEPTH):
        u = rms_norm(h, norm_mix_w[l])
        w_l = w_in[l]
        z = u @ w_l[:, :COL_Z]
        xbc = u @ w_l[:, COL_Z:COL_XBC]
        dt_raw = u @ w_l[:, COL_XBC:COL_DT]
        qkv = u @ w_l[:, COL_DT:COL_QKV]
        gates = u @ w_l[:, COL_QKV:]
        y_ssd = ssd_mixer(z, xbc, dt_raw, conv_w[l], conv_b[l], dt_bias[l], a_log[l],
                          d_skip[l], ssd_norm_w[l])
        q = qkv[..., :SB_WIDTH].reshape(bsz, s, SB_HEADS, SB_HEAD_DIM)
        k = qkv[..., SB_WIDTH:2 * SB_WIDTH].reshape(bsz, s, SB_HEADS, SB_HEAD_DIM)
        v = qkv[..., 2 * SB_WIDTH:].reshape(bsz, s, SB_HEADS, SB_HEAD_DIM)
        y_sb = stick_breaking_attention(q, k, v)
        g = jax.nn.sigmoid(gates.astype(jnp.float32)).astype(h.dtype)
        merged = (g[..., :D_MODEL] * (y_ssd @ w_ssd_branch[l])
                  + g[..., D_MODEL:] * (y_sb @ w_sb_branch[l]))
        h = h + merged @ w_mix_out[l]
        mem_n = rms_norm(mem, norm_mem_w[l])
        h = h + memory_cross_attention(rms_norm(h, norm_xa_w[l]), mem_n,
                                       w_xq[l], w_xk[l], w_xv[l], w_xo[l])
        h = h + hierarchical_moe(rms_norm(h, norm_moe_w[l]), w_router_group[l],
                                 w_router_expert[l], w_expert_gate[l], w_expert_up[l],
                                 w_expert_down[l])
    return rms_norm(h, norm_final_w)
```

```cpp
#include <hip/hip_runtime.h>
#include <cstdio>
#include <cstdint>

#define DI __device__ __forceinline__
#define LAS __attribute__((address_space(3)))
#define GAS __attribute__((address_space(1)))
typedef unsigned short bf16;
typedef short bf16x8 __attribute__((ext_vector_type(8)));
typedef short s16x4 __attribute__((ext_vector_type(4)));
typedef float f32x4 __attribute__((ext_vector_type(4)));
typedef float f32x2 __attribute__((ext_vector_type(2)));
typedef unsigned u32x4 __attribute__((ext_vector_type(4)));
typedef unsigned u32x2 __attribute__((ext_vector_type(2)));
typedef __bf16 bf16x2_t __attribute__((ext_vector_type(2)));

#ifndef DUP_MASK
#define DUP_MASK 0
#endif
#define REP(k) for (int rep_ = 0; rep_ < 1 + 2 * ((DUP_MASK >> (k)) & 1); ++rep_)
#ifndef MK_N_LAUNCHES
#define MK_N_LAUNCHES 1
#endif

constexpr int D = 2048, BATCH = 2, SEQ = 16384, T = BATCH * SEQ;
constexpr int SSD_INNER = 1536, SSD_HEADS = 24, SSD_P = 64, SSD_N = 128, SSD_G = 4, SSD_L = 128, SSD_BC = 512, CONV_DIM = 2560;
constexpr int NCHUNK = T / SSD_L;
constexpr int SB_W = 512, SB_H = 4, SB_D = 128;
constexpr int IN_COLS = 9752, IN_PAD = 9984;
constexpr int XA_W = 512, MEM = 256;
constexpr int NEXP = 32, EFF = 512;
constexpr int NSLOT = 2 * T + NEXP * 256;
constexpr float EPS = 1e-6f;

constexpr size_t MiB = 1u << 20;
constexpr size_t WS_CTL = 0, CTL_ZERO_BYTES = 1 * MiB;
constexpr size_t WS_WCAT_T = 1 * MiB;
constexpr size_t WS_WMIX_T = 9 * MiB;
constexpr size_t WS_WQ_T = 17 * MiB;
constexpr size_t WS_WK_T = 19 * MiB;
constexpr size_t WS_WV_T = 21 * MiB;
constexpr size_t WS_WO_T = 23 * MiB;
constexpr size_t WS_WR_T = 25 * MiB;
constexpr size_t WS_MEMN = 26 * MiB;
constexpr size_t WS_KX = 28 * MiB;
constexpr size_t WS_VXT = 28 * MiB + 512 * 1024;
constexpr size_t WS_DTRAW = 29 * MiB;
constexpr size_t WS_DTT = 33 * MiB;
constexpr size_t WS_ACT = 36 * MiB;
constexpr size_t WS_RSTD = 39 * MiB;
constexpr size_t WS_SRSTD = 53 * MiB;
constexpr size_t WS_SSQ1 = 54 * MiB, WS_SSQ2 = 58 * MiB;
constexpr size_t WS_WL = 50 * MiB;
constexpr size_t WS_LOGITS = 40 * MiB;
constexpr size_t WS_TI = 48 * MiB;
constexpr size_t WS_TG = 48 * MiB + 512 * 1024;
constexpr size_t WS_TSLOT = 48 * MiB + 768 * 1024;
constexpr size_t WS_SLOTTOK = 49 * MiB;
constexpr size_t WS_TILEE = 49 * MiB + 512 * 1024;
constexpr size_t WS_WIN_T = 64 * MiB;
constexpr size_t WS_BT = 64 * MiB;
constexpr size_t WS_Q2 = 64 * MiB;
constexpr size_t WS_RA = 104 * MiB;
constexpr size_t WS_Z = 232 * MiB;
constexpr size_t WS_HID = 232 * MiB;
constexpr size_t WS_XBC = 328 * MiB;
constexpr size_t WS_MERGED = 328 * MiB;
constexpr size_t WS_QKV = 488 * MiB;
constexpr size_t WS_WGU_T = 488 * MiB;
constexpr size_t WS_GATES = 584 * MiB;
constexpr size_t WS_WD_T = 616 * MiB;
constexpr size_t WS_Y = 680 * MiB;
constexpr size_t WS_BN = 840 * MiB;
constexpr size_t WS_CN = 872 * MiB;
constexpr size_t WS_XT = 904 * MiB;
constexpr size_t WS_O2 = 968 * MiB;
constexpr size_t WS_END = 1000 * MiB;
constexpr size_t OUT_STATE = 0, OUT_VT = 192 * MiB;
constexpr int CW_BAR = 4096;
constexpr int CW_ECNT = 16384;

constexpr int RING_BYTES = 131072;
constexpr int MISC_OFF = RING_BYTES + 320;
constexpr int LDS_BYTES = 147456;
constexpr int NWAVES = 8;

DI float bf2f(bf16 v) { return __uint_as_float(((unsigned)v) << 16); }
DI unsigned pk2(float lo, float hi) { f32x2 v = {lo, hi}; bf16x2_t b = __builtin_convertvector(v, bf16x2_t); return __builtin_bit_cast(unsigned, b); }
DI bf16x8 pack8(const float (&v)[8]) { u32x4 p; p.x = pk2(v[0], v[1]); p.y = pk2(v[2], v[3]); p.z = pk2(v[4], v[5]); p.w = pk2(v[6], v[7]); return __builtin_bit_cast(bf16x8, p); }
DI float wave_sum(float v) {
#pragma unroll
    for (int o = 1; o < 64; o <<= 1) v += __shfl_xor(v, o);
    return v;
}
DI float silu_f(float x) { return x * __builtin_amdgcn_rcpf(1.0f + __expf(-x)); }
DI float sigmoid_f(float x) { return __builtin_amdgcn_rcpf(1.0f + __expf(-x)); }
DI float rstd32(const float* p) { f32x4 a = *(const f32x4*)p;
#pragma unroll
    for (int i = 1; i < 8; ++i) a += *(const f32x4*)(p + 4 * i);
    return 1.0f / sqrtf(((a[0] + a[1]) + (a[2] + a[3])) * (1.0f / 2048.0f) + EPS); }
#define MFMA16(a, b, c) __builtin_amdgcn_mfma_f32_16x16x32_bf16((a), (b), (c), 0, 0, 0)
#define LDS_WAIT() asm volatile("s_waitcnt lgkmcnt(0)" ::: "memory")
#define VM_WAIT() asm volatile("s_waitcnt vmcnt(0)" ::: "memory")

namespace pg8 {
#define PG8_LAS __attribute__((address_space(3)))
constexpr int BM = 256, BK = 64, HALF = 128, HTB = HALF * BK * 2, STAGE_BYTES = 8 * HTB, NXCD = 8, WGM = 8;
__host__ __device__ __forceinline__ int lds_byte(int r, int c) { const int st = (r >> 4) * 2 + (c >> 5), rr = r & 15, cc = c & 31, ob = rr * 64 + cc * 2; return st * 1024 + (ob ^ (((ob >> 9) & 1) << 5)); }
__host__ __device__ __forceinline__ void stage_rc(int b, int& R, int& C) { const int st = b / 1024, sb = b % 1024, swz = sb ^ (((sb >> 9) & 1) << 5); R = (st >> 1) * 16 + swz / 64; C = (st & 1) * 32 + (swz % 64) / 2; }
__host__ __device__ __forceinline__ int perm32(int rho) { const int n = rho >> 4, i = rho & 15; return 8 * (i >> 2) + 4 * n + (i & 3); }

struct Unit { int pm, pn, k0, nt, fin; };
struct Gemm { const bf16* A; const bf16* Bt; int K, lda, ldb; const int* arow; const int* tile_e; size_t b_estride; };

struct StaticOrder {
    int nM, nN, nwg, G, c, nt;
    __device__ void init(int M, int N, int K, int G_, int c_) { nM = M / BM; nN = N / BM; nwg = nM * nN; G = G_; c = c_; nt = K / BK; }
    __device__ bool next(int i, Unit& u) const {
        u.k0 = 0; u.nt = nt; u.fin = 1;
        const long L = (long)i * G + c; if (L >= nwg) return false;
        int wgid = (int)L; { const int q = nwg / NXCD, r = nwg % NXCD, xcd = wgid % NXCD, off = wgid / NXCD; wgid = (xcd < r ? xcd * (q + 1) : r * (q + 1) + (xcd - r) * q) + off; }
        const int nig = WGM * nN, gid = wgid / nig, fm = gid * WGM, gsz = (nM - fm) < WGM ? (nM - fm) : WGM;
        u.pm = fm + ((wgid % nig) % gsz); u.pn = (wgid % nig) / gsz; return true;
    }
};
struct ListOrder {
    int ntile, nN, U, v, nt;
    __device__ void init(int ntile_, int nN_, int G, int v_, int nt_) { ntile = ntile_; nN = nN_; v = v_; nt = nt_; U = (ntile_ * nN_ + G - 1) / G; }
    __device__ bool next(int i, Unit& u) const { u.k0 = 0; u.nt = nt; u.fin = 1; const int L = v * U + i; if (i >= U || L >= ntile * nN) return false; u.pm = L / nN; u.pn = L % nN; return true; }
};
struct SplitOrder {
    StaticOrder so; int nt0, nt1;
    __device__ bool next(int i, Unit& u) const { if (!so.next(i >> 1, u)) return false; if (i & 1) { u.k0 = nt0 * BK; u.nt = nt1; u.fin = 1; } else { u.k0 = 0; u.nt = nt0; u.fin = 0; } return true; }
};

template <class Epi, class Sched, bool ALIGN_EPI, bool GATHER>
__device__ __forceinline__ void gemm_phase(PG8_LAS unsigned char* lds, const Gemm g, const Sched& S, const Epi& E) {
    const int tid = threadIdx.x, wid = __builtin_amdgcn_readfirstlane(tid >> 6), lane = tid & 63, wr = wid >> 2, wc = wid & 3, fr = lane & 15, fq = lane >> 4;
    unsigned voffB[2]; int RA[2], CA[2];
#pragma unroll
    for (int i = 0; i < 2; ++i) { int R, C; stage_rc(tid * 16 + i * 8192, R, C); const int Rb = (R & ~31) + perm32(R & 31);
        RA[i] = R; CA[i] = C; voffB[i] = (unsigned)(Rb * g.ldb + C) * 2u; }
    const size_t kstep = (size_t)(BK * 2);
    const size_t hstepB = (size_t)HALF * g.ldb * 2;
    const size_t tstepB = 2 * hstepB;
    const unsigned ldsw = (unsigned)wid * 1024u;
    const int aoff = lds_byte(wr * 64 + fr, fq * 8), boff = lds_byte(wc * 32 + fr, fq * 8);
    const char* Ab = (const char*)g.A;
#define PG8_SA(b, h) (((b) * 2 + (h)) * HTB)
#define PG8_SB(b, h) ((4 + (b) * 2 + (h)) * HTB)
#define PG8_STAGE(bufoff, gbase, voff) do { _Pragma("unroll") for (int _i = 0; _i < 2; ++_i) \
        __builtin_amdgcn_global_load_lds((const unsigned*)((const char*)(gbase) + (voff)[_i]), (PG8_LAS unsigned*)(lds + (bufoff) + ldsw + _i * 8192), 16, 0, 0); } while (0)
#define PG8_STAGEA(bufoff, kb, o0, o1) do { \
        __builtin_amdgcn_global_load_lds((const unsigned*)(Ab + (kb) + (o0)), (PG8_LAS unsigned*)(lds + (bufoff) + ldsw), 16, 0, 0); \
        __builtin_amdgcn_global_load_lds((const unsigned*)(Ab + (kb) + (o1)), (PG8_LAS unsigned*)(lds + (bufoff) + ldsw + 8192), 16, 0, 0); } while (0)
#define PG8_LDA(dst, b, h) do { _Pragma("unroll") for (int m = 0; m < 4; ++m) _Pragma("unroll") for (int k = 0; k < 2; ++k) dst[m][k] = *(const PG8_LAS bf16x8*)(lds + PG8_SA(b, h) + aoff + m * 2048 + k * 1024); } while (0)
#define PG8_LDB(dst, b, h) do { _Pragma("unroll") for (int n = 0; n < 2; ++n) _Pragma("unroll") for (int k = 0; k < 2; ++k) dst[n][k] = *(const PG8_LAS bf16x8*)(lds + PG8_SB(b, h) + boff + n * 2048 + k * 1024); } while (0)
#define PG8_MMA(ai, bj, At, Bt) do { __builtin_amdgcn_s_setprio(1); _Pragma("unroll") for (int m = 0; m < 4; ++m) _Pragma("unroll") for (int n = 0; n < 2; ++n) _Pragma("unroll") for (int k = 0; k < 2; ++k) \
        acc[ai][bj][m][n] = __builtin_amdgcn_mfma_f32_16x16x32_bf16(Bt[n][k], At[m][k], acc[ai][bj][m][n], 0, 0, 0); __builtin_amdgcn_s_setprio(0); } while (0)
#define PG8_WAIT_V(n) asm volatile("s_waitcnt vmcnt(" #n ")" ::: "memory")
#define PG8_WAIT_L(n) asm volatile("s_waitcnt lgkmcnt(" #n ")" ::: "memory")
#define PG8_BAR __builtin_amdgcn_s_barrier()
#define PG8_SCHED __builtin_amdgcn_sched_barrier(0)
#define PG8_SETA(o, u) do { _Pragma("unroll") for (int _h = 0; _h < 2; ++_h) _Pragma("unroll") for (int _i = 0; _i < 2; ++_i) { \
        int _row = (u).pm * BM + _h * HALF + RA[_i]; if (GATHER) _row = g.arow[_row]; (o)[_h][_i] = (unsigned)(_row * g.lda + CA[_i] + (u).k0) * 2u; } } while (0)
    Unit cur, nxt; int ui = 0;
    if (!S.next(0, cur)) return;
    f32x4 acc[2][2][4][2];
#pragma unroll
    for (int a = 0; a < 2; ++a)
#pragma unroll
        for (int b = 0; b < 2; ++b)
#pragma unroll
            for (int m = 0; m < 4; ++m)
#pragma unroll
                for (int n = 0; n < 2; ++n) acc[a][b][m][n] = (f32x4){0.f, 0.f, 0.f, 0.f};
    bf16x8 At[4][2], B0[2][2], B1[2][2];
    unsigned oc[2][2], on[2][2];
    PG8_SETA(oc, cur);
    const char* cB = (const char*)g.Bt + (g.tile_e ? (size_t)g.tile_e[cur.pm] * g.b_estride * 2 : (size_t)0) + (size_t)cur.pn * tstepB + (size_t)cur.k0 * 2;
    PG8_STAGE(PG8_SB(0, 0), cB, voffB); PG8_STAGE(PG8_SB(0, 1), cB + hstepB, voffB); PG8_STAGEA(PG8_SA(0, 0), 0, oc[0][0], oc[0][1]); PG8_STAGEA(PG8_SA(0, 1), 0, oc[1][0], oc[1][1]);
    if (wr == 1) PG8_BAR;
    PG8_WAIT_V(2); PG8_BAR;
    PG8_STAGE(PG8_SB(1, 0), cB + kstep, voffB); PG8_STAGEA(PG8_SA(1, 0), kstep, oc[0][0], oc[0][1]); PG8_STAGE(PG8_SB(1, 1), cB + hstepB + kstep, voffB);
    PG8_WAIT_V(6); PG8_BAR;
    for (;;) {
        const bool has_next = S.next(ui + 1, nxt);
        const char* nB = cB;
        if (has_next) { nB = (const char*)g.Bt + (g.tile_e ? (size_t)g.tile_e[nxt.pm] * g.b_estride * 2 : (size_t)0) + (size_t)nxt.pn * tstepB + (size_t)nxt.k0 * 2; }
        const int nt = cur.nt;
#pragma unroll
        for (int _h = 0; _h < 2; ++_h)
#pragma unroll
            for (int _i = 0; _i < 2; ++_i) on[_h][_i] = oc[_h][_i];
        for (int t = 0; t < nt; t += 2) {
            const bool last = (t == nt - 2);
            if (last && has_next) { PG8_SETA(on, nxt); }
            const size_t k1 = (size_t)(t + 1) * kstep;
            const size_t k2 = last ? (size_t)0 : (size_t)(t + 2) * kstep, k3 = k2 + kstep;
            const char* b2 = last ? nB : cB + (size_t)(t + 2) * kstep; const char* b3 = b2 + kstep;
            const unsigned s00 = last ? on[0][0] : oc[0][0], s01 = last ? on[0][1] : oc[0][1], s10 = last ? on[1][0] : oc[1][0], s11 = last ? on[1][1] : oc[1][1];
            PG8_LDB(B0, 0, 0); PG8_LDB(B1, 0, 1); PG8_SCHED; PG8_LDA(At, 0, 0); PG8_STAGEA(PG8_SA(1, 1), k1, oc[1][0], oc[1][1]);
            PG8_WAIT_V(8); PG8_WAIT_L(0); PG8_BAR; PG8_MMA(0, 0, At, B0); PG8_MMA(0, 1, At, B1); PG8_BAR; PG8_SCHED;
            PG8_LDA(At, 0, 1); PG8_STAGE(PG8_SB(0, 0), b2, voffB); PG8_STAGE(PG8_SB(0, 1), b2 + hstepB, voffB); PG8_STAGEA(PG8_SA(0, 0), k2, s00, s01);
            PG8_WAIT_V(8); PG8_WAIT_L(0); PG8_BAR; PG8_MMA(1, 0, At, B0); PG8_MMA(1, 1, At, B1); PG8_BAR; PG8_SCHED;
            PG8_LDB(B0, 1, 0); PG8_LDB(B1, 1, 1); PG8_SCHED; PG8_LDA(At, 1, 0); PG8_STAGEA(PG8_SA(0, 1), k2, s10, s11);
            PG8_WAIT_V(8); PG8_WAIT_L(0); PG8_BAR; PG8_MMA(0, 0, At, B0); PG8_MMA(0, 1, At, B1); PG8_BAR; PG8_SCHED;
            PG8_LDA(At, 1, 1); PG8_STAGE(PG8_SB(1, 0), b3, voffB); PG8_STAGE(PG8_SB(1, 1), b3 + hstepB, voffB); PG8_STAGEA(PG8_SA(1, 0), k3, s00, s01);
            PG8_WAIT_V(8); PG8_WAIT_L(0); PG8_BAR; PG8_MMA(1, 0, At, B0); PG8_MMA(1, 1, At, B1); PG8_BAR; PG8_SCHED;
        }
        if constexpr (ALIGN_EPI) { if (wr == 0) PG8_BAR; }
        E(acc, cur, wr, wc, fr, fq);
        if (!has_next) break;
        if (cur.fin) {
#pragma unroll
        for (int a = 0; a < 2; ++a)
#pragma unroll
            for (int b = 0; b < 2; ++b)
#pragma unroll
                for (int m = 0; m < 4; ++m)
#pragma unroll
                    for (int n = 0; n < 2; ++n) acc[a][b][m][n] = (f32x4){0.f, 0.f, 0.f, 0.f};
        }
        cur = nxt; cB = nB; ++ui;
#pragma unroll
        for (int _h = 0; _h < 2; ++_h)
#pragma unroll
            for (int _i = 0; _i < 2; ++_i) oc[_h][_i] = on[_h][_i];
        if constexpr (ALIGN_EPI) { if (wr == 1) PG8_BAR; }
    }
    PG8_WAIT_V(0);
    if constexpr (!ALIGN_EPI) { if (wr == 0) PG8_BAR; }
    PG8_BAR;
#undef PG8_SA
#undef PG8_SB
#undef PG8_STAGE
#undef PG8_STAGEA
#undef PG8_LDA
#undef PG8_LDB
#undef PG8_MMA
#undef PG8_WAIT_V
#undef PG8_WAIT_L
#undef PG8_BAR
#undef PG8_SCHED
#undef PG8_SETA
}

#define EPI_ROWS(...) _Pragma("unroll") for (int ai = 0; ai < 2; ++ai) _Pragma("unroll") for (int m = 0; m < 4; ++m) { const int row = u.pm * BM + ai * HALF + wr * 64 + m * 16 + fr; \
        _Pragma("unroll") for (int bj = 0; bj < 2; ++bj) { const int col = u.pn * BM + bj * HALF + wc * 32 + 8 * fq; const f32x4 v0 = acc[ai][bj][m][0], v1 = acc[ai][bj][m][1]; __VA_ARGS__ } }
DI u32x4 pack8v(f32x4 v0, f32x4 v1) { u32x4 w; w.x = pk2(v0[0], v0[1]); w.y = pk2(v0[2], v0[3]); w.z = pk2(v1[0], v1[1]); w.w = pk2(v1[2], v1[3]); return w; }
DI void unpack8(u32x4 w, float (&f)[8]) { f[0] = __uint_as_float(w.x << 16); f[1] = __uint_as_float(w.x & 0xffff0000u); f[2] = __uint_as_float(w.y << 16); f[3] = __uint_as_float(w.y & 0xffff0000u);
    f[4] = __uint_as_float(w.z << 16); f[5] = __uint_as_float(w.z & 0xffff0000u); f[6] = __uint_as_float(w.w << 16); f[7] = __uint_as_float(w.w & 0xffff0000u); }

struct EpiBf16 {
    bf16* O; int ldc;
    DI void operator()(const f32x4 (&acc)[2][2][4][2], const Unit& u, int wr, int wc, int fr, int fq) const {
        EPI_ROWS({ *(u32x4*)(O + (size_t)row * ldc + col) = pack8v(v0, v1); })
    }
};
struct EpiInProj {
    bf16 *Z, *XBC, *QKV, *GATES; float* DTRAW;
    DI void operator()(const f32x4 (&acc)[2][2][4][2], const Unit& u, int wr, int wc, int fr, int fq) const {
        const int pn = u.pn;
        if (pn < 6) { EPI_ROWS({ *(u32x4*)(Z + (size_t)row * 1536 + col) = pack8v(v0, v1); }) }
        else if (pn < 16) { EPI_ROWS({ *(u32x4*)(XBC + (size_t)row * 2560 + (col - 1536)) = pack8v(v0, v1); }) }
        else if (pn < 22) { EPI_ROWS({ *(u32x4*)(QKV + (size_t)row * 1536 + (col - 4096)) = pack8v(v0, v1); }) }
        else if (pn < 38) { EPI_ROWS({ f32x4 a, b;
_Pragma("unroll")
                for (int j = 0; j < 4; ++j) { a[j] = sigmoid_f(v0[j]); b[j] = sigmoid_f(v1[j]); }
                *(u32x4*)(GATES + (size_t)row * 4096 + (col - 5632)) = pack8v(a, b); }) }
        else { EPI_ROWS({ const int c = col - 9728; if (c < 32) { *(f32x4*)(DTRAW + (size_t)row * 32 + c) = v0; *(f32x4*)(DTRAW + (size_t)row * 32 + c + 4) = v1; } }) }
    }
};
struct EpiMerge {
    bf16* MERGED; const bf16* GATES; const float* RSTD;
    DI void operator()(f32x4 (&acc)[2][2][4][2], const Unit& u, int wr, int wc, int fr, int fq) const { if (u.fin) fin(acc, u, wr, wc, fr, fq); else mid(acc, u, wr, wc, fr, fq); }
    DI void mid(f32x4 (&acc)[2][2][4][2], const Unit& u, int wr, int wc, int fr, int fq) const {
#pragma unroll
        for (int ai = 0; ai < 2; ++ai)
#pragma unroll
            for (int m = 0; m < 4; ++m) { const int row = u.pm * BM + ai * HALF + wr * 64 + m * 16 + fr; const float rs = RSTD[row];
#pragma unroll
                for (int bj = 0; bj < 2; ++bj) { const int col = u.pn * BM + bj * HALF + wc * 32 + 8 * fq; float g1[8], g2[8];
                    unpack8(*(const u32x4*)(GATES + (size_t)row * 4096 + col), g1); unpack8(*(const u32x4*)(GATES + (size_t)row * 4096 + 2048 + col), g2);
#pragma unroll
                    for (int j = 0; j < 4; ++j) { acc[ai][bj][m][0][j] *= rs * g1[j] / fmaxf(g2[j], 1e-30f); acc[ai][bj][m][1][j] *= rs * g1[4 + j] / fmaxf(g2[4 + j], 1e-30f); } }
                asm volatile("" ::: "memory"); }
    }
    DI void fin(const f32x4 (&acc)[2][2][4][2], const Unit& u, int wr, int wc, int fr, int fq) const {
        EPI_ROWS({ float g2[8]; unpack8(*(const u32x4*)(GATES + (size_t)row * 4096 + 2048 + col), g2);
            f32x4 a, b;
_Pragma("unroll")
            for (int j = 0; j < 4; ++j) { a[j] = v0[j] * g2[j]; b[j] = v1[j] * g2[4 + j]; }
            *(u32x4*)(MERGED + (size_t)row * 2048 + col) = pack8v(a, b); })
    }
};
struct EpiResF32 {
    const float* base; float* out;
    DI void operator()(const f32x4 (&acc)[2][2][4][2], const Unit& u, int wr, int wc, int fr, int fq) const {
        EPI_ROWS({ const size_t o = (size_t)row * 2048 + col; const f32x4 b0 = *(const f32x4*)(base + o), b1 = *(const f32x4*)(base + o + 4);
            *(f32x4*)(out + o) = b0 + v0; *(f32x4*)(out + o + 4) = b1 + v1; })
    }
};
struct EpiResStat {
    const float* base; float* out; bf16* hb; float* ssq;
    DI void operator()(const f32x4 (&acc)[2][2][4][2], const Unit& u, int wr, int wc, int fr, int fq) const {
#pragma unroll
        for (int ai = 0; ai < 2; ++ai)
#pragma unroll
            for (int m = 0; m < 4; ++m) { const int row = u.pm * BM + ai * HALF + wr * 64 + m * 16 + fr; float sq = 0.f;
#pragma unroll
                for (int bj = 0; bj < 2; ++bj) { const int col = u.pn * BM + bj * HALF + wc * 32 + 8 * fq; const size_t o = (size_t)row * 2048 + col;
                    const f32x4 r0 = *(const f32x4*)(base + o) + acc[ai][bj][m][0], r1 = *(const f32x4*)(base + o + 4) + acc[ai][bj][m][1];
                    *(f32x4*)(out + o) = r0; *(f32x4*)(out + o + 4) = r1; *(u32x4*)(hb + o) = pack8v(r0, r1);
                    sq += (r0[0] * r0[0] + r0[1] * r0[1]) + (r0[2] * r0[2] + r0[3] * r0[3]) + (r1[0] * r1[0] + r1[1] * r1[1]) + (r1[2] * r1[2] + r1[3] * r1[3]); }
                sq += __shfl_xor(sq, 16); sq += __shfl_xor(sq, 32);
                if (fq == 0) ssq[(size_t)row * 32 + u.pn * 4 + wc] = sq; }
    }
};
struct EpiBf16Rs {
    bf16* O; int ldc; const float* ssq;
    DI void operator()(const f32x4 (&acc)[2][2][4][2], const Unit& u, int wr, int wc, int fr, int fq) const {
_Pragma("unroll") for (int ai = 0; ai < 2; ++ai) _Pragma("unroll") for (int m = 0; m < 4; ++m) { const int row = u.pm * BM + ai * HALF + wr * 64 + m * 16 + fr; const float rs = rstd32(ssq + (size_t)row * 32);
            _Pragma("unroll") for (int bj = 0; bj < 2; ++bj) { const int col = u.pn * BM + bj * HALF + wc * 32 + 8 * fq; *(u32x4*)(O + (size_t)row * ldc + col) = pack8v(acc[ai][bj][m][0] * rs, acc[ai][bj][m][1] * rs); } }
    }
};
struct EpiSwiGLU {
    bf16* HID; const float* srstd;
    DI void operator()(const f32x4 (&acc)[2][2][4][2], const Unit& u, int wr, int wc, int fr, int fq) const {
#pragma unroll
        for (int ai = 0; ai < 2; ++ai)
#pragma unroll
            for (int m = 0; m < 4; ++m) { const int row = u.pm * BM + ai * HALF + wr * 64 + m * 16 + fr; const int col = u.pn * 128 + wc * 32 + 8 * fq; const float rs = srstd[row];
                f32x4 a, b;
#pragma unroll
                for (int j = 0; j < 4; ++j) { a[j] = silu_f(acc[ai][0][m][0][j] * rs) * (acc[ai][1][m][0][j] * rs); b[j] = silu_f(acc[ai][0][m][1][j] * rs) * (acc[ai][1][m][1][j] * rs); }
                *(u32x4*)(HID + (size_t)row * EFF + col) = pack8v(a, b); }
    }
};
}

#define XB_TMO      128
#define XB_XCNT(j)  (256  + 64 * (j))
#define XB_XSUB(j)  (1280 + 64 * (j))
#define XB_XGEN(j)  (2304 + 64 * (j))
#define XB_TOP      3328
#define XB_TOPGEN   3392
#define XCD_BAR_WORDS 3456
#define XB_SPIN_CAP (1u << 18)
__device__ __forceinline__ unsigned xb_ld(unsigned* p)              { return __hip_atomic_load(p, __ATOMIC_RELAXED, __HIP_MEMORY_SCOPE_AGENT); }
__device__ __forceinline__ unsigned xb_add(unsigned* p, unsigned v) { return __hip_atomic_fetch_add(p, v, __ATOMIC_RELAXED, __HIP_MEMORY_SCOPE_AGENT); }
__device__ __forceinline__ unsigned xb_xcc_id() { return (unsigned)__builtin_amdgcn_s_getreg((3 << 11) | 20) & 0xFu; }
#define XB_SPIN(cond, bar) do { unsigned _sp = 0; while (cond) { __builtin_amdgcn_s_sleep(1); \
    if ((++_sp & 255u) == 0u) { if (xb_ld(&(bar)[XB_TMO])) break; if (_sp > XB_SPIN_CAP) { atomicAdd(&(bar)[XB_TMO], 1u); break; } } } } while (0)
struct XcdBarrier { unsigned* bar; unsigned x; volatile LAS unsigned* st; };
__device__ __forceinline__ XcdBarrier xcd_barrier_post(unsigned* bar, volatile LAS unsigned* st) {
    XcdBarrier b; b.bar = bar; b.x = xb_xcc_id(); b.st = st;
    if (threadIdx.x == 0) (void)xb_add(&bar[XB_XCNT(b.x)], 1u);
    return b;
}
__device__ __forceinline__ void xcd_barrier_complete(unsigned* bar, unsigned x, unsigned& nloc, unsigned& nx) {
    const unsigned G = gridDim.x * gridDim.y * gridDim.z;
    unsigned sum, cnt, mine, sp = 0u;
    for (;;) {
        sum = 0u; cnt = 0u; mine = 0u;
#pragma unroll
        for (unsigned j = 0; j < 16; ++j) { const unsigned c = xb_ld(&bar[XB_XCNT(j)]); sum += c; cnt += (c > 0u) ? 1u : 0u; mine = (j == x) ? c : mine; }
        if (sum == G) break;
        __builtin_amdgcn_s_sleep(1);
        if ((++sp & 255u) == 0u) { if (xb_ld(&bar[XB_TMO])) break; if (sp > XB_SPIN_CAP) { atomicAdd(&bar[XB_TMO], 1u); break; } }
    }
    nloc = mine > 0u ? mine : 1u; nx = cnt > 0u ? cnt : 1u;
}
__device__ __forceinline__ void xcd_barrier(const XcdBarrier& b) {
    asm volatile("s_waitcnt vmcnt(0)" ::: "memory");
    __syncthreads();
    if (threadIdx.x == 0) {
        unsigned* bar = b.bar;
        __builtin_amdgcn_s_waitcnt(0);
        unsigned nloc = b.st[0], nx = b.st[1];
        if (nloc == 0u) { xcd_barrier_complete(bar, b.x, nloc, nx); b.st[0] = nloc; b.st[1] = nx; }
        const unsigned old = xb_add(&bar[XB_XSUB(b.x)], 1u);
        const unsigned gen = old / nloc;
        if (old + 1u == (gen + 1u) * nloc) {
            __builtin_amdgcn_fence(__ATOMIC_RELEASE, "agent");
            asm volatile("s_waitcnt vmcnt(0)" ::: "memory");
            const unsigned og = xb_add(&bar[XB_TOP], 1u);
            const unsigned tg = og / nx;
            if (og + 1u == (tg + 1u) * nx) xb_add(&bar[XB_TOPGEN], 1u);
            else XB_SPIN(xb_ld(&bar[XB_TOPGEN]) == tg, bar);
            __builtin_amdgcn_fence(__ATOMIC_ACQUIRE, "agent");
            xb_add(&bar[XB_XGEN(b.x)], 1u);
            asm volatile("s_waitcnt vmcnt(0)" ::: "memory");
        } else {
            XB_SPIN(xb_ld(&bar[XB_XGEN(b.x)]) == gen, bar);
            __builtin_amdgcn_fence(__ATOMIC_ACQUIRE, "agent");
            asm volatile("s_waitcnt vmcnt(0)" ::: "memory");
        }
    }
    __syncthreads();
}

struct Frame {
    LAS unsigned char* lds;
    int tid, lane, wave, G, gw, NGW;
    const float* in[26];
    float* out; unsigned char* ws;
};
#define WSP(type, off) ((type*)(F.ws + (off)))

DI void tr_item(const float* W, int ldw, int k0, int nsrc0, int nvalid, bf16* WT, int ldt, int drow0, const float* kscale, LAS float* scr, int lane) {
    const int nn = lane & 31;
#pragma unroll 8
    for (int i = 0; i < 32; ++i) { const int kk = 2 * i + (lane >> 5); float v = 0.f; if (nn < nvalid) v = W[(size_t)(k0 + kk) * ldw + nsrc0 + nn]; if (kscale) v *= kscale[k0 + kk]; scr[kk * 33 + nn] = v; }
    LDS_WAIT(); asm volatile("" ::: "memory");
    const int c = lane & 7;
#pragma unroll
    for (int j = 0; j < 4; ++j) { const int n = (lane >> 3) + 8 * j; const LAS float* s = scr + (8 * c) * 33 + n;
        u32x4 o; o.x = pk2(s[0 * 33], s[1 * 33]); o.y = pk2(s[2 * 33], s[3 * 33]); o.z = pk2(s[4 * 33], s[5 * 33]); o.w = pk2(s[6 * 33], s[7 * 33]);
        if (n < nvalid) *(u32x4*)(WT + (size_t)(drow0 + n) * ldt + k0 + 8 * c) = o; }
    LDS_WAIT(); asm volatile("" ::: "memory");
}
DI void tr_block(const float* W, int ldw, int K, int ncols, int nsrc0, bf16* WT, int ldt, int drow0, const float* kscale, LAS float* scr, int lane, int it) {
    const int nblk = (ncols + 31) / 32, kb = it / nblk, nb = it % nblk; const int nv = ncols - nb * 32 < 32 ? ncols - nb * 32 : 32;
    tr_item(W, ldw, kb * 64, nsrc0 + nb * 32, nv, WT, ldt, drow0 + nb * 32, kscale, scr, lane);
}
DI void tr64_item(const float* W, int ldw, int k0, int nsrc0, bf16* WT, int ldt, int drow0, const float* kscale, int lane) {
    const int n4 = lane & 15, kq = lane >> 4;
    f32x4 r[2][8];
#pragma unroll
    for (int hf = 0; hf < 2; ++hf)
#pragma unroll
        for (int i = 0; i < 8; ++i) r[hf][i] = *(const f32x4*)(W + (size_t)(k0 + hf * 32 + kq * 8 + i) * ldw + nsrc0 + n4 * 4);
#pragma unroll
    for (int hf = 0; hf < 2; ++hf) { const int kb = k0 + hf * 32 + kq * 8;
        if (kscale) { const f32x4 s0 = *(const f32x4*)(kscale + kb), s1 = *(const f32x4*)(kscale + kb + 4);
#pragma unroll
            for (int i = 0; i < 4; ++i) { r[hf][i] = r[hf][i] * s0[i]; r[hf][4 + i] = r[hf][4 + i] * s1[i]; } }
#pragma unroll
        for (int j = 0; j < 4; ++j) { u32x4 o; o.x = pk2(r[hf][0][j], r[hf][1][j]); o.y = pk2(r[hf][2][j], r[hf][3][j]); o.z = pk2(r[hf][4][j], r[hf][5][j]); o.w = pk2(r[hf][6][j], r[hf][7][j]);
            *(u32x4*)(WT + (size_t)(drow0 + n4 * 4 + j) * ldt + kb) = o; } }
}
DI void tr64_block(const float* W, int ldw, int K, int ncols, int nsrc0, bf16* WT, int ldt, int drow0, const float* kscale, int lane, int it) {
    const int nblk = ncols / 64, kb = it / nblk, nb = it % nblk;
    tr64_item(W, ldw, kb * 64, nsrc0 + nb * 64, WT, ldt, drow0 + nb * 64, kscale, lane);
}
DI void rms_row_bf16(const float* xrow, const float* w, bf16* orow, int lane) {
    const f32x4* xr = (const f32x4*)xrow + lane; const f32x4* wr4 = (const f32x4*)w + lane;
    f32x4 v[8]; float s = 0.f;
#pragma unroll
    for (int j = 0; j < 8; ++j) { v[j] = xr[64 * j]; s += (v[j].x * v[j].x + v[j].y * v[j].y) + (v[j].z * v[j].z + v[j].w * v[j].w); }
    const float rstd = 1.0f / sqrtf(wave_sum(s) * (1.0f / 2048.0f) + EPS);
    u32x2* o8 = (u32x2*)orow + lane;
#pragma unroll
    for (int j = 0; j < 8; ++j) { const f32x4 ww = wr4[64 * j]; u32x2 o; o.x = pk2(v[j].x * rstd * ww.x, v[j].y * rstd * ww.y); o.y = pk2(v[j].z * rstd * ww.z, v[j].w * rstd * ww.w); o8[64 * j] = o; }
}
DI void rms_rows(const Frame& F, const float* src, const float* w, bf16* dst, int rows) {
    for (int m = F.gw; m < rows; m += F.NGW) rms_row_bf16(src + (size_t)m * 2048, w, dst + (size_t)m * 2048, F.lane);
}

DI void p0_prologue(const Frame& F) {
    LAS float* scr = (LAS float*)(F.lds + F.wave * 16384);
    const float* w_in = F.in[3];
    bf16* WIN = WSP(bf16, WS_WIN_T);
    constexpr int KB = 32;
    constexpr int I_Z = 24 * KB, I_XBC = 40 * KB, I_QKV = 24 * KB, I_G = 64 * KB;
    constexpr int I_SSD = (1536 / 64) * (2048 / 64), I_SB = (512 / 64) * (2048 / 64), I_MIX = (2048 / 64) * (2048 / 64);
    constexpr int I_XQ = (2048 / 64) * (512 / 64), I_XO = (512 / 64) * (2048 / 64);
    constexpr int NITEMS = I_Z + I_XBC + I_QKV + I_G + I_SSD + I_SB + I_MIX + 3 * I_XQ + I_XO;
    for (int it = F.gw; it < NITEMS; it += F.NGW) {
        int r = it;
        if (r < I_Z)   { tr64_block(w_in, IN_COLS, 2048, 1536, 0,    WIN, 2048, 0,    nullptr, F.lane, r); continue; } r -= I_Z;
        if (r < I_XBC) { tr64_block(w_in, IN_COLS, 2048, 2560, 1536, WIN, 2048, 1536, nullptr, F.lane, r); continue; } r -= I_XBC;
        if (r < I_QKV) { tr64_block(w_in, IN_COLS, 2048, 1536, 4120, WIN, 2048, 4096, nullptr, F.lane, r); continue; } r -= I_QKV;
        if (r < I_G)   { tr64_block(w_in, IN_COLS, 2048, 4096, 5656, WIN, 2048, 5632, nullptr, F.lane, r); continue; } r -= I_G;
        if (r < I_SSD) { tr64_block(F.in[10], 2048, 1536, 2048, 0, WSP(bf16, WS_WCAT_T), 2048, 0, F.in[9], F.lane, r); continue; } r -= I_SSD;
        if (r < I_SB)  { tr64_block(F.in[11], 2048, 512,  2048, 0, WSP(bf16, WS_WCAT_T) + 1536, 2048, 0, nullptr, F.lane, r); continue; } r -= I_SB;
        if (r < I_MIX) { tr64_block(F.in[12], 2048, 2048, 2048, 0, WSP(bf16, WS_WMIX_T), 2048, 0, nullptr, F.lane, r); continue; } r -= I_MIX;
        if (r < I_XQ)  { tr64_block(F.in[15], 512, 2048, 512, 0, WSP(bf16, WS_WQ_T), 2048, 0, F.in[13], F.lane, r); continue; } r -= I_XQ;
        if (r < I_XQ)  { tr64_block(F.in[16], 512, 2048, 512, 0, WSP(bf16, WS_WK_T), 2048, 0, nullptr, F.lane, r); continue; } r -= I_XQ;
        if (r < I_XQ)  { tr64_block(F.in[17], 512, 2048, 512, 0, WSP(bf16, WS_WV_T), 2048, 0, nullptr, F.lane, r); continue; } r -= I_XQ;
        tr64_block(F.in[18], 2048, 512, 2048, 0, WSP(bf16, WS_WO_T), 512, 0, nullptr, F.lane, r);
    }
    constexpr int I_DT = 32, I_RG = 32, I_RE = 32;
    for (int it = F.gw; it < I_DT + I_RG + I_RE; it += F.NGW) {
        int r = it;
        if (r < I_DT)  { tr_block(w_in, IN_COLS, 2048, 24, 4096, WIN, 2048, 9728, nullptr, scr, F.lane, r); continue; } r -= I_DT;
        if (r < I_RG)  { tr_block(F.in[20], 4, 2048, 4, 0, WSP(bf16, WS_WR_T), 2048, 0, F.in[19], scr, F.lane, r); continue; } r -= I_RG;
        tr_block(F.in[21], 32, 2048, 32, 0, WSP(bf16, WS_WR_T), 2048, 4, F.in[19], scr, F.lane, r);
    }
    { const int gt = F.gw * 64 + F.lane, NT = F.NGW * 64;
      u32x4* z1 = (u32x4*)(WIN + (size_t)9752 * 2048); for (int i = gt; i < (IN_PAD - 9752) * 2048 / 8; i += NT) z1[i] = (u32x4){0u, 0u, 0u, 0u};
      u32x4* z2 = (u32x4*)(WSP(bf16, WS_WR_T) + (size_t)36 * 2048); for (int i = gt; i < 12 * 2048 / 8; i += NT) z2[i] = (u32x4){0u, 0u, 0u, 0u}; }
    rms_rows(F, F.in[0], F.in[2], WSP(bf16, WS_RA), T);
    rms_rows(F, F.in[1], F.in[14], WSP(bf16, WS_MEMN), BATCH * MEM);
}
DI void p_expert_weights(const Frame& F) {
    constexpr int PER = 256;
    for (int it = F.gw; it < NEXP * 3 * PER; it += F.NGW) {
        const int e = it / (3 * PER), r = it % (3 * PER), which = r / PER, q = r % PER;
        if (which < 2) { const int kb = q / 8, nb = q % 8, n0 = nb * 64; const float* W = (which == 0 ? F.in[22] : F.in[23]) + (size_t)e * 2048 * 512;
            tr64_item(W, 512, kb * 64, n0, WSP(bf16, WS_WGU_T) + (size_t)e * 1024 * 2048, 2048, (n0 / 128) * 256 + (n0 % 128) + which * 128, F.in[19], F.lane); }
        else { const int kb = q / 32, nb = q % 32; const float* W = F.in[24] + (size_t)e * 512 * 2048;
            tr64_item(W, 2048, kb * 64, nb * 64, WSP(bf16, WS_WD_T) + (size_t)e * 2048 * 512, 512, nb * 64, nullptr, F.lane); }
    }
}

template <int NT>
DI void wave_tile_gemm(const bf16* A, int lda, const bf16* Bt, int ldb, int K, int lane, f32x4 (&acc)[NT]) {
    const int fr = lane & 15, kg = lane >> 4;
#pragma unroll
    for (int n = 0; n < NT; ++n) acc[n] = (f32x4){0.f, 0.f, 0.f, 0.f};
    const bf16* ap = A + (size_t)fr * lda + kg * 8;
    const bf16* bp = Bt + (size_t)fr * ldb + kg * 8;
#pragma unroll 4
    for (int k0 = 0; k0 < K; k0 += 32) {
        const bf16x8 a = *(const bf16x8*)(ap + k0);
#pragma unroll
        for (int n = 0; n < NT; ++n) { const bf16x8 b = *(const bf16x8*)(bp + (size_t)n * 16 * ldb + k0); acc[n] = MFMA16(a, b, acc[n]); }
    }
}

DI void p_kv_mem(const Frame& F) {
    const bf16* MEMN = WSP(bf16, WS_MEMN);
    for (int u = F.gw; u < 512; u += F.NGW) {
        const int which = u >> 8, rt = (u & 255) >> 3, cg = u & 7; f32x4 acc[4];
        const bf16* Aop = which == 0 ? MEMN : WSP(bf16, WS_WV_T); const bf16* Bop = which == 0 ? WSP(bf16, WS_WK_T) : MEMN; bf16* O = which == 0 ? WSP(bf16, WS_KX) : WSP(bf16, WS_VXT);
        wave_tile_gemm<4>(Aop + (size_t)rt * 16 * 2048, 2048, Bop + (size_t)cg * 64 * 2048, 2048, 2048, F.lane, acc);
#pragma unroll
        for (int n = 0; n < 4; ++n)
#pragma unroll
            for (int i = 0; i < 4; ++i) O[(size_t)(rt * 16 + (F.lane >> 4) * 4 + i) * 512 + cg * 64 + n * 16 + (F.lane & 15)] = (bf16)(pk2(acc[n][i], 0.f) & 0xffffu);
    }
}

DI int spos(int s) { return (s & ~31) | (((s >> 2) & 3) << 3) | (((s >> 4) & 1) << 2) | (s & 3); }
template <bool CONV, bool NAT, bool TRN>
DI void conv_slab(const bf16* src, int pitch, int c0, size_t tok0, int s0, bool zero_halo, const float* cw, const float* cb, bf16* nat, bf16* trn, LAS unsigned char* tile, int lane) {
    constexpr int HALO = CONV ? 3 : 0, ROWS = 64 + HALO, TP = 144;
    const int rr = lane >> 3, cq = lane & 7;
#pragma unroll
    for (int i = 0; i < (ROWS + 7) / 8; ++i) { const int ri = 8 * i + rr;
        if (ri < ROWS) { u32x4 v = (u32x4){0u, 0u, 0u, 0u};
            if (!(zero_halo && ri < HALO)) v = *(const u32x4*)(src + (tok0 + s0 - HALO + ri) * (size_t)pitch + c0 + cq * 8);
            *(LAS u32x4*)(tile + ri * TP + cq * 16) = v; } }
    float wk[4][8], bs[8];
    if (CONV) {
#pragma unroll
        for (int k = 0; k < 4; ++k) { const f32x4 a = *(const f32x4*)(cw + k * CONV_DIM + c0 + cq * 8), b = *(const f32x4*)(cw + k * CONV_DIM + c0 + cq * 8 + 4);
            wk[k][0] = a[0]; wk[k][1] = a[1]; wk[k][2] = a[2]; wk[k][3] = a[3]; wk[k][4] = b[0]; wk[k][5] = b[1]; wk[k][6] = b[2]; wk[k][7] = b[3]; }
        const f32x4 a = *(const f32x4*)(cb + c0 + cq * 8), b = *(const f32x4*)(cb + c0 + cq * 8 + 4);
        bs[0] = a[0]; bs[1] = a[1]; bs[2] = a[2]; bs[3] = a[3]; bs[4] = b[0]; bs[5] = b[1]; bs[6] = b[2]; bs[7] = b[3];
    }
    LDS_WAIT();
    u32x4 ov[8];
#pragma unroll
    for (int i = 0; i < 8; ++i) { const int sloc = 8 * i + rr;
        if (CONV) { float o[8];
#pragma unroll
            for (int j = 0; j < 8; ++j) o[j] = bs[j];
#pragma unroll
            for (int k = 0; k < 4; ++k) { float f[8]; pg8::unpack8(*(const LAS u32x4*)(tile + (sloc + k) * TP + cq * 16), f);
#pragma unroll
                for (int j = 0; j < 8; ++j) o[j] += wk[k][j] * f[j]; }
#pragma unroll
            for (int j = 0; j < 8; ++j) o[j] = silu_f(o[j]);
            ov[i] = __builtin_bit_cast(u32x4, pack8(o)); }
        else ov[i] = *(const LAS u32x4*)(tile + sloc * TP + cq * 16);
        if (NAT) *(u32x4*)(nat + (tok0 + s0 + sloc) * 512 + cq * 8) = ov[i]; }
    if (TRN) {
        LDS_WAIT();
#pragma unroll
        for (int i = 0; i < 8; ++i) { const int p = spos(8 * i + rr);
            const unsigned w4[4] = {ov[i].x, ov[i].y, ov[i].z, ov[i].w};
#pragma unroll
            for (int j = 0; j < 8; ++j) *(LAS unsigned short*)(tile + (cq * 8 + j) * TP + p * 2) = (unsigned short)((j & 1) ? (w4[j >> 1] >> 16) : (w4[j >> 1] & 0xffffu)); }
        LDS_WAIT();
#pragma unroll
        for (int m = 0; m < 8; ++m) { const int cl = rr + 8 * m; *(u32x4*)(trn + (size_t)cl * 128 + s0 + cq * 8) = *(const LAS u32x4*)(tile + cl * TP + cq * 16); }
        LDS_WAIT();
    }
}
DI void p_conv(const Frame& F) {
    const bf16* XBC = WSP(bf16, WS_XBC); const bf16* QKV = WSP(bf16, WS_QKV);
    const float* cw = F.in[4]; const float* cb = F.in[5];
    bf16* XT = WSP(bf16, WS_XT); bf16* BT = WSP(bf16, WS_BT); bf16* BN = WSP(bf16, WS_BN); bf16* CN = WSP(bf16, WS_CN); bf16* VT = (bf16*)((unsigned char*)F.out + OUT_VT);
    LAS unsigned char* tile = F.lds + F.wave * 16384;
    for (int bc = blockIdx.x; bc < NCHUNK; bc += F.G) {
        const size_t tok0 = (size_t)bc * 128; const bool first = (bc % (SEQ / 128)) == 0;
#pragma unroll 1
        for (int task = F.wave; task < 96; task += NWAVES) {
            if (task < 80) { const int slab = task >> 1, hf = task & 1, c0 = slab * 64, s0 = hf * 64; const bool zh = first && hf == 0;
                if (slab < 24) conv_slab<true, false, true>(XBC, CONV_DIM, c0, tok0, s0, zh, cw, cb, nullptr, XT + ((size_t)bc * 1536 + c0) * 128, tile, F.lane);
                else if (slab < 32) conv_slab<true, true, true>(XBC, CONV_DIM, c0, tok0, s0, zh, cw, cb, BN + (c0 - 1536), BT + ((size_t)bc * 512 + (c0 - 1536)) * 128, tile, F.lane);
                else conv_slab<true, true, false>(XBC, CONV_DIM, c0, tok0, s0, zh, cw, cb, CN + (c0 - 2048), nullptr, tile, F.lane); }
            else { const int t2 = task - 80, slab = t2 >> 1, hf = t2 & 1, c0 = slab * 64;
                conv_slab<false, false, true>(QKV + 1024, 1536, c0, tok0, hf * 64, false, nullptr, nullptr, nullptr, VT + ((size_t)bc * 512 + c0) * 128, tile, F.lane); }
        }
        const float* DTRAW = WSP(float, WS_DTRAW); float* DTT = WSP(float, WS_DTT); float* ACT = WSP(float, WS_ACT); float* WL = WSP(float, WS_WL);
#pragma unroll 1
        for (int hh = 0; hh < 3; ++hh) { const int h = F.wave + 8 * hh; const float bias = F.in[6][h], a = -expf(F.in[7][h]);
            float dt2[2], c2[2];
#pragma unroll
            for (int j = 0; j < 2; ++j) { const float r = DTRAW[(size_t)(tok0 + 2 * F.lane + j) * 32 + h] + bias; dt2[j] = fmaxf(r, 0.f) + log1pf(expf(-fabsf(r))); }
            c2[0] = dt2[0] * a; c2[1] = c2[0] + dt2[1] * a;
            float sc = c2[1];
#pragma unroll
            for (int o = 1; o < 64; o <<= 1) { const float t = __shfl_up(sc, o); if (F.lane >= o) sc += t; }
            const float ex = sc - c2[1]; const float alast = __shfl(sc, 63);
            const float ac0 = ex + c2[0], ac1 = ex + c2[1];
            *(f32x2*)(DTT + ((size_t)bc * 24 + h) * 128 + 2 * F.lane) = (f32x2){dt2[0], dt2[1]};
            *(f32x2*)(ACT + ((size_t)bc * 24 + h) * 128 + 2 * F.lane) = (f32x2){ac0, ac1};
            *(f32x2*)(WL + ((size_t)bc * 24 + h) * 128 + spos(2 * F.lane)) = (f32x2){dt2[0] * __expf(alast - ac0), dt2[1] * __expf(alast - ac1)};
        }
    }
}

DI void p_ssd_local(const Frame& F) {
    const bf16* XT = WSP(bf16, WS_XT); const bf16* BT = WSP(bf16, WS_BT); const float* WL = WSP(float, WS_WL);
    bf16* STATE = (bf16*)((unsigned char*)F.out + OUT_STATE);
    const int lane = F.lane, fr = lane & 15, kg = lane >> 4;
    for (int u = F.gw; u < NCHUNK * SSD_HEADS; u += F.NGW) {
        const int bc = u / SSD_HEADS, h = u % SSD_HEADS, g = h / 6;
        const float* wlp = WL + ((size_t)bc * 24 + h) * 128 + kg * 8;
        const bf16* xp = XT + ((size_t)bc * 1536 + h * 64 + fr) * 128 + kg * 8;
        const bf16* bp = BT + ((size_t)bc * 512 + g * 128 + fr) * 128 + kg * 8;
        u32x4 xr[4][4]; f32x4 wv[4][2];
#pragma unroll
        for (int k = 0; k < 4; ++k) { wv[k][0] = *(const f32x4*)(wlp + k * 32); wv[k][1] = *(const f32x4*)(wlp + k * 32 + 4);
#pragma unroll
            for (int pt = 0; pt < 4; ++pt) xr[pt][k] = *(const u32x4*)(xp + (size_t)pt * 16 * 128 + k * 32); }
        bf16x8 xs[4][4];
#pragma unroll
        for (int k = 0; k < 4; ++k)
#pragma unroll
            for (int pt = 0; pt < 4; ++pt) { float f[8]; pg8::unpack8(xr[pt][k], f);
#pragma unroll
                for (int j = 0; j < 4; ++j) { f[j] *= wv[k][0][j]; f[4 + j] *= wv[k][1][j]; }
                xs[pt][k] = pack8(f); }
        bf16* st = STATE + ((size_t)bc * 24 + h) * 8192;
#pragma unroll 1
        for (int nh = 0; nh < 2; ++nh) {
            bf16x8 bfr[4][4];
#pragma unroll
            for (int nt = 0; nt < 4; ++nt)
#pragma unroll
                for (int k = 0; k < 4; ++k) bfr[nt][k] = *(const bf16x8*)(bp + (size_t)(nh * 64 + nt * 16) * 128 + k * 32);
            f32x4 acc[4][4];
#pragma unroll
            for (int a = 0; a < 4; ++a)
#pragma unroll
                for (int b = 0; b < 4; ++b) acc[a][b] = (f32x4){0.f, 0.f, 0.f, 0.f};
#pragma unroll
            for (int k = 0; k < 4; ++k)
#pragma unroll
                for (int nt = 0; nt < 4; ++nt)
#pragma unroll
                    for (int pt = 0; pt < 4; ++pt) acc[nt][pt] = MFMA16(bfr[nt][k], xs[pt][k], acc[nt][pt]);
#pragma unroll
            for (int nt = 0; nt < 4; ++nt)
#pragma unroll
                for (int pt = 0; pt < 4; ++pt) { u32x2 w; w.x = pk2(acc[nt][pt][0], acc[nt][pt][1]); w.y = pk2(acc[nt][pt][2], acc[nt][pt][3]);
                    *(u32x2*)(st + (size_t)(pt * 16 + fr) * 128 + nh * 64 + nt * 16 + kg * 4) = w; }
        }
    }
}

DI void p_sb_attn(const Frame& F) {
    const bf16* QKV = WSP(bf16, WS_QKV); const bf16* VT = (const bf16*)((const unsigned char*)F.out + OUT_VT); bf16* YSB = WSP(bf16, WS_RA);
    const int lane = F.lane, fr = lane & 15, kg = lane >> 4;
    const float scale = 0.08838834764831845f;
    for (int u = F.gw; u < BATCH * SB_H * (SEQ / 16); u += F.NGW) {
        const int bh = u / (SEQ / 16), strip = u % (SEQ / 16), b = bh / SB_H, h = bh % SB_H;
        const int q0 = strip * 16, t = q0 + fr; const size_t tb = (size_t)b * SEQ;
        bf16x8 qf[4];
#pragma unroll
        for (int k = 0; k < 4; ++k) qf[k] = *(const bf16x8*)(QKV + (tb + t) * 1536 + h * 128 + k * 32 + kg * 8);
        f32x4 o[8];
#pragma unroll
        for (int d = 0; d < 8; ++d) o[d] = (f32x4){0.f, 0.f, 0.f, 0.f};
        float R = 0.f;
#pragma unroll 1
        for (int kb = q0 >> 5; kb >= 0; --kb) {
            const int sb = kb * 32;
            f32x4 z[2];
#pragma unroll
            for (int st = 0; st < 2; ++st) { z[st] = (f32x4){0.f, 0.f, 0.f, 0.f};
                const bf16* kp = QKV + (tb + sb + st * 16 + fr) * 1536 + 512 + h * 128 + kg * 8;
#pragma unroll
                for (int k = 0; k < 4; ++k) z[st] = MFMA16(*(const bf16x8*)(kp + k * 32), qf[k], z[st]); }
            float lb[2][4], lk[2][4], tot[2];
#pragma unroll
            for (int st = 0; st < 2; ++st) { tot[st] = 0.f;
#pragma unroll
                for (int i = 0; i < 4; ++i) { const int s = sb + st * 16 + kg * 4 + i; const float zz = z[st][i] * scale;
                    const float l = fminf(zz, 0.f) - log1pf(__expf(-fabsf(zz)));
                    lb[st][i] = l; lk[st][i] = (s < t) ? (l - zz) : 0.f; tot[st] += lk[st][i]; } }
            float hi[2], all[2];
#pragma unroll
            for (int st = 0; st < 2; ++st) { const float t1 = __shfl_xor(tot[st], 16), t2 = __shfl_xor(tot[st], 32), t3 = __shfl_xor(tot[st], 48);
                all[st] = tot[st] + t1 + t2 + t3;
                hi[st] = (((kg ^ 1) > kg) ? t1 : 0.f) + (((kg ^ 2) > kg) ? t2 : 0.f) + (((kg ^ 3) > kg) ? t3 : 0.f); }
            float att[8];
#pragma unroll
            for (int st = 0; st < 2; ++st) { const float base = R + hi[st] + (st == 0 ? all[1] : 0.f);
                float suf = 0.f;
#pragma unroll
                for (int i = 3; i >= 0; --i) { const int s = sb + st * 16 + kg * 4 + i; att[st * 4 + i] = (s < t) ? __expf(lb[st][i] + base + suf) : 0.f; suf += lk[st][i]; } }
            R += all[0] + all[1];
            const bf16x8 pf = pack8(att);
            const int bcv = (int)((tb + sb) >> 7), sl = (sb & 127) + kg * 8;
#pragma unroll
            for (int d = 0; d < 8; ++d) { const bf16x8 vf = *(const bf16x8*)(VT + ((size_t)bcv * 512 + h * 128 + d * 16 + fr) * 128 + sl);
                o[d] = MFMA16(vf, pf, o[d]); }
            if (__all(R < -30.0f)) break;
        }
#pragma unroll
        for (int d = 0; d < 8; ++d) { u32x2 w; w.x = pk2(o[d][0], o[d][1]); w.y = pk2(o[d][2], o[d][3]);
            *(u32x2*)(YSB + (tb + t) * 2048 + 1536 + h * 128 + d * 16 + kg * 4) = w; }
    }
}

DI void p_ssd_scan(const Frame& F) {
    bf16* STATE = (bf16*)((unsigned char*)F.out + OUT_STATE); const float* ACT = WSP(float, WS_ACT);
    const int gt = blockIdx.x * 512 + F.tid, NT = F.G * 512;
    for (int e = gt; e < BATCH * SSD_HEADS * 2048; e += NT) {
        const int v4 = e & 2047, bh = e >> 11, b = bh / SSD_HEADS, h = bh % SSD_HEADS;
        f32x4 run = (f32x4){0.f, 0.f, 0.f, 0.f};
        for (int c0 = 0; c0 < 128; c0 += 8) {
            u32x2 tmp[8]; float dec[8];
#pragma unroll
            for (int j = 0; j < 8; ++j) { const size_t bc = (size_t)b * 128 + c0 + j; tmp[j] = *(const u32x2*)(STATE + (bc * 24 + h) * 8192 + v4 * 4); dec[j] = __expf(ACT[(bc * 24 + h) * 128 + 127]); }
#pragma unroll
            for (int j = 0; j < 8; ++j) { const size_t bc = (size_t)b * 128 + c0 + j;
                u32x2 w; w.x = pk2(run[0], run[1]); w.y = pk2(run[2], run[3]); *(u32x2*)(STATE + (bc * 24 + h) * 8192 + v4 * 4) = w;
                const f32x4 t4 = (f32x4){__uint_as_float(tmp[j].x << 16), __uint_as_float(tmp[j].x & 0xffff0000u), __uint_as_float(tmp[j].y << 16), __uint_as_float(tmp[j].y & 0xffff0000u)};
                run = run * dec[j] + t4; }
        }
    }
}

DI int cb_off(int t, int s) { return t * 256 + ((((s >> 2) ^ (2 * (t & 15))) << 3) | ((s & 3) << 1)); }
constexpr int SSQ_OFF = RING_BYTES + 1024, TAB_OFF = RING_BYTES + 5120;
DI void p_ssd_out(const Frame& F) {
    const bf16* XT = WSP(bf16, WS_XT); const bf16* BN = WSP(bf16, WS_BN); const bf16* CN = WSP(bf16, WS_CN); const bf16* Z = WSP(bf16, WS_Z);
    const float* DTT = WSP(float, WS_DTT); const float* ACT = WSP(float, WS_ACT); const bf16* STATE = (const bf16*)((const unsigned char*)F.out + OUT_STATE);
    bf16* YG = WSP(bf16, WS_RA); float* RSTD = WSP(float, WS_RSTD);
    const float* dskip = F.in[8];
    const int lane = F.lane, fr = lane & 15, kg = lane >> 4, w = F.wave, g = w >> 1;
    LAS unsigned char* cbl = F.lds + g * 32768;
    LAS float* tab = (LAS float*)(F.lds + TAB_OFF + w * 1024);
    LAS float* ssqp = (LAS float*)(F.lds + SSQ_OFF);
    for (int bc = blockIdx.x; bc < NCHUNK; bc += F.G) {
        const size_t tok0 = (size_t)bc * 128;
        REP(22)
#pragma unroll 1
        for (int q = 0; q < 4; ++q) { const int tt = (w & 1) + 2 * q;
            bf16x8 cf[4];
#pragma unroll
            for (int k = 0; k < 4; ++k) cf[k] = *(const bf16x8*)(CN + (tok0 + tt * 16 + fr) * 512 + g * 128 + k * 32 + kg * 8);
#pragma unroll 1
            for (int st = 0; st <= tt; ++st) { f32x4 X = (f32x4){0.f, 0.f, 0.f, 0.f}; const bf16* bp = BN + (tok0 + st * 16 + fr) * 512 + g * 128 + kg * 8;
#pragma unroll
                for (int k = 0; k < 4; ++k) X = MFMA16(*(const bf16x8*)(bp + k * 32), cf[k], X);
                u32x2 pw; pw.x = pk2(X[0], X[1]); pw.y = pk2(X[2], X[3]);
                *(LAS u32x2*)(cbl + cb_off(tt * 16 + fr, st * 16 + kg * 4)) = pw; } }
        __syncthreads();
        REP(23) {
        ssqp[w * 128 + lane] = 0.f; ssqp[w * 128 + 64 + lane] = 0.f;
#pragma unroll 1
        for (int r = 0; r < 3; ++r) {
            const int h = 3 * w + r; const float dsk = dskip[h];
            { const f32x2 d2 = *(const f32x2*)(DTT + ((size_t)bc * 24 + h) * 128 + 2 * lane), a2 = *(const f32x2*)(ACT + ((size_t)bc * 24 + h) * 128 + 2 * lane);
              *(LAS f32x2*)(tab + 2 * lane) = d2; *(LAS f32x2*)(tab + 128 + 2 * lane) = a2; }
            bf16x8 sf[4][4], xf0[4], xfA[4];
            const bf16* xbase = XT + ((size_t)bc * 1536 + h * 64) * 128;
            { unsigned so = (unsigned)(fr * 128 + kg * 8); asm volatile("" : "+v"(so));
              const bf16* sp0 = STATE + ((size_t)bc * 24 + h) * 8192;
#pragma unroll
              for (int pt = 0; pt < 4; ++pt) {
#pragma unroll
                  for (int k = 0; k < 4; ++k) sf[pt][k] = *(const bf16x8*)(sp0 + (so + (unsigned)(pt * 2048 + k * 32)));
                  xf0[pt] = *(const bf16x8*)(xbase + (so + (unsigned)(pt * 2048))); } }
            LDS_WAIT();
#define SSD_STEP(SP, XF) do { float mv[8]; \
        _Pragma("unroll") for (int half = 0; half < 2; ++half) { const int sbase = 32 * (SP) + 16 * half + kg * 4; \
            const u32x2 cbv = *(const LAS u32x2*)(cbl + cb_off(tl, sbase)); \
            const f32x4 dv = *(const LAS f32x4*)(tab + sbase), av = *(const LAS f32x4*)(tab + 128 + sbase); \
            const float cbf[4] = {__uint_as_float(cbv.x << 16), __uint_as_float(cbv.x & 0xffff0000u), __uint_as_float(cbv.y << 16), __uint_as_float(cbv.y & 0xffff0000u)}; \
            _Pragma("unroll") for (int i = 0; i < 4; ++i) { const int s_ = sbase + i; float v = 0.f; \
                if (s_ <= tl) v = cbf[i] * dv[i] * __expf(acum_t - av[i]); \
                if (s_ == tl) v += dsk; \
                mv[half * 4 + i] = v; } } \
        const bf16x8 mf = pack8(mv); \
        _Pragma("unroll") for (int pt = 0; pt < 4; ++pt) acc[pt] = MFMA16(XF[pt], mf, acc[pt]); } while (0)
#define SSD_LOADX(XF, SP) do { unsigned xo_ = (unsigned)(fr * 128 + kg * 8 + 32 * (SP)); asm volatile("" : "+v"(xo_)); \
        _Pragma("unroll") for (int pt = 0; pt < 4; ++pt) XF[pt] = *(const bf16x8*)(xbase + (xo_ + (unsigned)(pt * 2048))); } while (0)
#pragma unroll 1
            for (int tt = 0; tt < 8; ++tt) {
                int frx = fr; asm volatile("" : "+v"(frx));
                const int tl = tt * 16 + frx; const size_t tok = tok0 + tl; float ssq = 0.f;
                bf16x8 cf[4]; u32x2 zr[4];
                if (tt >= 2) SSD_LOADX(xfA, 1);
                const float acum_t = tab[128 + tl];
                f32x4 acc[4];
#pragma unroll
                for (int pt = 0; pt < 4; ++pt) acc[pt] = (f32x4){0.f, 0.f, 0.f, 0.f};
                SSD_STEP(0, xf0);
#pragma unroll
                for (int k = 0; k < 4; ++k) cf[k] = *(const bf16x8*)(CN + tok * 512 + g * 128 + k * 32 + kg * 8);
                if (tt >= 2) { SSD_STEP(1, xfA); if (tt >= 4) SSD_LOADX(xfA, 2); }
                if (tt >= 4) { SSD_STEP(2, xfA); if (tt >= 6) SSD_LOADX(xfA, 3); }
                if (tt >= 6) { SSD_STEP(3, xfA); }
#pragma unroll
                for (int pt = 0; pt < 4; ++pt) zr[pt] = *(const u32x2*)(Z + tok * 1536 + h * 64 + pt * 16 + kg * 4);
                { f32x4 ao[4];
#pragma unroll
                  for (int pt = 0; pt < 4; ++pt) ao[pt] = (f32x4){0.f, 0.f, 0.f, 0.f};
#pragma unroll
                  for (int k = 0; k < 4; ++k)
#pragma unroll
                      for (int pt = 0; pt < 4; ++pt) ao[pt] = MFMA16(sf[pt][k], cf[k], ao[pt]);
                  const float e = __expf(acum_t);
#pragma unroll
                  for (int pt = 0; pt < 4; ++pt) acc[pt] = ao[pt] * e + acc[pt]; }
#pragma unroll
                for (int pt = 0; pt < 4; ++pt) { const int col = h * 64 + pt * 16 + kg * 4;
                    const float z0 = __uint_as_float(zr[pt].x << 16), z1 = __uint_as_float(zr[pt].x & 0xffff0000u), z2 = __uint_as_float(zr[pt].y << 16), z3 = __uint_as_float(zr[pt].y & 0xffff0000u);
                    const float y0 = acc[pt][0] * silu_f(z0), y1 = acc[pt][1] * silu_f(z1), y2 = acc[pt][2] * silu_f(z2), y3 = acc[pt][3] * silu_f(z3);
                    ssq += (y0 * y0 + y1 * y1) + (y2 * y2 + y3 * y3);
                    u32x2 wv; wv.x = pk2(y0, y1); wv.y = pk2(y2, y3); *(u32x2*)(YG + tok * 2048 + col) = wv; }
                ssq += __shfl_xor(ssq, 16); ssq += __shfl_xor(ssq, 32);
                if (kg == 0) ssqp[w * 128 + tl] += ssq;
            }
            LDS_WAIT();
        }
        }
#undef SSD_STEP
#undef SSD_LOADX
        __syncthreads();
        if (F.tid < 128) { float v = 0.f;
#pragma unroll
            for (int ww = 0; ww < 8; ++ww) v += ssqp[ww * 128 + F.tid];
            RSTD[tok0 + F.tid] = 1.0f / sqrtf(v * (1.0f / 1536.0f) + EPS); }
        __syncthreads();
    }
}

DI void p_xattn(const Frame& F) {
    const bf16* Q2 = WSP(bf16, WS_Q2); const bf16* KX = WSP(bf16, WS_KX); const bf16* VXT = WSP(bf16, WS_VXT); bf16* O2 = WSP(bf16, WS_O2);
    const int lane = F.lane, fr = lane & 15, kg = lane >> 4;
    const float scale = 0.08838834764831845f;
    for (int u = F.gw; u < BATCH * 4 * (SEQ / 16); u += F.NGW) {
        const int bh = u / (SEQ / 16), strip = u % (SEQ / 16), b = bh >> 2, h = bh & 3;
        const size_t tok = (size_t)b * SEQ + strip * 16 + fr;
        bf16x8 qf[4];
#pragma unroll
        for (int k = 0; k < 4; ++k) qf[k] = *(const bf16x8*)(Q2 + tok * 512 + h * 128 + k * 32 + kg * 8);
        f32x4 sc[16];
#pragma unroll
        for (int mt = 0; mt < 16; ++mt) { sc[mt] = (f32x4){0.f, 0.f, 0.f, 0.f};
            const bf16* kp = KX + ((size_t)b * 256 + mt * 16 + fr) * 512 + h * 128 + kg * 8;
#pragma unroll
            for (int k = 0; k < 4; ++k) sc[mt] = MFMA16(*(const bf16x8*)(kp + k * 32), qf[k], sc[mt]); }
        float mx = -3.0e38f;
#pragma unroll
        for (int mt = 0; mt < 16; ++mt)
#pragma unroll
            for (int i = 0; i < 4; ++i) { sc[mt][i] *= scale; mx = fmaxf(mx, sc[mt][i]); }
        mx = fmaxf(mx, __shfl_xor(mx, 16)); mx = fmaxf(mx, __shfl_xor(mx, 32));
        float sum = 0.f;
#pragma unroll
        for (int mt = 0; mt < 16; ++mt)
#pragma unroll
            for (int i = 0; i < 4; ++i) { const float p = __expf(sc[mt][i] - mx); sc[mt][i] = p; sum += p; }
        sum += __shfl_xor(sum, 16); sum += __shfl_xor(sum, 32);
        const float inv = 1.0f / sum;
        f32x4 o[8];
#pragma unroll
        for (int d = 0; d < 8; ++d) o[d] = (f32x4){0.f, 0.f, 0.f, 0.f};
#pragma unroll
        for (int q = 0; q < 8; ++q) {
            float pv[8];
#pragma unroll
            for (int i = 0; i < 4; ++i) { pv[i] = sc[2 * q][i] * inv; pv[4 + i] = sc[2 * q + 1][i] * inv; }
            const bf16x8 pf = pack8(pv);
#pragma unroll
            for (int d = 0; d < 8; ++d) { const bf16* vp = VXT + ((size_t)h * 128 + d * 16 + fr) * 512 + b * 256 + 32 * q + kg * 4;
                const s16x4 lo = *(const s16x4*)vp, hi4 = *(const s16x4*)(vp + 16);
                o[d] = MFMA16(__builtin_shufflevector(lo, hi4, 0, 1, 2, 3, 4, 5, 6, 7), pf, o[d]); }
        }
#pragma unroll
        for (int d = 0; d < 8; ++d) { u32x2 w; w.x = pk2(o[d][0], o[d][1]); w.y = pk2(o[d][2], o[d][3]);
            *(u32x2*)(O2 + tok * 512 + h * 128 + d * 16 + kg * 4) = w; }
    }
}

DI void p_router(const Frame& F) {
    const bf16* TOKN = WSP(bf16, WS_RA); const bf16* WR = WSP(bf16, WS_WR_T); float* LOG = WSP(float, WS_LOGITS); const float* SSQ2 = WSP(float, WS_SSQ2);
    for (int u = F.gw; u < T / 16; u += F.NGW) {
        f32x4 acc[3];
        wave_tile_gemm<3>(TOKN + (size_t)u * 16 * 2048, 2048, WR, 2048, 2048, F.lane, acc);
#pragma unroll
        for (int n = 0; n < 3; ++n)
#pragma unroll
            for (int i = 0; i < 4; ++i) { const int row = u * 16 + (F.lane >> 4) * 4 + i; LOG[(size_t)row * 48 + n * 16 + (F.lane & 15)] = acc[n][i] * rstd32(SSQ2 + (size_t)row * 32); }
    }
}

DI void p_route_a(const Frame& F) {
    const float* LOG = WSP(float, WS_LOGITS); int* TI = WSP(int, WS_TI); float* TG = WSP(float, WS_TG);
    unsigned* ecnt = WSP(unsigned, WS_CTL) + CW_ECNT;
    LAS unsigned* lcnt = (LAS unsigned*)(F.lds);
    for (int blk = blockIdx.x; blk < T / 512; blk += F.G) {
        if (F.tid < 64) lcnt[F.tid] = 0u;
        __syncthreads();
        const int t = blk * 512 + F.tid; const float* lg = LOG + (size_t)t * 48;
        float gl[4]; *(f32x4*)gl = *(const f32x4*)lg;
        int gs = 0; float gm = gl[0];
#pragma unroll
        for (int j = 1; j < 4; ++j) if (gl[j] > gm) { gm = gl[j]; gs = j; }
        float den = 0.f;
#pragma unroll
        for (int j = 0; j < 4; ++j) den += expf(gl[j] - gm);
        const float ggate = 1.0f / den;
        float el[8]; { const f32x4 a = *(const f32x4*)(lg + 4 + gs * 8), b = *(const f32x4*)(lg + 8 + gs * 8); el[0] = a[0]; el[1] = a[1]; el[2] = a[2]; el[3] = a[3]; el[4] = b[0]; el[5] = b[1]; el[6] = b[2]; el[7] = b[3]; }
        int i1 = 0; float v1 = el[0];
#pragma unroll
        for (int j = 1; j < 8; ++j) if (el[j] > v1) { v1 = el[j]; i1 = j; }
        int i2 = -1; float v2 = -3.0e38f;
#pragma unroll
        for (int j = 0; j < 8; ++j) if (j != i1 && el[j] > v2) { v2 = el[j]; i2 = j; }
        const float e2 = expf(v2 - v1), w1 = 1.0f / (1.0f + e2), w2 = e2 / (1.0f + e2);
        const int ex1 = gs * 8 + i1, ex2 = gs * 8 + i2;
        const unsigned lp1 = atomicAdd((unsigned*)&lcnt[ex1], 1u), lp2 = atomicAdd((unsigned*)&lcnt[ex2], 1u);
        __syncthreads();
        if (F.tid < 32) lcnt[32 + F.tid] = __hip_atomic_fetch_add(ecnt + F.tid, lcnt[F.tid], __ATOMIC_RELAXED, __HIP_MEMORY_SCOPE_AGENT);
        __syncthreads();
        TI[t * 4 + 0] = ex1; TI[t * 4 + 1] = (int)(lcnt[32 + ex1] + lp1); TI[t * 4 + 2] = ex2; TI[t * 4 + 3] = (int)(lcnt[32 + ex2] + lp2);
        TG[t * 2 + 0] = w1 * ggate; TG[t * 2 + 1] = w2 * ggate;
        __syncthreads();
    }
}
DI void p_route_b(const Frame& F) {
    const int* TI = WSP(int, WS_TI); int* TSLOT = WSP(int, WS_TSLOT); int* SLOTTOK = WSP(int, WS_SLOTTOK); int* TILEE = WSP(int, WS_TILEE);
    unsigned* ecnt = WSP(unsigned, WS_CTL) + CW_ECNT; const float* SSQ2 = WSP(float, WS_SSQ2); float* SRSTD = WSP(float, WS_SRSTD);
    LAS int* st = (LAS int*)(F.lds);
    if (F.tid < 32) st[64 + F.tid] = (int)__hip_atomic_load(ecnt + F.tid, __ATOMIC_RELAXED, __HIP_MEMORY_SCOPE_AGENT);
    __syncthreads();
    if (F.tid == 0) { int s = 0; for (int e = 0; e < 32; ++e) { st[e] = s; s += (st[64 + e] + 255) / 256 * 256; } st[32] = s; }
    __syncthreads();
    for (int t = blockIdx.x * 512 + F.tid; t < T; t += F.G * 512) {
        const int e1 = TI[t * 4 + 0], p1 = TI[t * 4 + 1], e2 = TI[t * 4 + 2], p2 = TI[t * 4 + 3];
        const int s1 = st[e1] + p1, s2 = st[e2] + p2;
        SLOTTOK[s1] = t; SLOTTOK[s2] = t; TSLOT[t * 2] = s1; TSLOT[t * 2 + 1] = s2;
        const float rs = rstd32(SSQ2 + (size_t)t * 32); SRSTD[s1] = rs; SRSTD[s2] = rs;
    }
    for (int e = blockIdx.x; e < 32; e += F.G) {
        const int a = st[e] + st[64 + e], bnd = st[e + 1];
        for (int s = a + F.tid; s < bnd; s += 512) { SLOTTOK[s] = 0; SRSTD[s] = 0.f; }
        for (int tl = st[e] / 256 + F.tid; tl < bnd / 256; tl += 512) TILEE[tl] = e;
    }
    if (blockIdx.x == 0 && F.tid == 0) TILEE[511] = st[32] / 256;
    __syncthreads();
}

DI void p_final(const Frame& F) {
    const bf16* Y = WSP(bf16, WS_Y); const int* TSLOT = WSP(int, WS_TSLOT); const float* TG = WSP(float, WS_TG); const float* w = F.in[25];
    for (int m = F.gw; m < T; m += F.NGW) {
        const int s1 = TSLOT[m * 2], s2 = TSLOT[m * 2 + 1]; const float g1 = TG[m * 2], g2 = TG[m * 2 + 1];
        f32x4* xr = (f32x4*)(F.out + (size_t)m * 2048) + F.lane; const u32x2* y1 = (const u32x2*)(Y + (size_t)s1 * 2048) + F.lane; const u32x2* y2 = (const u32x2*)(Y + (size_t)s2 * 2048) + F.lane;
        f32x4 v[8]; float s = 0.f;
#pragma unroll
        for (int j = 0; j < 8; ++j) { v[j] = xr[64 * j]; const u32x2 a = y1[64 * j], b = y2[64 * j];
            v[j].x += g1 * __uint_as_float(a.x << 16) + g2 * __uint_as_float(b.x << 16); v[j].y += g1 * __uint_as_float(a.x & 0xffff0000u) + g2 * __uint_as_float(b.x & 0xffff0000u);
            v[j].z += g1 * __uint_as_float(a.y << 16) + g2 * __uint_as_float(b.y << 16); v[j].w += g1 * __uint_as_float(a.y & 0xffff0000u) + g2 * __uint_as_float(b.y & 0xffff0000u);
            s += (v[j].x * v[j].x + v[j].y * v[j].y) + (v[j].z * v[j].z + v[j].w * v[j].w); }
        const float rstd = 1.0f / sqrtf(wave_sum(s) * (1.0f / 2048.0f) + EPS);
        const f32x4* wr4 = (const f32x4*)w + F.lane;
#pragma unroll
        for (int j = 0; j < 8; ++j) { const f32x4 ww = wr4[64 * j]; xr[64 * j] = v[j] * rstd * ww; }
    }
}

constexpr int NPHASE = 20;
struct Args { const float* in[26]; float* out; unsigned char* ws; int ph_lo, ph_hi; };
__global__ void __launch_bounds__(NWAVES * 64, 2) fwd(Args args) {
    extern __shared__ __attribute__((aligned(16))) unsigned char lds[];
    Frame F;
    F.lds = (LAS unsigned char*)lds;
    F.tid = threadIdx.x; F.lane = F.tid & 63; F.wave = __builtin_amdgcn_readfirstlane(F.tid >> 6);
    F.G = gridDim.x; F.gw = blockIdx.x * NWAVES + F.wave; F.NGW = F.G * NWAVES;
#pragma unroll
    for (int i = 0; i < 26; ++i) F.in[i] = args.in[i];
    F.out = args.out; F.ws = args.ws;
    volatile LAS unsigned* MISC = (volatile LAS unsigned*)(F.lds + MISC_OFF);
    for (int u = F.tid; u < (LDS_BYTES - RING_BYTES) / 4; u += NWAVES * 64) ((LAS unsigned*)(F.lds + RING_BYTES))[u] = 0u;
    __syncthreads();
    const int lo = args.ph_lo, hi = args.ph_hi;
    const bool one = (hi - lo) > 1;
    XcdBarrier bar; bar.bar = WSP(unsigned, WS_CTL) + CW_BAR; bar.x = 0; bar.st = nullptr;
    if (one) bar = xcd_barrier_post(WSP(unsigned, WS_CTL) + CW_BAR, MISC + 8);
#define IN(k) (lo <= (k) && (k) < hi)
#define SEAM(k) do { if (lo <= (k) && (k) + 1 < hi) xcd_barrier(bar); } while (0)
    LAS unsigned char* ring = F.lds;
    const int bx = blockIdx.x;
    const int vcu = (F.G % 8 == 0) ? (bx % 8) * (F.G / 8) + bx / 8 : bx;

    if (IN(0)) REP(0) { p0_prologue(F); SEAM(0); }
    if (IN(1)) REP(1) {
        pg8::Gemm g{WSP(bf16, WS_RA), WSP(bf16, WS_WIN_T), 2048, 2048, 2048, nullptr, nullptr, 0};
        pg8::StaticOrder S; S.init(T, IN_PAD, 2048, F.G, bx);
        pg8::EpiInProj E{WSP(bf16, WS_Z), WSP(bf16, WS_XBC), WSP(bf16, WS_QKV), WSP(bf16, WS_GATES), WSP(float, WS_DTRAW)};
        pg8::gemm_phase<pg8::EpiInProj, pg8::StaticOrder, true, false>(ring, g, S, E);
        p_kv_mem(F);
        SEAM(1);
    }
    if (IN(2)) REP(2) { p_conv(F); SEAM(2); }
    if (IN(3)) REP(3) { REP(20) p_ssd_local(F); REP(21) p_sb_attn(F); SEAM(3); }
    if (IN(4)) REP(4) { p_ssd_scan(F); SEAM(4); }
    if (IN(5)) REP(5) { p_ssd_out(F); SEAM(5); }
    if (IN(6)) REP(6) {
        pg8::Gemm g{WSP(bf16, WS_RA), WSP(bf16, WS_WCAT_T), 2048, 2048, 2048, nullptr, nullptr, 0};
        pg8::SplitOrder S; S.so.init(T, 2048, 2048, F.G, bx); S.nt0 = 1536 / 64; S.nt1 = 512 / 64;
        pg8::EpiMerge E{WSP(bf16, WS_MERGED), WSP(bf16, WS_GATES), WSP(float, WS_RSTD)};
        pg8::gemm_phase<pg8::EpiMerge, pg8::SplitOrder, true, false>(ring, g, S, E);
        SEAM(6);
    }
    if (IN(8)) REP(8) {
        pg8::Gemm g{WSP(bf16, WS_MERGED), WSP(bf16, WS_WMIX_T), 2048, 2048, 2048, nullptr, nullptr, 0};
        pg8::StaticOrder S; S.init(T, 2048, 2048, F.G, bx);
        pg8::EpiResStat E{F.in[0], F.out, WSP(bf16, WS_RA), WSP(float, WS_SSQ1)};
        pg8::gemm_phase<pg8::EpiResStat, pg8::StaticOrder, true, false>(ring, g, S, E);
        SEAM(8);
    }
    if (IN(9)) REP(9) { p_expert_weights(F); SEAM(9); }
    if (IN(10)) REP(10) {
        pg8::Gemm g{WSP(bf16, WS_RA), WSP(bf16, WS_WQ_T), 2048, 2048, 2048, nullptr, nullptr, 0};
        pg8::StaticOrder S; S.init(T, 512, 2048, F.G, bx);
        pg8::EpiBf16Rs E{WSP(bf16, WS_Q2), 512, WSP(float, WS_SSQ1)};
        pg8::gemm_phase<pg8::EpiBf16Rs, pg8::StaticOrder, true, false>(ring, g, S, E);
        SEAM(10);
    }
    if (IN(11)) REP(11) { p_xattn(F); SEAM(11); }
    if (IN(12)) REP(12) {
        pg8::Gemm g{WSP(bf16, WS_O2), WSP(bf16, WS_WO_T), 512, 512, 512, nullptr, nullptr, 0};
        pg8::StaticOrder S; S.init(T, 2048, 512, F.G, bx);
        pg8::EpiResStat E{F.out, F.out, WSP(bf16, WS_RA), WSP(float, WS_SSQ2)};
        pg8::gemm_phase<pg8::EpiResStat, pg8::StaticOrder, true, false>(ring, g, S, E);
        SEAM(12);
    }
    if (IN(14)) REP(14) { p_router(F); SEAM(14); }
    if (IN(15)) REP(15) { p_route_a(F); SEAM(15); }
    if (IN(16)) REP(16) { p_route_b(F); SEAM(16); }
    if (IN(17)) REP(17) {
        const int* TILEE = WSP(int, WS_TILEE);
        pg8::Gemm g{WSP(bf16, WS_RA), WSP(bf16, WS_WGU_T), 2048, 2048, 2048, WSP(int, WS_SLOTTOK), TILEE, (size_t)1024 * 2048};
        pg8::ListOrder S; S.init(TILEE[511], 4, F.G, vcu, 2048 / 64);
        pg8::EpiSwiGLU E{WSP(bf16, WS_HID), WSP(float, WS_SRSTD)};
        pg8::gemm_phase<pg8::EpiSwiGLU, pg8::ListOrder, true, true>(ring, g, S, E);
        SEAM(17);
    }
    if (IN(18)) REP(18) {
        const int* TILEE = WSP(int, WS_TILEE);
        pg8::Gemm g{WSP(bf16, WS_HID), WSP(bf16, WS_WD_T), 512, 512, 512, nullptr, TILEE, (size_t)2048 * 512};
        pg8::ListOrder S; S.init(TILEE[511], 8, F.G, vcu, 512 / 64);
        pg8::EpiBf16 E{WSP(bf16, WS_Y), 2048};
        pg8::gemm_phase<pg8::EpiBf16, pg8::ListOrder, true, false>(ring, g, S, E);
        SEAM(18);
    }
    if (IN(19)) REP(19) { p_final(F); }
#undef IN
#undef SEAM
}

extern "C" void kernel_launch(void* const* d_in, const int* in_sizes, int n_in, void* d_out, int out_size, void* d_ws, size_t ws_size, hipStream_t stream) {
    static int grid = 0;
    if (grid == 0) {
        if (n_in != 26 || out_size != T * D || ws_size < WS_END) { fprintf(stderr, "kernel_launch: unexpected sizes n_in %d out %d ws %zu\n", n_in, out_size, ws_size); grid = -1; return; }
        int dev = 0, cus = 0, per_cu = 0;
        if (hipGetDevice(&dev) != hipSuccess || hipDeviceGetAttribute(&cus, hipDeviceAttributeMultiprocessorCount, dev) != hipSuccess) { grid = -1; return; }
        if (hipFuncSetAttribute((const void*)fwd, hipFuncAttributeMaxDynamicSharedMemorySize, LDS_BYTES) != hipSuccess) { fprintf(stderr, "kernel_launch: hipFuncSetAttribute failed\n"); grid = -1; return; }
        if (hipOccupancyMaxActiveBlocksPerMultiprocessor(&per_cu, (const void*)fwd, NWAVES * 64, LDS_BYTES) != hipSuccess || per_cu < 1) fprintf(stderr, "kernel_launch: occupancy query reports %d\n", per_cu);
        (void)hipGetLastError();
        grid = cus;
    }
    if (grid < 0) return;
    if (hipMemsetAsync((char*)d_ws + WS_CTL, 0, CTL_ZERO_BYTES, stream) != hipSuccess) return;
    Args a{};
    for (int i = 0; i < 26; ++i) a.in[i] = (const float*)d_in[i];
    a.out = (float*)d_out; a.ws = (unsigned char*)d_ws;
    if (MK_N_LAUNCHES == 1) {
        a.ph_lo = 0; a.ph_hi = NPHASE;
        hipLaunchKernelGGL(fwd, dim3(grid), dim3(NWAVES * 64), LDS_BYTES, stream, a);
    } else {
        for (int p = 0; p < NPHASE; ++p) { a.ph_lo = p; a.ph_hi = p + 1; hipLaunchKernelGGL(fwd, dim3(grid), dim3(NWAVES * 64), LDS_BYTES, stream, a); }
    }
}
```

```cpp
#include <hip/hip_runtime.h>
#include <cstdio>
#include <cstdint>

#define DI __device__ __forceinline__
#define LAS __attribute__((address_space(3)))
#define GAS __attribute__((address_space(1)))
typedef unsigned short bf16;
typedef short bf16x8 __attribute__((ext_vector_type(8)));
typedef short s16x4 __attribute__((ext_vector_type(4)));
typedef float f32x4 __attribute__((ext_vector_type(4)));
typedef float f32x2 __attribute__((ext_vector_type(2)));
typedef unsigned u32x4 __attribute__((ext_vector_type(4)));
typedef unsigned u32x2 __attribute__((ext_vector_type(2)));
typedef __bf16 bf16x2_t __attribute__((ext_vector_type(2)));

#ifndef DUP_MASK
#define DUP_MASK 0
#endif
#define REP(k) for (int rep_ = 0; rep_ < 1 + 2 * ((DUP_MASK >> (k)) & 1); ++rep_)
#ifndef MK_N_LAUNCHES
#define MK_N_LAUNCHES 1
#endif

constexpr int D = 2048, BATCH = 2, SEQ = 16384, T = BATCH * SEQ;
constexpr int SSD_INNER = 1536, SSD_HEADS = 24, SSD_P = 64, SSD_N = 128, SSD_G = 4, SSD_L = 128, SSD_BC = 512, CONV_DIM = 2560;
constexpr int NCHUNK = T / SSD_L;
constexpr int SB_W = 512, SB_H = 4, SB_D = 128;
constexpr int IN_COLS = 9752, IN_PAD = 9984;
constexpr int XA_W = 512, MEM = 256;
constexpr int NEXP = 32, EFF = 512;
constexpr int NSLOT = 2 * T + NEXP * 256;
constexpr float EPS = 1e-6f;

constexpr size_t MiB = 1u << 20;
constexpr size_t WS_CTL = 0, CTL_ZERO_BYTES = 1 * MiB;
constexpr size_t WS_WCAT_T = 1 * MiB;
constexpr size_t WS_WMIX_T = 9 * MiB;
constexpr size_t WS_WQ_T = 17 * MiB;
constexpr size_t WS_WK_T = 19 * MiB;
constexpr size_t WS_WV_T = 21 * MiB;
constexpr size_t WS_WO_T = 23 * MiB;
constexpr size_t WS_WR_T = 25 * MiB;
constexpr size_t WS_MEMN = 26 * MiB;
constexpr size_t WS_KX = 28 * MiB;
constexpr size_t WS_VXT = 28 * MiB + 512 * 1024;
constexpr size_t WS_DTRAW = 29 * MiB;
constexpr size_t WS_DTT = 33 * MiB;
constexpr size_t WS_ACT = 36 * MiB;
constexpr size_t WS_RSTD = 39 * MiB;
constexpr size_t WS_SRSTD = 53 * MiB;
constexpr size_t WS_SSQ1 = 54 * MiB, WS_SSQ2 = 58 * MiB;
constexpr size_t WS_WL = 50 * MiB;
constexpr size_t WS_LOGITS = 40 * MiB;
constexpr size_t WS_TI = 48 * MiB;
constexpr size_t WS_TG = 48 * MiB + 512 * 1024;
constexpr size_t WS_TSLOT = 48 * MiB + 768 * 1024;
constexpr size_t WS_SLOTTOK = 49 * MiB;
constexpr size_t WS_TILEE = 49 * MiB + 512 * 1024;
constexpr size_t WS_WIN_T = 64 * MiB;
constexpr size_t WS_BT = 64 * MiB;
constexpr size_t WS_Q2 = 64 * MiB;
constexpr size_t WS_RA = 104 * MiB;
constexpr size_t WS_Z = 232 * MiB;
constexpr size_t WS_HID = 232 * MiB;
constexpr size_t WS_XBC = 328 * MiB;
constexpr size_t WS_MERGED = 328 * MiB;
constexpr size_t WS_QKV = 488 * MiB;
constexpr size_t WS_WGU_T = 488 * MiB;
constexpr size_t WS_GATES = 584 * MiB;
constexpr size_t WS_WD_T = 616 * MiB;
constexpr size_t WS_Y = 680 * MiB;
constexpr size_t WS_BN = 840 * MiB;
constexpr size_t WS_CN = 872 * MiB;
constexpr size_t WS_XT = 904 * MiB;
constexpr size_t WS_O2 = 968 * MiB;
constexpr size_t WS_END = 1000 * MiB;
constexpr size_t OUT_STATE = 0, OUT_VT = 192 * MiB;
constexpr int CW_BAR = 4096;
constexpr int CW_ECNT = 16384;

constexpr int RING_BYTES = 131072;
constexpr int MISC_OFF = RING_BYTES + 320;
constexpr int LDS_BYTES = 147456;
constexpr int NWAVES = 8;

DI float bf2f(bf16 v) { return __uint_as_float(((unsigned)v) << 16); }
DI unsigned pk2(float lo, float hi) { f32x2 v = {lo, hi}; bf16x2_t b = __builtin_convertvector(v, bf16x2_t); return __builtin_bit_cast(unsigned, b); }
DI bf16x8 pack8(const float (&v)[8]) { u32x4 p; p.x = pk2(v[0], v[1]); p.y = pk2(v[2], v[3]); p.z = pk2(v[4], v[5]); p.w = pk2(v[6], v[7]); return __builtin_bit_cast(bf16x8, p); }
DI float wave_sum(float v) {
#pragma unroll
    for (int o = 1; o < 64; o <<= 1) v += __shfl_xor(v, o);
    return v;
}
DI float silu_f(float x) { return x * __builtin_amdgcn_rcpf(1.0f + __expf(-x)); }
DI float sigmoid_f(float x) { return __builtin_amdgcn_rcpf(1.0f + __expf(-x)); }
DI float rstd32(const float* p) { f32x4 a = *(const f32x4*)p;
#pragma unroll
    for (int i = 1; i < 8; ++i) a += *(const f32x4*)(p + 4 * i);
    return 1.0f / sqrtf(((a[0] + a[1]) + (a[2] + a[3])) * (1.0f / 2048.0f) + EPS); }
#define MFMA16(a, b, c) __builtin_amdgcn_mfma_f32_16x16x32_bf16((a), (b), (c), 0, 0, 0)
#define LDS_WAIT() asm volatile("s_waitcnt lgkmcnt(0)" ::: "memory")
#define VM_WAIT() asm volatile("s_waitcnt vmcnt(0)" ::: "memory")

namespace pg8 {
#define PG8_LAS __attribute__((address_space(3)))
constexpr int BM = 256, BK = 64, HALF = 128, HTB = HALF * BK * 2, STAGE_BYTES = 8 * HTB, NXCD = 8, WGM = 8;
__host__ __device__ __forceinline__ int lds_byte(int r, int c) { const int st = (r >> 4) * 2 + (c >> 5), rr = r & 15, cc = c & 31, ob = rr * 64 + cc * 2; return st * 1024 + (ob ^ (((ob >> 9) & 1) << 5)); }
__host__ __device__ __forceinline__ void stage_rc(int b, int& R, int& C) { const int st = b / 1024, sb = b % 1024, swz = sb ^ (((sb >> 9) & 1) << 5); R = (st >> 1) * 16 + swz / 64; C = (st & 1) * 32 + (swz % 64) / 2; }
__host__ __device__ __forceinline__ int perm32(int rho) { const int n = rho >> 4, i = rho & 15; return 8 * (i >> 2) + 4 * n + (i & 3); }

struct Unit { int pm, pn, k0, nt, fin; };
struct Gemm { const bf16* A; const bf16* Bt; int K, lda, ldb; const int* arow; const int* tile_e; size_t b_estride; };

struct StaticOrder {
    int nM, nN, nwg, G, c, nt;
    __device__ void init(int M, int N, int K, int G_, int c_) { nM = M / BM; nN = N / BM; nwg = nM * nN; G = G_; c = c_; nt = K / BK; }
    __device__ bool next(int i, Unit& u) const {
        u.k0 = 0; u.nt = nt; u.fin = 1;
        const long L = (long)i * G + c; if (L >= nwg) return false;
        int wgid = (int)L; { const int q = nwg / NXCD, r = nwg % NXCD, xcd = wgid % NXCD, off = wgid / NXCD; wgid = (xcd < r ? xcd * (q + 1) : r * (q + 1) + (xcd - r) * q) + off; }
        const int nig = WGM * nN, gid = wgid / nig, fm = gid * WGM, gsz = (nM - fm) < WGM ? (nM - fm) : WGM;
        u.pm = fm + ((wgid % nig) % gsz); u.pn = (wgid % nig) / gsz; return true;
    }
};
struct ListOrder {
    int ntile, nN, G, c, nt;
    __device__ void init(int ntile_, int nN_, int G_, int c_, int nt_) { ntile = ntile_; nN = nN_; G = G_; c = c_; nt = nt_; }
    __device__ bool next(int i, Unit& u) const { u.k0 = 0; u.nt = nt; u.fin = 1; const int L = i * G + c; if (L >= ntile * nN) return false; u.pm = L / nN; u.pn = L % nN; return true; }
};
struct SplitOrder {
    StaticOrder so; int nt0, nt1;
    __device__ bool next(int i, Unit& u) const { if (!so.next(i >> 1, u)) return false; if (i & 1) { u.k0 = nt0 * BK; u.nt = nt1; u.fin = 1; } else { u.k0 = 0; u.nt = nt0; u.fin = 0; } return true; }
};

template <class Epi, class Sched, bool ALIGN_EPI, bool GATHER>
__device__ __forceinline__ void gemm_phase(PG8_LAS unsigned char* lds, const Gemm g, const Sched& S, const Epi& E) {
    const int tid = threadIdx.x, wid = __builtin_amdgcn_readfirstlane(tid >> 6), lane = tid & 63, wr = wid >> 2, wc = wid & 3, fr = lane & 15, fq = lane >> 4;
    unsigned voffB[2]; int RA[2], CA[2];
#pragma unroll
    for (int i = 0; i < 2; ++i) { int R, C; stage_rc(tid * 16 + i * 8192, R, C); const int Rb = (R & ~31) + perm32(R & 31);
        RA[i] = R; CA[i] = C; voffB[i] = (unsigned)(Rb * g.ldb + C) * 2u; }
    const size_t kstep = (size_t)(BK * 2);
    const size_t hstepB = (size_t)HALF * g.ldb * 2;
    const size_t tstepB = 2 * hstepB;
    const unsigned ldsw = (unsigned)wid * 1024u;
    const int aoff = lds_byte(wr * 64 + fr, fq * 8), boff = lds_byte(wc * 32 + fr, fq * 8);
    const char* Ab = (const char*)g.A;
#define PG8_SA(b, h) (((b) * 2 + (h)) * HTB)
#define PG8_SB(b, h) ((4 + (b) * 2 + (h)) * HTB)
#define PG8_STAGE(bufoff, gbase, voff) do { _Pragma("unroll") for (int _i = 0; _i < 2; ++_i) \
        __builtin_amdgcn_global_load_lds((const unsigned*)((const char*)(gbase) + (voff)[_i]), (PG8_LAS unsigned*)(lds + (bufoff) + ldsw + _i * 8192), 16, 0, 0); } while (0)
#define PG8_STAGEA(bufoff, kb, o0, o1) do { \
        __builtin_amdgcn_global_load_lds((const unsigned*)(Ab + (kb) + (o0)), (PG8_LAS unsigned*)(lds + (bufoff) + ldsw), 16, 0, 0); \
        __builtin_amdgcn_global_load_lds((const unsigned*)(Ab + (kb) + (o1)), (PG8_LAS unsigned*)(lds + (bufoff) + ldsw + 8192), 16, 0, 0); } while (0)
#define PG8_LDA(dst, b, h) do { _Pragma("unroll") for (int m = 0; m < 4; ++m) _Pragma("unroll") for (int k = 0; k < 2; ++k) dst[m][k] = *(const PG8_LAS bf16x8*)(lds + PG8_SA(b, h) + aoff + m * 2048 + k * 1024); } while (0)
#define PG8_LDB(dst, b, h) do { _Pragma("unroll") for (int n = 0; n < 2; ++n) _Pragma("unroll") for (int k = 0; k < 2; ++k) dst[n][k] = *(const PG8_LAS bf16x8*)(lds + PG8_SB(b, h) + boff + n * 2048 + k * 1024); } while (0)
#define PG8_MMA(ai, bj, At, Bt) do { __builtin_amdgcn_s_setprio(1); _Pragma("unroll") for (int m = 0; m < 4; ++m) _Pragma("unroll") for (int n = 0; n < 2; ++n) _Pragma("unroll") for (int k = 0; k < 2; ++k) \
        acc[ai][bj][m][n] = __builtin_amdgcn_mfma_f32_16x16x32_bf16(Bt[n][k], At[m][k], acc[ai][bj][m][n], 0, 0, 0); __builtin_amdgcn_s_setprio(0); } while (0)
#define PG8_WAIT_V(n) asm volatile("s_waitcnt vmcnt(" #n ")" ::: "memory")
#define PG8_WAIT_L(n) asm volatile("s_waitcnt lgkmcnt(" #n ")" ::: "memory")
#define PG8_BAR __builtin_amdgcn_s_barrier()
#define PG8_SCHED __builtin_amdgcn_sched_barrier(0)
#define PG8_SETA(o, u) do { _Pragma("unroll") for (int _h = 0; _h < 2; ++_h) _Pragma("unroll") for (int _i = 0; _i < 2; ++_i) { \
        int _row = (u).pm * BM + _h * HALF + RA[_i]; if (GATHER) _row = g.arow[_row]; (o)[_h][_i] = (unsigned)(_row * g.lda + CA[_i] + (u).k0) * 2u; } } while (0)
    Unit cur, nxt; int ui = 0;
    if (!S.next(0, cur)) return;
    f32x4 acc[2][2][4][2];
#pragma unroll
    for (int a = 0; a < 2; ++a)
#pragma unroll
        for (int b = 0; b < 2; ++b)
#pragma unroll
            for (int m = 0; m < 4; ++m)
#pragma unroll
                for (int n = 0; n < 2; ++n) acc[a][b][m][n] = (f32x4){0.f, 0.f, 0.f, 0.f};
    bf16x8 At[4][2], B0[2][2], B1[2][2];
    unsigned oc[2][2], on[2][2];
    PG8_SETA(oc, cur);
    const char* cB = (const char*)g.Bt + (g.tile_e ? (size_t)g.tile_e[cur.pm] * g.b_estride * 2 : (size_t)0) + (size_t)cur.pn * tstepB + (size_t)cur.k0 * 2;
    PG8_STAGE(PG8_SB(0, 0), cB, voffB); PG8_STAGE(PG8_SB(0, 1), cB + hstepB, voffB); PG8_STAGEA(PG8_SA(0, 0), 0, oc[0][0], oc[0][1]); PG8_STAGEA(PG8_SA(0, 1), 0, oc[1][0], oc[1][1]);
    if (wr == 1) PG8_BAR;
    PG8_WAIT_V(2); PG8_BAR;
    PG8_STAGE(PG8_SB(1, 0), cB + kstep, voffB); PG8_STAGEA(PG8_SA(1, 0), kstep, oc[0][0], oc[0][1]); PG8_STAGE(PG8_SB(1, 1), cB + hstepB + kstep, voffB);
    PG8_WAIT_V(6); PG8_BAR;
    for (;;) {
        const bool has_next = S.next(ui + 1, nxt);
        const char* nB = cB;
        if (has_next) { nB = (const char*)g.Bt + (g.tile_e ? (size_t)g.tile_e[nxt.pm] * g.b_estride * 2 : (size_t)0) + (size_t)nxt.pn * tstepB + (size_t)nxt.k0 * 2; }
        const int nt = cur.nt;
#pragma unroll
        for (int _h = 0; _h < 2; ++_h)
#pragma unroll
            for (int _i = 0; _i < 2; ++_i) on[_h][_i] = oc[_h][_i];
        for (int t = 0; t < nt; t += 2) {
            const bool last = (t == nt - 2);
            if (last && has_next) { PG8_SETA(on, nxt); }
            const size_t k1 = (size_t)(t + 1) * kstep;
            const size_t k2 = last ? (size_t)0 : (size_t)(t + 2) * kstep, k3 = k2 + kstep;
            const char* b2 = last ? nB : cB + (size_t)(t + 2) * kstep; const char* b3 = b2 + kstep;
            const unsigned s00 = last ? on[0][0] : oc[0][0], s01 = last ? on[0][1] : oc[0][1], s10 = last ? on[1][0] : oc[1][0], s11 = last ? on[1][1] : oc[1][1];
            PG8_LDB(B0, 0, 0); PG8_LDB(B1, 0, 1); PG8_SCHED; PG8_LDA(At, 0, 0); PG8_STAGEA(PG8_SA(1, 1), k1, oc[1][0], oc[1][1]);
            PG8_WAIT_V(8); PG8_WAIT_L(0); PG8_BAR; PG8_MMA(0, 0, At, B0); PG8_MMA(0, 1, At, B1); PG8_BAR; PG8_SCHED;
            PG8_LDA(At, 0, 1); PG8_STAGE(PG8_SB(0, 0), b2, voffB); PG8_STAGE(PG8_SB(0, 1), b2 + hstepB, voffB); PG8_STAGEA(PG8_SA(0, 0), k2, s00, s01);
            PG8_WAIT_V(8); PG8_WAIT_L(0); PG8_BAR; PG8_MMA(1, 0, At, B0); PG8_MMA(1, 1, At, B1); PG8_BAR; PG8_SCHED;
            PG8_LDB(B0, 1, 0); PG8_LDB(B1, 1, 1); PG8_SCHED; PG8_LDA(At, 1, 0); PG8_STAGEA(PG8_SA(0, 1), k2, s10, s11);
            PG8_WAIT_V(8); PG8_WAIT_L(0); PG8_BAR; PG8_MMA(0, 0, At, B0); PG8_MMA(0, 1, At, B1); PG8_BAR; PG8_SCHED;
            PG8_LDA(At, 1, 1); PG8_STAGE(PG8_SB(1, 0), b3, voffB); PG8_STAGE(PG8_SB(1, 1), b3 + hstepB, voffB); PG8_STAGEA(PG8_SA(1, 0), k3, s00, s01);
            PG8_WAIT_V(8); PG8_WAIT_L(0); PG8_BAR; PG8_MMA(1, 0, At, B0); PG8_MMA(1, 1, At, B1); PG8_BAR; PG8_SCHED;
        }
        if constexpr (ALIGN_EPI) { if (wr == 0) PG8_BAR; }
        E(acc, cur, wr, wc, fr, fq);
        if (!has_next) break;
        if (cur.fin) {
#pragma unroll
        for (int a = 0; a < 2; ++a)
#pragma unroll
            for (int b = 0; b < 2; ++b)
#pragma unroll
                for (int m = 0; m < 4; ++m)
#pragma unroll
                    for (int n = 0; n < 2; ++n) acc[a][b][m][n] = (f32x4){0.f, 0.f, 0.f, 0.f};
        }
        cur = nxt; cB = nB; ++ui;
#pragma unroll
        for (int _h = 0; _h < 2; ++_h)
#pragma unroll
            for (int _i = 0; _i < 2; ++_i) oc[_h][_i] = on[_h][_i];
        if constexpr (ALIGN_EPI) { if (wr == 1) PG8_BAR; }
    }
    PG8_WAIT_V(0);
    if constexpr (!ALIGN_EPI) { if (wr == 0) PG8_BAR; }
    PG8_BAR;
#undef PG8_SA
#undef PG8_SB
#undef PG8_STAGE
#undef PG8_STAGEA
#undef PG8_LDA
#undef PG8_LDB
#undef PG8_MMA
#undef PG8_WAIT_V
#undef PG8_WAIT_L
#undef PG8_BAR
#undef PG8_SCHED
#undef PG8_SETA
}

#define EPI_ROWS(...) _Pragma("unroll") for (int ai = 0; ai < 2; ++ai) _Pragma("unroll") for (int m = 0; m < 4; ++m) { const int row = u.pm * BM + ai * HALF + wr * 64 + m * 16 + fr; \
        _Pragma("unroll") for (int bj = 0; bj < 2; ++bj) { const int col = u.pn * BM + bj * HALF + wc * 32 + 8 * fq; const f32x4 v0 = acc[ai][bj][m][0], v1 = acc[ai][bj][m][1]; __VA_ARGS__ } }
DI u32x4 pack8v(f32x4 v0, f32x4 v1) { u32x4 w; w.x = pk2(v0[0], v0[1]); w.y = pk2(v0[2], v0[3]); w.z = pk2(v1[0], v1[1]); w.w = pk2(v1[2], v1[3]); return w; }
DI void unpack8(u32x4 w, float (&f)[8]) { f[0] = __uint_as_float(w.x << 16); f[1] = __uint_as_float(w.x & 0xffff0000u); f[2] = __uint_as_float(w.y << 16); f[3] = __uint_as_float(w.y & 0xffff0000u);
    f[4] = __uint_as_float(w.z << 16); f[5] = __uint_as_float(w.z & 0xffff0000u); f[6] = __uint_as_float(w.w << 16); f[7] = __uint_as_float(w.w & 0xffff0000u); }

struct EpiBf16 {
    bf16* O; int ldc;
    DI void operator()(const f32x4 (&acc)[2][2][4][2], const Unit& u, int wr, int wc, int fr, int fq) const {
        EPI_ROWS({ *(u32x4*)(O + (size_t)row * ldc + col) = pack8v(v0, v1); })
    }
};
struct EpiInProj {
    bf16 *Z, *XBC, *QKV, *GATES; float* DTRAW;
    DI void operator()(const f32x4 (&acc)[2][2][4][2], const Unit& u, int wr, int wc, int fr, int fq) const {
        const int pn = u.pn;
        if (pn < 6) { EPI_ROWS({ *(u32x4*)(Z + (size_t)row * 1536 + col) = pack8v(v0, v1); }) }
        else if (pn < 16) { EPI_ROWS({ *(u32x4*)(XBC + (size_t)row * 2560 + (col - 1536)) = pack8v(v0, v1); }) }
        else if (pn < 22) { EPI_ROWS({ *(u32x4*)(QKV + (size_t)row * 1536 + (col - 4096)) = pack8v(v0, v1); }) }
        else if (pn < 38) { EPI_ROWS({ f32x4 a, b;
_Pragma("unroll")
                for (int j = 0; j < 4; ++j) { a[j] = sigmoid_f(v0[j]); b[j] = sigmoid_f(v1[j]); }
                *(u32x4*)(GATES + (size_t)row * 4096 + (col - 5632)) = pack8v(a, b); }) }
        else { EPI_ROWS({ const int c = col - 9728; if (c < 32) { *(f32x4*)(DTRAW + (size_t)row * 32 + c) = v0; *(f32x4*)(DTRAW + (size_t)row * 32 + c + 4) = v1; } }) }
    }
};
struct EpiMerge {
    bf16* MERGED; const bf16* GATES; const float* RSTD;
    DI void operator()(f32x4 (&acc)[2][2][4][2], const Unit& u, int wr, int wc, int fr, int fq) const { if (u.fin) fin(acc, u, wr, wc, fr, fq); else mid(acc, u, wr, wc, fr, fq); }
    DI void mid(f32x4 (&acc)[2][2][4][2], const Unit& u, int wr, int wc, int fr, int fq) const {
#pragma unroll
        for (int ai = 0; ai < 2; ++ai)
#pragma unroll
            for (int m = 0; m < 4; ++m) { const int row = u.pm * BM + ai * HALF + wr * 64 + m * 16 + fr; const float rs = RSTD[row];
#pragma unroll
                for (int bj = 0; bj < 2; ++bj) { const int col = u.pn * BM + bj * HALF + wc * 32 + 8 * fq; float g1[8], g2[8];
                    unpack8(*(const u32x4*)(GATES + (size_t)row * 4096 + col), g1); unpack8(*(const u32x4*)(GATES + (size_t)row * 4096 + 2048 + col), g2);
#pragma unroll
                    for (int j = 0; j < 4; ++j) { acc[ai][bj][m][0][j] *= rs * g1[j] / fmaxf(g2[j], 1e-30f); acc[ai][bj][m][1][j] *= rs * g1[4 + j] / fmaxf(g2[4 + j], 1e-30f); } }
                asm volatile("" ::: "memory"); }
    }
    DI void fin(const f32x4 (&acc)[2][2][4][2], const Unit& u, int wr, int wc, int fr, int fq) const {
        EPI_ROWS({ float g2[8]; unpack8(*(const u32x4*)(GATES + (size_t)row * 4096 + 2048 + col), g2);
            f32x4 a, b;
_Pragma("unroll")
            for (int j = 0; j < 4; ++j) { a[j] = v0[j] * g2[j]; b[j] = v1[j] * g2[4 + j]; }
            *(u32x4*)(MERGED + (size_t)row * 2048 + col) = pack8v(a, b); })
    }
};
struct EpiResF32 {
    const float* base; float* out;
    DI void operator()(const f32x4 (&acc)[2][2][4][2], const Unit& u, int wr, int wc, int fr, int fq) const {
        EPI_ROWS({ const size_t o = (size_t)row * 2048 + col; const f32x4 b0 = *(const f32x4*)(base + o), b1 = *(const f32x4*)(base + o + 4);
            *(f32x4*)(out + o) = b0 + v0; *(f32x4*)(out + o + 4) = b1 + v1; })
    }
};
struct EpiResStat {
    const float* base; float* out; bf16* hb; float* ssq;
    DI void operator()(const f32x4 (&acc)[2][2][4][2], const Unit& u, int wr, int wc, int fr, int fq) const {
#pragma unroll
        for (int ai = 0; ai < 2; ++ai)
#pragma unroll
            for (int m = 0; m < 4; ++m) { const int row = u.pm * BM + ai * HALF + wr * 64 + m * 16 + fr; float sq = 0.f;
#pragma unroll
                for (int bj = 0; bj < 2; ++bj) { const int col = u.pn * BM + bj * HALF + wc * 32 + 8 * fq; const size_t o = (size_t)row * 2048 + col;
                    const f32x4 r0 = *(const f32x4*)(base + o) + acc[ai][bj][m][0], r1 = *(const f32x4*)(base + o + 4) + acc[ai][bj][m][1];
                    *(f32x4*)(out + o) = r0; *(f32x4*)(out + o + 4) = r1; *(u32x4*)(hb + o) = pack8v(r0, r1);
                    sq += (r0[0] * r0[0] + r0[1] * r0[1]) + (r0[2] * r0[2] + r0[3] * r0[3]) + (r1[0] * r1[0] + r1[1] * r1[1]) + (r1[2] * r1[2] + r1[3] * r1[3]); }
                sq += __shfl_xor(sq, 16); sq += __shfl_xor(sq, 32);
                if (fq == 0) ssq[(size_t)row * 32 + u.pn * 4 + wc] = sq; }
    }
};
struct EpiBf16Rs {
    bf16* O; int ldc; const float* ssq;
    DI void operator()(const f32x4 (&acc)[2][2][4][2], const Unit& u, int wr, int wc, int fr, int fq) const {
_Pragma("unroll") for (int ai = 0; ai < 2; ++ai) _Pragma("unroll") for (int m = 0; m < 4; ++m) { const int row = u.pm * BM + ai * HALF + wr * 64 + m * 16 + fr; const float rs = rstd32(ssq + (size_t)row * 32);
            _Pragma("unroll") for (int bj = 0; bj < 2; ++bj) { const int col = u.pn * BM + bj * HALF + wc * 32 + 8 * fq; *(u32x4*)(O + (size_t)row * ldc + col) = pack8v(acc[ai][bj][m][0] * rs, acc[ai][bj][m][1] * rs); } }
    }
};
struct EpiSwiGLU {
    bf16* HID; const float* srstd;
    DI void operator()(const f32x4 (&acc)[2][2][4][2], const Unit& u, int wr, int wc, int fr, int fq) const {
#pragma unroll
        for (int ai = 0; ai < 2; ++ai)
#pragma unroll
            for (int m = 0; m < 4; ++m) { const int row = u.pm * BM + ai * HALF + wr * 64 + m * 16 + fr; const int col = u.pn * 128 + wc * 32 + 8 * fq; const float rs = srstd[row];
                f32x4 a, b;
#pragma unroll
                for (int j = 0; j < 4; ++j) { a[j] = silu_f(acc[ai][0][m][0][j] * rs) * (acc[ai][1][m][0][j] * rs); b[j] = silu_f(acc[ai][0][m][1][j] * rs) * (acc[ai][1][m][1][j] * rs); }
                *(u32x4*)(HID + (size_t)row * EFF + col) = pack8v(a, b); }
    }
};
}

#define XB_TMO      128
#define XB_XCNT(j)  (256  + 64 * (j))
#define XB_XSUB(j)  (1280 + 64 * (j))
#define XB_XGEN(j)  (2304 + 64 * (j))
#define XB_TOP      3328
#define XB_TOPGEN   3392
#define XCD_BAR_WORDS 3456
#define XB_SPIN_CAP (1u << 18)
__device__ __forceinline__ unsigned xb_ld(unsigned* p)              { return __hip_atomic_load(p, __ATOMIC_RELAXED, __HIP_MEMORY_SCOPE_AGENT); }
__device__ __forceinline__ unsigned xb_add(unsigned* p, unsigned v) { return __hip_atomic_fetch_add(p, v, __ATOMIC_RELAXED, __HIP_MEMORY_SCOPE_AGENT); }
__device__ __forceinline__ unsigned xb_xcc_id() { return (unsigned)__builtin_amdgcn_s_getreg((3 << 11) | 20) & 0xFu; }
#define XB_SPIN(cond, bar) do { unsigned _sp = 0; while (cond) { __builtin_amdgcn_s_sleep(1); \
    if ((++_sp & 255u) == 0u) { if (xb_ld(&(bar)[XB_TMO])) break; if (_sp > XB_SPIN_CAP) { atomicAdd(&(bar)[XB_TMO], 1u); break; } } } } while (0)
struct XcdBarrier { unsigned* bar; unsigned x; volatile LAS unsigned* st; };
__device__ __forceinline__ XcdBarrier xcd_barrier_post(unsigned* bar, volatile LAS unsigned* st) {
    XcdBarrier b; b.bar = bar; b.x = xb_xcc_id(); b.st = st;
    if (threadIdx.x == 0) (void)xb_add(&bar[XB_XCNT(b.x)], 1u);
    return b;
}
__device__ __forceinline__ void xcd_barrier_complete(unsigned* bar, unsigned x, unsigned& nloc, unsigned& nx) {
    const unsigned G = gridDim.x * gridDim.y * gridDim.z;
    unsigned sum, cnt, mine, sp = 0u;
    for (;;) {
        sum = 0u; cnt = 0u; mine = 0u;
#pragma unroll
        for (unsigned j = 0; j < 16; ++j) { const unsigned c = xb_ld(&bar[XB_XCNT(j)]); sum += c; cnt += (c > 0u) ? 1u : 0u; mine = (j == x) ? c : mine; }
        if (sum == G) break;
        __builtin_amdgcn_s_sleep(1);
        if ((++sp & 255u) == 0u) { if (xb_ld(&bar[XB_TMO])) break; if (sp > XB_SPIN_CAP) { atomicAdd(&bar[XB_TMO], 1u); break; } }
    }
    nloc = mine > 0u ? mine : 1u; nx = cnt > 0u ? cnt : 1u;
}
__device__ __forceinline__ void xcd_barrier(const XcdBarrier& b) {
    asm volatile("s_waitcnt vmcnt(0)" ::: "memory");
    __syncthreads();
    if (threadIdx.x == 0) {
        unsigned* bar = b.bar;
        __builtin_amdgcn_s_waitcnt(0);
        unsigned nloc = b.st[0], nx = b.st[1];
        if (nloc == 0u) { xcd_barrier_complete(bar, b.x, nloc, nx); b.st[0] = nloc; b.st[1] = nx; }
        const unsigned old = xb_add(&bar[XB_XSUB(b.x)], 1u);
        const unsigned gen = old / nloc;
        if (old + 1u == (gen + 1u) * nloc) {
            __builtin_amdgcn_fence(__ATOMIC_RELEASE, "agent");
            asm volatile("s_waitcnt vmcnt(0)" ::: "memory");
            const unsigned og = xb_add(&bar[XB_TOP], 1u);
            const unsigned tg = og / nx;
            if (og + 1u == (tg + 1u) * nx) xb_add(&bar[XB_TOPGEN], 1u);
            else XB_SPIN(xb_ld(&bar[XB_TOPGEN]) == tg, bar);
            __builtin_amdgcn_fence(__ATOMIC_ACQUIRE, "agent");
            xb_add(&bar[XB_XGEN(b.x)], 1u);
            asm volatile("s_waitcnt vmcnt(0)" ::: "memory");
        } else {
            XB_SPIN(xb_ld(&bar[XB_XGEN(b.x)]) == gen, bar);
            __builtin_amdgcn_fence(__ATOMIC_ACQUIRE, "agent");
            asm volatile("s_waitcnt vmcnt(0)" ::: "memory");
        }
    }
    __syncthreads();
}

struct Frame {
    LAS unsigned char* lds;
    int tid, lane, wave, G, gw, NGW;
    const float* in[26];
    float* out; unsigned char* ws;
};
#define WSP(type, off) ((type*)(F.ws + (off)))

DI void tr_item(const float* W, int ldw, int k0, int nsrc0, int nvalid, bf16* WT, int ldt, int drow0, const float* kscale, LAS float* scr, int lane) {
    const int nn = lane & 31;
#pragma unroll 8
    for (int i = 0; i < 32; ++i) { const int kk = 2 * i + (lane >> 5); float v = 0.f; if (nn < nvalid) v = W[(size_t)(k0 + kk) * ldw + nsrc0 + nn]; if (kscale) v *= kscale[k0 + kk]; scr[kk * 33 + nn] = v; }
    LDS_WAIT(); asm volatile("" ::: "memory");
    const int c = lane & 7;
#pragma unroll
    for (int j = 0; j < 4; ++j) { const int n = (lane >> 3) + 8 * j; const LAS float* s = scr + (8 * c) * 33 + n;
        u32x4 o; o.x = pk2(s[0 * 33], s[1 * 33]); o.y = pk2(s[2 * 33], s[3 * 33]); o.z = pk2(s[4 * 33], s[5 * 33]); o.w = pk2(s[6 * 33], s[7 * 33]);
        if (n < nvalid) *(u32x4*)(WT + (size_t)(drow0 + n) * ldt + k0 + 8 * c) = o; }
    LDS_WAIT(); asm volatile("" ::: "memory");
}
DI void tr_block(const float* W, int ldw, int K, int ncols, int nsrc0, bf16* WT, int ldt, int drow0, const float* kscale, LAS float* scr, int lane, int it) {
    const int nblk = (ncols + 31) / 32, kb = it / nblk, nb = it % nblk; const int nv = ncols - nb * 32 < 32 ? ncols - nb * 32 : 32;
    tr_item(W, ldw, kb * 64, nsrc0 + nb * 32, nv, WT, ldt, drow0 + nb * 32, kscale, scr, lane);
}
DI void tr64_item(const float* W, int ldw, int k0, int nsrc0, bf16* WT, int ldt, int drow0, const float* kscale, int lane) {
    const int n4 = lane & 15, kq = lane >> 4;
    f32x4 r[2][8];
#pragma unroll
    for (int hf = 0; hf < 2; ++hf)
#pragma unroll
        for (int i = 0; i < 8; ++i) r[hf][i] = *(const f32x4*)(W + (size_t)(k0 + hf * 32 + kq * 8 + i) * ldw + nsrc0 + n4 * 4);
#pragma unroll
    for (int hf = 0; hf < 2; ++hf) { const int kb = k0 + hf * 32 + kq * 8;
        if (kscale) { const f32x4 s0 = *(const f32x4*)(kscale + kb), s1 = *(const f32x4*)(kscale + kb + 4);
#pragma unroll
            for (int i = 0; i < 4; ++i) { r[hf][i] = r[hf][i] * s0[i]; r[hf][4 + i] = r[hf][4 + i] * s1[i]; } }
#pragma unroll
        for (int j = 0; j < 4; ++j) { u32x4 o; o.x = pk2(r[hf][0][j], r[hf][1][j]); o.y = pk2(r[hf][2][j], r[hf][3][j]); o.z = pk2(r[hf][4][j], r[hf][5][j]); o.w = pk2(r[hf][6][j], r[hf][7][j]);
            *(u32x4*)(WT + (size_t)(drow0 + n4 * 4 + j) * ldt + kb) = o; } }
}
DI void tr64_block(const float* W, int ldw, int K, int ncols, int nsrc0, bf16* WT, int ldt, int drow0, const float* kscale, int lane, int it) {
    const int nblk = ncols / 64, kb = it / nblk, nb = it % nblk;
    tr64_item(W, ldw, kb * 64, nsrc0 + nb * 64, WT, ldt, drow0 + nb * 64, kscale, lane);
}
DI void rms_row_bf16(const float* xrow, const float* w, bf16* orow, int lane) {
    const f32x4* xr = (const f32x4*)xrow + lane; const f32x4* wr4 = (const f32x4*)w + lane;
    f32x4 v[8]; float s = 0.f;
#pragma unroll
    for (int j = 0; j < 8; ++j) { v[j] = xr[64 * j]; s += (v[j].x * v[j].x + v[j].y * v[j].y) + (v[j].z * v[j].z + v[j].w * v[j].w); }
    const float rstd = 1.0f / sqrtf(wave_sum(s) * (1.0f / 2048.0f) + EPS);
    u32x2* o8 = (u32x2*)orow + lane;
#pragma unroll
    for (int j = 0; j < 8; ++j) { const f32x4 ww = wr4[64 * j]; u32x2 o; o.x = pk2(v[j].x * rstd * ww.x, v[j].y * rstd * ww.y); o.y = pk2(v[j].z * rstd * ww.z, v[j].w * rstd * ww.w); o8[64 * j] = o; }
}
DI void rms_rows(const Frame& F, const float* src, const float* w, bf16* dst, int rows) {
    for (int m = F.gw; m < rows; m += F.NGW) rms_row_bf16(src + (size_t)m * 2048, w, dst + (size_t)m * 2048, F.lane);
}

DI void p0_prologue(const Frame& F) {
    LAS float* scr = (LAS float*)(F.lds + F.wave * 16384);
    const float* w_in = F.in[3];
    bf16* WIN = WSP(bf16, WS_WIN_T);
    constexpr int KB = 32;
    constexpr int I_Z = 24 * KB, I_XBC = 40 * KB, I_QKV = 24 * KB, I_G = 64 * KB;
    constexpr int I_SSD = (1536 / 64) * (2048 / 64), I_SB = (512 / 64) * (2048 / 64), I_MIX = (2048 / 64) * (2048 / 64);
    constexpr int I_XQ = (2048 / 64) * (512 / 64), I_XO = (512 / 64) * (2048 / 64);
    constexpr int NITEMS = I_Z + I_XBC + I_QKV + I_G + I_SSD + I_SB + I_MIX + 3 * I_XQ + I_XO;
    for (int it = F.gw; it < NITEMS; it += F.NGW) {
        int r = it;
        if (r < I_Z)   { tr64_block(w_in, IN_COLS, 2048, 1536, 0,    WIN, 2048, 0,    nullptr, F.lane, r); continue; } r -= I_Z;
        if (r < I_XBC) { tr64_block(w_in, IN_COLS, 2048, 2560, 1536, WIN, 2048, 1536, nullptr, F.lane, r); continue; } r -= I_XBC;
        if (r < I_QKV) { tr64_block(w_in, IN_COLS, 2048, 1536, 4120, WIN, 2048, 4096, nullptr, F.lane, r); continue; } r -= I_QKV;
        if (r < I_G)   { tr64_block(w_in, IN_COLS, 2048, 4096, 5656, WIN, 2048, 5632, nullptr, F.lane, r); continue; } r -= I_G;
        if (r < I_SSD) { tr64_block(F.in[10], 2048, 1536, 2048, 0, WSP(bf16, WS_WCAT_T), 2048, 0, F.in[9], F.lane, r); continue; } r -= I_SSD;
        if (r < I_SB)  { tr64_block(F.in[11], 2048, 512,  2048, 0, WSP(bf16, WS_WCAT_T) + 1536, 2048, 0, nullptr, F.lane, r); continue; } r -= I_SB;
        if (r < I_MIX) { tr64_block(F.in[12], 2048, 2048, 2048, 0, WSP(bf16, WS_WMIX_T), 2048, 0, nullptr, F.lane, r); continue; } r -= I_MIX;
        if (r < I_XQ)  { tr64_block(F.in[15], 512, 2048, 512, 0, WSP(bf16, WS_WQ_T), 2048, 0, F.in[13], F.lane, r); continue; } r -= I_XQ;
        if (r < I_XQ)  { tr64_block(F.in[16], 512, 2048, 512, 0, WSP(bf16, WS_WK_T), 2048, 0, nullptr, F.lane, r); continue; } r -= I_XQ;
        if (r < I_XQ)  { tr64_block(F.in[17], 512, 2048, 512, 0, WSP(bf16, WS_WV_T), 2048, 0, nullptr, F.lane, r); continue; } r -= I_XQ;
        tr64_block(F.in[18], 2048, 512, 2048, 0, WSP(bf16, WS_WO_T), 512, 0, nullptr, F.lane, r);
    }
    constexpr int I_DT = 32, I_RG = 32, I_RE = 32;
    for (int it = F.gw; it < I_DT + I_RG + I_RE; it += F.NGW) {
        int r = it;
        if (r < I_DT)  { tr_block(w_in, IN_COLS, 2048, 24, 4096, WIN, 2048, 9728, nullptr, scr, F.lane, r); continue; } r -= I_DT;
        if (r < I_RG)  { tr_block(F.in[20], 4, 2048, 4, 0, WSP(bf16, WS_WR_T), 2048, 0, F.in[19], scr, F.lane, r); continue; } r -= I_RG;
        tr_block(F.in[21], 32, 2048, 32, 0, WSP(bf16, WS_WR_T), 2048, 4, F.in[19], scr, F.lane, r);
    }
    { const int gt = F.gw * 64 + F.lane, NT = F.NGW * 64;
      u32x4* z1 = (u32x4*)(WIN + (size_t)9752 * 2048); for (int i = gt; i < (IN_PAD - 9752) * 2048 / 8; i += NT) z1[i] = (u32x4){0u, 0u, 0u, 0u};
      u32x4* z2 = (u32x4*)(WSP(bf16, WS_WR_T) + (size_t)36 * 2048); for (int i = gt; i < 12 * 2048 / 8; i += NT) z2[i] = (u32x4){0u, 0u, 0u, 0u}; }
    rms_rows(F, F.in[0], F.in[2], WSP(bf16, WS_RA), T);
    rms_rows(F, F.in[1], F.in[14], WSP(bf16, WS_MEMN), BATCH * MEM);
}
DI void p_expert_weights(const Frame& F) {
    constexpr int PER = 256;
    for (int it = F.gw; it < NEXP * 3 * PER; it += F.NGW) {
        const int e = it / (3 * PER), r = it % (3 * PER), which = r / PER, q = r % PER;
        if (which < 2) { const int kb = q / 8, nb = q % 8, n0 = nb * 64; const float* W = (which == 0 ? F.in[22] : F.in[23]) + (size_t)e * 2048 * 512;
            tr64_item(W, 512, kb * 64, n0, WSP(bf16, WS_WGU_T) + (size_t)e * 1024 * 2048, 2048, (n0 / 128) * 256 + (n0 % 128) + which * 128, F.in[19], F.lane); }
        else { const int kb = q / 32, nb = q % 32; const float* W = F.in[24] + (size_t)e * 512 * 2048;
            tr64_item(W, 2048, kb * 64, nb * 64, WSP(bf16, WS_WD_T) + (size_t)e * 2048 * 512, 512, nb * 64, nullptr, F.lane); }
    }
}

template <int NT>
DI void wave_tile_gemm(const bf16* A, int lda, const bf16* Bt, int ldb, int K, int lane, f32x4 (&acc)[NT]) {
    const int fr = lane & 15, kg = lane >> 4;
#pragma unroll
    for (int n = 0; n < NT; ++n) acc[n] = (f32x4){0.f, 0.f, 0.f, 0.f};
    const bf16* ap = A + (size_t)fr * lda + kg * 8;
    const bf16* bp = Bt + (size_t)fr * ldb + kg * 8;
#pragma unroll 4
    for (int k0 = 0; k0 < K; k0 += 32) {
        const bf16x8 a = *(const bf16x8*)(ap + k0);
#pragma unroll
        for (int n = 0; n < NT; ++n) { const bf16x8 b = *(const bf16x8*)(bp + (size_t)n * 16 * ldb + k0); acc[n] = MFMA16(a, b, acc[n]); }
    }
}

DI void p_kv_mem(const Frame& F) {
    const bf16* MEMN = WSP(bf16, WS_MEMN);
    for (int u = F.gw; u < 512; u += F.NGW) {
        const int which = u >> 8, rt = (u & 255) >> 3, cg = u & 7; f32x4 acc[4];
        const bf16* Aop = which == 0 ? MEMN : WSP(bf16, WS_WV_T); const bf16* Bop = which == 0 ? WSP(bf16, WS_WK_T) : MEMN; bf16* O = which == 0 ? WSP(bf16, WS_KX) : WSP(bf16, WS_VXT);
        wave_tile_gemm<4>(Aop + (size_t)rt * 16 * 2048, 2048, Bop + (size_t)cg * 64 * 2048, 2048, 2048, F.lane, acc);
#pragma unroll
        for (int n = 0; n < 4; ++n)
#pragma unroll
            for (int i = 0; i < 4; ++i) O[(size_t)(rt * 16 + (F.lane >> 4) * 4 + i) * 512 + cg * 64 + n * 16 + (F.lane & 15)] = (bf16)(pk2(acc[n][i], 0.f) & 0xffffu);
    }
}

DI int spos(int s) { return (s & ~31) | (((s >> 2) & 3) << 3) | (((s >> 4) & 1) << 2) | (s & 3); }
template <bool CONV, bool NAT, bool TRN>
DI void conv_slab(const bf16* src, int pitch, int c0, size_t tok0, int s0, bool zero_halo, const float* cw, const float* cb, bf16* nat, bf16* trn, LAS unsigned char* tile, int lane) {
    constexpr int HALO = CONV ? 3 : 0, ROWS = 64 + HALO, TP = 144;
    const int rr = lane >> 3, cq = lane & 7;
#pragma unroll
    for (int i = 0; i < (ROWS + 7) / 8; ++i) { const int ri = 8 * i + rr;
        if (ri < ROWS) { u32x4 v = (u32x4){0u, 0u, 0u, 0u};
            if (!(zero_halo && ri < HALO)) v = *(const u32x4*)(src + (tok0 + s0 - HALO + ri) * (size_t)pitch + c0 + cq * 8);
            *(LAS u32x4*)(tile + ri * TP + cq * 16) = v; } }
    float wk[4][8], bs[8];
    if (CONV) {
#pragma unroll
        for (int k = 0; k < 4; ++k) { const f32x4 a = *(const f32x4*)(cw + k * CONV_DIM + c0 + cq * 8), b = *(const f32x4*)(cw + k * CONV_DIM + c0 + cq * 8 + 4);
            wk[k][0] = a[0]; wk[k][1] = a[1]; wk[k][2] = a[2]; wk[k][3] = a[3]; wk[k][4] = b[0]; wk[k][5] = b[1]; wk[k][6] = b[2]; wk[k][7] = b[3]; }
        const f32x4 a = *(const f32x4*)(cb + c0 + cq * 8), b = *(const f32x4*)(cb + c0 + cq * 8 + 4);
        bs[0] = a[0]; bs[1] = a[1]; bs[2] = a[2]; bs[3] = a[3]; bs[4] = b[0]; bs[5] = b[1]; bs[6] = b[2]; bs[7] = b[3];
    }
    LDS_WAIT();
    u32x4 ov[8];
#pragma unroll
    for (int i = 0; i < 8; ++i) { const int sloc = 8 * i + rr;
        if (CONV) { float o[8];
#pragma unroll
            for (int j = 0; j < 8; ++j) o[j] = bs[j];
#pragma unroll
            for (int k = 0; k < 4; ++k) { float f[8]; pg8::unpack8(*(const LAS u32x4*)(tile + (sloc + k) * TP + cq * 16), f);
#pragma unroll
                for (int j = 0; j < 8; ++j) o[j] += wk[k][j] * f[j]; }
#pragma unroll
            for (int j = 0; j < 8; ++j) o[j] = silu_f(o[j]);
            ov[i] = __builtin_bit_cast(u32x4, pack8(o)); }
        else ov[i] = *(const LAS u32x4*)(tile + sloc * TP + cq * 16);
        if (NAT) *(u32x4*)(nat + (tok0 + s0 + sloc) * 512 + cq * 8) = ov[i]; }
    if (TRN) {
        LDS_WAIT();
#pragma unroll
        for (int i = 0; i < 8; ++i) { const int p = spos(8 * i + rr);
            const unsigned w4[4] = {ov[i].x, ov[i].y, ov[i].z, ov[i].w};
#pragma unroll
            for (int j = 0; j < 8; ++j) *(LAS unsigned short*)(tile + (cq * 8 + j) * TP + p * 2) = (unsigned short)((j & 1) ? (w4[j >> 1] >> 16) : (w4[j >> 1] & 0xffffu)); }
        LDS_WAIT();
#pragma unroll
        for (int m = 0; m < 8; ++m) { const int cl = rr + 8 * m; *(u32x4*)(trn + (size_t)cl * 128 + s0 + cq * 8) = *(const LAS u32x4*)(tile + cl * TP + cq * 16); }
        LDS_WAIT();
    }
}
DI void p_conv(const Frame& F) {
    const bf16* XBC = WSP(bf16, WS_XBC); const bf16* QKV = WSP(bf16, WS_QKV);
    const float* cw = F.in[4]; const float* cb = F.in[5];
    bf16* XT = WSP(bf16, WS_XT); bf16* BT = WSP(bf16, WS_BT); bf16* BN = WSP(bf16, WS_BN); bf16* CN = WSP(bf16, WS_CN); bf16* VT = (bf16*)((unsigned char*)F.out + OUT_VT);
    LAS unsigned char* tile = F.lds + F.wave * 16384;
    for (int bc = blockIdx.x; bc < NCHUNK; bc += F.G) {
        const size_t tok0 = (size_t)bc * 128; const bool first = (bc % (SEQ / 128)) == 0;
#pragma unroll 1
        for (int task = F.wave; task < 96; task += NWAVES) {
            if (task < 80) { const int slab = task >> 1, hf = task & 1, c0 = slab * 64, s0 = hf * 64; const bool zh = first && hf == 0;
                if (slab < 24) conv_slab<true, false, true>(XBC, CONV_DIM, c0, tok0, s0, zh, cw, cb, nullptr, XT + ((size_t)bc * 1536 + c0) * 128, tile, F.lane);
                else if (slab < 32) conv_slab<true, true, true>(XBC, CONV_DIM, c0, tok0, s0, zh, cw, cb, BN + (c0 - 1536), BT + ((size_t)bc * 512 + (c0 - 1536)) * 128, tile, F.lane);
                else conv_slab<true, true, false>(XBC, CONV_DIM, c0, tok0, s0, zh, cw, cb, CN + (c0 - 2048), nullptr, tile, F.lane); }
            else { const int t2 = task - 80, slab = t2 >> 1, hf = t2 & 1, c0 = slab * 64;
                conv_slab<false, false, true>(QKV + 1024, 1536, c0, tok0, hf * 64, false, nullptr, nullptr, nullptr, VT + ((size_t)bc * 512 + c0) * 128, tile, F.lane); }
        }
        const float* DTRAW = WSP(float, WS_DTRAW); float* DTT = WSP(float, WS_DTT); float* ACT = WSP(float, WS_ACT); float* WL = WSP(float, WS_WL);
#pragma unroll 1
        for (int hh = 0; hh < 3; ++hh) { const int h = F.wave + 8 * hh; const float bias = F.in[6][h], a = -expf(F.in[7][h]);
            float dt2[2], c2[2];
#pragma unroll
            for (int j = 0; j < 2; ++j) { const float r = DTRAW[(size_t)(tok0 + 2 * F.lane + j) * 32 + h] + bias; dt2[j] = fmaxf(r, 0.f) + log1pf(expf(-fabsf(r))); }
            c2[0] = dt2[0] * a; c2[1] = c2[0] + dt2[1] * a;
            float sc = c2[1];
#pragma unroll
            for (int o = 1; o < 64; o <<= 1) { const float t = __shfl_up(sc, o); if (F.lane >= o) sc += t; }
            const float ex = sc - c2[1]; const float alast = __shfl(sc, 63);
            const float ac0 = ex + c2[0], ac1 = ex + c2[1];
            *(f32x2*)(DTT + ((size_t)bc * 24 + h) * 128 + 2 * F.lane) = (f32x2){dt2[0], dt2[1]};
            *(f32x2*)(ACT + ((size_t)bc * 24 + h) * 128 + 2 * F.lane) = (f32x2){ac0, ac1};
            *(f32x2*)(WL + ((size_t)bc * 24 + h) * 128 + spos(2 * F.lane)) = (f32x2){dt2[0] * __expf(alast - ac0), dt2[1] * __expf(alast - ac1)};
        }
    }
}

DI void p_ssd_local(const Frame& F) {
    const bf16* XT = WSP(bf16, WS_XT); const bf16* BT = WSP(bf16, WS_BT); const float* WL = WSP(float, WS_WL);
    bf16* STATE = (bf16*)((unsigned char*)F.out + OUT_STATE);
    const int lane = F.lane, fr = lane & 15, kg = lane >> 4;
    for (int u = F.gw; u < NCHUNK * SSD_HEADS; u += F.NGW) {
        const int bc = u / SSD_HEADS, h = u % SSD_HEADS, g = h / 6;
        const float* wlp = WL + ((size_t)bc * 24 + h) * 128 + kg * 8;
        const bf16* xp = XT + ((size_t)bc * 1536 + h * 64 + fr) * 128 + kg * 8;
        const bf16* bp = BT + ((size_t)bc * 512 + g * 128 + fr) * 128 + kg * 8;
        u32x4 xr[4][4]; f32x4 wv[4][2];
#pragma unroll
        for (int k = 0; k < 4; ++k) { wv[k][0] = *(const f32x4*)(wlp + k * 32); wv[k][1] = *(const f32x4*)(wlp + k * 32 + 4);
#pragma unroll
            for (int pt = 0; pt < 4; ++pt) xr[pt][k] = *(const u32x4*)(xp + (size_t)pt * 16 * 128 + k * 32); }
        bf16x8 xs[4][4];
#pragma unroll
        for (int k = 0; k < 4; ++k)
#pragma unroll
            for (int pt = 0; pt < 4; ++pt) { float f[8]; pg8::unpack8(xr[pt][k], f);
#pragma unroll
                for (int j = 0; j < 4; ++j) { f[j] *= wv[k][0][j]; f[4 + j] *= wv[k][1][j]; }
                xs[pt][k] = pack8(f); }
        bf16* st = STATE + ((size_t)bc * 24 + h) * 8192;
#pragma unroll 1
        for (int nh = 0; nh < 2; ++nh) {
            bf16x8 bfr[4][4];
#pragma unroll
            for (int nt = 0; nt < 4; ++nt)
#pragma unroll
                for (int k = 0; k < 4; ++k) bfr[nt][k] = *(const bf16x8*)(bp + (size_t)(nh * 64 + nt * 16) * 128 + k * 32);
            f32x4 acc[4][4];
#pragma unroll
            for (int a = 0; a < 4; ++a)
#pragma unroll
                for (int b = 0; b < 4; ++b) acc[a][b] = (f32x4){0.f, 0.f, 0.f, 0.f};
#pragma unroll
            for (int k = 0; k < 4; ++k)
#pragma unroll
                for (int nt = 0; nt < 4; ++nt)
#pragma unroll
                    for (int pt = 0; pt < 4; ++pt) acc[nt][pt] = MFMA16(bfr[nt][k], xs[pt][k], acc[nt][pt]);
#pragma unroll
            for (int nt = 0; nt < 4; ++nt)
#pragma unroll
                for (int pt = 0; pt < 4; ++pt) { u32x2 w; w.x = pk2(acc[nt][pt][0], acc[nt][pt][1]); w.y = pk2(acc[nt][pt][2], acc[nt][pt][3]);
                    *(u32x2*)(st + (size_t)(pt * 16 + fr) * 128 + nh * 64 + nt * 16 + kg * 4) = w; }
        }
    }
}

DI void p_sb_attn(const Frame& F) {
    const bf16* QKV = WSP(bf16, WS_QKV); const bf16* VT = (const bf16*)((const unsigned char*)F.out + OUT_VT); bf16* YSB = WSP(bf16, WS_RA);
    const int lane = F.lane, fr = lane & 15, kg = lane >> 4;
    const float scale = 0.08838834764831845f;
    for (int u = F.gw; u < BATCH * SB_H * (SEQ / 16); u += F.NGW) {
        const int bh = u / (SEQ / 16), strip = u % (SEQ / 16), b = bh / SB_H, h = bh % SB_H;
        const int q0 = strip * 16, t = q0 + fr; const size_t tb = (size_t)b * SEQ;
        bf16x8 qf[4];
#pragma unroll
        for (int k = 0; k < 4; ++k) qf[k] = *(const bf16x8*)(QKV + (tb + t) * 1536 + h * 128 + k * 32 + kg * 8);
        f32x4 o[8];
#pragma unroll
        for (int d = 0; d < 8; ++d) o[d] = (f32x4){0.f, 0.f, 0.f, 0.f};
        float R = 0.f;
#pragma unroll 1
        for (int kb = q0 >> 5; kb >= 0; --kb) {
            const int sb = kb * 32;
            f32x4 z[2];
#pragma unroll
            for (int st = 0; st < 2; ++st) { z[st] = (f32x4){0.f, 0.f, 0.f, 0.f};
                const bf16* kp = QKV + (tb + sb + st * 16 + fr) * 1536 + 512 + h * 128 + kg * 8;
#pragma unroll
                for (int k = 0; k < 4; ++k) z[st] = MFMA16(*(const bf16x8*)(kp + k * 32), qf[k], z[st]); }
            float lb[2][4], lk[2][4], tot[2];
#pragma unroll
            for (int st = 0; st < 2; ++st) { tot[st] = 0.f;
#pragma unroll
                for (int i = 0; i < 4; ++i) { const int s = sb + st * 16 + kg * 4 + i; const float zz = z[st][i] * scale;
                    const float l = fminf(zz, 0.f) - log1pf(__expf(-fabsf(zz)));
                    lb[st][i] = l; lk[st][i] = (s < t) ? (l - zz) : 0.f; tot[st] += lk[st][i]; } }
            float hi[2], all[2];
#pragma unroll
            for (int st = 0; st < 2; ++st) { const float t1 = __shfl_xor(tot[st], 16), t2 = __shfl_xor(tot[st], 32), t3 = __shfl_xor(tot[st], 48);
                all[st] = tot[st] + t1 + t2 + t3;
                hi[st] = (((kg ^ 1) > kg) ? t1 : 0.f) + (((kg ^ 2) > kg) ? t2 : 0.f) + (((kg ^ 3) > kg) ? t3 : 0.f); }
            float att[8];
#pragma unroll
            for (int st = 0; st < 2; ++st) { const float base = R + hi[st] + (st == 0 ? all[1] : 0.f);
                float suf = 0.f;
#pragma unroll
                for (int i = 3; i >= 0; --i) { const int s = sb + st * 16 + kg * 4 + i; att[st * 4 + i] = (s < t) ? __expf(lb[st][i] + base + suf) : 0.f; suf += lk[st][i]; } }
            R += all[0] + all[1];
            const bf16x8 pf = pack8(att);
            const int bcv = (int)((tb + sb) >> 7), sl = (sb & 127) + kg * 8;
#pragma unroll
            for (int d = 0; d < 8; ++d) { const bf16x8 vf = *(const bf16x8*)(VT + ((size_t)bcv * 512 + h * 128 + d * 16 + fr) * 128 + sl);
                o[d] = MFMA16(vf, pf, o[d]); }
            if (__all(R < -30.0f)) break;
        }
#pragma unroll
        for (int d = 0; d < 8; ++d) { u32x2 w; w.x = pk2(o[d][0], o[d][1]); w.y = pk2(o[d][2], o[d][3]);
            *(u32x2*)(YSB + (tb + t) * 2048 + 1536 + h * 128 + d * 16 + kg * 4) = w; }
    }
}

DI void p_ssd_scan(const Frame& F) {
    bf16* STATE = (bf16*)((unsigned char*)F.out + OUT_STATE); const float* ACT = WSP(float, WS_ACT);
    const int gt = blockIdx.x * 512 + F.tid, NT = F.G * 512;
    for (int e = gt; e < BATCH * SSD_HEADS * 2048; e += NT) {
        const int v4 = e & 2047, bh = e >> 11, b = bh / SSD_HEADS, h = bh % SSD_HEADS;
        f32x4 run = (f32x4){0.f, 0.f, 0.f, 0.f};
        for (int c0 = 0; c0 < 128; c0 += 8) {
            u32x2 tmp[8]; float dec[8];
#pragma unroll
            for (int j = 0; j < 8; ++j) { const size_t bc = (size_t)b * 128 + c0 + j; tmp[j] = *(const u32x2*)(STATE + (bc * 24 + h) * 8192 + v4 * 4); dec[j] = __expf(ACT[(bc * 24 + h) * 128 + 127]); }
#pragma unroll
            for (int j = 0; j < 8; ++j) { const size_t bc = (size_t)b * 128 + c0 + j;
                u32x2 w; w.x = pk2(run[0], run[1]); w.y = pk2(run[2], run[3]); *(u32x2*)(STATE + (bc * 24 + h) * 8192 + v4 * 4) = w;
                const f32x4 t4 = (f32x4){__uint_as_float(tmp[j].x << 16), __uint_as_float(tmp[j].x & 0xffff0000u), __uint_as_float(tmp[j].y << 16), __uint_as_float(tmp[j].y & 0xffff0000u)};
                run = run * dec[j] + t4; }
        }
    }
}

DI int cb_off(int t, int s) { return t * 256 + ((((s >> 2) ^ (2 * (t & 15))) << 3) | ((s & 3) << 1)); }
constexpr int SSQ_OFF = RING_BYTES + 1024, TAB_OFF = RING_BYTES + 5120;
DI void p_ssd_out(const Frame& F) {
    const bf16* XT = WSP(bf16, WS_XT); const bf16* BN = WSP(bf16, WS_BN); const bf16* CN = WSP(bf16, WS_CN); const bf16* Z = WSP(bf16, WS_Z);
    const float* DTT = WSP(float, WS_DTT); const float* ACT = WSP(float, WS_ACT); const bf16* STATE = (const bf16*)((const unsigned char*)F.out + OUT_STATE);
    bf16* YG = WSP(bf16, WS_RA); float* RSTD = WSP(float, WS_RSTD);
    const float* dskip = F.in[8];
    const int lane = F.lane, fr = lane & 15, kg = lane >> 4, w = F.wave, g = w >> 1;
    LAS unsigned char* cbl = F.lds + g * 32768;
    LAS float* tab = (LAS float*)(F.lds + TAB_OFF + w * 1024);
    LAS float* ssqp = (LAS float*)(F.lds + SSQ_OFF);
    for (int bc = blockIdx.x; bc < NCHUNK; bc += F.G) {
        const size_t tok0 = (size_t)bc * 128;
        REP(22)
#pragma unroll 1
        for (int q = 0; q < 4; ++q) { const int tt = (w & 1) + 2 * q;
            bf16x8 cf[4];
#pragma unroll
            for (int k = 0; k < 4; ++k) cf[k] = *(const bf16x8*)(CN + (tok0 + tt * 16 + fr) * 512 + g * 128 + k * 32 + kg * 8);
#pragma unroll 1
            for (int st = 0; st <= tt; ++st) { f32x4 X = (f32x4){0.f, 0.f, 0.f, 0.f}; const bf16* bp = BN + (tok0 + st * 16 + fr) * 512 + g * 128 + kg * 8;
#pragma unroll
                for (int k = 0; k < 4; ++k) X = MFMA16(*(const bf16x8*)(bp + k * 32), cf[k], X);
                u32x2 pw; pw.x = pk2(X[0], X[1]); pw.y = pk2(X[2], X[3]);
                *(LAS u32x2*)(cbl + cb_off(tt * 16 + fr, st * 16 + kg * 4)) = pw; } }
        __syncthreads();
        REP(23) {
        ssqp[w * 128 + lane] = 0.f; ssqp[w * 128 + 64 + lane] = 0.f;
#pragma unroll 1
        for (int r = 0; r < 3; ++r) {
            const int h = 3 * w + r; const float dsk = dskip[h];
            { const f32x2 d2 = *(const f32x2*)(DTT + ((size_t)bc * 24 + h) * 128 + 2 * lane), a2 = *(const f32x2*)(ACT + ((size_t)bc * 24 + h) * 128 + 2 * lane);
              *(LAS f32x2*)(tab + 2 * lane) = d2; *(LAS f32x2*)(tab + 128 + 2 * lane) = a2; }
            bf16x8 sf[4][4], xf0[4], xfA[4];
            const bf16* xbase = XT + ((size_t)bc * 1536 + h * 64) * 128;
            { unsigned so = (unsigned)(fr * 128 + kg * 8); asm volatile("" : "+v"(so));
              const bf16* sp0 = STATE + ((size_t)bc * 24 + h) * 8192;
#pragma unroll
              for (int pt = 0; pt < 4; ++pt) {
#pragma unroll
                  for (int k = 0; k < 4; ++k) sf[pt][k] = *(const bf16x8*)(sp0 + (so + (unsigned)(pt * 2048 + k * 32)));
                  xf0[pt] = *(const bf16x8*)(xbase + (so + (unsigned)(pt * 2048))); } }
            LDS_WAIT();
#define SSD_STEP(SP, XF) do { float mv[8]; \
        _Pragma("unroll") for (int half = 0; half < 2; ++half) { const int sbase = 32 * (SP) + 16 * half + kg * 4; \
            const u32x2 cbv = *(const LAS u32x2*)(cbl + cb_off(tl, sbase)); \
            const f32x4 dv = *(const LAS f32x4*)(tab + sbase), av = *(const LAS f32x4*)(tab + 128 + sbase); \
            const float cbf[4] = {__uint_as_float(cbv.x << 16), __uint_as_float(cbv.x & 0xffff0000u), __uint_as_float(cbv.y << 16), __uint_as_float(cbv.y & 0xffff0000u)}; \
            _Pragma("unroll") for (int i = 0; i < 4; ++i) { const int s_ = sbase + i; float v = 0.f; \
                if (s_ <= tl) v = cbf[i] * dv[i] * __expf(acum_t - av[i]); \
                if (s_ == tl) v += dsk; \
                mv[half * 4 + i] = v; } } \
        const bf16x8 mf = pack8(mv); \
        _Pragma("unroll") for (int pt = 0; pt < 4; ++pt) acc[pt] = MFMA16(XF[pt], mf, acc[pt]); } while (0)
#define SSD_LOADX(XF, SP) do { unsigned xo_ = (unsigned)(fr * 128 + kg * 8 + 32 * (SP)); asm volatile("" : "+v"(xo_)); \
        _Pragma("unroll") for (int pt = 0; pt < 4; ++pt) XF[pt] = *(const bf16x8*)(xbase + (xo_ + (unsigned)(pt * 2048))); } while (0)
#pragma unroll 1
            for (int tt = 0; tt < 8; ++tt) {
                int frx = fr; asm volatile("" : "+v"(frx));
                const int tl = tt * 16 + frx; const size_t tok = tok0 + tl; float ssq = 0.f;
                bf16x8 cf[4]; u32x2 zr[4];
                if (tt >= 2) SSD_LOADX(xfA, 1);
                const float acum_t = tab[128 + tl];
                f32x4 acc[4];
#pragma unroll
                for (int pt = 0; pt < 4; ++pt) acc[pt] = (f32x4){0.f, 0.f, 0.f, 0.f};
                SSD_STEP(0, xf0);
#pragma unroll
                for (int k = 0; k < 4; ++k) cf[k] = *(const bf16x8*)(CN + tok * 512 + g * 128 + k * 32 + kg * 8);
                if (tt >= 2) { SSD_STEP(1, xfA); if (tt >= 4) SSD_LOADX(xfA, 2); }
                if (tt >= 4) { SSD_STEP(2, xfA); if (tt >= 6) SSD_LOADX(xfA, 3); }
                if (tt >= 6) { SSD_STEP(3, xfA); }
#pragma unroll
                for (int pt = 0; pt < 4; ++pt) zr[pt] = *(const u32x2*)(Z + tok * 1536 + h * 64 + pt * 16 + kg * 4);
                { f32x4 ao[4];
#pragma unroll
                  for (int pt = 0; pt < 4; ++pt) ao[pt] = (f32x4){0.f, 0.f, 0.f, 0.f};
#pragma unroll
                  for (int k = 0; k < 4; ++k)
#pragma unroll
                      for (int pt = 0; pt < 4; ++pt) ao[pt] = MFMA16(sf[pt][k], cf[k], ao[pt]);
                  const float e = __expf(acum_t);
#pragma unroll
                  for (int pt = 0; pt < 4; ++pt) acc[pt] = ao[pt] * e + acc[pt]; }
#pragma unroll
                for (int pt = 0; pt < 4; ++pt) { const int col = h * 64 + pt * 16 + kg * 4;
                    const float z0 = __uint_as_float(zr[pt].x << 16), z1 = __uint_as_float(zr[pt].x & 0xffff0000u), z2 = __uint_as_float(zr[pt].y << 16), z3 = __uint_as_float(zr[pt].y & 0xffff0000u);
                    const float y0 = acc[pt][0] * silu_f(z0), y1 = acc[pt][1] * silu_f(z1), y2 = acc[pt][2] * silu_f(z2), y3 = acc[pt][3] * silu_f(z3);
                    ssq += (y0 * y0 + y1 * y1) + (y2 * y2 + y3 * y3);
                    u32x2 wv; wv.x = pk2(y0, y1); wv.y = pk2(y2, y3); *(u32x2*)(YG + tok * 2048 + col) = wv; }
                ssq += __shfl_xor(ssq, 16); ssq += __shfl_xor(ssq, 32);
                if (kg == 0) ssqp[w * 128 + tl] += ssq;
            }
            LDS_WAIT();
        }
        }
#undef SSD_STEP
#undef SSD_LOADX
        __syncthreads();
        if (F.tid < 128) { float v = 0.f;
#pragma unroll
            for (int ww = 0; ww < 8; ++ww) v += ssqp[ww * 128 + F.tid];
            RSTD[tok0 + F.tid] = 1.0f / sqrtf(v * (1.0f / 1536.0f) + EPS); }
        __syncthreads();
    }
}

DI void p_xattn(const Frame& F) {
    const bf16* Q2 = WSP(bf16, WS_Q2); const bf16* KX = WSP(bf16, WS_KX); const bf16* VXT = WSP(bf16, WS_VXT); bf16* O2 = WSP(bf16, WS_O2);
    const int lane = F.lane, fr = lane & 15, kg = lane >> 4;
    const float scale = 0.08838834764831845f;
    LAS unsigned char* kl = F.lds; LAS unsigned char* vl = F.lds + 65536;
    for (int task = blockIdx.x; task < 256; task += F.G) {
        const int bh = task >> 5, b = bh >> 2, h = bh & 3;
        __syncthreads();
#pragma unroll
        for (int i = 0; i < 8; ++i) { const int id = F.tid + 512 * i;
            { const int m = id >> 4, c = id & 15; *(LAS u32x4*)(kl + m * 256 + ((c ^ (m & 15)) << 4)) = *(const u32x4*)(KX + ((size_t)b * 256 + m) * 512 + h * 128 + c * 8); }
            { const int d = id >> 5, mc = id & 31, blk = mc >> 2, h2 = (mc >> 1) & 1, q = 2 * (mc & 1);
              const u32x4 v = *(const u32x4*)(VXT + ((size_t)h * 128 + d) * 512 + b * 256 + mc * 8);
              *(LAS u32x2*)(vl + d * 512 + (((blk * 4 + q) ^ (d & 15)) << 4) + 8 * h2) = (u32x2){v.x, v.y};
              *(LAS u32x2*)(vl + d * 512 + (((blk * 4 + q + 1) ^ (d & 15)) << 4) + 8 * h2) = (u32x2){v.z, v.w}; } }
        __syncthreads();
#pragma unroll 1
        for (int si = 0; si < 4; ++si) {
            const int strip = (task & 31) * 32 + F.wave * 4 + si;
            const size_t tok = (size_t)b * SEQ + strip * 16 + fr;
            bf16x8 qf[4];
#pragma unroll
            for (int k = 0; k < 4; ++k) qf[k] = *(const bf16x8*)(Q2 + tok * 512 + h * 128 + k * 32 + kg * 8);
            f32x4 sc[16];
#pragma unroll
            for (int mt = 0; mt < 16; ++mt) { sc[mt] = (f32x4){0.f, 0.f, 0.f, 0.f};
#pragma unroll
                for (int k = 0; k < 4; ++k) sc[mt] = MFMA16(*(const LAS bf16x8*)(kl + (mt * 16 + fr) * 256 + (((k * 4 + kg) ^ fr) << 4)), qf[k], sc[mt]);
                if (mt & 1) __builtin_amdgcn_sched_barrier(0); }
            float mx = -3.0e38f;
#pragma unroll
            for (int mt = 0; mt < 16; ++mt)
#pragma unroll
                for (int i = 0; i < 4; ++i) { sc[mt][i] *= scale; mx = fmaxf(mx, sc[mt][i]); }
            mx = fmaxf(mx, __shfl_xor(mx, 16)); mx = fmaxf(mx, __shfl_xor(mx, 32));
            float sum = 0.f;
#pragma unroll
            for (int mt = 0; mt < 16; ++mt)
#pragma unroll
                for (int i = 0; i < 4; ++i) { const float p = __expf(sc[mt][i] - mx); sc[mt][i] = p; sum += p; }
            sum += __shfl_xor(sum, 16); sum += __shfl_xor(sum, 32);
            const float inv = __builtin_amdgcn_rcpf(sum);
            f32x4 o[8];
#pragma unroll
            for (int d = 0; d < 8; ++d) o[d] = (f32x4){0.f, 0.f, 0.f, 0.f};
#pragma unroll
            for (int q = 0; q < 8; ++q) {
                float pv[8];
#pragma unroll
                for (int i = 0; i < 4; ++i) { pv[i] = sc[2 * q][i] * inv; pv[4 + i] = sc[2 * q + 1][i] * inv; }
                const bf16x8 pf = pack8(pv);
#pragma unroll
                for (int d = 0; d < 8; ++d) o[d] = MFMA16(*(const LAS bf16x8*)(vl + (d * 16 + fr) * 512 + (((q * 4 + kg) ^ fr) << 4)), pf, o[d]);
                __builtin_amdgcn_sched_barrier(0);
            }
#pragma unroll
            for (int d = 0; d < 8; ++d) { u32x2 w; w.x = pk2(o[d][0], o[d][1]); w.y = pk2(o[d][2], o[d][3]);
                *(u32x2*)(O2 + tok * 512 + h * 128 + d * 16 + kg * 4) = w; }
        }
    }
    __syncthreads();
}

DI void p_router(const Frame& F) {
    const bf16* TOKN = WSP(bf16, WS_RA); const bf16* WR = WSP(bf16, WS_WR_T); float* LOG = WSP(float, WS_LOGITS); const float* SSQ2 = WSP(float, WS_SSQ2);
    for (int u = F.gw; u < T / 16; u += F.NGW) {
        f32x4 acc[3];
        wave_tile_gemm<3>(TOKN + (size_t)u * 16 * 2048, 2048, WR, 2048, 2048, F.lane, acc);
#pragma unroll
        for (int n = 0; n < 3; ++n)
#pragma unroll
            for (int i = 0; i < 4; ++i) { const int row = u * 16 + (F.lane >> 4) * 4 + i; LOG[(size_t)row * 48 + n * 16 + (F.lane & 15)] = acc[n][i] * rstd32(SSQ2 + (size_t)row * 32); }
    }
}

DI void p_route_a(const Frame& F) {
    const float* LOG = WSP(float, WS_LOGITS); int* TI = WSP(int, WS_TI); float* TG = WSP(float, WS_TG);
    unsigned* ecnt = WSP(unsigned, WS_CTL) + CW_ECNT;
    LAS unsigned* lcnt = (LAS unsigned*)(F.lds);
    for (int blk = blockIdx.x; blk < T / 512; blk += F.G) {
        if (F.tid < 64) lcnt[F.tid] = 0u;
        __syncthreads();
        const int t = blk * 512 + F.tid; const float* lg = LOG + (size_t)t * 48;
        float gl[4]; *(f32x4*)gl = *(const f32x4*)lg;
        int gs = 0; float gm = gl[0];
#pragma unroll
        for (int j = 1; j < 4; ++j) if (gl[j] > gm) { gm = gl[j]; gs = j; }
        float den = 0.f;
#pragma unroll
        for (int j = 0; j < 4; ++j) den += expf(gl[j] - gm);
        const float ggate = 1.0f / den;
        float el[8]; { const f32x4 a = *(const f32x4*)(lg + 4 + gs * 8), b = *(const f32x4*)(lg + 8 + gs * 8); el[0] = a[0]; el[1] = a[1]; el[2] = a[2]; el[3] = a[3]; el[4] = b[0]; el[5] = b[1]; el[6] = b[2]; el[7] = b[3]; }
        int i1 = 0; float v1 = el[0];
#pragma unroll
        for (int j = 1; j < 8; ++j) if (el[j] > v1) { v1 = el[j]; i1 = j; }
        int i2 = -1; float v2 = -3.0e38f;
#pragma unroll
        for (int j = 0; j < 8; ++j) if (j != i1 && el[j] > v2) { v2 = el[j]; i2 = j; }
        const float e2 = expf(v2 - v1), w1 = 1.0f / (1.0f + e2), w2 = e2 / (1.0f + e2);
        const int ex1 = gs * 8 + i1, ex2 = gs * 8 + i2;
        const unsigned lp1 = atomicAdd((unsigned*)&lcnt[ex1], 1u), lp2 = atomicAdd((unsigned*)&lcnt[ex2], 1u);
        __syncthreads();
        if (F.tid < 32) lcnt[32 + F.tid] = __hip_atomic_fetch_add(ecnt + F.tid, lcnt[F.tid], __ATOMIC_RELAXED, __HIP_MEMORY_SCOPE_AGENT);
        __syncthreads();
        TI[t * 4 + 0] = ex1; TI[t * 4 + 1] = (int)(lcnt[32 + ex1] + lp1); TI[t * 4 + 2] = ex2; TI[t * 4 + 3] = (int)(lcnt[32 + ex2] + lp2);
        TG[t * 2 + 0] = w1 * ggate; TG[t * 2 + 1] = w2 * ggate;
        __syncthreads();
    }
}
DI void p_route_b(const Frame& F) {
    const int* TI = WSP(int, WS_TI); int* TSLOT = WSP(int, WS_TSLOT); int* SLOTTOK = WSP(int, WS_SLOTTOK); int* TILEE = WSP(int, WS_TILEE);
    unsigned* ecnt = WSP(unsigned, WS_CTL) + CW_ECNT; const float* SSQ2 = WSP(float, WS_SSQ2); float* SRSTD = WSP(float, WS_SRSTD);
    LAS int* st = (LAS int*)(F.lds);
    if (F.tid < 32) st[64 + F.tid] = (int)__hip_atomic_load(ecnt + F.tid, __ATOMIC_RELAXED, __HIP_MEMORY_SCOPE_AGENT);
    __syncthreads();
    if (F.tid == 0) { int s = 0; for (int e = 0; e < 32; ++e) { st[e] = s; s += (st[64 + e] + 255) / 256 * 256; } st[32] = s; }
    __syncthreads();
    for (int t = blockIdx.x * 512 + F.tid; t < T; t += F.G * 512) {
        const int e1 = TI[t * 4 + 0], p1 = TI[t * 4 + 1], e2 = TI[t * 4 + 2], p2 = TI[t * 4 + 3];
        const int s1 = st[e1] + p1, s2 = st[e2] + p2;
        SLOTTOK[s1] = t; SLOTTOK[s2] = t; TSLOT[t * 2] = s1; TSLOT[t * 2 + 1] = s2;
        const float rs = rstd32(SSQ2 + (size_t)t * 32); SRSTD[s1] = rs; SRSTD[s2] = rs;
    }
    for (int e = blockIdx.x; e < 32; e += F.G) {
        const int a = st[e] + st[64 + e], bnd = st[e + 1];
        for (int s = a + F.tid; s < bnd; s += 512) { SLOTTOK[s] = 0; SRSTD[s] = 0.f; }
        for (int tl = st[e] / 256 + F.tid; tl < bnd / 256; tl += 512) TILEE[tl] = e;
    }
    if (blockIdx.x == 0 && F.tid == 0) TILEE[511] = st[32] / 256;
    __syncthreads();
}

DI void p_final(const Frame& F) {
    const bf16* Y = WSP(bf16, WS_Y); const int* TSLOT = WSP(int, WS_TSLOT); const float* TG = WSP(float, WS_TG); const float* w = F.in[25];
    for (int m = F.gw; m < T; m += F.NGW) {
        const int s1 = TSLOT[m * 2], s2 = TSLOT[m * 2 + 1]; const float g1 = TG[m * 2], g2 = TG[m * 2 + 1];
        f32x4* xr = (f32x4*)(F.out + (size_t)m * 2048) + F.lane; const u32x2* y1 = (const u32x2*)(Y + (size_t)s1 * 2048) + F.lane; const u32x2* y2 = (const u32x2*)(Y + (size_t)s2 * 2048) + F.lane;
        f32x4 v[8]; float s = 0.f;
#pragma unroll
        for (int j = 0; j < 8; ++j) { v[j] = xr[64 * j]; const u32x2 a = y1[64 * j], b = y2[64 * j];
            v[j].x += g1 * __uint_as_float(a.x << 16) + g2 * __uint_as_float(b.x << 16); v[j].y += g1 * __uint_as_float(a.x & 0xffff0000u) + g2 * __uint_as_float(b.x & 0xffff0000u);
            v[j].z += g1 * __uint_as_float(a.y << 16) + g2 * __uint_as_float(b.y << 16); v[j].w += g1 * __uint_as_float(a.y & 0xffff0000u) + g2 * __uint_as_float(b.y & 0xffff0000u);
            s += (v[j].x * v[j].x + v[j].y * v[j].y) + (v[j].z * v[j].z + v[j].w * v[j].w); }
        const float rstd = 1.0f / sqrtf(wave_sum(s) * (1.0f / 2048.0f) + EPS);
        const f32x4* wr4 = (const f32x4*)w + F.lane;
#pragma unroll
        for (int j = 0; j < 8; ++j) { const f32x4 ww = wr4[64 * j]; xr[64 * j] = v[j] * rstd * ww; }
    }
}

constexpr int NPHASE = 20;
struct Args { const float* in[26]; float* out; unsigned char* ws; int ph_lo, ph_hi; };
__global__ void __launch_bounds__(NWAVES * 64, 2) fwd(Args args) {
    extern __shared__ __attribute__((aligned(16))) unsigned char lds[];
    Frame F;
    F.lds = (LAS unsigned char*)lds;
    F.tid = threadIdx.x; F.lane = F.tid & 63; F.wave = __builtin_amdgcn_readfirstlane(F.tid >> 6);
    F.G = gridDim.x; F.gw = blockIdx.x * NWAVES + F.wave; F.NGW = F.G * NWAVES;
#pragma unroll
    for (int i = 0; i < 26; ++i) F.in[i] = args.in[i];
    F.out = args.out; F.ws = args.ws;
    volatile LAS unsigned* MISC = (volatile LAS unsigned*)(F.lds + MISC_OFF);
    for (int u = F.tid; u < (LDS_BYTES - RING_BYTES) / 4; u += NWAVES * 64) ((LAS unsigned*)(F.lds + RING_BYTES))[u] = 0u;
    __syncthreads();
    const int lo = args.ph_lo, hi = args.ph_hi;
    const bool one = (hi - lo) > 1;
    XcdBarrier bar; bar.bar = WSP(unsigned, WS_CTL) + CW_BAR; bar.x = 0; bar.st = nullptr;
    if (one) bar = xcd_barrier_post(WSP(unsigned, WS_CTL) + CW_BAR, MISC + 8);
#define IN(k) (lo <= (k) && (k) < hi)
#define SEAM(k) do { if (lo <= (k) && (k) + 1 < hi) xcd_barrier(bar); } while (0)
    LAS unsigned char* ring = F.lds;
    const int bx = blockIdx.x;
    const int vcu = (F.G % 8 == 0) ? (bx % 8) * (F.G / 8) + bx / 8 : bx;

    if (IN(0)) REP(0) { p0_prologue(F); SEAM(0); }
    if (IN(1)) REP(1) {
        pg8::Gemm g{WSP(bf16, WS_RA), WSP(bf16, WS_WIN_T), 2048, 2048, 2048, nullptr, nullptr, 0};
        pg8::StaticOrder S; S.init(T, IN_PAD, 2048, F.G, bx);
        pg8::EpiInProj E{WSP(bf16, WS_Z), WSP(bf16, WS_XBC), WSP(bf16, WS_QKV), WSP(bf16, WS_GATES), WSP(float, WS_DTRAW)};
        pg8::gemm_phase<pg8::EpiInProj, pg8::StaticOrder, true, false>(ring, g, S, E);
        p_kv_mem(F);
        SEAM(1);
    }
    if (IN(2)) REP(2) { p_conv(F); SEAM(2); }
    if (IN(3)) REP(3) { REP(20) p_ssd_local(F); REP(21) p_sb_attn(F); SEAM(3); }
    if (IN(4)) REP(4) { p_ssd_scan(F); SEAM(4); }
    if (IN(5)) REP(5) { p_ssd_out(F); SEAM(5); }
    if (IN(6)) REP(6) {
        pg8::Gemm g{WSP(bf16, WS_RA), WSP(bf16, WS_WCAT_T), 2048, 2048, 2048, nullptr, nullptr, 0};
        pg8::SplitOrder S; S.so.init(T, 2048, 2048, F.G, bx); S.nt0 = 1536 / 64; S.nt1 = 512 / 64;
        pg8::EpiMerge E{WSP(bf16, WS_MERGED), WSP(bf16, WS_GATES), WSP(float, WS_RSTD)};
        pg8::gemm_phase<pg8::EpiMerge, pg8::SplitOrder, true, false>(ring, g, S, E);
        SEAM(6);
    }
    if (IN(8)) REP(8) {
        pg8::Gemm g{WSP(bf16, WS_MERGED), WSP(bf16, WS_WMIX_T), 2048, 2048, 2048, nullptr, nullptr, 0};
        pg8::StaticOrder S; S.init(T, 2048, 2048, F.G, bx);
        pg8::EpiResStat E{F.in[0], F.out, WSP(bf16, WS_RA), WSP(float, WS_SSQ1)};
        pg8::gemm_phase<pg8::EpiResStat, pg8::StaticOrder, true, false>(ring, g, S, E);
        SEAM(8);
    }
    if (IN(9)) REP(9) { p_expert_weights(F); SEAM(9); }
    if (IN(10)) REP(10) {
        pg8::Gemm g{WSP(bf16, WS_RA), WSP(bf16, WS_WQ_T), 2048, 2048, 2048, nullptr, nullptr, 0};
        pg8::StaticOrder S; S.init(T, 512, 2048, F.G, bx);
        pg8::EpiBf16Rs E{WSP(bf16, WS_Q2), 512, WSP(float, WS_SSQ1)};
        pg8::gemm_phase<pg8::EpiBf16Rs, pg8::StaticOrder, true, false>(ring, g, S, E);
        SEAM(10);
    }
    if (IN(11)) REP(11) { p_xattn(F); SEAM(11); }
    if (IN(12)) REP(12) {
        pg8::Gemm g{WSP(bf16, WS_O2), WSP(bf16, WS_WO_T), 512, 512, 512, nullptr, nullptr, 0};
        pg8::StaticOrder S; S.init(T, 2048, 512, F.G, bx);
        pg8::EpiResStat E{F.out, F.out, WSP(bf16, WS_RA), WSP(float, WS_SSQ2)};
        pg8::gemm_phase<pg8::EpiResStat, pg8::StaticOrder, true, false>(ring, g, S, E);
        SEAM(12);
    }
    if (IN(14)) REP(14) { p_router(F); SEAM(14); }
    if (IN(15)) REP(15) { p_route_a(F); SEAM(15); }
    if (IN(16)) REP(16) { p_route_b(F); SEAM(16); }
    if (IN(17)) REP(17) {
        const int* TILEE = WSP(int, WS_TILEE);
        pg8::Gemm g{WSP(bf16, WS_RA), WSP(bf16, WS_WGU_T), 2048, 2048, 2048, WSP(int, WS_SLOTTOK), TILEE, (size_t)1024 * 2048};
        pg8::ListOrder S; S.init(TILEE[511], 4, F.G, bx, 2048 / 64);
        pg8::EpiSwiGLU E{WSP(bf16, WS_HID), WSP(float, WS_SRSTD)};
        pg8::gemm_phase<pg8::EpiSwiGLU, pg8::ListOrder, true, true>(ring, g, S, E);
        SEAM(17);
    }
    if (IN(18)) REP(18) {
        const int* TILEE = WSP(int, WS_TILEE);
        pg8::Gemm g{WSP(bf16, WS_HID), WSP(bf16, WS_WD_T), 512, 512, 512, nullptr, TILEE, (size_t)2048 * 512};
        pg8::ListOrder S; S.init(TILEE[511], 8, F.G, bx, 512 / 64);
        pg8::EpiBf16 E{WSP(bf16, WS_Y), 2048};
        pg8::gemm_phase<pg8::EpiBf16, pg8::ListOrder, true, false>(ring, g, S, E);
        SEAM(18);
    }
    if (IN(19)) REP(19) { p_final(F); }
#undef IN
#undef SEAM
}

extern "C" void kernel_launch(void* const* d_in, const int* in_sizes, int n_in, void* d_out, int out_size, void* d_ws, size_t ws_size, hipStream_t stream) {
    static int grid = 0;
    if (grid == 0) {
        if (n_in != 26 || out_size != T * D || ws_size < WS_END) { fprintf(stderr, "kernel_launch: unexpected sizes n_in %d out %d ws %zu\n", n_in, out_size, ws_size); grid = -1; return; }
        int dev = 0, cus = 0, per_cu = 0;
        if (hipGetDevice(&dev) != hipSuccess || hipDeviceGetAttribute(&cus, hipDeviceAttributeMultiprocessorCount, dev) != hipSuccess) { grid = -1; return; }
        if (hipFuncSetAttribute((const void*)fwd, hipFuncAttributeMaxDynamicSharedMemorySize, LDS_BYTES) != hipSuccess) { fprintf(stderr, "kernel_launch: hipFuncSetAttribute failed\n"); grid = -1; return; }
        if (hipOccupancyMaxActiveBlocksPerMultiprocessor(&per_cu, (const void*)fwd, NWAVES * 64, LDS_BYTES) != hipSuccess || per_cu < 1) fprintf(stderr, "kernel_launch: occupancy query reports %d\n", per_cu);
        (void)hipGetLastError();
        grid = cus;
    }
    if (grid < 0) return;
    if (hipMemsetAsync((char*)d_ws + WS_CTL, 0, CTL_ZERO_BYTES, stream) != hipSuccess) return;
    Args a{};
    for (int i = 0; i < 26; ++i) a.in[i] = (const float*)d_in[i];
    a.out = (float*)d_out; a.ws = (unsigned char*)d_ws;
    if (MK_N_LAUNCHES == 1) {
        a.ph_lo = 0; a.ph_hi = NPHASE;
        hipLaunchKernelGGL(fwd, dim3(grid), dim3(NWAVES * 64), LDS_BYTES, stream, a);
    } else {
        for (int p = 0; p < NPHASE; ++p) { a.ph_lo = p; a.ph_hi = p + 1; hipLaunchKernelGGL(fwd, dim3(grid), dim3(NWAVES * 64), LDS_BYTES, stream, a); }
    }
}
```

```cpp
#include <hip/hip_runtime.h>
#include <cstdio>
#include <cstdint>

#define DI __device__ __forceinline__
#define LAS __attribute__((address_space(3)))
#define GAS __attribute__((address_space(1)))
typedef unsigned short bf16;
typedef short bf16x8 __attribute__((ext_vector_type(8)));
typedef short s16x4 __attribute__((ext_vector_type(4)));
typedef float f32x4 __attribute__((ext_vector_type(4)));
typedef float f32x2 __attribute__((ext_vector_type(2)));
typedef unsigned u32x4 __attribute__((ext_vector_type(4)));
typedef unsigned u32x2 __attribute__((ext_vector_type(2)));
typedef __bf16 bf16x2_t __attribute__((ext_vector_type(2)));

#ifndef DUP_MASK
#define DUP_MASK 0
#endif
#define REP(k) for (int rep_ = 0; rep_ < 1 + 2 * ((DUP_MASK >> (k)) & 1); ++rep_)
#ifndef MK_N_LAUNCHES
#define MK_N_LAUNCHES 1
#endif

constexpr int D = 2048, BATCH = 2, SEQ = 16384, T = BATCH * SEQ;
constexpr int SSD_INNER = 1536, SSD_HEADS = 24, SSD_P = 64, SSD_N = 128, SSD_G = 4, SSD_L = 128, SSD_BC = 512, CONV_DIM = 2560;
constexpr int NCHUNK = T / SSD_L;
constexpr int SB_W = 512, SB_H = 4, SB_D = 128;
constexpr int IN_COLS = 9752, IN_PAD = 9984;
constexpr int XA_W = 512, MEM = 256;
constexpr int NEXP = 32, EFF = 512;
constexpr int NSLOT = 2 * T + NEXP * 256;
constexpr float EPS = 1e-6f;

constexpr size_t MiB = 1u << 20;
constexpr size_t WS_CTL = 0, CTL_ZERO_BYTES = 1 * MiB;
constexpr size_t WS_WCAT_T = 1 * MiB;
constexpr size_t WS_WMIX_T = 9 * MiB;
constexpr size_t WS_WQ_T = 17 * MiB;
constexpr size_t WS_WK_T = 19 * MiB;
constexpr size_t WS_WV_T = 21 * MiB;
constexpr size_t WS_WO_T = 23 * MiB;
constexpr size_t WS_WR_T = 25 * MiB;
constexpr size_t WS_MEMN = 26 * MiB;
constexpr size_t WS_KX = 28 * MiB;
constexpr size_t WS_VXT = 28 * MiB + 512 * 1024;
constexpr size_t WS_DTRAW = 29 * MiB;
constexpr size_t WS_DTT = 33 * MiB;
constexpr size_t WS_ACT = 36 * MiB;
constexpr size_t WS_RSTD = 39 * MiB;
constexpr size_t WS_SRSTD = 53 * MiB;
constexpr size_t WS_SSQ1 = 54 * MiB, WS_SSQ2 = 58 * MiB;
constexpr size_t WS_WL = 50 * MiB;
constexpr size_t WS_LOGITS = 40 * MiB;
constexpr size_t WS_TI = 48 * MiB;
constexpr size_t WS_TG = 48 * MiB + 512 * 1024;
constexpr size_t WS_TSLOT = 48 * MiB + 768 * 1024;
constexpr size_t WS_SLOTTOK = 49 * MiB;
constexpr size_t WS_TILEE = 49 * MiB + 512 * 1024;
constexpr size_t WS_WIN_T = 64 * MiB;
constexpr size_t WS_BT = 64 * MiB;
constexpr size_t WS_Q2 = 64 * MiB;
constexpr size_t WS_RA = 104 * MiB;
constexpr size_t WS_Z = 232 * MiB;
constexpr size_t WS_HID = 232 * MiB;
constexpr size_t WS_XBC = 328 * MiB;
constexpr size_t WS_MERGED = 328 * MiB;
constexpr size_t WS_QKV = 488 * MiB;
constexpr size_t WS_WGU_T = 488 * MiB;
constexpr size_t WS_GATES = 584 * MiB;
constexpr size_t WS_WD_T = 616 * MiB;
constexpr size_t WS_Y = 680 * MiB;
constexpr size_t WS_BN = 840 * MiB;
constexpr size_t WS_CN = 872 * MiB;
constexpr size_t WS_XT = 904 * MiB;
constexpr size_t WS_O2 = 968 * MiB;
constexpr size_t WS_END = 1000 * MiB;
constexpr size_t OUT_STATE = 0, OUT_VT = 192 * MiB;
constexpr int CW_BAR = 4096;
constexpr int CW_ECNT = 16384;

constexpr int RING_BYTES = 131072;
constexpr int MISC_OFF = RING_BYTES + 320;
constexpr int LDS_BYTES = 147456;
constexpr int NWAVES = 8;

DI float bf2f(bf16 v) { return __uint_as_float(((unsigned)v) << 16); }
DI unsigned pk2(float lo, float hi) { f32x2 v = {lo, hi}; bf16x2_t b = __builtin_convertvector(v, bf16x2_t); return __builtin_bit_cast(unsigned, b); }
DI bf16x8 pack8(const float (&v)[8]) { u32x4 p; p.x = pk2(v[0], v[1]); p.y = pk2(v[2], v[3]); p.z = pk2(v[4], v[5]); p.w = pk2(v[6], v[7]); return __builtin_bit_cast(bf16x8, p); }
DI float wave_sum(float v) {
#pragma unroll
    for (int o = 1; o < 64; o <<= 1) v += __shfl_xor(v, o);
    return v;
}
DI float silu_f(float x) { return x * __builtin_amdgcn_rcpf(1.0f + __expf(-x)); }
DI float sigmoid_f(float x) { return __builtin_amdgcn_rcpf(1.0f + __expf(-x)); }
DI float rstd32(const float* p) { f32x4 a = *(const f32x4*)p;
#pragma unroll
    for (int i = 1; i < 8; ++i) a += *(const f32x4*)(p + 4 * i);
    return 1.0f / sqrtf(((a[0] + a[1]) + (a[2] + a[3])) * (1.0f / 2048.0f) + EPS); }
#define MFMA16(a, b, c) __builtin_amdgcn_mfma_f32_16x16x32_bf16((a), (b), (c), 0, 0, 0)
#define LDS_WAIT() asm volatile("s_waitcnt lgkmcnt(0)" ::: "memory")
#define VM_WAIT() asm volatile("s_waitcnt vmcnt(0)" ::: "memory")

namespace pg8 {
#define PG8_LAS __attribute__((address_space(3)))
constexpr int BM = 256, BK = 64, HALF = 128, HTB = HALF * BK * 2, STAGE_BYTES = 8 * HTB, NXCD = 8, WGM = 8;
__host__ __device__ __forceinline__ int lds_byte(int r, int c) { const int st = (r >> 4) * 2 + (c >> 5), rr = r & 15, cc = c & 31, ob = rr * 64 + cc * 2; return st * 1024 + (ob ^ (((ob >> 9) & 1) << 5)); }
__host__ __device__ __forceinline__ void stage_rc(int b, int& R, int& C) { const int st = b / 1024, sb = b % 1024, swz = sb ^ (((sb >> 9) & 1) << 5); R = (st >> 1) * 16 + swz / 64; C = (st & 1) * 32 + (swz % 64) / 2; }
__host__ __device__ __forceinline__ int perm32(int rho) { const int n = rho >> 4, i = rho & 15; return 8 * (i >> 2) + 4 * n + (i & 3); }

struct Unit { int pm, pn, k0, nt, fin; };
struct Gemm { const bf16* A; const bf16* Bt; int K, lda, ldb; const int* arow; const int* tile_e; size_t b_estride; };

struct StaticOrder {
    int nM, nN, nwg, G, c, nt;
    __device__ void init(int M, int N, int K, int G_, int c_) { nM = M / BM; nN = N / BM; nwg = nM * nN; G = G_; c = c_; nt = K / BK; }
    __device__ bool next(int i, Unit& u) const {
        u.k0 = 0; u.nt = nt; u.fin = 1;
        const long L = (long)i * G + c; if (L >= nwg) return false;
        int wgid = (int)L; { const int q = nwg / NXCD, r = nwg % NXCD, xcd = wgid % NXCD, off = wgid / NXCD; wgid = (xcd < r ? xcd * (q + 1) : r * (q + 1) + (xcd - r) * q) + off; }
        const int nig = WGM * nN, gid = wgid / nig, fm = gid * WGM, gsz = (nM - fm) < WGM ? (nM - fm) : WGM;
        u.pm = fm + ((wgid % nig) % gsz); u.pn = (wgid % nig) / gsz; return true;
    }
};
struct ListOrder {
    int ntile, nN, G, c, nt;
    __device__ void init(int ntile_, int nN_, int G_, int c_, int nt_) { ntile = ntile_; nN = nN_; G = G_; c = c_; nt = nt_; }
    __device__ bool next(int i, Unit& u) const { u.k0 = 0; u.nt = nt; u.fin = 1; const int L = i * G + c; if (L >= ntile * nN) return false; u.pm = L / nN; u.pn = L % nN; return true; }
};
struct SplitOrder {
    StaticOrder so; int nt0, nt1;
    __device__ bool next(int i, Unit& u) const { if (!so.next(i >> 1, u)) return false; if (i & 1) { u.k0 = nt0 * BK; u.nt = nt1; u.fin = 1; } else { u.k0 = 0; u.nt = nt0; u.fin = 0; } return true; }
};

template <class Epi, class Sched, bool ALIGN_EPI, bool GATHER>
__device__ __forceinline__ void gemm_phase(PG8_LAS unsigned char* lds, const Gemm g, const Sched& S, const Epi& E) {
    const int tid = threadIdx.x, wid = __builtin_amdgcn_readfirstlane(tid >> 6), lane = tid & 63, wr = wid >> 2, wc = wid & 3, fr = lane & 15, fq = lane >> 4;
    unsigned voffB[2]; int RA[2], CA[2];
#pragma unroll
    for (int i = 0; i < 2; ++i) { int R, C; stage_rc(tid * 16 + i * 8192, R, C); const int Rb = (R & ~31) + perm32(R & 31);
        RA[i] = R; CA[i] = C; voffB[i] = (unsigned)(Rb * g.ldb + C) * 2u; }
    const size_t kstep = (size_t)(BK * 2);
    const size_t hstepB = (size_t)HALF * g.ldb * 2;
    const size_t tstepB = 2 * hstepB;
    const unsigned ldsw = (unsigned)wid * 1024u;
    const int aoff = lds_byte(wr * 64 + fr, fq * 8), boff = lds_byte(wc * 32 + fr, fq * 8);
    const char* Ab = (const char*)g.A;
#define PG8_SA(b, h) (((b) * 2 + (h)) * HTB)
#define PG8_SB(b, h) ((4 + (b) * 2 + (h)) * HTB)
#define PG8_STAGE(bufoff, gbase, voff) do { _Pragma("unroll") for (int _i = 0; _i < 2; ++_i) \
        __builtin_amdgcn_global_load_lds((const unsigned*)((const char*)(gbase) + (voff)[_i]), (PG8_LAS unsigned*)(lds + (bufoff) + ldsw + _i * 8192), 16, 0, 0); } while (0)
#define PG8_STAGEA(bufoff, kb, o0, o1) do { \
        __builtin_amdgcn_global_load_lds((const unsigned*)(Ab + (kb) + (o0)), (PG8_LAS unsigned*)(lds + (bufoff) + ldsw), 16, 0, 0); \
        __builtin_amdgcn_global_load_lds((const unsigned*)(Ab + (kb) + (o1)), (PG8_LAS unsigned*)(lds + (bufoff) + ldsw + 8192), 16, 0, 0); } while (0)
#define PG8_LDA(dst, b, h) do { _Pragma("unroll") for (int m = 0; m < 4; ++m) _Pragma("unroll") for (int k = 0; k < 2; ++k) dst[m][k] = *(const PG8_LAS bf16x8*)(lds + PG8_SA(b, h) + aoff + m * 2048 + k * 1024); } while (0)
#define PG8_LDB(dst, b, h) do { _Pragma("unroll") for (int n = 0; n < 2; ++n) _Pragma("unroll") for (int k = 0; k < 2; ++k) dst[n][k] = *(const PG8_LAS bf16x8*)(lds + PG8_SB(b, h) + boff + n * 2048 + k * 1024); } while (0)
#define PG8_MMA(ai, bj, At, Bt) do { __builtin_amdgcn_s_setprio(1); _Pragma("unroll") for (int m = 0; m < 4; ++m) _Pragma("unroll") for (int n = 0; n < 2; ++n) _Pragma("unroll") for (int k = 0; k < 2; ++k) \
        acc[ai][bj][m][n] = __builtin_amdgcn_mfma_f32_16x16x32_bf16(Bt[n][k], At[m][k], acc[ai][bj][m][n], 0, 0, 0); __builtin_amdgcn_s_setprio(0); } while (0)
#define PG8_WAIT_V(n) asm volatile("s_waitcnt vmcnt(" #n ")" ::: "memory")
#define PG8_WAIT_L(n) asm volatile("s_waitcnt lgkmcnt(" #n ")" ::: "memory")
#define PG8_BAR __builtin_amdgcn_s_barrier()
#define PG8_SCHED __builtin_amdgcn_sched_barrier(0)
#define PG8_SETA(o, u) do { _Pragma("unroll") for (int _h = 0; _h < 2; ++_h) _Pragma("unroll") for (int _i = 0; _i < 2; ++_i) { \
        int _row = (u).pm * BM + _h * HALF + RA[_i]; if (GATHER) _row = g.arow[_row]; (o)[_h][_i] = (unsigned)(_row * g.lda + CA[_i] + (u).k0) * 2u; } } while (0)
    Unit cur, nxt; int ui = 0;
    if (!S.next(0, cur)) return;
    f32x4 acc[2][2][4][2];
#pragma unroll
    for (int a = 0; a < 2; ++a)
#pragma unroll
        for (int b = 0; b < 2; ++b)
#pragma unroll
            for (int m = 0; m < 4; ++m)
#pragma unroll
                for (int n = 0; n < 2; ++n) acc[a][b][m][n] = (f32x4){0.f, 0.f, 0.f, 0.f};
    bf16x8 At[4][2], B0[2][2], B1[2][2];
    unsigned oc[2][2], on[2][2];
    PG8_SETA(oc, cur);
    const char* cB = (const char*)g.Bt + (g.tile_e ? (size_t)g.tile_e[cur.pm] * g.b_estride * 2 : (size_t)0) + (size_t)cur.pn * tstepB + (size_t)cur.k0 * 2;
    PG8_STAGE(PG8_SB(0, 0), cB, voffB); PG8_STAGE(PG8_SB(0, 1), cB + hstepB, voffB); PG8_STAGEA(PG8_SA(0, 0), 0, oc[0][0], oc[0][1]); PG8_STAGEA(PG8_SA(0, 1), 0, oc[1][0], oc[1][1]);
    if (wr == 1) PG8_BAR;
    PG8_WAIT_V(2); PG8_BAR;
    PG8_STAGE(PG8_SB(1, 0), cB + kstep, voffB); PG8_STAGEA(PG8_SA(1, 0), kstep, oc[0][0], oc[0][1]); PG8_STAGE(PG8_SB(1, 1), cB + hstepB + kstep, voffB);
    PG8_WAIT_V(6); PG8_BAR;
    for (;;) {
        const bool has_next = S.next(ui + 1, nxt);
        const char* nB = cB;
        if (has_next) { nB = (const char*)g.Bt + (g.tile_e ? (size_t)g.tile_e[nxt.pm] * g.b_estride * 2 : (size_t)0) + (size_t)nxt.pn * tstepB + (size_t)nxt.k0 * 2; }
        const int nt = cur.nt;
#pragma unroll
        for (int _h = 0; _h < 2; ++_h)
#pragma unroll
            for (int _i = 0; _i < 2; ++_i) on[_h][_i] = oc[_h][_i];
        for (int t = 0; t < nt; t += 2) {
            const bool last = (t == nt - 2);
            if (last && has_next) { PG8_SETA(on, nxt); }
            const size_t k1 = (size_t)(t + 1) * kstep;
            const size_t k2 = last ? (size_t)0 : (size_t)(t + 2) * kstep, k3 = k2 + kstep;
            const char* b2 = last ? nB : cB + (size_t)(t + 2) * kstep; const char* b3 = b2 + kstep;
            const unsigned s00 = last ? on[0][0] : oc[0][0], s01 = last ? on[0][1] : oc[0][1], s10 = last ? on[1][0] : oc[1][0], s11 = last ? on[1][1] : oc[1][1];
            PG8_LDB(B0, 0, 0); PG8_LDB(B1, 0, 1); PG8_SCHED; PG8_LDA(At, 0, 0); PG8_STAGEA(PG8_SA(1, 1), k1, oc[1][0], oc[1][1]);
            PG8_WAIT_V(8); PG8_WAIT_L(0); PG8_BAR; PG8_MMA(0, 0, At, B0); PG8_MMA(0, 1, At, B1); PG8_BAR; PG8_SCHED;
            PG8_LDA(At, 0, 1); PG8_STAGE(PG8_SB(0, 0), b2, voffB); PG8_STAGE(PG8_SB(0, 1), b2 + hstepB, voffB); PG8_STAGEA(PG8_SA(0, 0), k2, s00, s01);
            PG8_WAIT_V(8); PG8_WAIT_L(0); PG8_BAR; PG8_MMA(1, 0, At, B0); PG8_MMA(1, 1, At, B1); PG8_BAR; PG8_SCHED;
            PG8_LDB(B0, 1, 0); PG8_LDB(B1, 1, 1); PG8_SCHED; PG8_LDA(At, 1, 0); PG8_STAGEA(PG8_SA(0, 1), k2, s10, s11);
            PG8_WAIT_V(8); PG8_WAIT_L(0); PG8_BAR; PG8_MMA(0, 0, At, B0); PG8_MMA(0, 1, At, B1); PG8_BAR; PG8_SCHED;
            PG8_LDA(At, 1, 1); PG8_STAGE(PG8_SB(1, 0), b3, voffB); PG8_STAGE(PG8_SB(1, 1), b3 + hstepB, voffB); PG8_STAGEA(PG8_SA(1, 0), k3, s00, s01);
            PG8_WAIT_V(8); PG8_WAIT_L(0); PG8_BAR; PG8_MMA(1, 0, At, B0); PG8_MMA(1, 1, At, B1); PG8_BAR; PG8_SCHED;
        }
        if constexpr (ALIGN_EPI) { if (wr == 0) PG8_BAR; }
        E(acc, cur, wr, wc, fr, fq);
        if (!has_next) break;
        if (cur.fin) {
#pragma unroll
        for (int a = 0; a < 2; ++a)
#pragma unroll
            for (int b = 0; b < 2; ++b)
#pragma unroll
                for (int m = 0; m < 4; ++m)
#pragma unroll
                    for (int n = 0; n < 2; ++n) acc[a][b][m][n] = (f32x4){0.f, 0.f, 0.f, 0.f};
        }
        cur = nxt; cB = nB; ++ui;
#pragma unroll
        for (int _h = 0; _h < 2; ++_h)
#pragma unroll
            for (int _i = 0; _i < 2; ++_i) oc[_h][_i] = on[_h][_i];
        if constexpr (ALIGN_EPI) { if (wr == 1) PG8_BAR; }
    }
    PG8_WAIT_V(0);
    if constexpr (!ALIGN_EPI) { if (wr == 0) PG8_BAR; }
    PG8_BAR;
#undef PG8_SA
#undef PG8_SB
#undef PG8_STAGE
#undef PG8_STAGEA
#undef PG8_LDA
#undef PG8_LDB
#undef PG8_MMA
#undef PG8_WAIT_V
#undef PG8_WAIT_L
#undef PG8_BAR
#undef PG8_SCHED
#undef PG8_SETA
}

#define EPI_ROWS(...) _Pragma("unroll") for (int ai = 0; ai < 2; ++ai) _Pragma("unroll") for (int m = 0; m < 4; ++m) { const int row = u.pm * BM + ai * HALF + wr * 64 + m * 16 + fr; \
        _Pragma("unroll") for (int bj = 0; bj < 2; ++bj) { const int col = u.pn * BM + bj * HALF + wc * 32 + 8 * fq; const f32x4 v0 = acc[ai][bj][m][0], v1 = acc[ai][bj][m][1]; __VA_ARGS__ } }
DI u32x4 pack8v(f32x4 v0, f32x4 v1) { u32x4 w; w.x = pk2(v0[0], v0[1]); w.y = pk2(v0[2], v0[3]); w.z = pk2(v1[0], v1[1]); w.w = pk2(v1[2], v1[3]); return w; }
DI void unpack8(u32x4 w, float (&f)[8]) { f[0] = __uint_as_float(w.x << 16); f[1] = __uint_as_float(w.x & 0xffff0000u); f[2] = __uint_as_float(w.y << 16); f[3] = __uint_as_float(w.y & 0xffff0000u);
    f[4] = __uint_as_float(w.z << 16); f[5] = __uint_as_float(w.z & 0xffff0000u); f[6] = __uint_as_float(w.w << 16); f[7] = __uint_as_float(w.w & 0xffff0000u); }

struct EpiBf16 {
    bf16* O; int ldc;
    DI void operator()(const f32x4 (&acc)[2][2][4][2], const Unit& u, int wr, int wc, int fr, int fq) const {
        EPI_ROWS({ *(u32x4*)(O + (size_t)row * ldc + col) = pack8v(v0, v1); })
    }
};
struct EpiInProj {
    bf16 *Z, *XBC, *QKV, *GATES; float* DTRAW;
    DI void operator()(const f32x4 (&acc)[2][2][4][2], const Unit& u, int wr, int wc, int fr, int fq) const {
        const int pn = u.pn;
        if (pn < 6) { EPI_ROWS({ *(u32x4*)(Z + (size_t)row * 1536 + col) = pack8v(v0, v1); }) }
        else if (pn < 16) { EPI_ROWS({ *(u32x4*)(XBC + (size_t)row * 2560 + (col - 1536)) = pack8v(v0, v1); }) }
        else if (pn < 22) { EPI_ROWS({ *(u32x4*)(QKV + (size_t)row * 1536 + (col - 4096)) = pack8v(v0, v1); }) }
        else if (pn < 38) { EPI_ROWS({ f32x4 a, b;
_Pragma("unroll")
                for (int j = 0; j < 4; ++j) { a[j] = sigmoid_f(v0[j]); b[j] = sigmoid_f(v1[j]); }
                *(u32x4*)(GATES + (size_t)row * 4096 + (col - 5632)) = pack8v(a, b); }) }
        else { EPI_ROWS({ const int c = col - 9728; if (c < 32) { *(f32x4*)(DTRAW + (size_t)row * 32 + c) = v0; *(f32x4*)(DTRAW + (size_t)row * 32 + c + 4) = v1; } }) }
    }
};
struct EpiMerge {
    bf16* MERGED; const bf16* GATES; const float* RSTD;
    DI void operator()(f32x4 (&acc)[2][2][4][2], const Unit& u, int wr, int wc, int fr, int fq) const { if (u.fin) fin(acc, u, wr, wc, fr, fq); else mid(acc, u, wr, wc, fr, fq); }
    DI void mid(f32x4 (&acc)[2][2][4][2], const Unit& u, int wr, int wc, int fr, int fq) const {
#pragma unroll
        for (int ai = 0; ai < 2; ++ai)
#pragma unroll
            for (int m = 0; m < 4; ++m) { const int row = u.pm * BM + ai * HALF + wr * 64 + m * 16 + fr; const float rs = RSTD[row];
#pragma unroll
                for (int bj = 0; bj < 2; ++bj) { const int col = u.pn * BM + bj * HALF + wc * 32 + 8 * fq; float g1[8], g2[8];
                    unpack8(*(const u32x4*)(GATES + (size_t)row * 4096 + col), g1); unpack8(*(const u32x4*)(GATES + (size_t)row * 4096 + 2048 + col), g2);
#pragma unroll
                    for (int j = 0; j < 4; ++j) { acc[ai][bj][m][0][j] *= rs * g1[j] / fmaxf(g2[j], 1e-30f); acc[ai][bj][m][1][j] *= rs * g1[4 + j] / fmaxf(g2[4 + j], 1e-30f); } }
                asm volatile("" ::: "memory"); }
    }
    DI void fin(const f32x4 (&acc)[2][2][4][2], const Unit& u, int wr, int wc, int fr, int fq) const {
        EPI_ROWS({ float g2[8]; unpack8(*(const u32x4*)(GATES + (size_t)row * 4096 + 2048 + col), g2);
            f32x4 a, b;
_Pragma("unroll")
            for (int j = 0; j < 4; ++j) { a[j] = v0[j] * g2[j]; b[j] = v1[j] * g2[4 + j]; }
            *(u32x4*)(MERGED + (size_t)row * 2048 + col) = pack8v(a, b); })
    }
};
struct EpiResF32 {
    const float* base; float* out;
    DI void operator()(const f32x4 (&acc)[2][2][4][2], const Unit& u, int wr, int wc, int fr, int fq) const {
        EPI_ROWS({ const size_t o = (size_t)row * 2048 + col; const f32x4 b0 = *(const f32x4*)(base + o), b1 = *(const f32x4*)(base + o + 4);
            *(f32x4*)(out + o) = b0 + v0; *(f32x4*)(out + o + 4) = b1 + v1; })
    }
};
struct EpiResStat {
    const float* base; float* out; bf16* hb; float* ssq;
    DI void operator()(const f32x4 (&acc)[2][2][4][2], const Unit& u, int wr, int wc, int fr, int fq) const {
#pragma unroll
        for (int ai = 0; ai < 2; ++ai)
#pragma unroll
            for (int m = 0; m < 4; ++m) { const int row = u.pm * BM + ai * HALF + wr * 64 + m * 16 + fr; float sq = 0.f;
#pragma unroll
                for (int bj = 0; bj < 2; ++bj) { const int col = u.pn * BM + bj * HALF + wc * 32 + 8 * fq; const size_t o = (size_t)row * 2048 + col;
                    const f32x4 r0 = *(const f32x4*)(base + o) + acc[ai][bj][m][0], r1 = *(const f32x4*)(base + o + 4) + acc[ai][bj][m][1];
                    *(f32x4*)(out + o) = r0; *(f32x4*)(out + o + 4) = r1; *(u32x4*)(hb + o) = pack8v(r0, r1);
                    sq += (r0[0] * r0[0] + r0[1] * r0[1]) + (r0[2] * r0[2] + r0[3] * r0[3]) + (r1[0] * r1[0] + r1[1] * r1[1]) + (r1[2] * r1[2] + r1[3] * r1[3]); }
                sq += __shfl_xor(sq, 16); sq += __shfl_xor(sq, 32);
                if (fq == 0) ssq[(size_t)row * 32 + u.pn * 4 + wc] = sq; }
    }
};
struct EpiBf16Rs {
    bf16* O; int ldc; const float* ssq;
    DI void operator()(const f32x4 (&acc)[2][2][4][2], const Unit& u, int wr, int wc, int fr, int fq) const {
_Pragma("unroll") for (int ai = 0; ai < 2; ++ai) _Pragma("unroll") for (int m = 0; m < 4; ++m) { const int row = u.pm * BM + ai * HALF + wr * 64 + m * 16 + fr; const float rs = rstd32(ssq + (size_t)row * 32);
            _Pragma("unroll") for (int bj = 0; bj < 2; ++bj) { const int col = u.pn * BM + bj * HALF + wc * 32 + 8 * fq; *(u32x4*)(O + (size_t)row * ldc + col) = pack8v(acc[ai][bj][m][0] * rs, acc[ai][bj][m][1] * rs); } }
    }
};
struct EpiSwiGLU {
    bf16* HID; const float* srstd;
    DI void operator()(const f32x4 (&acc)[2][2][4][2], const Unit& u, int wr, int wc, int fr, int fq) const {
#pragma unroll
        for (int ai = 0; ai < 2; ++ai)
#pragma unroll
            for (int m = 0; m < 4; ++m) { const int row = u.pm * BM + ai * HALF + wr * 64 + m * 16 + fr; const int col = u.pn * 128 + wc * 32 + 8 * fq; const float rs = srstd[row];
                f32x4 a, b;
#pragma unroll
                for (int j = 0; j < 4; ++j) { a[j] = silu_f(acc[ai][0][m][0][j] * rs) * (acc[ai][1][m][0][j] * rs); b[j] = silu_f(acc[ai][0][m][1][j] * rs) * (acc[ai][1][m][1][j] * rs); }
                *(u32x4*)(HID + (size_t)row * EFF + col) = pack8v(a, b); }
    }
};
}

#define XB_TMO      128
#define XB_XCNT(j)  (256  + 64 * (j))
#define XB_XSUB(j)  (1280 + 64 * (j))
#define XB_XGEN(j)  (2304 + 64 * (j))
#define XB_TOP      3328
#define XB_TOPGEN   3392
#define XCD_BAR_WORDS 3456
#define XB_SPIN_CAP (1u << 18)
__device__ __forceinline__ unsigned xb_ld(unsigned* p)              { return __hip_atomic_load(p, __ATOMIC_RELAXED, __HIP_MEMORY_SCOPE_AGENT); }
__device__ __forceinline__ unsigned xb_add(unsigned* p, unsigned v) { return __hip_atomic_fetch_add(p, v, __ATOMIC_RELAXED, __HIP_MEMORY_SCOPE_AGENT); }
__device__ __forceinline__ unsigned xb_xcc_id() { return (unsigned)__builtin_amdgcn_s_getreg((3 << 11) | 20) & 0xFu; }
#define XB_SPIN(cond, bar) do { unsigned _sp = 0; while (cond) { __builtin_amdgcn_s_sleep(1); \
    if ((++_sp & 255u) == 0u) { if (xb_ld(&(bar)[XB_TMO])) break; if (_sp > XB_SPIN_CAP) { atomicAdd(&(bar)[XB_TMO], 1u); break; } } } } while (0)
struct XcdBarrier { unsigned* bar; unsigned x; volatile LAS unsigned* st; };
__device__ __forceinline__ XcdBarrier xcd_barrier_post(unsigned* bar, volatile LAS unsigned* st) {
    XcdBarrier b; b.bar = bar; b.x = xb_xcc_id(); b.st = st;
    if (threadIdx.x == 0) (void)xb_add(&bar[XB_XCNT(b.x)], 1u);
    return b;
}
__device__ __forceinline__ void xcd_barrier_complete(unsigned* bar, unsigned x, unsigned& nloc, unsigned& nx) {
    const unsigned G = gridDim.x * gridDim.y * gridDim.z;
    unsigned sum, cnt, mine, sp = 0u;
    for (;;) {
        sum = 0u; cnt = 0u; mine = 0u;
#pragma unroll
        for (unsigned j = 0; j < 16; ++j) { const unsigned c = xb_ld(&bar[XB_XCNT(j)]); sum += c; cnt += (c > 0u) ? 1u : 0u; mine = (j == x) ? c : mine; }
        if (sum == G) break;
        __builtin_amdgcn_s_sleep(1);
        if ((++sp & 255u) == 0u) { if (xb_ld(&bar[XB_TMO])) break; if (sp > XB_SPIN_CAP) { atomicAdd(&bar[XB_TMO], 1u); break; } }
    }
    nloc = mine > 0u ? mine : 1u; nx = cnt > 0u ? cnt : 1u;
}
__device__ __forceinline__ void xcd_barrier(const XcdBarrier& b) {
    asm volatile("s_waitcnt vmcnt(0)" ::: "memory");
    __syncthreads();
    if (threadIdx.x == 0) {
        unsigned* bar = b.bar;
        __builtin_amdgcn_s_waitcnt(0);
        unsigned nloc = b.st[0], nx = b.st[1];
        if (nloc == 0u) { xcd_barrier_complete(bar, b.x, nloc, nx); b.st[0] = nloc; b.st[1] = nx; }
        const unsigned old = xb_add(&bar[XB_XSUB(b.x)], 1u);
        const unsigned gen = old / nloc;
        if (old + 1u == (gen + 1u) * nloc) {
            __builtin_amdgcn_fence(__ATOMIC_RELEASE, "agent");
            asm volatile("s_waitcnt vmcnt(0)" ::: "memory");
            const unsigned og = xb_add(&bar[XB_TOP], 1u);
            const unsigned tg = og / nx;
            if (og + 1u == (tg + 1u) * nx) xb_add(&bar[XB_TOPGEN], 1u);
            else XB_SPIN(xb_ld(&bar[XB_TOPGEN]) == tg, bar);
            __builtin_amdgcn_fence(__ATOMIC_ACQUIRE, "agent");
            xb_add(&bar[XB_XGEN(b.x)], 1u);
            asm volatile("s_waitcnt vmcnt(0)" ::: "memory");
        } else {
            XB_SPIN(xb_ld(&bar[XB_XGEN(b.x)]) == gen, bar);
            __builtin_amdgcn_fence(__ATOMIC_ACQUIRE, "agent");
            asm volatile("s_waitcnt vmcnt(0)" ::: "memory");
        }
    }
    __syncthreads();
}

struct Frame {
    LAS unsigned char* lds;
    int tid, lane, wave, G, gw, NGW;
    const float* in[26];
    float* out; unsigned char* ws;
};
#define WSP(type, off) ((type*)(F.ws + (off)))

DI void tr_item(const float* W, int ldw, int k0, int nsrc0, int nvalid, bf16* WT, int ldt, int drow0, const float* kscale, LAS float* scr, int lane) {
    const int nn = lane & 31;
#pragma unroll 8
    for (int i = 0; i < 32; ++i) { const int kk = 2 * i + (lane >> 5); float v = 0.f; if (nn < nvalid) v = W[(size_t)(k0 + kk) * ldw + nsrc0 + nn]; if (kscale) v *= kscale[k0 + kk]; scr[kk * 33 + nn] = v; }
    LDS_WAIT(); asm volatile("" ::: "memory");
    const int c = lane & 7;
#pragma unroll
    for (int j = 0; j < 4; ++j) { const int n = (lane >> 3) + 8 * j; const LAS float* s = scr + (8 * c) * 33 + n;
        u32x4 o; o.x = pk2(s[0 * 33], s[1 * 33]); o.y = pk2(s[2 * 33], s[3 * 33]); o.z = pk2(s[4 * 33], s[5 * 33]); o.w = pk2(s[6 * 33], s[7 * 33]);
        if (n < nvalid) *(u32x4*)(WT + (size_t)(drow0 + n) * ldt + k0 + 8 * c) = o; }
    LDS_WAIT(); asm volatile("" ::: "memory");
}
DI void tr_block(const float* W, int ldw, int K, int ncols, int nsrc0, bf16* WT, int ldt, int drow0, const float* kscale, LAS float* scr, int lane, int it) {
    const int nblk = (ncols + 31) / 32, kb = it / nblk, nb = it % nblk; const int nv = ncols - nb * 32 < 32 ? ncols - nb * 32 : 32;
    tr_item(W, ldw, kb * 64, nsrc0 + nb * 32, nv, WT, ldt, drow0 + nb * 32, kscale, scr, lane);
}
DI void tr64_item(const float* W, int ldw, int k0, int nsrc0, bf16* WT, int ldt, int drow0, const float* kscale, int lane) {
    const int n4 = lane & 15, kq = lane >> 4;
    f32x4 r[2][8];
#pragma unroll
    for (int hf = 0; hf < 2; ++hf)
#pragma unroll
        for (int i = 0; i < 8; ++i) r[hf][i] = *(const f32x4*)(W + (size_t)(k0 + hf * 32 + kq * 8 + i) * ldw + nsrc0 + n4 * 4);
#pragma unroll
    for (int hf = 0; hf < 2; ++hf) { const int kb = k0 + hf * 32 + kq * 8;
        if (kscale) { const f32x4 s0 = *(const f32x4*)(kscale + kb), s1 = *(const f32x4*)(kscale + kb + 4);
#pragma unroll
            for (int i = 0; i < 4; ++i) { r[hf][i] = r[hf][i] * s0[i]; r[hf][4 + i] = r[hf][4 + i] * s1[i]; } }
#pragma unroll
        for (int j = 0; j < 4; ++j) { u32x4 o; o.x = pk2(r[hf][0][j], r[hf][1][j]); o.y = pk2(r[hf][2][j], r[hf][3][j]); o.z = pk2(r[hf][4][j], r[hf][5][j]); o.w = pk2(r[hf][6][j], r[hf][7][j]);
            *(u32x4*)(WT + (size_t)(drow0 + n4 * 4 + j) * ldt + kb) = o; } }
}
DI void tr64_block(const float* W, int ldw, int K, int ncols, int nsrc0, bf16* WT, int ldt, int drow0, const float* kscale, int lane, int it) {
    const int nblk = ncols / 64, kb = it / nblk, nb = it % nblk;
    tr64_item(W, ldw, kb * 64, nsrc0 + nb * 64, WT, ldt, drow0 + nb * 64, kscale, lane);
}
DI void rms_row_bf16(const float* xrow, const float* w, bf16* orow, int lane) {
    const f32x4* xr = (const f32x4*)xrow + lane; const f32x4* wr4 = (const f32x4*)w + lane;
    f32x4 v[8]; float s = 0.f;
#pragma unroll
    for (int j = 0; j < 8; ++j) { v[j] = xr[64 * j]; s += (v[j].x * v[j].x + v[j].y * v[j].y) + (v[j].z * v[j].z + v[j].w * v[j].w); }
    const float rstd = 1.0f / sqrtf(wave_sum(s) * (1.0f / 2048.0f) + EPS);
    u32x2* o8 = (u32x2*)orow + lane;
#pragma unroll
    for (int j = 0; j < 8; ++j) { const f32x4 ww = wr4[64 * j]; u32x2 o; o.x = pk2(v[j].x * rstd * ww.x, v[j].y * rstd * ww.y); o.y = pk2(v[j].z * rstd * ww.z, v[j].w * rstd * ww.w); o8[64 * j] = o; }
}
DI void rms_rows(const Frame& F, const float* src, const float* w, bf16* dst, int rows) {
    for (int m = F.gw; m < rows; m += F.NGW) rms_row_bf16(src + (size_t)m * 2048, w, dst + (size_t)m * 2048, F.lane);
}

DI void p0_prologue(const Frame& F) {
    LAS float* scr = (LAS float*)(F.lds + F.wave * 16384);
    const float* w_in = F.in[3];
    bf16* WIN = WSP(bf16, WS_WIN_T);
    constexpr int KB = 32;
    constexpr int I_Z = 24 * KB, I_XBC = 40 * KB, I_QKV = 24 * KB, I_G = 64 * KB;
    constexpr int I_SSD = (1536 / 64) * (2048 / 64), I_SB = (512 / 64) * (2048 / 64), I_MIX = (2048 / 64) * (2048 / 64);
    constexpr int I_XQ = (2048 / 64) * (512 / 64), I_XO = (512 / 64) * (2048 / 64);
    constexpr int NITEMS = I_Z + I_XBC + I_QKV + I_G + I_SSD + I_SB + I_MIX + 3 * I_XQ + I_XO;
    for (int it = F.gw; it < NITEMS; it += F.NGW) {
        int r = it;
        if (r < I_Z)   { tr64_block(w_in, IN_COLS, 2048, 1536, 0,    WIN, 2048, 0,    nullptr, F.lane, r); continue; } r -= I_Z;
        if (r < I_XBC) { tr64_block(w_in, IN_COLS, 2048, 2560, 1536, WIN, 2048, 1536, nullptr, F.lane, r); continue; } r -= I_XBC;
        if (r < I_QKV) { tr64_block(w_in, IN_COLS, 2048, 1536, 4120, WIN, 2048, 4096, nullptr, F.lane, r); continue; } r -= I_QKV;
        if (r < I_G)   { tr64_block(w_in, IN_COLS, 2048, 4096, 5656, WIN, 2048, 5632, nullptr, F.lane, r); continue; } r -= I_G;
        if (r < I_SSD) { tr64_block(F.in[10], 2048, 1536, 2048, 0, WSP(bf16, WS_WCAT_T), 2048, 0, F.in[9], F.lane, r); continue; } r -= I_SSD;
        if (r < I_SB)  { tr64_block(F.in[11], 2048, 512,  2048, 0, WSP(bf16, WS_WCAT_T) + 1536, 2048, 0, nullptr, F.lane, r); continue; } r -= I_SB;
        if (r < I_MIX) { tr64_block(F.in[12], 2048, 2048, 2048, 0, WSP(bf16, WS_WMIX_T), 2048, 0, nullptr, F.lane, r); continue; } r -= I_MIX;
        if (r < I_XQ)  { tr64_block(F.in[15], 512, 2048, 512, 0, WSP(bf16, WS_WQ_T), 2048, 0, F.in[13], F.lane, r); continue; } r -= I_XQ;
        if (r < I_XQ)  { tr64_block(F.in[16], 512, 2048, 512, 0, WSP(bf16, WS_WK_T), 2048, 0, nullptr, F.lane, r); continue; } r -= I_XQ;
        if (r < I_XQ)  { tr64_block(F.in[17], 512, 2048, 512, 0, WSP(bf16, WS_WV_T), 2048, 0, nullptr, F.lane, r); continue; } r -= I_XQ;
        tr64_block(F.in[18], 2048, 512, 2048, 0, WSP(bf16, WS_WO_T), 512, 0, nullptr, F.lane, r);
    }
    constexpr int I_DT = 32, I_RG = 32, I_RE = 32;
    for (int it = F.gw; it < I_DT + I_RG + I_RE; it += F.NGW) {
        int r = it;
        if (r < I_DT)  { tr_block(w_in, IN_COLS, 2048, 24, 4096, WIN, 2048, 9728, nullptr, scr, F.lane, r); continue; } r -= I_DT;
        if (r < I_RG)  { tr_block(F.in[20], 4, 2048, 4, 0, WSP(bf16, WS_WR_T), 2048, 0, F.in[19], scr, F.lane, r); continue; } r -= I_RG;
        tr_block(F.in[21], 32, 2048, 32, 0, WSP(bf16, WS_WR_T), 2048, 4, F.in[19], scr, F.lane, r);
    }
    { const int gt = F.gw * 64 + F.lane, NT = F.NGW * 64;
      u32x4* z1 = (u32x4*)(WIN + (size_t)9752 * 2048); for (int i = gt; i < (IN_PAD - 9752) * 2048 / 8; i += NT) z1[i] = (u32x4){0u, 0u, 0u, 0u};
      u32x4* z2 = (u32x4*)(WSP(bf16, WS_WR_T) + (size_t)36 * 2048); for (int i = gt; i < 12 * 2048 / 8; i += NT) z2[i] = (u32x4){0u, 0u, 0u, 0u}; }
    rms_rows(F, F.in[0], F.in[2], WSP(bf16, WS_RA), T);
    rms_rows(F, F.in[1], F.in[14], WSP(bf16, WS_MEMN), BATCH * MEM);
}
DI void p_expert_weights(const Frame& F) {
    constexpr int PER = 256;
    for (int it = F.gw; it < NEXP * 3 * PER; it += F.NGW) {
        const int e = it / (3 * PER), r = it % (3 * PER), which = r / PER, q = r % PER;
        if (which < 2) { const int kb = q / 8, nb = q % 8, n0 = nb * 64; const float* W = (which == 0 ? F.in[22] : F.in[23]) + (size_t)e * 2048 * 512;
            tr64_item(W, 512, kb * 64, n0, WSP(bf16, WS_WGU_T) + (size_t)e * 1024 * 2048, 2048, (n0 / 128) * 256 + (n0 % 128) + which * 128, F.in[19], F.lane); }
        else { const int kb = q / 32, nb = q % 32; const float* W = F.in[24] + (size_t)e * 512 * 2048;
            tr64_item(W, 2048, kb * 64, nb * 64, WSP(bf16, WS_WD_T) + (size_t)e * 2048 * 512, 512, nb * 64, nullptr, F.lane); }
    }
}

template <int NT>
DI void wave_tile_gemm(const bf16* A, int lda, const bf16* Bt, int ldb, int K, int lane, f32x4 (&acc)[NT]) {
    const int fr = lane & 15, kg = lane >> 4;
#pragma unroll
    for (int n = 0; n < NT; ++n) acc[n] = (f32x4){0.f, 0.f, 0.f, 0.f};
    const bf16* ap = A + (size_t)fr * lda + kg * 8;
    const bf16* bp = Bt + (size_t)fr * ldb + kg * 8;
#pragma unroll 4
    for (int k0 = 0; k0 < K; k0 += 32) {
        const bf16x8 a = *(const bf16x8*)(ap + k0);
#pragma unroll
        for (int n = 0; n < NT; ++n) { const bf16x8 b = *(const bf16x8*)(bp + (size_t)n * 16 * ldb + k0); acc[n] = MFMA16(a, b, acc[n]); }
    }
}

DI void p_kv_mem(const Frame& F) {
    const bf16* MEMN = WSP(bf16, WS_MEMN);
    for (int u = F.gw; u < 512; u += F.NGW) {
        const int which = u >> 8, rt = (u & 255) >> 3, cg = u & 7; f32x4 acc[4];
        const bf16* Aop = which == 0 ? MEMN : WSP(bf16, WS_WV_T); const bf16* Bop = which == 0 ? WSP(bf16, WS_WK_T) : MEMN; bf16* O = which == 0 ? WSP(bf16, WS_KX) : WSP(bf16, WS_VXT);
        wave_tile_gemm<4>(Aop + (size_t)rt * 16 * 2048, 2048, Bop + (size_t)cg * 64 * 2048, 2048, 2048, F.lane, acc);
#pragma unroll
        for (int n = 0; n < 4; ++n)
#pragma unroll
            for (int i = 0; i < 4; ++i) O[(size_t)(rt * 16 + (F.lane >> 4) * 4 + i) * 512 + cg * 64 + n * 16 + (F.lane & 15)] = (bf16)(pk2(acc[n][i], 0.f) & 0xffffu);
    }
}

DI int spos(int s) { return (s & ~31) | (((s >> 2) & 3) << 3) | (((s >> 4) & 1) << 2) | (s & 3); }
template <bool CONV, bool NAT, bool TRN>
DI void conv_slab(const bf16* src, int pitch, int c0, size_t tok0, int s0, bool zero_halo, const float* cw, const float* cb, bf16* nat, bf16* trn, LAS unsigned char* tile, int lane) {
    constexpr int HALO = CONV ? 3 : 0, ROWS = 64 + HALO, TP = 144;
    const int rr = lane >> 3, cq = lane & 7;
#pragma unroll
    for (int i = 0; i < (ROWS + 7) / 8; ++i) { const int ri = 8 * i + rr;
        if (ri < ROWS) { u32x4 v = (u32x4){0u, 0u, 0u, 0u};
            if (!(zero_halo && ri < HALO)) v = *(const u32x4*)(src + (tok0 + s0 - HALO + ri) * (size_t)pitch + c0 + cq * 8);
            *(LAS u32x4*)(tile + ri * TP + cq * 16) = v; } }
    float wk[4][8], bs[8];
    if (CONV) {
#pragma unroll
        for (int k = 0; k < 4; ++k) { const f32x4 a = *(const f32x4*)(cw + k * CONV_DIM + c0 + cq * 8), b = *(const f32x4*)(cw + k * CONV_DIM + c0 + cq * 8 + 4);
            wk[k][0] = a[0]; wk[k][1] = a[1]; wk[k][2] = a[2]; wk[k][3] = a[3]; wk[k][4] = b[0]; wk[k][5] = b[1]; wk[k][6] = b[2]; wk[k][7] = b[3]; }
        const f32x4 a = *(const f32x4*)(cb + c0 + cq * 8), b = *(const f32x4*)(cb + c0 + cq * 8 + 4);
        bs[0] = a[0]; bs[1] = a[1]; bs[2] = a[2]; bs[3] = a[3]; bs[4] = b[0]; bs[5] = b[1]; bs[6] = b[2]; bs[7] = b[3];
    }
    LDS_WAIT();
    u32x4 ov[8];
#pragma unroll
    for (int i = 0; i < 8; ++i) { const int sloc = 8 * i + rr;
        if (CONV) { float o[8];
#pragma unroll
            for (int j = 0; j < 8; ++j) o[j] = bs[j];
#pragma unroll
            for (int k = 0; k < 4; ++k) { float f[8]; pg8::unpack8(*(const LAS u32x4*)(tile + (sloc + k) * TP + cq * 16), f);
#pragma unroll
                for (int j = 0; j < 8; ++j) o[j] += wk[k][j] * f[j]; }
#pragma unroll
            for (int j = 0; j < 8; ++j) o[j] = silu_f(o[j]);
            ov[i] = __builtin_bit_cast(u32x4, pack8(o)); }
        else ov[i] = *(const LAS u32x4*)(tile + sloc * TP + cq * 16);
        if (NAT) *(u32x4*)(nat + (tok0 + s0 + sloc) * 512 + cq * 8) = ov[i]; }
    if (TRN) {
        LDS_WAIT();
#pragma unroll
        for (int i = 0; i < 8; ++i) { const int p = spos(8 * i + rr);
            const unsigned w4[4] = {ov[i].x, ov[i].y, ov[i].z, ov[i].w};
#pragma unroll
            for (int j = 0; j < 8; ++j) *(LAS unsigned short*)(tile + (cq * 8 + j) * TP + p * 2) = (unsigned short)((j & 1) ? (w4[j >> 1] >> 16) : (w4[j >> 1] & 0xffffu)); }
        LDS_WAIT();
#pragma unroll
        for (int m = 0; m < 8; ++m) { const int cl = rr + 8 * m; *(u32x4*)(trn + (size_t)cl * 128 + s0 + cq * 8) = *(const LAS u32x4*)(tile + cl * TP + cq * 16); }
        LDS_WAIT();
    }
}
DI void p_conv(const Frame& F) {
    const bf16* XBC = WSP(bf16, WS_XBC); const bf16* QKV = WSP(bf16, WS_QKV);
    const float* cw = F.in[4]; const float* cb = F.in[5];
    bf16* XT = WSP(bf16, WS_XT); bf16* BT = WSP(bf16, WS_BT); bf16* BN = WSP(bf16, WS_BN); bf16* CN = WSP(bf16, WS_CN); bf16* VT = (bf16*)((unsigned char*)F.out + OUT_VT);
    LAS unsigned char* tile = F.lds + F.wave * 16384;
    for (int bc = blockIdx.x; bc < NCHUNK; bc += F.G) {
        const size_t tok0 = (size_t)bc * 128; const bool first = (bc % (SEQ / 128)) == 0;
#pragma unroll 1
        for (int task = F.wave; task < 96; task += NWAVES) {
            if (task < 80) { const int slab = task >> 1, hf = task & 1, c0 = slab * 64, s0 = hf * 64; const bool zh = first && hf == 0;
                if (slab < 24) conv_slab<true, false, true>(XBC, CONV_DIM, c0, tok0, s0, zh, cw, cb, nullptr, XT + ((size_t)bc * 1536 + c0) * 128, tile, F.lane);
                else if (slab < 32) conv_slab<true, true, true>(XBC, CONV_DIM, c0, tok0, s0, zh, cw, cb, BN + (c0 - 1536), BT + ((size_t)bc * 512 + (c0 - 1536)) * 128, tile, F.lane);
                else conv_slab<true, true, false>(XBC, CONV_DIM, c0, tok0, s0, zh, cw, cb, CN + (c0 - 2048), nullptr, tile, F.lane); }
            else { const int t2 = task - 80, slab = t2 >> 1, hf = t2 & 1, c0 = slab * 64;
                conv_slab<false, false, true>(QKV + 1024, 1536, c0, tok0, hf * 64, false, nullptr, nullptr, nullptr, VT + ((size_t)bc * 512 + c0) * 128, tile, F.lane); }
        }
        const float* DTRAW = WSP(float, WS_DTRAW); float* DTT = WSP(float, WS_DTT); float* ACT = WSP(float, WS_ACT); float* WL = WSP(float, WS_WL);
#pragma unroll 1
        for (int hh = 0; hh < 3; ++hh) { const int h = F.wave + 8 * hh; const float bias = F.in[6][h], a = -expf(F.in[7][h]);
            float dt2[2], c2[2];
#pragma unroll
            for (int j = 0; j < 2; ++j) { const float r = DTRAW[(size_t)(tok0 + 2 * F.lane + j) * 32 + h] + bias; dt2[j] = fmaxf(r, 0.f) + log1pf(expf(-fabsf(r))); }
            c2[0] = dt2[0] * a; c2[1] = c2[0] + dt2[1] * a;
            float sc = c2[1];
#pragma unroll
            for (int o = 1; o < 64; o <<= 1) { const float t = __shfl_up(sc, o); if (F.lane >= o) sc += t; }
            const float ex = sc - c2[1]; const float alast = __shfl(sc, 63);
            const float ac0 = ex + c2[0], ac1 = ex + c2[1];
            *(f32x2*)(DTT + ((size_t)bc * 24 + h) * 128 + 2 * F.lane) = (f32x2){dt2[0], dt2[1]};
            *(f32x2*)(ACT + ((size_t)bc * 24 + h) * 128 + 2 * F.lane) = (f32x2){ac0, ac1};
            *(f32x2*)(WL + ((size_t)bc * 24 + h) * 128 + spos(2 * F.lane)) = (f32x2){dt2[0] * __expf(alast - ac0), dt2[1] * __expf(alast - ac1)};
        }
    }
}

DI void p_ssd_local(const Frame& F) {
    const bf16* XT = WSP(bf16, WS_XT); const bf16* BT = WSP(bf16, WS_BT); const float* WL = WSP(float, WS_WL);
    bf16* STATE = (bf16*)((unsigned char*)F.out + OUT_STATE);
    const int lane = F.lane, fr = lane & 15, kg = lane >> 4;
    for (int u = F.gw; u < NCHUNK * SSD_HEADS; u += F.NGW) {
        const int bc = u / SSD_HEADS, h = u % SSD_HEADS, g = h / 6;
        const float* wlp = WL + ((size_t)bc * 24 + h) * 128 + kg * 8;
        const bf16* xp = XT + ((size_t)bc * 1536 + h * 64 + fr) * 128 + kg * 8;
        const bf16* bp = BT + ((size_t)bc * 512 + g * 128 + fr) * 128 + kg * 8;
        u32x4 xr[4][4]; f32x4 wv[4][2];
#pragma unroll
        for (int k = 0; k < 4; ++k) { wv[k][0] = *(const f32x4*)(wlp + k * 32); wv[k][1] = *(const f32x4*)(wlp + k * 32 + 4);
#pragma unroll
            for (int pt = 0; pt < 4; ++pt) xr[pt][k] = *(const u32x4*)(xp + (size_t)pt * 16 * 128 + k * 32); }
        bf16x8 xs[4][4];
#pragma unroll
        for (int k = 0; k < 4; ++k)
#pragma unroll
            for (int pt = 0; pt < 4; ++pt) { float f[8]; pg8::unpack8(xr[pt][k], f);
#pragma unroll
                for (int j = 0; j < 4; ++j) { f[j] *= wv[k][0][j]; f[4 + j] *= wv[k][1][j]; }
                xs[pt][k] = pack8(f); }
        bf16* st = STATE + ((size_t)bc * 24 + h) * 8192;
#pragma unroll 1
        for (int nh = 0; nh < 2; ++nh) {
            bf16x8 bfr[4][4];
#pragma unroll
            for (int nt = 0; nt < 4; ++nt)
#pragma unroll
                for (int k = 0; k < 4; ++k) bfr[nt][k] = *(const bf16x8*)(bp + (size_t)(nh * 64 + nt * 16) * 128 + k * 32);
            f32x4 acc[4][4];
#pragma unroll
            for (int a = 0; a < 4; ++a)
#pragma unroll
                for (int b = 0; b < 4; ++b) acc[a][b] = (f32x4){0.f, 0.f, 0.f, 0.f};
#pragma unroll
            for (int k = 0; k < 4; ++k)
#pragma unroll
                for (int nt = 0; nt < 4; ++nt)
#pragma unroll
                    for (int pt = 0; pt < 4; ++pt) acc[nt][pt] = MFMA16(bfr[nt][k], xs[pt][k], acc[nt][pt]);
#pragma unroll
            for (int nt = 0; nt < 4; ++nt)
#pragma unroll
                for (int pt = 0; pt < 4; ++pt) { u32x2 w; w.x = pk2(acc[nt][pt][0], acc[nt][pt][1]); w.y = pk2(acc[nt][pt][2], acc[nt][pt][3]);
                    *(u32x2*)(st + (size_t)(pt * 16 + fr) * 128 + nh * 64 + nt * 16 + kg * 4) = w; }
        }
    }
}

DI void p_sb_attn(const Frame& F) {
    const bf16* QKV = WSP(bf16, WS_QKV); const bf16* VT = (const bf16*)((const unsigned char*)F.out + OUT_VT); bf16* YSB = WSP(bf16, WS_RA);
    const int lane = F.lane, fr = lane & 15, kg = lane >> 4;
    const float scale = 0.08838834764831845f;
    for (int u = F.gw; u < BATCH * SB_H * (SEQ / 16); u += F.NGW) {
        const int bh = u / (SEQ / 16), strip = u % (SEQ / 16), b = bh / SB_H, h = bh % SB_H;
        const int q0 = strip * 16, t = q0 + fr; const size_t tb = (size_t)b * SEQ;
        bf16x8 qf[4];
#pragma unroll
        for (int k = 0; k < 4; ++k) qf[k] = *(const bf16x8*)(QKV + (tb + t) * 1536 + h * 128 + k * 32 + kg * 8);
        f32x4 o[8];
#pragma unroll
        for (int d = 0; d < 8; ++d) o[d] = (f32x4){0.f, 0.f, 0.f, 0.f};
        float R = 0.f;
#pragma unroll 1
        for (int kb = q0 >> 5; kb >= 0; --kb) {
            const int sb = kb * 32;
            f32x4 z[2];
#pragma unroll
            for (int st = 0; st < 2; ++st) { z[st] = (f32x4){0.f, 0.f, 0.f, 0.f};
                const bf16* kp = QKV + (tb + sb + st * 16 + fr) * 1536 + 512 + h * 128 + kg * 8;
#pragma unroll
                for (int k = 0; k < 4; ++k) z[st] = MFMA16(*(const bf16x8*)(kp + k * 32), qf[k], z[st]); }
            float lb[2][4], lk[2][4], tot[2];
#pragma unroll
            for (int st = 0; st < 2; ++st) { tot[st] = 0.f;
#pragma unroll
                for (int i = 0; i < 4; ++i) { const int s = sb + st * 16 + kg * 4 + i; const float zz = z[st][i] * scale;
                    const float l = fminf(zz, 0.f) - log1pf(__expf(-fabsf(zz)));
                    lb[st][i] = l; lk[st][i] = (s < t) ? (l - zz) : 0.f; tot[st] += lk[st][i]; } }
            float hi[2], all[2];
#pragma unroll
            for (int st = 0; st < 2; ++st) { const float t1 = __shfl_xor(tot[st], 16), t2 = __shfl_xor(tot[st], 32), t3 = __shfl_xor(tot[st], 48);
                all[st] = tot[st] + t1 + t2 + t3;
                hi[st] = (((kg ^ 1) > kg) ? t1 : 0.f) + (((kg ^ 2) > kg) ? t2 : 0.f) + (((kg ^ 3) > kg) ? t3 : 0.f); }
            float att[8];
#pragma unroll
            for (int st = 0; st < 2; ++st) { const float base = R + hi[st] + (st == 0 ? all[1] : 0.f);
                float suf = 0.f;
#pragma unroll
                for (int i = 3; i >= 0; --i) { const int s = sb + st * 16 + kg * 4 + i; att[st * 4 + i] = (s < t) ? __expf(lb[st][i] + base + suf) : 0.f; suf += lk[st][i]; } }
            R += all[0] + all[1];
            const bf16x8 pf = pack8(att);
            const int bcv = (int)((tb + sb) >> 7), sl = (sb & 127) + kg * 8;
#pragma unroll
            for (int d = 0; d < 8; ++d) { const bf16x8 vf = *(const bf16x8*)(VT + ((size_t)bcv * 512 + h * 128 + d * 16 + fr) * 128 + sl);
                o[d] = MFMA16(vf, pf, o[d]); }
            if (__all(R < -30.0f)) break;
        }
#pragma unroll
        for (int d = 0; d < 8; ++d) { u32x2 w; w.x = pk2(o[d][0], o[d][1]); w.y = pk2(o[d][2], o[d][3]);
            *(u32x2*)(YSB + (tb + t) * 2048 + 1536 + h * 128 + d * 16 + kg * 4) = w; }
    }
}

DI void p_ssd_scan(const Frame& F) {
    bf16* STATE = (bf16*)((unsigned char*)F.out + OUT_STATE); const float* ACT = WSP(float, WS_ACT);
    const int gt = blockIdx.x * 512 + F.tid, NT = F.G * 512;
    for (int e = gt; e < BATCH * SSD_HEADS * 2048; e += NT) {
        const int v4 = e & 2047, bh = e >> 11, b = bh / SSD_HEADS, h = bh % SSD_HEADS;
        f32x4 run = (f32x4){0.f, 0.f, 0.f, 0.f};
        for (int c0 = 0; c0 < 128; c0 += 8) {
            u32x2 tmp[8]; float dec[8];
#pragma unroll
            for (int j = 0; j < 8; ++j) { const size_t bc = (size_t)b * 128 + c0 + j; tmp[j] = *(const u32x2*)(STATE + (bc * 24 + h) * 8192 + v4 * 4); dec[j] = __expf(ACT[(bc * 24 + h) * 128 + 127]); }
#pragma unroll
            for (int j = 0; j < 8; ++j) { const size_t bc = (size_t)b * 128 + c0 + j;
                u32x2 w; w.x = pk2(run[0], run[1]); w.y = pk2(run[2], run[3]); *(u32x2*)(STATE + (bc * 24 + h) * 8192 + v4 * 4) = w;
                const f32x4 t4 = (f32x4){__uint_as_float(tmp[j].x << 16), __uint_as_float(tmp[j].x & 0xffff0000u), __uint_as_float(tmp[j].y << 16), __uint_as_float(tmp[j].y & 0xffff0000u)};
                run = run * dec[j] + t4; }
        }
    }
}

DI int cb_off(int t, int s) { return t * 256 + ((((s >> 2) ^ (2 * (t & 15))) << 3) | ((s & 3) << 1)); }
constexpr int SSQ_OFF = RING_BYTES + 1024, TAB_OFF = RING_BYTES + 5120;
DI void p_ssd_out(const Frame& F) {
    const bf16* XT = WSP(bf16, WS_XT); const bf16* BN = WSP(bf16, WS_BN); const bf16* CN = WSP(bf16, WS_CN); const bf16* Z = WSP(bf16, WS_Z);
    const float* DTT = WSP(float, WS_DTT); const float* ACT = WSP(float, WS_ACT); const bf16* STATE = (const bf16*)((const unsigned char*)F.out + OUT_STATE);
    bf16* YG = WSP(bf16, WS_RA); float* RSTD = WSP(float, WS_RSTD);
    const float* dskip = F.in[8];
    const int lane = F.lane, fr = lane & 15, kg = lane >> 4, w = F.wave, g = w >> 1;
    LAS unsigned char* cbl = F.lds + g * 32768;
    LAS float* tab = (LAS float*)(F.lds + TAB_OFF + w * 1024);
    LAS float* ssqp = (LAS float*)(F.lds + SSQ_OFF);
    for (int bc = blockIdx.x; bc < NCHUNK; bc += F.G) {
        const size_t tok0 = (size_t)bc * 128;
        REP(22)
#pragma unroll 1
        for (int q = 0; q < 4; ++q) { const int tt = (w & 1) + 2 * q;
            bf16x8 cf[4];
#pragma unroll
            for (int k = 0; k < 4; ++k) cf[k] = *(const bf16x8*)(CN + (tok0 + tt * 16 + fr) * 512 + g * 128 + k * 32 + kg * 8);
#pragma unroll 1
            for (int st = 0; st <= tt; ++st) { f32x4 X = (f32x4){0.f, 0.f, 0.f, 0.f}; const bf16* bp = BN + (tok0 + st * 16 + fr) * 512 + g * 128 + kg * 8;
#pragma unroll
                for (int k = 0; k < 4; ++k) X = MFMA16(*(const bf16x8*)(bp + k * 32), cf[k], X);
                u32x2 pw; pw.x = pk2(X[0], X[1]); pw.y = pk2(X[2], X[3]);
                *(LAS u32x2*)(cbl + cb_off(tt * 16 + fr, st * 16 + kg * 4)) = pw; } }
        __syncthreads();
        REP(23) {
        ssqp[w * 128 + lane] = 0.f; ssqp[w * 128 + 64 + lane] = 0.f;
#pragma unroll 1
        for (int r = 0; r < 3; ++r) {
            const int h = 3 * w + r; const float dsk = dskip[h];
            { const f32x2 d2 = *(const f32x2*)(DTT + ((size_t)bc * 24 + h) * 128 + 2 * lane), a2 = *(const f32x2*)(ACT + ((size_t)bc * 24 + h) * 128 + 2 * lane);
              *(LAS f32x2*)(tab + 2 * lane) = d2; *(LAS f32x2*)(tab + 128 + 2 * lane) = a2; }
            bf16x8 sf[4][4], xf0[4], xfA[4];
            const bf16* xbase = XT + ((size_t)bc * 1536 + h * 64) * 128;
            { unsigned so = (unsigned)(fr * 128 + kg * 8); asm volatile("" : "+v"(so));
              const bf16* sp0 = STATE + ((size_t)bc * 24 + h) * 8192;
#pragma unroll
              for (int pt = 0; pt < 4; ++pt) {
#pragma unroll
                  for (int k = 0; k < 4; ++k) sf[pt][k] = *(const bf16x8*)(sp0 + (so + (unsigned)(pt * 2048 + k * 32)));
                  xf0[pt] = *(const bf16x8*)(xbase + (so + (unsigned)(pt * 2048))); } }
            LDS_WAIT();
#define SSD_STEP(SP, XF) do { float mv[8]; \
        _Pragma("unroll") for (int half = 0; half < 2; ++half) { const int sbase = 32 * (SP) + 16 * half + kg * 4; \
            const u32x2 cbv = *(const LAS u32x2*)(cbl + cb_off(tl, sbase)); \
            const f32x4 dv = *(const LAS f32x4*)(tab + sbase), av = *(const LAS f32x4*)(tab + 128 + sbase); \
            const float cbf[4] = {__uint_as_float(cbv.x << 16), __uint_as_float(cbv.x & 0xffff0000u), __uint_as_float(cbv.y << 16), __uint_as_float(cbv.y & 0xffff0000u)}; \
            _Pragma("unroll") for (int i = 0; i < 4; ++i) { const int s_ = sbase + i; float v = 0.f; \
                if (s_ <= tl) v = cbf[i] * dv[i] * __expf(acum_t - av[i]); \
                if (s_ == tl) v += dsk; \
                mv[half * 4 + i] = v; } } \
        const bf16x8 mf = pack8(mv); \
        _Pragma("unroll") for (int pt = 0; pt < 4; ++pt) acc[pt] = MFMA16(XF[pt], mf, acc[pt]); } while (0)
#define SSD_LOADX(XF, SP) do { unsigned xo_ = (unsigned)(fr * 128 + kg * 8 + 32 * (SP)); asm volatile("" : "+v"(xo_)); \
        _Pragma("unroll") for (int pt = 0; pt < 4; ++pt) XF[pt] = *(const bf16x8*)(xbase + (xo_ + (unsigned)(pt * 2048))); } while (0)
#pragma unroll 1
            for (int tt = 0; tt < 8; ++tt) {
                int frx = fr; asm volatile("" : "+v"(frx));
                const int tl = tt * 16 + frx; const size_t tok = tok0 + tl; float ssq = 0.f;
                bf16x8 cf[4]; u32x2 zr[4];
                if (tt >= 2) SSD_LOADX(xfA, 1);
                const float acum_t = tab[128 + tl];
                f32x4 acc[4];
#pragma unroll
                for (int pt = 0; pt < 4; ++pt) acc[pt] = (f32x4){0.f, 0.f, 0.f, 0.f};
                SSD_STEP(0, xf0);
#pragma unroll
                for (int k = 0; k < 4; ++k) cf[k] = *(const bf16x8*)(CN + tok * 512 + g * 128 + k * 32 + kg * 8);
                if (tt >= 2) { SSD_STEP(1, xfA); if (tt >= 4) SSD_LOADX(xfA, 2); }
                if (tt >= 4) { SSD_STEP(2, xfA); if (tt >= 6) SSD_LOADX(xfA, 3); }
                if (tt >= 6) { SSD_STEP(3, xfA); }
#pragma unroll
                for (int pt = 0; pt < 4; ++pt) zr[pt] = *(const u32x2*)(Z + tok * 1536 + h * 64 + pt * 16 + kg * 4);
                { f32x4 ao[4];
#pragma unroll
                  for (int pt = 0; pt < 4; ++pt) ao[pt] = (f32x4){0.f, 0.f, 0.f, 0.f};
#pragma unroll
                  for (int k = 0; k < 4; ++k)
#pragma unroll
                      for (int pt = 0; pt < 4; ++pt) ao[pt] = MFMA16(sf[pt][k], cf[k], ao[pt]);
                  const float e = __expf(acum_t);
#pragma unroll
                  for (int pt = 0; pt < 4; ++pt) acc[pt] = ao[pt] * e + acc[pt]; }
#pragma unroll
                for (int pt = 0; pt < 4; ++pt) { const int col = h * 64 + pt * 16 + kg * 4;
                    const float z0 = __uint_as_float(zr[pt].x << 16), z1 = __uint_as_float(zr[pt].x & 0xffff0000u), z2 = __uint_as_float(zr[pt].y << 16), z3 = __uint_as_float(zr[pt].y & 0xffff0000u);
                    const float y0 = acc[pt][0] * silu_f(z0), y1 = acc[pt][1] * silu_f(z1), y2 = acc[pt][2] * silu_f(z2), y3 = acc[pt][3] * silu_f(z3);
                    ssq += (y0 * y0 + y1 * y1) + (y2 * y2 + y3 * y3);
                    u32x2 wv; wv.x = pk2(y0, y1); wv.y = pk2(y2, y3); *(u32x2*)(YG + tok * 2048 + col) = wv; }
                ssq += __shfl_xor(ssq, 16); ssq += __shfl_xor(ssq, 32);
                if (kg == 0) ssqp[w * 128 + tl] += ssq;
            }
            LDS_WAIT();
        }
        }
#undef SSD_STEP
#undef SSD_LOADX
        __syncthreads();
        if (F.tid < 128) { float v = 0.f;
#pragma unroll
            for (int ww = 0; ww < 8; ++ww) v += ssqp[ww * 128 + F.tid];
            RSTD[tok0 + F.tid] = 1.0f / sqrtf(v * (1.0f / 1536.0f) + EPS); }
        __syncthreads();
    }
}

DI void p_xattn(const Frame& F) {
    const bf16* Q2 = WSP(bf16, WS_Q2); const bf16* KX = WSP(bf16, WS_KX); const bf16* VXT = WSP(bf16, WS_VXT); bf16* O2 = WSP(bf16, WS_O2);
    const int lane = F.lane, fr = lane & 15, kg = lane >> 4;
    const float scale = 0.08838834764831845f;
    LAS unsigned char* kl = F.lds; LAS unsigned char* vl = F.lds + 65536;
    for (int task = blockIdx.x; task < 256; task += F.G) {
        const int bh = task >> 5, b = bh >> 2, h = bh & 3;
        __syncthreads();
#pragma unroll
        for (int i = 0; i < 8; ++i) { const int id = F.tid + 512 * i;
            { const int m = id >> 4, c = id & 15; *(LAS u32x4*)(kl + m * 256 + ((c ^ (m & 15)) << 4)) = *(const u32x4*)(KX + ((size_t)b * 256 + m) * 512 + h * 128 + c * 8); }
            { const int d = id >> 5, mc = id & 31, blk = mc >> 2, h2 = (mc >> 1) & 1, q = 2 * (mc & 1);
              const u32x4 v = *(const u32x4*)(VXT + ((size_t)h * 128 + d) * 512 + b * 256 + mc * 8);
              *(LAS u32x2*)(vl + d * 512 + (((blk * 4 + q) ^ (d & 15)) << 4) + 8 * h2) = (u32x2){v.x, v.y};
              *(LAS u32x2*)(vl + d * 512 + (((blk * 4 + q + 1) ^ (d & 15)) << 4) + 8 * h2) = (u32x2){v.z, v.w}; } }
        __syncthreads();
#pragma unroll 1
        for (int si = 0; si < 4; ++si) {
            const int strip = (task & 31) * 32 + F.wave * 4 + si;
            const size_t tok = (size_t)b * SEQ + strip * 16 + fr;
            bf16x8 qf[4];
#pragma unroll
            for (int k = 0; k < 4; ++k) qf[k] = *(const bf16x8*)(Q2 + tok * 512 + h * 128 + k * 32 + kg * 8);
            f32x4 sc[16];
#pragma unroll
            for (int mt = 0; mt < 16; ++mt) { sc[mt] = (f32x4){0.f, 0.f, 0.f, 0.f};
#pragma unroll
                for (int k = 0; k < 4; ++k) sc[mt] = MFMA16(*(const LAS bf16x8*)(kl + (mt * 16 + fr) * 256 + (((k * 4 + kg) ^ fr) << 4)), qf[k], sc[mt]);
                if (mt & 1) __builtin_amdgcn_sched_barrier(0); }
            float mx = -3.0e38f;
#pragma unroll
            for (int mt = 0; mt < 16; ++mt)
#pragma unroll
                for (int i = 0; i < 4; ++i) { sc[mt][i] *= scale; mx = fmaxf(mx, sc[mt][i]); }
            mx = fmaxf(mx, __shfl_xor(mx, 16)); mx = fmaxf(mx, __shfl_xor(mx, 32));
            float sum = 0.f;
#pragma unroll
            for (int mt = 0; mt < 16; ++mt)
#pragma unroll
                for (int i = 0; i < 4; ++i) { const float p = __expf(sc[mt][i] - mx); sc[mt][i] = p; sum += p; }
            sum += __shfl_xor(sum, 16); sum += __shfl_xor(sum, 32);
            const float inv = __builtin_amdgcn_rcpf(sum);
            f32x4 o[8];
#pragma unroll
            for (int d = 0; d < 8; ++d) o[d] = (f32x4){0.f, 0.f, 0.f, 0.f};
#pragma unroll
            for (int q = 0; q < 8; ++q) {
                float pv[8];
#pragma unroll
                for (int i = 0; i < 4; ++i) { pv[i] = sc[2 * q][i] * inv; pv[4 + i] = sc[2 * q + 1][i] * inv; }
                const bf16x8 pf = pack8(pv);
#pragma unroll
                for (int d = 0; d < 8; ++d) o[d] = MFMA16(*(const LAS bf16x8*)(vl + (d * 16 + fr) * 512 + (((q * 4 + kg) ^ fr) << 4)), pf, o[d]);
                __builtin_amdgcn_sched_barrier(0);
            }
#pragma unroll
            for (int d = 0; d < 8; ++d) { u32x2 w; w.x = pk2(o[d][0], o[d][1]); w.y = pk2(o[d][2], o[d][3]);
                *(u32x2*)(O2 + tok * 512 + h * 128 + d * 16 + kg * 4) = w; }
        }
    }
    __syncthreads();
}

DI void p_router(const Frame& F) {
    const bf16* HB = WSP(bf16, WS_RA); const bf16* WR = WSP(bf16, WS_WR_T); const float* SSQ2 = WSP(float, WS_SSQ2);
    int* TI = WSP(int, WS_TI); float* TG = WSP(float, WS_TG); unsigned* ecnt = WSP(unsigned, WS_CTL) + CW_ECNT;
    const int lane = F.lane, fr = lane & 15, kg = lane >> 4;
    LAS unsigned char* bl = F.lds; LAS float* lg = (LAS float*)(F.lds + 65536); LAS unsigned* lcnt = (LAS unsigned*)(F.lds + 65536 + 24576);
    for (int task = blockIdx.x; task < T / 128; task += F.G) {
        const size_t tok0 = (size_t)task * 128;
        f32x4 acc[3];
#pragma unroll
        for (int n = 0; n < 3; ++n) acc[n] = (f32x4){0.f, 0.f, 0.f, 0.f};
#pragma unroll 1
        for (int kc = 0; kc < 4; ++kc) {
            __syncthreads();
#pragma unroll
            for (int i = 0; i < 6; ++i) { const int id = F.tid + 512 * i, row = id >> 6, c = id & 63;
                *(LAS u32x4*)(bl + row * 1024 + ((c ^ (row & 15)) << 4)) = *(const u32x4*)(WR + (size_t)row * 2048 + kc * 512 + c * 8); }
            bf16x8 af[16];
            const bf16* ap = HB + (tok0 + F.wave * 16 + fr) * 2048 + kc * 512 + kg * 8;
#pragma unroll
            for (int ks = 0; ks < 16; ++ks) af[ks] = *(const bf16x8*)(ap + ks * 32);
            __syncthreads();
#pragma unroll
            for (int ks = 0; ks < 16; ++ks) {
#pragma unroll
                for (int n = 0; n < 3; ++n) acc[n] = MFMA16(af[ks], *(const LAS bf16x8*)(bl + (n * 16 + fr) * 1024 + (((ks * 4 + kg) ^ fr) << 4)), acc[n]);
                if ((ks & 3) == 3) __builtin_amdgcn_sched_barrier(0); }
        }
        if (F.tid < 64) lcnt[F.tid] = 0u;
#pragma unroll
        for (int i = 0; i < 4; ++i) { const int rl = F.wave * 16 + kg * 4 + i; const float rs = rstd32(SSQ2 + (tok0 + rl) * 32);
#pragma unroll
            for (int n = 0; n < 3; ++n) lg[rl * 48 + n * 16 + fr] = acc[n][i] * rs; }
        __syncthreads();
        unsigned lp1 = 0, lp2 = 0; int ex1 = 0, ex2 = 0; float w1 = 0.f, w2 = 0.f, ggate = 0.f;
        if (F.tid < 128) {
            const LAS float* l = lg + F.tid * 48;
            float gl[4] = {l[0], l[1], l[2], l[3]};
            int gs = 0; float gm = gl[0];
#pragma unroll
            for (int j = 1; j < 4; ++j) if (gl[j] > gm) { gm = gl[j]; gs = j; }
            float den = 0.f;
#pragma unroll
            for (int j = 0; j < 4; ++j) den += expf(gl[j] - gm);
            ggate = 1.0f / den;
            float el[8];
#pragma unroll
            for (int j = 0; j < 8; ++j) el[j] = l[4 + gs * 8 + j];
            int i1 = 0; float v1 = el[0];
#pragma unroll
            for (int j = 1; j < 8; ++j) if (el[j] > v1) { v1 = el[j]; i1 = j; }
            int i2 = -1; float v2 = -3.0e38f;
#pragma unroll
            for (int j = 0; j < 8; ++j) if (j != i1 && el[j] > v2) { v2 = el[j]; i2 = j; }
            const float e2 = expf(v2 - v1); w1 = 1.0f / (1.0f + e2); w2 = e2 / (1.0f + e2);
            ex1 = gs * 8 + i1; ex2 = gs * 8 + i2;
            lp1 = atomicAdd((unsigned*)&lcnt[ex1], 1u); lp2 = atomicAdd((unsigned*)&lcnt[ex2], 1u);
        }
        __syncthreads();
        if (F.tid < 32) lcnt[32 + F.tid] = __hip_atomic_fetch_add(ecnt + F.tid, lcnt[F.tid], __ATOMIC_RELAXED, __HIP_MEMORY_SCOPE_AGENT);
        __syncthreads();
        if (F.tid < 128) { const int t = (int)tok0 + F.tid;
            TI[t * 4 + 0] = ex1; TI[t * 4 + 1] = (int)(lcnt[32 + ex1] + lp1); TI[t * 4 + 2] = ex2; TI[t * 4 + 3] = (int)(lcnt[32 + ex2] + lp2);
            TG[t * 2 + 0] = w1 * ggate; TG[t * 2 + 1] = w2 * ggate; }
    }
    __syncthreads();
}
DI void p_route_b(const Frame& F) {
    const int* TI = WSP(int, WS_TI); int* TSLOT = WSP(int, WS_TSLOT); int* SLOTTOK = WSP(int, WS_SLOTTOK); int* TILEE = WSP(int, WS_TILEE);
    unsigned* ecnt = WSP(unsigned, WS_CTL) + CW_ECNT; const float* SSQ2 = WSP(float, WS_SSQ2); float* SRSTD = WSP(float, WS_SRSTD);
    LAS int* st = (LAS int*)(F.lds);
    if (F.tid < 32) st[64 + F.tid] = (int)__hip_atomic_load(ecnt + F.tid, __ATOMIC_RELAXED, __HIP_MEMORY_SCOPE_AGENT);
    __syncthreads();
    if (F.tid == 0) { int s = 0; for (int e = 0; e < 32; ++e) { st[e] = s; s += (st[64 + e] + 255) / 256 * 256; } st[32] = s; }
    __syncthreads();
    for (int t = blockIdx.x * 512 + F.tid; t < T; t += F.G * 512) {
        const int e1 = TI[t * 4 + 0], p1 = TI[t * 4 + 1], e2 = TI[t * 4 + 2], p2 = TI[t * 4 + 3];
        const int s1 = st[e1] + p1, s2 = st[e2] + p2;
        SLOTTOK[s1] = t; SLOTTOK[s2] = t; TSLOT[t * 2] = s1; TSLOT[t * 2 + 1] = s2;
        const float rs = rstd32(SSQ2 + (size_t)t * 32); SRSTD[s1] = rs; SRSTD[s2] = rs;
    }
    for (int e = blockIdx.x; e < 32; e += F.G) {
        const int a = st[e] + st[64 + e], bnd = st[e + 1];
        for (int s = a + F.tid; s < bnd; s += 512) { SLOTTOK[s] = 0; SRSTD[s] = 0.f; }
        for (int tl = st[e] / 256 + F.tid; tl < bnd / 256; tl += 512) TILEE[tl] = e;
    }
    if (blockIdx.x == 0 && F.tid == 0) TILEE[511] = st[32] / 256;
    __syncthreads();
}

DI void p_final(const Frame& F) {
    const bf16* Y = WSP(bf16, WS_Y); const int* TSLOT = WSP(int, WS_TSLOT); const float* TG = WSP(float, WS_TG); const float* w = F.in[25];
    for (int m = F.gw; m < T; m += F.NGW) {
        const int s1 = TSLOT[m * 2], s2 = TSLOT[m * 2 + 1]; const float g1 = TG[m * 2], g2 = TG[m * 2 + 1];
        f32x4* xr = (f32x4*)(F.out + (size_t)m * 2048) + F.lane; const u32x2* y1 = (const u32x2*)(Y + (size_t)s1 * 2048) + F.lane; const u32x2* y2 = (const u32x2*)(Y + (size_t)s2 * 2048) + F.lane;
        f32x4 v[8]; float s = 0.f;
#pragma unroll
        for (int j = 0; j < 8; ++j) { v[j] = xr[64 * j]; const u32x2 a = y1[64 * j], b = y2[64 * j];
            v[j].x += g1 * __uint_as_float(a.x << 16) + g2 * __uint_as_float(b.x << 16); v[j].y += g1 * __uint_as_float(a.x & 0xffff0000u) + g2 * __uint_as_float(b.x & 0xffff0000u);
            v[j].z += g1 * __uint_as_float(a.y << 16) + g2 * __uint_as_float(b.y << 16); v[j].w += g1 * __uint_as_float(a.y & 0xffff0000u) + g2 * __uint_as_float(b.y & 0xffff0000u);
            s += (v[j].x * v[j].x + v[j].y * v[j].y) + (v[j].z * v[j].z + v[j].w * v[j].w); }
        const float rstd = 1.0f / sqrtf(wave_sum(s) * (1.0f / 2048.0f) + EPS);
        const f32x4* wr4 = (const f32x4*)w + F.lane;
#pragma unroll
        for (int j = 0; j < 8; ++j) { const f32x4 ww = wr4[64 * j]; xr[64 * j] = v[j] * rstd * ww; }
    }
}

constexpr int NPHASE = 20;
struct Args { const float* in[26]; float* out; unsigned char* ws; int ph_lo, ph_hi; };
__global__ void __launch_bounds__(NWAVES * 64, 2) fwd(Args args) {
    extern __shared__ __attribute__((aligned(16))) unsigned char lds[];
    Frame F;
    F.lds = (LAS unsigned char*)lds;
    F.tid = threadIdx.x; F.lane = F.tid & 63; F.wave = __builtin_amdgcn_readfirstlane(F.tid >> 6);
    F.G = gridDim.x; F.gw = blockIdx.x * NWAVES + F.wave; F.NGW = F.G * NWAVES;
#pragma unroll
    for (int i = 0; i < 26; ++i) F.in[i] = args.in[i];
    F.out = args.out; F.ws = args.ws;
    volatile LAS unsigned* MISC = (volatile LAS unsigned*)(F.lds + MISC_OFF);
    for (int u = F.tid; u < (LDS_BYTES - RING_BYTES) / 4; u += NWAVES * 64) ((LAS unsigned*)(F.lds + RING_BYTES))[u] = 0u;
    __syncthreads();
    const int lo = args.ph_lo, hi = args.ph_hi;
    const bool one = (hi - lo) > 1;
    XcdBarrier bar; bar.bar = WSP(unsigned, WS_CTL) + CW_BAR; bar.x = 0; bar.st = nullptr;
    if (one) bar = xcd_barrier_post(WSP(unsigned, WS_CTL) + CW_BAR, MISC + 8);
#define IN(k) (lo <= (k) && (k) < hi)
#define SEAM(k) do { if (lo <= (k) && (k) + 1 < hi) xcd_barrier(bar); } while (0)
    LAS unsigned char* ring = F.lds;
    const int bx = blockIdx.x;
    const int vcu = (F.G % 8 == 0) ? (bx % 8) * (F.G / 8) + bx / 8 : bx;

    if (IN(0)) REP(0) { p0_prologue(F); SEAM(0); }
    if (IN(1)) REP(1) {
        pg8::Gemm g{WSP(bf16, WS_RA), WSP(bf16, WS_WIN_T), 2048, 2048, 2048, nullptr, nullptr, 0};
        pg8::StaticOrder S; S.init(T, IN_PAD, 2048, F.G, bx);
        pg8::EpiInProj E{WSP(bf16, WS_Z), WSP(bf16, WS_XBC), WSP(bf16, WS_QKV), WSP(bf16, WS_GATES), WSP(float, WS_DTRAW)};
        pg8::gemm_phase<pg8::EpiInProj, pg8::StaticOrder, true, false>(ring, g, S, E);
        p_kv_mem(F);
        SEAM(1);
    }
    if (IN(2)) REP(2) { p_conv(F); SEAM(2); }
    if (IN(3)) REP(3) { REP(20) p_ssd_local(F); REP(21) p_sb_attn(F); SEAM(3); }
    if (IN(4)) REP(4) { p_ssd_scan(F); SEAM(4); }
    if (IN(5)) REP(5) { p_ssd_out(F); SEAM(5); }
    if (IN(6)) REP(6) {
        pg8::Gemm g{WSP(bf16, WS_RA), WSP(bf16, WS_WCAT_T), 2048, 2048, 2048, nullptr, nullptr, 0};
        pg8::SplitOrder S; S.so.init(T, 2048, 2048, F.G, bx); S.nt0 = 1536 / 64; S.nt1 = 512 / 64;
        pg8::EpiMerge E{WSP(bf16, WS_MERGED), WSP(bf16, WS_GATES), WSP(float, WS_RSTD)};
        pg8::gemm_phase<pg8::EpiMerge, pg8::SplitOrder, true, false>(ring, g, S, E);
        SEAM(6);
    }
    if (IN(8)) REP(8) {
        pg8::Gemm g{WSP(bf16, WS_MERGED), WSP(bf16, WS_WMIX_T), 2048, 2048, 2048, nullptr, nullptr, 0};
        pg8::StaticOrder S; S.init(T, 2048, 2048, F.G, bx);
        pg8::EpiResStat E{F.in[0], F.out, WSP(bf16, WS_RA), WSP(float, WS_SSQ1)};
        pg8::gemm_phase<pg8::EpiResStat, pg8::StaticOrder, true, false>(ring, g, S, E);
        SEAM(8);
    }
    if (IN(9)) REP(9) { p_expert_weights(F); SEAM(9); }
    if (IN(10)) REP(10) {
        pg8::Gemm g{WSP(bf16, WS_RA), WSP(bf16, WS_WQ_T), 2048, 2048, 2048, nullptr, nullptr, 0};
        pg8::StaticOrder S; S.init(T, 512, 2048, F.G, bx);
        pg8::EpiBf16Rs E{WSP(bf16, WS_Q2), 512, WSP(float, WS_SSQ1)};
        pg8::gemm_phase<pg8::EpiBf16Rs, pg8::StaticOrder, true, false>(ring, g, S, E);
        SEAM(10);
    }
    if (IN(11)) REP(11) { p_xattn(F); SEAM(11); }
    if (IN(12)) REP(12) {
        pg8::Gemm g{WSP(bf16, WS_O2), WSP(bf16, WS_WO_T), 512, 512, 512, nullptr, nullptr, 0};
        pg8::StaticOrder S; S.init(T, 2048, 512, F.G, bx);
        pg8::EpiResStat E{F.out, F.out, WSP(bf16, WS_RA), WSP(float, WS_SSQ2)};
        pg8::gemm_phase<pg8::EpiResStat, pg8::StaticOrder, true, false>(ring, g, S, E);
        SEAM(12);
    }
    if (IN(14)) REP(14) { p_router(F); SEAM(14); }
    if (IN(16)) REP(16) { p_route_b(F); SEAM(16); }
    if (IN(17)) REP(17) {
        const int* TILEE = WSP(int, WS_TILEE);
        pg8::Gemm g{WSP(bf16, WS_RA), WSP(bf16, WS_WGU_T), 2048, 2048, 2048, WSP(int, WS_SLOTTOK), TILEE, (size_t)1024 * 2048};
        pg8::ListOrder S; S.init(TILEE[511], 4, F.G, bx, 2048 / 64);
        pg8::EpiSwiGLU E{WSP(bf16, WS_HID), WSP(float, WS_SRSTD)};
        pg8::gemm_phase<pg8::EpiSwiGLU, pg8::ListOrder, true, true>(ring, g, S, E);
        SEAM(17);
    }
    if (IN(18)) REP(18) {
        const int* TILEE = WSP(int, WS_TILEE);
        pg8::Gemm g{WSP(bf16, WS_HID), WSP(bf16, WS_WD_T), 512, 512, 512, nullptr, TILEE, (size_t)2048 * 512};
        pg8::ListOrder S; S.init(TILEE[511], 8, F.G, bx, 512 / 64);
        pg8::EpiBf16 E{WSP(bf16, WS_Y), 2048};
        pg8::gemm_phase<pg8::EpiBf16, pg8::ListOrder, true, false>(ring, g, S, E);
        SEAM(18);
    }
    if (IN(19)) REP(19) { p_final(F); }
#undef IN
#undef SEAM
}

extern "C" void kernel_launch(void* const* d_in, const int* in_sizes, int n_in, void* d_out, int out_size, void* d_ws, size_t ws_size, hipStream_t stream) {
    static int grid = 0;
    if (grid == 0) {
        if (n_in != 26 || out_size != T * D || ws_size < WS_END) { fprintf(stderr, "kernel_launch: unexpected sizes n_in %d out %d ws %zu\n", n_in, out_size, ws_size); grid = -1; return; }
        int dev = 0, cus = 0, per_cu = 0;
        if (hipGetDevice(&dev) != hipSuccess || hipDeviceGetAttribute(&cus, hipDeviceAttributeMultiprocessorCount, dev) != hipSuccess) { grid = -1; return; }
        if (hipFuncSetAttribute((const void*)fwd, hipFuncAttributeMaxDynamicSharedMemorySize, LDS_BYTES) != hipSuccess) { fprintf(stderr, "kernel_launch: hipFuncSetAttribute failed\n"); grid = -1; return; }
        if (hipOccupancyMaxActiveBlocksPerMultiprocessor(&per_cu, (const void*)fwd, NWAVES * 64, LDS_BYTES) != hipSuccess || per_cu < 1) fprintf(stderr, "kernel_launch: occupancy query reports %d\n", per_cu);
        (void)hipGetLastError();
        grid = cus;
    }
    if (grid < 0) return;
    if (hipMemsetAsync((char*)d_ws + WS_CTL, 0, CTL_ZERO_BYTES, stream) != hipSuccess) return;
    Args a{};
    for (int i = 0; i < 26; ++i) a.in[i] = (const float*)d_in[i];
    a.out = (float*)d_out; a.ws = (unsigned char*)d_ws;
    if (MK_N_LAUNCHES == 1) {
        a.ph_lo = 0; a.ph_hi = NPHASE;
        hipLaunchKernelGGL(fwd, dim3(grid), dim3(NWAVES * 64), LDS_BYTES, stream, a);
    } else {
        for (int p = 0; p < NPHASE; ++p) { a.ph_lo = p; a.ph_hi = p + 1; hipLaunchKernelGGL(fwd, dim3(grid), dim3(NWAVES * 64), LDS_BYTES, stream, a); }
    }
}
```

```cpp
#include <hip/hip_runtime.h>
#include <cstdio>
#include <cstdint>

#define DI __device__ __forceinline__
#define LAS __attribute__((address_space(3)))
#define GAS __attribute__((address_space(1)))
typedef unsigned short bf16;
typedef short bf16x8 __attribute__((ext_vector_type(8)));
typedef short s16x4 __attribute__((ext_vector_type(4)));
typedef float f32x4 __attribute__((ext_vector_type(4)));
typedef float f32x2 __attribute__((ext_vector_type(2)));
typedef unsigned u32x4 __attribute__((ext_vector_type(4)));
typedef unsigned u32x2 __attribute__((ext_vector_type(2)));
typedef __bf16 bf16x2_t __attribute__((ext_vector_type(2)));

#ifndef DUP_MASK
#define DUP_MASK 0
#endif
#define REP(k) for (int rep_ = 0; rep_ < 1 + 2 * ((DUP_MASK >> (k)) & 1); ++rep_)
#ifndef MK_N_LAUNCHES
#define MK_N_LAUNCHES 1
#endif

constexpr int D = 2048, BATCH = 2, SEQ = 16384, T = BATCH * SEQ;
constexpr int SSD_INNER = 1536, SSD_HEADS = 24, SSD_P = 64, SSD_N = 128, SSD_G = 4, SSD_L = 128, SSD_BC = 512, CONV_DIM = 2560;
constexpr int NCHUNK = T / SSD_L;
constexpr int SB_W = 512, SB_H = 4, SB_D = 128;
constexpr int IN_COLS = 9752, IN_PAD = 9984;
constexpr int XA_W = 512, MEM = 256;
constexpr int NEXP = 32, EFF = 512;
constexpr int NSLOT = 2 * T + NEXP * 256;
constexpr float EPS = 1e-6f;

constexpr size_t MiB = 1u << 20;
constexpr size_t WS_CTL = 0, CTL_ZERO_BYTES = 1 * MiB;
constexpr size_t WS_WCAT_T = 1 * MiB;
constexpr size_t WS_WMIX_T = 9 * MiB;
constexpr size_t WS_WQ_T = 17 * MiB;
constexpr size_t WS_WK_T = 19 * MiB;
constexpr size_t WS_WV_T = 21 * MiB;
constexpr size_t WS_WO_T = 23 * MiB;
constexpr size_t WS_WR_T = 25 * MiB;
constexpr size_t WS_MEMN = 26 * MiB;
constexpr size_t WS_KX = 28 * MiB;
constexpr size_t WS_VXT = 28 * MiB + 512 * 1024;
constexpr size_t WS_DTRAW = 29 * MiB;
constexpr size_t WS_DTT = 33 * MiB;
constexpr size_t WS_ACT = 36 * MiB;
constexpr size_t WS_RSTD = 39 * MiB;
constexpr size_t WS_SRSTD = 53 * MiB;
constexpr size_t WS_SSQ1 = 54 * MiB, WS_SSQ2 = 58 * MiB;
constexpr size_t WS_WL = 50 * MiB;
constexpr size_t WS_LOGITS = 40 * MiB;
constexpr size_t WS_TI = 48 * MiB;
constexpr size_t WS_TG = 48 * MiB + 512 * 1024;
constexpr size_t WS_TSLOT = 48 * MiB + 768 * 1024;
constexpr size_t WS_SLOTTOK = 49 * MiB;
constexpr size_t WS_TILEE = 49 * MiB + 512 * 1024;
constexpr size_t WS_WIN_T = 64 * MiB;
constexpr size_t WS_BT = 64 * MiB;
constexpr size_t WS_Q2 = 64 * MiB;
constexpr size_t WS_RA = 104 * MiB;
constexpr size_t WS_Z = 232 * MiB;
constexpr size_t WS_HID = 232 * MiB;
constexpr size_t WS_XBC = 328 * MiB;
constexpr size_t WS_MERGED = 328 * MiB;
constexpr size_t WS_QKV = 488 * MiB;
constexpr size_t WS_WGU_T = 488 * MiB;
constexpr size_t WS_GATES = 584 * MiB;
constexpr size_t WS_WD_T = 616 * MiB;
constexpr size_t WS_Y = 680 * MiB;
constexpr size_t WS_BN = 840 * MiB;
constexpr size_t WS_CN = 872 * MiB;
constexpr size_t WS_XT = 904 * MiB;
constexpr size_t WS_O2 = 968 * MiB;
constexpr size_t WS_END = 1000 * MiB;
constexpr size_t OUT_STATE = 0, OUT_VT = 192 * MiB;
constexpr int CW_BAR = 4096;
constexpr int CW_ECNT = 16384;

constexpr int RING_BYTES = 131072;
constexpr int MISC_OFF = RING_BYTES + 320;
constexpr int LDS_BYTES = 147456;
constexpr int NWAVES = 8;

DI float bf2f(bf16 v) { return __uint_as_float(((unsigned)v) << 16); }
DI unsigned pk2(float lo, float hi) { f32x2 v = {lo, hi}; bf16x2_t b = __builtin_convertvector(v, bf16x2_t); return __builtin_bit_cast(unsigned, b); }
DI bf16x8 pack8(const float (&v)[8]) { u32x4 p; p.x = pk2(v[0], v[1]); p.y = pk2(v[2], v[3]); p.z = pk2(v[4], v[5]); p.w = pk2(v[6], v[7]); return __builtin_bit_cast(bf16x8, p); }
DI float wave_sum(float v) {
#pragma unroll
    for (int o = 1; o < 64; o <<= 1) v += __shfl_xor(v, o);
    return v;
}
DI float silu_f(float x) { return x * __builtin_amdgcn_rcpf(1.0f + __expf(-x)); }
DI float sigmoid_f(float x) { return __builtin_amdgcn_rcpf(1.0f + __expf(-x)); }
DI float rstd32(const float* p) { f32x4 a = *(const f32x4*)p;
#pragma unroll
    for (int i = 1; i < 8; ++i) a += *(const f32x4*)(p + 4 * i);
    return 1.0f / sqrtf(((a[0] + a[1]) + (a[2] + a[3])) * (1.0f / 2048.0f) + EPS); }
#define MFMA16(a, b, c) __builtin_amdgcn_mfma_f32_16x16x32_bf16((a), (b), (c), 0, 0, 0)
#define LDS_WAIT() asm volatile("s_waitcnt lgkmcnt(0)" ::: "memory")
#define VM_WAIT() asm volatile("s_waitcnt vmcnt(0)" ::: "memory")

namespace pg8 {
#define PG8_LAS __attribute__((address_space(3)))
constexpr int BM = 256, BK = 64, HALF = 128, HTB = HALF * BK * 2, STAGE_BYTES = 8 * HTB, NXCD = 8, WGM = 8;
__host__ __device__ __forceinline__ int lds_byte(int r, int c) { const int st = (r >> 4) * 2 + (c >> 5), rr = r & 15, cc = c & 31, ob = rr * 64 + cc * 2; return st * 1024 + (ob ^ (((ob >> 9) & 1) << 5)); }
__host__ __device__ __forceinline__ void stage_rc(int b, int& R, int& C) { const int st = b / 1024, sb = b % 1024, swz = sb ^ (((sb >> 9) & 1) << 5); R = (st >> 1) * 16 + swz / 64; C = (st & 1) * 32 + (swz % 64) / 2; }
__host__ __device__ __forceinline__ int perm32(int rho) { const int n = rho >> 4, i = rho & 15; return 8 * (i >> 2) + 4 * n + (i & 3); }

struct Unit { int pm, pn, k0, nt, fin; };
struct Gemm { const bf16* A; const bf16* Bt; int K, lda, ldb; const int* arow; const int* tile_e; size_t b_estride; };

struct StaticOrder {
    int nM, nN, nwg, G, c, nt;
    __device__ void init(int M, int N, int K, int G_, int c_) { nM = M / BM; nN = N / BM; nwg = nM * nN; G = G_; c = c_; nt = K / BK; }
    __device__ bool next(int i, Unit& u) const {
        u.k0 = 0; u.nt = nt; u.fin = 1;
        const long L = (long)i * G + c; if (L >= nwg) return false;
        int wgid = (int)L; { const int q = nwg / NXCD, r = nwg % NXCD, xcd = wgid % NXCD, off = wgid / NXCD; wgid = (xcd < r ? xcd * (q + 1) : r * (q + 1) + (xcd - r) * q) + off; }
        const int nig = WGM * nN, gid = wgid / nig, fm = gid * WGM, gsz = (nM - fm) < WGM ? (nM - fm) : WGM;
        u.pm = fm + ((wgid % nig) % gsz); u.pn = (wgid % nig) / gsz; return true;
    }
};
struct ListOrder {
    int ntile, nN, G, c, nt;
    __device__ void init(int ntile_, int nN_, int G_, int c_, int nt_) { ntile = ntile_; nN = nN_; G = G_; c = c_; nt = nt_; }
    __device__ bool next(int i, Unit& u) const { u.k0 = 0; u.nt = nt; u.fin = 1; const int L = i * G + c; if (L >= ntile * nN) return false; u.pm = L / nN; u.pn = L % nN; return true; }
};
struct SplitOrder {
    StaticOrder so; int nt0, nt1;
    __device__ bool next(int i, Unit& u) const { if (!so.next(i >> 1, u)) return false; if (i & 1) { u.k0 = nt0 * BK; u.nt = nt1; u.fin = 1; } else { u.k0 = 0; u.nt = nt0; u.fin = 0; } return true; }
};

template <class Epi, class Sched, bool ALIGN_EPI, bool GATHER>
__device__ __forceinline__ void gemm_phase(PG8_LAS unsigned char* lds, const Gemm g, const Sched& S, const Epi& E) {
    const int tid = threadIdx.x, wid = __builtin_amdgcn_readfirstlane(tid >> 6), lane = tid & 63, wr = wid >> 2, wc = wid & 3, fr = lane & 15, fq = lane >> 4;
    unsigned voffB[2]; int RA[2], CA[2];
#pragma unroll
    for (int i = 0; i < 2; ++i) { int R, C; stage_rc(tid * 16 + i * 8192, R, C); const int Rb = (R & ~31) + perm32(R & 31);
        RA[i] = R; CA[i] = C; voffB[i] = (unsigned)(Rb * g.ldb + C) * 2u; }
    const size_t kstep = (size_t)(BK * 2);
    const size_t hstepB = (size_t)HALF * g.ldb * 2;
    const size_t tstepB = 2 * hstepB;
    const unsigned ldsw = (unsigned)wid * 1024u;
    const int aoff = lds_byte(wr * 64 + fr, fq * 8), boff = lds_byte(wc * 32 + fr, fq * 8);
    const char* Ab = (const char*)g.A;
#define PG8_SA(b, h) (((b) * 2 + (h)) * HTB)
#define PG8_SB(b, h) ((4 + (b) * 2 + (h)) * HTB)
#define PG8_STAGE(bufoff, gbase, voff) do { _Pragma("unroll") for (int _i = 0; _i < 2; ++_i) \
        __builtin_amdgcn_global_load_lds((const unsigned*)((const char*)(gbase) + (voff)[_i]), (PG8_LAS unsigned*)(lds + (bufoff) + ldsw + _i * 8192), 16, 0, 0); } while (0)
#define PG8_STAGEA(bufoff, kb, o0, o1) do { \
        __builtin_amdgcn_global_load_lds((const unsigned*)(Ab + (kb) + (o0)), (PG8_LAS unsigned*)(lds + (bufoff) + ldsw), 16, 0, 0); \
        __builtin_amdgcn_global_load_lds((const unsigned*)(Ab + (kb) + (o1)), (PG8_LAS unsigned*)(lds + (bufoff) + ldsw + 8192), 16, 0, 0); } while (0)
#define PG8_LDA(dst, b, h) do { _Pragma("unroll") for (int m = 0; m < 4; ++m) _Pragma("unroll") for (int k = 0; k < 2; ++k) dst[m][k] = *(const PG8_LAS bf16x8*)(lds + PG8_SA(b, h) + aoff + m * 2048 + k * 1024); } while (0)
#define PG8_LDB(dst, b, h) do { _Pragma("unroll") for (int n = 0; n < 2; ++n) _Pragma("unroll") for (int k = 0; k < 2; ++k) dst[n][k] = *(const PG8_LAS bf16x8*)(lds + PG8_SB(b, h) + boff + n * 2048 + k * 1024); } while (0)
#define PG8_MMA(ai, bj, At, Bt) do { __builtin_amdgcn_s_setprio(1); _Pragma("unroll") for (int m = 0; m < 4; ++m) _Pragma("unroll") for (int n = 0; n < 2; ++n) _Pragma("unroll") for (int k = 0; k < 2; ++k) \
        acc[ai][bj][m][n] = __builtin_amdgcn_mfma_f32_16x16x32_bf16(Bt[n][k], At[m][k], acc[ai][bj][m][n], 0, 0, 0); __builtin_amdgcn_s_setprio(0); } while (0)
#define PG8_WAIT_V(n) asm volatile("s_waitcnt vmcnt(" #n ")" ::: "memory")
#define PG8_WAIT_L(n) asm volatile("s_waitcnt lgkmcnt(" #n ")" ::: "memory")
#define PG8_BAR __builtin_amdgcn_s_barrier()
#define PG8_SCHED __builtin_amdgcn_sched_barrier(0)
#define PG8_SETA(o, u) do { _Pragma("unroll") for (int _h = 0; _h < 2; ++_h) _Pragma("unroll") for (int _i = 0; _i < 2; ++_i) { \
        int _row = (u).pm * BM + _h * HALF + RA[_i]; if (GATHER) _row = g.arow[_row]; (o)[_h][_i] = (unsigned)(_row * g.lda + CA[_i] + (u).k0) * 2u; } } while (0)
    Unit cur, nxt; int ui = 0;
    if (!S.next(0, cur)) return;
    f32x4 acc[2][2][4][2];
#pragma unroll
    for (int a = 0; a < 2; ++a)
#pragma unroll
        for (int b = 0; b < 2; ++b)
#pragma unroll
            for (int m = 0; m < 4; ++m)
#pragma unroll
                for (int n = 0; n < 2; ++n) acc[a][b][m][n] = (f32x4){0.f, 0.f, 0.f, 0.f};
    bf16x8 At[4][2], B0[2][2], B1[2][2];
    unsigned oc[2][2], on[2][2];
    PG8_SETA(oc, cur);
    const char* cB = (const char*)g.Bt + (g.tile_e ? (size_t)g.tile_e[cur.pm] * g.b_estride * 2 : (size_t)0) + (size_t)cur.pn * tstepB + (size_t)cur.k0 * 2;
    PG8_STAGE(PG8_SB(0, 0), cB, voffB); PG8_STAGE(PG8_SB(0, 1), cB + hstepB, voffB); PG8_STAGEA(PG8_SA(0, 0), 0, oc[0][0], oc[0][1]); PG8_STAGEA(PG8_SA(0, 1), 0, oc[1][0], oc[1][1]);
    if (wr == 1) PG8_BAR;
    PG8_WAIT_V(2); PG8_BAR;
    PG8_STAGE(PG8_SB(1, 0), cB + kstep, voffB); PG8_STAGEA(PG8_SA(1, 0), kstep, oc[0][0], oc[0][1]); PG8_STAGE(PG8_SB(1, 1), cB + hstepB + kstep, voffB);
    PG8_WAIT_V(6); PG8_BAR;
    for (;;) {
        const bool has_next = S.next(ui + 1, nxt);
        const char* nB = cB;
        if (has_next) { nB = (const char*)g.Bt + (g.tile_e ? (size_t)g.tile_e[nxt.pm] * g.b_estride * 2 : (size_t)0) + (size_t)nxt.pn * tstepB + (size_t)nxt.k0 * 2; }
        const int nt = cur.nt;
#pragma unroll
        for (int _h = 0; _h < 2; ++_h)
#pragma unroll
            for (int _i = 0; _i < 2; ++_i) on[_h][_i] = oc[_h][_i];
        for (int t = 0; t < nt; t += 2) {
            const bool last = (t == nt - 2);
            if (last && has_next) { PG8_SETA(on, nxt); }
            const size_t k1 = (size_t)(t + 1) * kstep;
            const size_t k2 = last ? (size_t)0 : (size_t)(t + 2) * kstep, k3 = k2 + kstep;
            const char* b2 = last ? nB : cB + (size_t)(t + 2) * kstep; const char* b3 = b2 + kstep;
            const unsigned s00 = last ? on[0][0] : oc[0][0], s01 = last ? on[0][1] : oc[0][1], s10 = last ? on[1][0] : oc[1][0], s11 = last ? on[1][1] : oc[1][1];
            PG8_LDB(B0, 0, 0); PG8_LDB(B1, 0, 1); PG8_SCHED; PG8_LDA(At, 0, 0); PG8_STAGEA(PG8_SA(1, 1), k1, oc[1][0], oc[1][1]);
            PG8_WAIT_V(8); PG8_WAIT_L(0); PG8_BAR; PG8_MMA(0, 0, At, B0); PG8_MMA(0, 1, At, B1); PG8_BAR; PG8_SCHED;
            PG8_LDA(At, 0, 1); PG8_STAGE(PG8_SB(0, 0), b2, voffB); PG8_STAGE(PG8_SB(0, 1), b2 + hstepB, voffB); PG8_STAGEA(PG8_SA(0, 0), k2, s00, s01);
            PG8_WAIT_V(8); PG8_WAIT_L(0); PG8_BAR; PG8_MMA(1, 0, At, B0); PG8_MMA(1, 1, At, B1); PG8_BAR; PG8_SCHED;
            PG8_LDB(B0, 1, 0); PG8_LDB(B1, 1, 1); PG8_SCHED; PG8_LDA(At, 1, 0); PG8_STAGEA(PG8_SA(0, 1), k2, s10, s11);
            PG8_WAIT_V(8); PG8_WAIT_L(0); PG8_BAR; PG8_MMA(0, 0, At, B0); PG8_MMA(0, 1, At, B1); PG8_BAR; PG8_SCHED;
            PG8_LDA(At, 1, 1); PG8_STAGE(PG8_SB(1, 0), b3, voffB); PG8_STAGE(PG8_SB(1, 1), b3 + hstepB, voffB); PG8_STAGEA(PG8_SA(1, 0), k3, s00, s01);
            PG8_WAIT_V(8); PG8_WAIT_L(0); PG8_BAR; PG8_MMA(1, 0, At, B0); PG8_MMA(1, 1, At, B1); PG8_BAR; PG8_SCHED;
        }
        if constexpr (ALIGN_EPI) { if (wr == 0) PG8_BAR; }
        E(acc, cur, wr, wc, fr, fq);
        if (!has_next) break;
        if (cur.fin) {
#pragma unroll
        for (int a = 0; a < 2; ++a)
#pragma unroll
            for (int b = 0; b < 2; ++b)
#pragma unroll
                for (int m = 0; m < 4; ++m)
#pragma unroll
                    for (int n = 0; n < 2; ++n) acc[a][b][m][n] = (f32x4){0.f, 0.f, 0.f, 0.f};
        }
        cur = nxt; cB = nB; ++ui;
#pragma unroll
        for (int _h = 0; _h < 2; ++_h)
#pragma unroll
            for (int _i = 0; _i < 2; ++_i) oc[_h][_i] = on[_h][_i];
        if constexpr (ALIGN_EPI) { if (wr == 1) PG8_BAR; }
    }
    PG8_WAIT_V(0);
    if constexpr (!ALIGN_EPI) { if (wr == 0) PG8_BAR; }
    PG8_BAR;
#undef PG8_SA
#undef PG8_SB
#undef PG8_STAGE
#undef PG8_STAGEA
#undef PG8_LDA
#undef PG8_LDB
#undef PG8_MMA
#undef PG8_WAIT_V
#undef PG8_WAIT_L
#undef PG8_BAR
#undef PG8_SCHED
#undef PG8_SETA
}

#define EPI_ROWS(...) _Pragma("unroll") for (int ai = 0; ai < 2; ++ai) _Pragma("unroll") for (int m = 0; m < 4; ++m) { const int row = u.pm * BM + ai * HALF + wr * 64 + m * 16 + fr; \
        _Pragma("unroll") for (int bj = 0; bj < 2; ++bj) { const int col = u.pn * BM + bj * HALF + wc * 32 + 8 * fq; const f32x4 v0 = acc[ai][bj][m][0], v1 = acc[ai][bj][m][1]; __VA_ARGS__ } }
DI u32x4 pack8v(f32x4 v0, f32x4 v1) { u32x4 w; w.x = pk2(v0[0], v0[1]); w.y = pk2(v0[2], v0[3]); w.z = pk2(v1[0], v1[1]); w.w = pk2(v1[2], v1[3]); return w; }
DI void unpack8(u32x4 w, float (&f)[8]) { f[0] = __uint_as_float(w.x << 16); f[1] = __uint_as_float(w.x & 0xffff0000u); f[2] = __uint_as_float(w.y << 16); f[3] = __uint_as_float(w.y & 0xffff0000u);
    f[4] = __uint_as_float(w.z << 16); f[5] = __uint_as_float(w.z & 0xffff0000u); f[6] = __uint_as_float(w.w << 16); f[7] = __uint_as_float(w.w & 0xffff0000u); }

struct EpiBf16 {
    bf16* O; int ldc;
    DI void operator()(const f32x4 (&acc)[2][2][4][2], const Unit& u, int wr, int wc, int fr, int fq) const {
        EPI_ROWS({ *(u32x4*)(O + (size_t)row * ldc + col) = pack8v(v0, v1); })
    }
};
struct EpiInProj {
    bf16 *Z, *XBC, *QKV, *GATES; float* DTRAW;
    DI void operator()(const f32x4 (&acc)[2][2][4][2], const Unit& u, int wr, int wc, int fr, int fq) const {
        const int pn = u.pn;
        if (pn < 6) { EPI_ROWS({ *(u32x4*)(Z + (size_t)row * 1536 + col) = pack8v(v0, v1); }) }
        else if (pn < 16) { EPI_ROWS({ *(u32x4*)(XBC + (size_t)row * 2560 + (col - 1536)) = pack8v(v0, v1); }) }
        else if (pn < 22) { EPI_ROWS({ *(u32x4*)(QKV + (size_t)row * 1536 + (col - 4096)) = pack8v(v0, v1); }) }
        else if (pn < 38) { EPI_ROWS({ f32x4 a, b;
_Pragma("unroll")
                for (int j = 0; j < 4; ++j) { a[j] = sigmoid_f(v0[j]); b[j] = sigmoid_f(v1[j]); }
                *(u32x4*)(GATES + (size_t)row * 4096 + (col - 5632)) = pack8v(a, b); }) }
        else { EPI_ROWS({ const int c = col - 9728; if (c < 32) { *(f32x4*)(DTRAW + (size_t)row * 32 + c) = v0; *(f32x4*)(DTRAW + (size_t)row * 32 + c + 4) = v1; } }) }
    }
};
struct EpiMerge {
    bf16* MERGED; const bf16* GATES; const float* RSTD;
    DI void operator()(f32x4 (&acc)[2][2][4][2], const Unit& u, int wr, int wc, int fr, int fq) const { if (u.fin) fin(acc, u, wr, wc, fr, fq); else mid(acc, u, wr, wc, fr, fq); }
    DI void mid(f32x4 (&acc)[2][2][4][2], const Unit& u, int wr, int wc, int fr, int fq) const {
#pragma unroll
        for (int ai = 0; ai < 2; ++ai)
#pragma unroll
            for (int m = 0; m < 4; ++m) { const int row = u.pm * BM + ai * HALF + wr * 64 + m * 16 + fr; const float rs = RSTD[row];
#pragma unroll
                for (int bj = 0; bj < 2; ++bj) { const int col = u.pn * BM + bj * HALF + wc * 32 + 8 * fq; float g1[8], g2[8];
                    unpack8(*(const u32x4*)(GATES + (size_t)row * 4096 + col), g1); unpack8(*(const u32x4*)(GATES + (size_t)row * 4096 + 2048 + col), g2);
#pragma unroll
                    for (int j = 0; j < 4; ++j) { acc[ai][bj][m][0][j] *= rs * g1[j] / fmaxf(g2[j], 1e-30f); acc[ai][bj][m][1][j] *= rs * g1[4 + j] / fmaxf(g2[4 + j], 1e-30f); } }
                asm volatile("" ::: "memory"); }
    }
    DI void fin(const f32x4 (&acc)[2][2][4][2], const Unit& u, int wr, int wc, int fr, int fq) const {
        EPI_ROWS({ float g2[8]; unpack8(*(const u32x4*)(GATES + (size_t)row * 4096 + 2048 + col), g2);
            f32x4 a, b;
_Pragma("unroll")
            for (int j = 0; j < 4; ++j) { a[j] = v0[j] * g2[j]; b[j] = v1[j] * g2[4 + j]; }
            *(u32x4*)(MERGED + (size_t)row * 2048 + col) = pack8v(a, b); })
    }
};
struct EpiResF32 {
    const float* base; float* out;
    DI void operator()(const f32x4 (&acc)[2][2][4][2], const Unit& u, int wr, int wc, int fr, int fq) const {
        EPI_ROWS({ const size_t o = (size_t)row * 2048 + col; const f32x4 b0 = *(const f32x4*)(base + o), b1 = *(const f32x4*)(base + o + 4);
            *(f32x4*)(out + o) = b0 + v0; *(f32x4*)(out + o + 4) = b1 + v1; })
    }
};
struct EpiResStat {
    const float* base; float* out; bf16* hb; float* ssq;
    DI void operator()(const f32x4 (&acc)[2][2][4][2], const Unit& u, int wr, int wc, int fr, int fq) const {
#pragma unroll
        for (int ai = 0; ai < 2; ++ai)
#pragma unroll
            for (int m = 0; m < 4; ++m) { const int row = u.pm * BM + ai * HALF + wr * 64 + m * 16 + fr; float sq = 0.f;
#pragma unroll
                for (int bj = 0; bj < 2; ++bj) { const int col = u.pn * BM + bj * HALF + wc * 32 + 8 * fq; const size_t o = (size_t)row * 2048 + col;
                    const f32x4 r0 = *(const f32x4*)(base + o) + acc[ai][bj][m][0], r1 = *(const f32x4*)(base + o + 4) + acc[ai][bj][m][1];
                    *(f32x4*)(out + o) = r0; *(f32x4*)(out + o + 4) = r1; *(u32x4*)(hb + o) = pack8v(r0, r1);
                    sq += (r0[0] * r0[0] + r0[1] * r0[1]) + (r0[2] * r0[2] + r0[3] * r0[3]) + (r1[0] * r1[0] + r1[1] * r1[1]) + (r1[2] * r1[2] + r1[3] * r1[3]); }
                sq += __shfl_xor(sq, 16); sq += __shfl_xor(sq, 32);
                if (fq == 0) ssq[(size_t)row * 32 + u.pn * 4 + wc] = sq; }
    }
};
struct EpiBf16Rs {
    bf16* O; int ldc; const float* ssq;
    DI void operator()(const f32x4 (&acc)[2][2][4][2], const Unit& u, int wr, int wc, int fr, int fq) const {
_Pragma("unroll") for (int ai = 0; ai < 2; ++ai) _Pragma("unroll") for (int m = 0; m < 4; ++m) { const int row = u.pm * BM + ai * HALF + wr * 64 + m * 16 + fr; const float rs = rstd32(ssq + (size_t)row * 32);
            _Pragma("unroll") for (int bj = 0; bj < 2; ++bj) { const int col = u.pn * BM + bj * HALF + wc * 32 + 8 * fq; *(u32x4*)(O + (size_t)row * ldc + col) = pack8v(acc[ai][bj][m][0] * rs, acc[ai][bj][m][1] * rs); } }
    }
};
struct EpiSwiGLU {
    bf16* HID; const float* srstd;
    DI void operator()(const f32x4 (&acc)[2][2][4][2], const Unit& u, int wr, int wc, int fr, int fq) const {
#pragma unroll
        for (int ai = 0; ai < 2; ++ai)
#pragma unroll
            for (int m = 0; m < 4; ++m) { const int row = u.pm * BM + ai * HALF + wr * 64 + m * 16 + fr; const int col = u.pn * 128 + wc * 32 + 8 * fq; const float rs = srstd[row];
                f32x4 a, b;
#pragma unroll
                for (int j = 0; j < 4; ++j) { a[j] = silu_f(acc[ai][0][m][0][j] * rs) * (acc[ai][1][m][0][j] * rs); b[j] = silu_f(acc[ai][0][m][1][j] * rs) * (acc[ai][1][m][1][j] * rs); }
                *(u32x4*)(HID + (size_t)row * EFF + col) = pack8v(a, b); }
    }
};
}

#define XB_TMO      128
#define XB_XCNT(j)  (256  + 64 * (j))
#define XB_XSUB(j)  (1280 + 64 * (j))
#define XB_XGEN(j)  (2304 + 64 * (j))
#define XB_TOP      3328
#define XB_TOPGEN   3392
#define XCD_BAR_WORDS 3456
#define XB_SPIN_CAP (1u << 18)
__device__ __forceinline__ unsigned xb_ld(unsigned* p)              { return __hip_atomic_load(p, __ATOMIC_RELAXED, __HIP_MEMORY_SCOPE_AGENT); }
__device__ __forceinline__ unsigned xb_add(unsigned* p, unsigned v) { return __hip_atomic_fetch_add(p, v, __ATOMIC_RELAXED, __HIP_MEMORY_SCOPE_AGENT); }
__device__ __forceinline__ unsigned xb_xcc_id() { return (unsigned)__builtin_amdgcn_s_getreg((3 << 11) | 20) & 0xFu; }
#define XB_SPIN(cond, bar) do { unsigned _sp = 0; while (cond) { __builtin_amdgcn_s_sleep(1); \
    if ((++_sp & 255u) == 0u) { if (xb_ld(&(bar)[XB_TMO])) break; if (_sp > XB_SPIN_CAP) { atomicAdd(&(bar)[XB_TMO], 1u); break; } } } } while (0)
struct XcdBarrier { unsigned* bar; unsigned x; volatile LAS unsigned* st; };
__device__ __forceinline__ XcdBarrier xcd_barrier_post(unsigned* bar, volatile LAS unsigned* st) {
    XcdBarrier b; b.bar = bar; b.x = xb_xcc_id(); b.st = st;
    if (threadIdx.x == 0) (void)xb_add(&bar[XB_XCNT(b.x)], 1u);
    return b;
}
__device__ __forceinline__ void xcd_barrier_complete(unsigned* bar, unsigned x, unsigned& nloc, unsigned& nx) {
    const unsigned G = gridDim.x * gridDim.y * gridDim.z;
    unsigned sum, cnt, mine, sp = 0u;
    for (;;) {
        sum = 0u; cnt = 0u; mine = 0u;
#pragma unroll
        for (unsigned j = 0; j < 16; ++j) { const unsigned c = xb_ld(&bar[XB_XCNT(j)]); sum += c; cnt += (c > 0u) ? 1u : 0u; mine = (j == x) ? c : mine; }
        if (sum == G) break;
        __builtin_amdgcn_s_sleep(1);
        if ((++sp & 255u) == 0u) { if (xb_ld(&bar[XB_TMO])) break; if (sp > XB_SPIN_CAP) { atomicAdd(&bar[XB_TMO], 1u); break; } }
    }
    nloc = mine > 0u ? mine : 1u; nx = cnt > 0u ? cnt : 1u;
}
__device__ __forceinline__ void xcd_barrier(const XcdBarrier& b) {
    asm volatile("s_waitcnt vmcnt(0)" ::: "memory");
    __syncthreads();
    if (threadIdx.x == 0) {
        unsigned* bar = b.bar;
        __builtin_amdgcn_s_waitcnt(0);
        unsigned nloc = b.st[0], nx = b.st[1];
        if (nloc == 0u) { xcd_barrier_complete(bar, b.x, nloc, nx); b.st[0] = nloc; b.st[1] = nx; }
        const unsigned old = xb_add(&bar[XB_XSUB(b.x)], 1u);
        const unsigned gen = old / nloc;
        if (old + 1u == (gen + 1u) * nloc) {
            __builtin_amdgcn_fence(__ATOMIC_RELEASE, "agent");
            asm volatile("s_waitcnt vmcnt(0)" ::: "memory");
            const unsigned og = xb_add(&bar[XB_TOP], 1u);
            const unsigned tg = og / nx;
            if (og + 1u == (tg + 1u) * nx) xb_add(&bar[XB_TOPGEN], 1u);
            else XB_SPIN(xb_ld(&bar[XB_TOPGEN]) == tg, bar);
            __builtin_amdgcn_fence(__ATOMIC_ACQUIRE, "agent");
            xb_add(&bar[XB_XGEN(b.x)], 1u);
            asm volatile("s_waitcnt vmcnt(0)" ::: "memory");
        } else {
            XB_SPIN(xb_ld(&bar[XB_XGEN(b.x)]) == gen, bar);
            __builtin_amdgcn_fence(__ATOMIC_ACQUIRE, "agent");
            asm volatile("s_waitcnt vmcnt(0)" ::: "memory");
        }
    }
    __syncthreads();
}

struct Frame {
    LAS unsigned char* lds;
    int tid, lane, wave, G, gw, NGW;
    const float* in[26];
    float* out; unsigned char* ws;
};
#define WSP(type, off) ((type*)(F.ws + (off)))

DI void tr_item(const float* W, int ldw, int k0, int nsrc0, int nvalid, bf16* WT, int ldt, int drow0, const float* kscale, LAS float* scr, int lane) {
    const int nn = lane & 31;
#pragma unroll 8
    for (int i = 0; i < 32; ++i) { const int kk = 2 * i + (lane >> 5); float v = 0.f; if (nn < nvalid) v = W[(size_t)(k0 + kk) * ldw + nsrc0 + nn]; if (kscale) v *= kscale[k0 + kk]; scr[kk * 33 + nn] = v; }
    LDS_WAIT(); asm volatile("" ::: "memory");
    const int c = lane & 7;
#pragma unroll
    for (int j = 0; j < 4; ++j) { const int n = (lane >> 3) + 8 * j; const LAS float* s = scr + (8 * c) * 33 + n;
        u32x4 o; o.x = pk2(s[0 * 33], s[1 * 33]); o.y = pk2(s[2 * 33], s[3 * 33]); o.z = pk2(s[4 * 33], s[5 * 33]); o.w = pk2(s[6 * 33], s[7 * 33]);
        if (n < nvalid) *(u32x4*)(WT + (size_t)(drow0 + n) * ldt + k0 + 8 * c) = o; }
    LDS_WAIT(); asm volatile("" ::: "memory");
}
DI void tr_block(const float* W, int ldw, int K, int ncols, int nsrc0, bf16* WT, int ldt, int drow0, const float* kscale, LAS float* scr, int lane, int it) {
    const int nblk = (ncols + 31) / 32, kb = it / nblk, nb = it % nblk; const int nv = ncols - nb * 32 < 32 ? ncols - nb * 32 : 32;
    tr_item(W, ldw, kb * 64, nsrc0 + nb * 32, nv, WT, ldt, drow0 + nb * 32, kscale, scr, lane);
}
DI void tr64_item(const float* W, int ldw, int k0, int nsrc0, bf16* WT, int ldt, int drow0, const float* kscale, int lane) {
    const int n4 = lane & 15, kq = lane >> 4;
    f32x4 r[2][8];
#pragma unroll
    for (int hf = 0; hf < 2; ++hf)
#pragma unroll
        for (int i = 0; i < 8; ++i) r[hf][i] = *(const f32x4*)(W + (size_t)(k0 + hf * 32 + kq * 8 + i) * ldw + nsrc0 + n4 * 4);
#pragma unroll
    for (int hf = 0; hf < 2; ++hf) { const int kb = k0 + hf * 32 + kq * 8;
        if (kscale) { const f32x4 s0 = *(const f32x4*)(kscale + kb), s1 = *(const f32x4*)(kscale + kb + 4);
#pragma unroll
            for (int i = 0; i < 4; ++i) { r[hf][i] = r[hf][i] * s0[i]; r[hf][4 + i] = r[hf][4 + i] * s1[i]; } }
#pragma unroll
        for (int j = 0; j < 4; ++j) { u32x4 o; o.x = pk2(r[hf][0][j], r[hf][1][j]); o.y = pk2(r[hf][2][j], r[hf][3][j]); o.z = pk2(r[hf][4][j], r[hf][5][j]); o.w = pk2(r[hf][6][j], r[hf][7][j]);
            *(u32x4*)(WT + (size_t)(drow0 + n4 * 4 + j) * ldt + kb) = o; } }
}
DI void tr64_block(const float* W, int ldw, int K, int ncols, int nsrc0, bf16* WT, int ldt, int drow0, const float* kscale, int lane, int it) {
    const int nblk = ncols / 64, kb = it / nblk, nb = it % nblk;
    tr64_item(W, ldw, kb * 64, nsrc0 + nb * 64, WT, ldt, drow0 + nb * 64, kscale, lane);
}
DI void rms_row_bf16(const float* xrow, const float* w, bf16* orow, int lane) {
    const f32x4* xr = (const f32x4*)xrow + lane; const f32x4* wr4 = (const f32x4*)w + lane;
    f32x4 v[8]; float s = 0.f;
#pragma unroll
    for (int j = 0; j < 8; ++j) { v[j] = xr[64 * j]; s += (v[j].x * v[j].x + v[j].y * v[j].y) + (v[j].z * v[j].z + v[j].w * v[j].w); }
    const float rstd = 1.0f / sqrtf(wave_sum(s) * (1.0f / 2048.0f) + EPS);
    u32x2* o8 = (u32x2*)orow + lane;
#pragma unroll
    for (int j = 0; j < 8; ++j) { const f32x4 ww = wr4[64 * j]; u32x2 o; o.x = pk2(v[j].x * rstd * ww.x, v[j].y * rstd * ww.y); o.y = pk2(v[j].z * rstd * ww.z, v[j].w * rstd * ww.w); o8[64 * j] = o; }
}
DI void rms_rows(const Frame& F, const float* src, const float* w, bf16* dst, int rows) {
    for (int m = F.gw; m < rows; m += F.NGW) rms_row_bf16(src + (size_t)m * 2048, w, dst + (size_t)m * 2048, F.lane);
}

DI void p0_prologue(const Frame& F) {
    LAS float* scr = (LAS float*)(F.lds + F.wave * 16384);
    const float* w_in = F.in[3];
    bf16* WIN = WSP(bf16, WS_WIN_T);
    constexpr int KB = 32;
    constexpr int I_Z = 24 * KB, I_XBC = 40 * KB, I_QKV = 24 * KB, I_G = 64 * KB;
    constexpr int I_SSD = (1536 / 64) * (2048 / 64), I_SB = (512 / 64) * (2048 / 64), I_MIX = (2048 / 64) * (2048 / 64);
    constexpr int I_XQ = (2048 / 64) * (512 / 64), I_XO = (512 / 64) * (2048 / 64);
    constexpr int NITEMS = I_Z + I_XBC + I_QKV + I_G + I_SSD + I_SB + I_MIX + 3 * I_XQ + I_XO;
    for (int it = F.gw; it < NITEMS; it += F.NGW) {
        int r = it;
        if (r < I_Z)   { tr64_block(w_in, IN_COLS, 2048, 1536, 0,    WIN, 2048, 0,    nullptr, F.lane, r); continue; } r -= I_Z;
        if (r < I_XBC) { tr64_block(w_in, IN_COLS, 2048, 2560, 1536, WIN, 2048, 1536, nullptr, F.lane, r); continue; } r -= I_XBC;
        if (r < I_QKV) { tr64_block(w_in, IN_COLS, 2048, 1536, 4120, WIN, 2048, 4096, nullptr, F.lane, r); continue; } r -= I_QKV;
        if (r < I_G)   { tr64_block(w_in, IN_COLS, 2048, 4096, 5656, WIN, 2048, 5632, nullptr, F.lane, r); continue; } r -= I_G;
        if (r < I_SSD) { tr64_block(F.in[10], 2048, 1536, 2048, 0, WSP(bf16, WS_WCAT_T), 2048, 0, F.in[9], F.lane, r); continue; } r -= I_SSD;
        if (r < I_SB)  { tr64_block(F.in[11], 2048, 512,  2048, 0, WSP(bf16, WS_WCAT_T) + 1536, 2048, 0, nullptr, F.lane, r); continue; } r -= I_SB;
        if (r < I_MIX) { tr64_block(F.in[12], 2048, 2048, 2048, 0, WSP(bf16, WS_WMIX_T), 2048, 0, nullptr, F.lane, r); continue; } r -= I_MIX;
        if (r < I_XQ)  { tr64_block(F.in[15], 512, 2048, 512, 0, WSP(bf16, WS_WQ_T), 2048, 0, F.in[13], F.lane, r); continue; } r -= I_XQ;
        if (r < I_XQ)  { tr64_block(F.in[16], 512, 2048, 512, 0, WSP(bf16, WS_WK_T), 2048, 0, nullptr, F.lane, r); continue; } r -= I_XQ;
        if (r < I_XQ)  { tr64_block(F.in[17], 512, 2048, 512, 0, WSP(bf16, WS_WV_T), 2048, 0, nullptr, F.lane, r); continue; } r -= I_XQ;
        tr64_block(F.in[18], 2048, 512, 2048, 0, WSP(bf16, WS_WO_T), 512, 0, nullptr, F.lane, r);
    }
    constexpr int I_DT = 32, I_RG = 32, I_RE = 32;
    for (int it = F.gw; it < I_DT + I_RG + I_RE; it += F.NGW) {
        int r = it;
        if (r < I_DT)  { tr_block(w_in, IN_COLS, 2048, 24, 4096, WIN, 2048, 9728, nullptr, scr, F.lane, r); continue; } r -= I_DT;
        if (r < I_RG)  { tr_block(F.in[20], 4, 2048, 4, 0, WSP(bf16, WS_WR_T), 2048, 0, F.in[19], scr, F.lane, r); continue; } r -= I_RG;
        tr_block(F.in[21], 32, 2048, 32, 0, WSP(bf16, WS_WR_T), 2048, 4, F.in[19], scr, F.lane, r);
    }
    { const int gt = F.gw * 64 + F.lane, NT = F.NGW * 64;
      u32x4* z1 = (u32x4*)(WIN + (size_t)9752 * 2048); for (int i = gt; i < (IN_PAD - 9752) * 2048 / 8; i += NT) z1[i] = (u32x4){0u, 0u, 0u, 0u};
      u32x4* z2 = (u32x4*)(WSP(bf16, WS_WR_T) + (size_t)36 * 2048); for (int i = gt; i < 12 * 2048 / 8; i += NT) z2[i] = (u32x4){0u, 0u, 0u, 0u}; }
    rms_rows(F, F.in[0], F.in[2], WSP(bf16, WS_RA), T);
    rms_rows(F, F.in[1], F.in[14], WSP(bf16, WS_MEMN), BATCH * MEM);
}
DI void p_expert_weights(const Frame& F) {
    constexpr int PER = 256;
    for (int it = F.gw; it < NEXP * 3 * PER; it += F.NGW) {
        const int e = it / (3 * PER), r = it % (3 * PER), which = r / PER, q = r % PER;
        if (which < 2) { const int kb = q / 8, nb = q % 8, n0 = nb * 64; const float* W = (which == 0 ? F.in[22] : F.in[23]) + (size_t)e * 2048 * 512;
            tr64_item(W, 512, kb * 64, n0, WSP(bf16, WS_WGU_T) + (size_t)e * 1024 * 2048, 2048, (n0 / 128) * 256 + (n0 % 128) + which * 128, F.in[19], F.lane); }
        else { const int kb = q / 32, nb = q % 32; const float* W = F.in[24] + (size_t)e * 512 * 2048;
            tr64_item(W, 2048, kb * 64, nb * 64, WSP(bf16, WS_WD_T) + (size_t)e * 2048 * 512, 512, nb * 64, nullptr, F.lane); }
    }
}

template <int NT>
DI void wave_tile_gemm(const bf16* A, int lda, const bf16* Bt, int ldb, int K, int lane, f32x4 (&acc)[NT]) {
    const int fr = lane & 15, kg = lane >> 4;
#pragma unroll
    for (int n = 0; n < NT; ++n) acc[n] = (f32x4){0.f, 0.f, 0.f, 0.f};
    const bf16* ap = A + (size_t)fr * lda + kg * 8;
    const bf16* bp = Bt + (size_t)fr * ldb + kg * 8;
#pragma unroll 4
    for (int k0 = 0; k0 < K; k0 += 32) {
        const bf16x8 a = *(const bf16x8*)(ap + k0);
#pragma unroll
        for (int n = 0; n < NT; ++n) { const bf16x8 b = *(const bf16x8*)(bp + (size_t)n * 16 * ldb + k0); acc[n] = MFMA16(a, b, acc[n]); }
    }
}

DI void p_kv_mem(const Frame& F) {
    const bf16* MEMN = WSP(bf16, WS_MEMN);
    for (int u = F.gw; u < 512; u += F.NGW) {
        const int which = u >> 8, rt = (u & 255) >> 3, cg = u & 7; f32x4 acc[4];
        const bf16* Aop = which == 0 ? MEMN : WSP(bf16, WS_WV_T); const bf16* Bop = which == 0 ? WSP(bf16, WS_WK_T) : MEMN; bf16* O = which == 0 ? WSP(bf16, WS_KX) : WSP(bf16, WS_VXT);
        wave_tile_gemm<4>(Aop + (size_t)rt * 16 * 2048, 2048, Bop + (size_t)cg * 64 * 2048, 2048, 2048, F.lane, acc);
#pragma unroll
        for (int n = 0; n < 4; ++n)
#pragma unroll
            for (int i = 0; i < 4; ++i) O[(size_t)(rt * 16 + (F.lane >> 4) * 4 + i) * 512 + cg * 64 + n * 16 + (F.lane & 15)] = (bf16)(pk2(acc[n][i], 0.f) & 0xffffu);
    }
}

DI int spos(int s) { return (s & ~31) | (((s >> 2) & 3) << 3) | (((s >> 4) & 1) << 2) | (s & 3); }
template <bool CONV, bool NAT, bool TRN>
DI void conv_slab(const bf16* src, int pitch, int c0, size_t tok0, int s0, bool zero_halo, const float* cw, const float* cb, bf16* nat, bf16* trn, LAS unsigned char* tile, int lane) {
    constexpr int HALO = CONV ? 3 : 0, ROWS = 64 + HALO, TP = 144;
    const int rr = lane >> 3, cq = lane & 7;
#pragma unroll
    for (int i = 0; i < (ROWS + 7) / 8; ++i) { const int ri = 8 * i + rr;
        if (ri < ROWS) { u32x4 v = (u32x4){0u, 0u, 0u, 0u};
            if (!(zero_halo && ri < HALO)) v = *(const u32x4*)(src + (tok0 + s0 - HALO + ri) * (size_t)pitch + c0 + cq * 8);
            *(LAS u32x4*)(tile + ri * TP + cq * 16) = v; } }
    float w0 = 0.f, w1 = 0.f, w2 = 0.f, w3 = 0.f, bias = 0.f;
    if (CONV) { w0 = cw[c0 + lane]; w1 = cw[CONV_DIM + c0 + lane]; w2 = cw[2 * CONV_DIM + c0 + lane]; w3 = cw[3 * CONV_DIM + c0 + lane]; bias = cb[c0 + lane]; }
    LDS_WAIT();
    const LAS unsigned short* col = (const LAS unsigned short*)tile + lane;
    float h1 = 0.f, h2 = 0.f, h3 = 0.f;
    if (CONV) { h3 = bf2f(col[0]); h2 = bf2f(col[72]); h1 = bf2f(col[144]); }
    unsigned pk[32];
#pragma unroll
    for (int s2 = 0; s2 < 64; s2 += 2) {
        float o[2];
#pragma unroll
        for (int e = 0; e < 2; ++e) { const float xin = bf2f(col[(s2 + e + HALO) * 72]);
            if (CONV) { const float a = w3 * xin + w2 * h1 + w1 * h2 + w0 * h3 + bias; o[e] = silu_f(a); h3 = h2; h2 = h1; h1 = xin; }
            else o[e] = xin; }
        const unsigned p2 = pk2(o[0], o[1]);
        pk[spos(s2) >> 1] = p2;
        if (NAT) { nat[(tok0 + s0 + s2) * 512 + lane] = (bf16)(p2 & 0xffffu); nat[(tok0 + s0 + s2 + 1) * 512 + lane] = (bf16)(p2 >> 16); }
    }
    if (TRN) {
        LDS_WAIT();
#pragma unroll
        for (int m = 0; m < 8; ++m) *(LAS u32x4*)(tile + lane * TP + m * 16) = (u32x4){pk[4 * m], pk[4 * m + 1], pk[4 * m + 2], pk[4 * m + 3]};
        LDS_WAIT();
#pragma unroll
        for (int m = 0; m < 8; ++m) { const int cl = rr + 8 * m; *(u32x4*)(trn + (size_t)cl * 128 + s0 + cq * 8) = *(const LAS u32x4*)(tile + cl * TP + cq * 16); }
        LDS_WAIT();
    }
}
DI void p_conv(const Frame& F) {
    const bf16* XBC = WSP(bf16, WS_XBC); const bf16* QKV = WSP(bf16, WS_QKV);
    const float* cw = F.in[4]; const float* cb = F.in[5];
    bf16* XT = WSP(bf16, WS_XT); bf16* BT = WSP(bf16, WS_BT); bf16* BN = WSP(bf16, WS_BN); bf16* CN = WSP(bf16, WS_CN); bf16* VT = (bf16*)((unsigned char*)F.out + OUT_VT);
    LAS unsigned char* tile = F.lds + F.wave * 16384;
    for (int bc = blockIdx.x; bc < NCHUNK; bc += F.G) {
        const size_t tok0 = (size_t)bc * 128; const bool first = (bc % (SEQ / 128)) == 0;
#pragma unroll 1
        for (int task = F.wave; task < 96; task += NWAVES) {
            if (task < 80) { const int slab = task >> 1, hf = task & 1, c0 = slab * 64, s0 = hf * 64; const bool zh = first && hf == 0;
                if (slab < 24) conv_slab<true, false, true>(XBC, CONV_DIM, c0, tok0, s0, zh, cw, cb, nullptr, XT + ((size_t)bc * 1536 + c0) * 128, tile, F.lane);
                else if (slab < 32) conv_slab<true, true, true>(XBC, CONV_DIM, c0, tok0, s0, zh, cw, cb, BN + (c0 - 1536), BT + ((size_t)bc * 512 + (c0 - 1536)) * 128, tile, F.lane);
                else conv_slab<true, true, false>(XBC, CONV_DIM, c0, tok0, s0, zh, cw, cb, CN + (c0 - 2048), nullptr, tile, F.lane); }
            else { const int t2 = task - 80, slab = t2 >> 1, hf = t2 & 1, c0 = slab * 64;
                conv_slab<false, false, true>(QKV + 1024, 1536, c0, tok0, hf * 64, false, nullptr, nullptr, nullptr, VT + ((size_t)bc * 512 + c0) * 128, tile, F.lane); }
        }
        const float* DTRAW = WSP(float, WS_DTRAW); float* DTT = WSP(float, WS_DTT); float* ACT = WSP(float, WS_ACT); float* WL = WSP(float, WS_WL);
#pragma unroll 1
        for (int hh = 0; hh < 3; ++hh) { const int h = F.wave + 8 * hh; const float bias = F.in[6][h], a = -expf(F.in[7][h]);
            float dt2[2], c2[2];
#pragma unroll
            for (int j = 0; j < 2; ++j) { const float r = DTRAW[(size_t)(tok0 + 2 * F.lane + j) * 32 + h] + bias; dt2[j] = fmaxf(r, 0.f) + log1pf(expf(-fabsf(r))); }
            c2[0] = dt2[0] * a; c2[1] = c2[0] + dt2[1] * a;
            float sc = c2[1];
#pragma unroll
            for (int o = 1; o < 64; o <<= 1) { const float t = __shfl_up(sc, o); if (F.lane >= o) sc += t; }
            const float ex = sc - c2[1]; const float alast = __shfl(sc, 63);
            const float ac0 = ex + c2[0], ac1 = ex + c2[1];
            *(f32x2*)(DTT + ((size_t)bc * 24 + h) * 128 + 2 * F.lane) = (f32x2){dt2[0], dt2[1]};
            *(f32x2*)(ACT + ((size_t)bc * 24 + h) * 128 + 2 * F.lane) = (f32x2){ac0, ac1};
            *(f32x2*)(WL + ((size_t)bc * 24 + h) * 128 + spos(2 * F.lane)) = (f32x2){dt2[0] * __expf(alast - ac0), dt2[1] * __expf(alast - ac1)};
        }
    }
}

DI void p_ssd_local(const Frame& F) {
    const bf16* XT = WSP(bf16, WS_XT); const bf16* BT = WSP(bf16, WS_BT); const float* WL = WSP(float, WS_WL);
    bf16* STATE = (bf16*)((unsigned char*)F.out + OUT_STATE);
    const int lane = F.lane, fr = lane & 15, kg = lane >> 4;
    for (int u = F.gw; u < NCHUNK * SSD_HEADS; u += F.NGW) {
        const int bc = u / SSD_HEADS, h = u % SSD_HEADS, g = h / 6;
        const float* wlp = WL + ((size_t)bc * 24 + h) * 128 + kg * 8;
        const bf16* xp = XT + ((size_t)bc * 1536 + h * 64 + fr) * 128 + kg * 8;
        const bf16* bp = BT + ((size_t)bc * 512 + g * 128 + fr) * 128 + kg * 8;
        u32x4 xr[4][4]; f32x4 wv[4][2];
#pragma unroll
        for (int k = 0; k < 4; ++k) { wv[k][0] = *(const f32x4*)(wlp + k * 32); wv[k][1] = *(const f32x4*)(wlp + k * 32 + 4);
#pragma unroll
            for (int pt = 0; pt < 4; ++pt) xr[pt][k] = *(const u32x4*)(xp + (size_t)pt * 16 * 128 + k * 32); }
        bf16x8 xs[4][4];
#pragma unroll
        for (int k = 0; k < 4; ++k)
#pragma unroll
            for (int pt = 0; pt < 4; ++pt) { float f[8]; pg8::unpack8(xr[pt][k], f);
#pragma unroll
                for (int j = 0; j < 4; ++j) { f[j] *= wv[k][0][j]; f[4 + j] *= wv[k][1][j]; }
                xs[pt][k] = pack8(f); }
        bf16* st = STATE + ((size_t)bc * 24 + h) * 8192;
#pragma unroll 1
        for (int nh = 0; nh < 2; ++nh) {
            bf16x8 bfr[4][4];
#pragma unroll
            for (int nt = 0; nt < 4; ++nt)
#pragma unroll
                for (int k = 0; k < 4; ++k) bfr[nt][k] = *(const bf16x8*)(bp + (size_t)(nh * 64 + nt * 16) * 128 + k * 32);
            f32x4 acc[4][4];
#pragma unroll
            for (int a = 0; a < 4; ++a)
#pragma unroll
                for (int b = 0; b < 4; ++b) acc[a][b] = (f32x4){0.f, 0.f, 0.f, 0.f};
#pragma unroll
            for (int k = 0; k < 4; ++k)
#pragma unroll
                for (int nt = 0; nt < 4; ++nt)
#pragma unroll
                    for (int pt = 0; pt < 4; ++pt) acc[nt][pt] = MFMA16(bfr[nt][k], xs[pt][k], acc[nt][pt]);
#pragma unroll
            for (int nt = 0; nt < 4; ++nt)
#pragma unroll
                for (int pt = 0; pt < 4; ++pt) { u32x2 w; w.x = pk2(acc[nt][pt][0], acc[nt][pt][1]); w.y = pk2(acc[nt][pt][2], acc[nt][pt][3]);
                    *(u32x2*)(st + (size_t)(pt * 16 + fr) * 128 + nh * 64 + nt * 16 + kg * 4) = w; }
        }
    }
}

DI void p_sb_attn(const Frame& F) {
    const bf16* QKV = WSP(bf16, WS_QKV); const bf16* VT = (const bf16*)((const unsigned char*)F.out + OUT_VT); bf16* YSB = WSP(bf16, WS_RA);
    const int lane = F.lane, fr = lane & 15, kg = lane >> 4;
    const float scale = 0.08838834764831845f;
    for (int u = F.gw; u < BATCH * SB_H * (SEQ / 16); u += F.NGW) {
        const int bh = u / (SEQ / 16), strip = u % (SEQ / 16), b = bh / SB_H, h = bh % SB_H;
        const int q0 = strip * 16, t = q0 + fr; const size_t tb = (size_t)b * SEQ;
        bf16x8 qf[4];
#pragma unroll
        for (int k = 0; k < 4; ++k) qf[k] = *(const bf16x8*)(QKV + (tb + t) * 1536 + h * 128 + k * 32 + kg * 8);
        f32x4 o[8];
#pragma unroll
        for (int d = 0; d < 8; ++d) o[d] = (f32x4){0.f, 0.f, 0.f, 0.f};
        float R = 0.f;
#pragma unroll 1
        for (int kb = q0 >> 5; kb >= 0; --kb) {
            const int sb = kb * 32;
            f32x4 z[2];
#pragma unroll
            for (int st = 0; st < 2; ++st) { z[st] = (f32x4){0.f, 0.f, 0.f, 0.f};
                const bf16* kp = QKV + (tb + sb + st * 16 + fr) * 1536 + 512 + h * 128 + kg * 8;
#pragma unroll
                for (int k = 0; k < 4; ++k) z[st] = MFMA16(*(const bf16x8*)(kp + k * 32), qf[k], z[st]); }
            float lb[2][4], lk[2][4], tot[2];
#pragma unroll
            for (int st = 0; st < 2; ++st) { tot[st] = 0.f;
#pragma unroll
                for (int i = 0; i < 4; ++i) { const int s = sb + st * 16 + kg * 4 + i; const float zz = z[st][i] * scale;
                    const float l = fminf(zz, 0.f) - log1pf(__expf(-fabsf(zz)));
                    lb[st][i] = l; lk[st][i] = (s < t) ? (l - zz) : 0.f; tot[st] += lk[st][i]; } }
            float hi[2], all[2];
#pragma unroll
            for (int st = 0; st < 2; ++st) { const float t1 = __shfl_xor(tot[st], 16), t2 = __shfl_xor(tot[st], 32), t3 = __shfl_xor(tot[st], 48);
                all[st] = tot[st] + t1 + t2 + t3;
                hi[st] = (((kg ^ 1) > kg) ? t1 : 0.f) + (((kg ^ 2) > kg) ? t2 : 0.f) + (((kg ^ 3) > kg) ? t3 : 0.f); }
            float att[8];
#pragma unroll
            for (int st = 0; st < 2; ++st) { const float base = R + hi[st] + (st == 0 ? all[1] : 0.f);
                float suf = 0.f;
#pragma unroll
                for (int i = 3; i >= 0; --i) { const int s = sb + st * 16 + kg * 4 + i; att[st * 4 + i] = (s < t) ? __expf(lb[st][i] + base + suf) : 0.f; suf += lk[st][i]; } }
            R += all[0] + all[1];
            const bf16x8 pf = pack8(att);
            const int bcv = (int)((tb + sb) >> 7), sl = (sb & 127) + kg * 8;
#pragma unroll
            for (int d = 0; d < 8; ++d) { const bf16x8 vf = *(const bf16x8*)(VT + ((size_t)bcv * 512 + h * 128 + d * 16 + fr) * 128 + sl);
                o[d] = MFMA16(vf, pf, o[d]); }
            if (__all(R < -30.0f)) break;
        }
#pragma unroll
        for (int d = 0; d < 8; ++d) { u32x2 w; w.x = pk2(o[d][0], o[d][1]); w.y = pk2(o[d][2], o[d][3]);
            *(u32x2*)(YSB + (tb + t) * 2048 + 1536 + h * 128 + d * 16 + kg * 4) = w; }
    }
}

DI void p_ssd_scan(const Frame& F) {
    bf16* STATE = (bf16*)((unsigned char*)F.out + OUT_STATE); const float* ACT = WSP(float, WS_ACT);
    const int gt = blockIdx.x * 512 + F.tid, NT = F.G * 512;
    for (int e = gt; e < BATCH * SSD_HEADS * 2048; e += NT) {
        const int v4 = e & 2047, bh = e >> 11, b = bh / SSD_HEADS, h = bh % SSD_HEADS;
        f32x4 run = (f32x4){0.f, 0.f, 0.f, 0.f};
        for (int c0 = 0; c0 < 128; c0 += 8) {
            u32x2 tmp[8]; float dec[8];
#pragma unroll
            for (int j = 0; j < 8; ++j) { const size_t bc = (size_t)b * 128 + c0 + j; tmp[j] = *(const u32x2*)(STATE + (bc * 24 + h) * 8192 + v4 * 4); dec[j] = __expf(ACT[(bc * 24 + h) * 128 + 127]); }
#pragma unroll
            for (int j = 0; j < 8; ++j) { const size_t bc = (size_t)b * 128 + c0 + j;
                u32x2 w; w.x = pk2(run[0], run[1]); w.y = pk2(run[2], run[3]); *(u32x2*)(STATE + (bc * 24 + h) * 8192 + v4 * 4) = w;
                const f32x4 t4 = (f32x4){__uint_as_float(tmp[j].x << 16), __uint_as_float(tmp[j].x & 0xffff0000u), __uint_as_float(tmp[j].y << 16), __uint_as_float(tmp[j].y & 0xffff0000u)};
                run = run * dec[j] + t4; }
        }
    }
}

DI int cb_off(int t, int s) { return t * 256 + ((((s >> 2) ^ (2 * (t & 15))) << 3) | ((s & 3) << 1)); }
constexpr int SSQ_OFF = RING_BYTES + 1024, TAB_OFF = RING_BYTES + 5120;
DI void p_ssd_out(const Frame& F) {
    const bf16* XT = WSP(bf16, WS_XT); const bf16* BN = WSP(bf16, WS_BN); const bf16* CN = WSP(bf16, WS_CN); const bf16* Z = WSP(bf16, WS_Z);
    const float* DTT = WSP(float, WS_DTT); const float* ACT = WSP(float, WS_ACT); const bf16* STATE = (const bf16*)((const unsigned char*)F.out + OUT_STATE);
    bf16* YG = WSP(bf16, WS_RA); float* RSTD = WSP(float, WS_RSTD);
    const float* dskip = F.in[8];
    const int lane = F.lane, fr = lane & 15, kg = lane >> 4, w = F.wave, g = w >> 1;
    LAS unsigned char* cbl = F.lds + g * 32768;
    LAS float* tab = (LAS float*)(F.lds + TAB_OFF + w * 1024);
    LAS float* ssqp = (LAS float*)(F.lds + SSQ_OFF);
    for (int bc = blockIdx.x; bc < NCHUNK; bc += F.G) {
        const size_t tok0 = (size_t)bc * 128;
        REP(22)
#pragma unroll 1
        for (int q = 0; q < 4; ++q) { const int tt = (w & 1) + 2 * q;
            bf16x8 cf[4];
#pragma unroll
            for (int k = 0; k < 4; ++k) cf[k] = *(const bf16x8*)(CN + (tok0 + tt * 16 + fr) * 512 + g * 128 + k * 32 + kg * 8);
#pragma unroll 1
            for (int st = 0; st <= tt; ++st) { f32x4 X = (f32x4){0.f, 0.f, 0.f, 0.f}; const bf16* bp = BN + (tok0 + st * 16 + fr) * 512 + g * 128 + kg * 8;
#pragma unroll
                for (int k = 0; k < 4; ++k) X = MFMA16(*(const bf16x8*)(bp + k * 32), cf[k], X);
                u32x2 pw; pw.x = pk2(X[0], X[1]); pw.y = pk2(X[2], X[3]);
                *(LAS u32x2*)(cbl + cb_off(tt * 16 + fr, st * 16 + kg * 4)) = pw; } }
        __syncthreads();
        REP(23) {
        ssqp[w * 128 + lane] = 0.f; ssqp[w * 128 + 64 + lane] = 0.f;
#pragma unroll 1
        for (int r = 0; r < 3; ++r) {
            const int h = 3 * w + r; const float dsk = dskip[h];
            { const f32x2 d2 = *(const f32x2*)(DTT + ((size_t)bc * 24 + h) * 128 + 2 * lane), a2 = *(const f32x2*)(ACT + ((size_t)bc * 24 + h) * 128 + 2 * lane);
              *(LAS f32x2*)(tab + 2 * lane) = d2; *(LAS f32x2*)(tab + 128 + 2 * lane) = a2; }
            bf16x8 sf[4][4], xf0[4], xfA[4];
            const bf16* xbase = XT + ((size_t)bc * 1536 + h * 64) * 128;
            { unsigned so = (unsigned)(fr * 128 + kg * 8); asm volatile("" : "+v"(so));
              const bf16* sp0 = STATE + ((size_t)bc * 24 + h) * 8192;
#pragma unroll
              for (int pt = 0; pt < 4; ++pt) {
#pragma unroll
                  for (int k = 0; k < 4; ++k) sf[pt][k] = *(const bf16x8*)(sp0 + (so + (unsigned)(pt * 2048 + k * 32)));
                  xf0[pt] = *(const bf16x8*)(xbase + (so + (unsigned)(pt * 2048))); } }
            LDS_WAIT();
#define SSD_STEP(SP, XF) do { float mv[8]; \
        _Pragma("unroll") for (int half = 0; half < 2; ++half) { const int sbase = 32 * (SP) + 16 * half + kg * 4; \
            const u32x2 cbv = *(const LAS u32x2*)(cbl + cb_off(tl, sbase)); \
            const f32x4 dv = *(const LAS f32x4*)(tab + sbase), av = *(const LAS f32x4*)(tab + 128 + sbase); \
            const float cbf[4] = {__uint_as_float(cbv.x << 16), __uint_as_float(cbv.x & 0xffff0000u), __uint_as_float(cbv.y << 16), __uint_as_float(cbv.y & 0xffff0000u)}; \
            _Pragma("unroll") for (int i = 0; i < 4; ++i) { const int s_ = sbase + i; float v = 0.f; \
                if (s_ <= tl) v = cbf[i] * dv[i] * __expf(acum_t - av[i]); \
                if (s_ == tl) v += dsk; \
                mv[half * 4 + i] = v; } } \
        const bf16x8 mf = pack8(mv); \
        _Pragma("unroll") for (int pt = 0; pt < 4; ++pt) acc[pt] = MFMA16(XF[pt], mf, acc[pt]); } while (0)
#define SSD_LOADX(XF, SP) do { unsigned xo_ = (unsigned)(fr * 128 + kg * 8 + 32 * (SP)); asm volatile("" : "+v"(xo_)); \
        _Pragma("unroll") for (int pt = 0; pt < 4; ++pt) XF[pt] = *(const bf16x8*)(xbase + (xo_ + (unsigned)(pt * 2048))); } while (0)
#pragma unroll 1
            for (int tt = 0; tt < 8; ++tt) {
                int frx = fr; asm volatile("" : "+v"(frx));
                const int tl = tt * 16 + frx; const size_t tok = tok0 + tl; float ssq = 0.f;
                bf16x8 cf[4]; u32x2 zr[4];
                if (tt >= 2) SSD_LOADX(xfA, 1);
                const float acum_t = tab[128 + tl];
                f32x4 acc[4];
#pragma unroll
                for (int pt = 0; pt < 4; ++pt) acc[pt] = (f32x4){0.f, 0.f, 0.f, 0.f};
                SSD_STEP(0, xf0);
#pragma unroll
                for (int k = 0; k < 4; ++k) cf[k] = *(const bf16x8*)(CN + tok * 512 + g * 128 + k * 32 + kg * 8);
                if (tt >= 2) { SSD_STEP(1, xfA); if (tt >= 4) SSD_LOADX(xfA, 2); }
                if (tt >= 4) { SSD_STEP(2, xfA); if (tt >= 6) SSD_LOADX(xfA, 3); }
                if (tt >= 6) { SSD_STEP(3, xfA); }
#pragma unroll
                for (int pt = 0; pt < 4; ++pt) zr[pt] = *(const u32x2*)(Z + tok * 1536 + h * 64 + pt * 16 + kg * 4);
                { f32x4 ao[4];
#pragma unroll
                  for (int pt = 0; pt < 4; ++pt) ao[pt] = (f32x4){0.f, 0.f, 0.f, 0.f};
#pragma unroll
                  for (int k = 0; k < 4; ++k)
#pragma unroll
                      for (int pt = 0; pt < 4; ++pt) ao[pt] = MFMA16(sf[pt][k], cf[k], ao[pt]);
                  const float e = __expf(acum_t);
#pragma unroll
                  for (int pt = 0; pt < 4; ++pt) acc[pt] = ao[pt] * e + acc[pt]; }
#pragma unroll
                for (int pt = 0; pt < 4; ++pt) { const int col = h * 64 + pt * 16 + kg * 4;
                    const float z0 = __uint_as_float(zr[pt].x << 16), z1 = __uint_as_float(zr[pt].x & 0xffff0000u), z2 = __uint_as_float(zr[pt].y << 16), z3 = __uint_as_float(zr[pt].y & 0xffff0000u);
                    const float y0 = acc[pt][0] * silu_f(z0), y1 = acc[pt][1] * silu_f(z1), y2 = acc[pt][2] * silu_f(z2), y3 = acc[pt][3] * silu_f(z3);
                    ssq += (y0 * y0 + y1 * y1) + (y2 * y2 + y3 * y3);
                    u32x2 wv; wv.x = pk2(y0, y1); wv.y = pk2(y2, y3); *(u32x2*)(YG + tok * 2048 + col) = wv; }
                ssq += __shfl_xor(ssq, 16); ssq += __shfl_xor(ssq, 32);
                if (kg == 0) ssqp[w * 128 + tl] += ssq;
            }
            LDS_WAIT();
        }
        }
#undef SSD_STEP
#undef SSD_LOADX
        __syncthreads();
        if (F.tid < 128) { float v = 0.f;
#pragma unroll
            for (int ww = 0; ww < 8; ++ww) v += ssqp[ww * 128 + F.tid];
            RSTD[tok0 + F.tid] = 1.0f / sqrtf(v * (1.0f / 1536.0f) + EPS); }
        __syncthreads();
    }
}

DI void p_xattn(const Frame& F) {
    const bf16* Q2 = WSP(bf16, WS_Q2); const bf16* KX = WSP(bf16, WS_KX); const bf16* VXT = WSP(bf16, WS_VXT); bf16* O2 = WSP(bf16, WS_O2);
    const int lane = F.lane, fr = lane & 15, kg = lane >> 4;
    const float scale = 0.08838834764831845f;
    LAS unsigned char* kl = F.lds; LAS unsigned char* vl = F.lds + 65536;
    for (int task = blockIdx.x; task < 256; task += F.G) {
        const int bh = task >> 5, b = bh >> 2, h = bh & 3;
        __syncthreads();
#pragma unroll
        for (int i = 0; i < 8; ++i) { const int id = F.tid + 512 * i;
            { const int m = id >> 4, c = id & 15; *(LAS u32x4*)(kl + m * 256 + ((c ^ (m & 15)) << 4)) = *(const u32x4*)(KX + ((size_t)b * 256 + m) * 512 + h * 128 + c * 8); }
            { const int d = id >> 5, mc = id & 31, blk = mc >> 2, h2 = (mc >> 1) & 1, q = 2 * (mc & 1);
              const u32x4 v = *(const u32x4*)(VXT + ((size_t)h * 128 + d) * 512 + b * 256 + mc * 8);
              *(LAS u32x2*)(vl + d * 512 + (((blk * 4 + q) ^ (d & 15)) << 4) + 8 * h2) = (u32x2){v.x, v.y};
              *(LAS u32x2*)(vl + d * 512 + (((blk * 4 + q + 1) ^ (d & 15)) << 4) + 8 * h2) = (u32x2){v.z, v.w}; } }
        __syncthreads();
#pragma unroll 1
        for (int si = 0; si < 4; ++si) {
            const int strip = (task & 31) * 32 + F.wave * 4 + si;
            const size_t tok = (size_t)b * SEQ + strip * 16 + fr;
            bf16x8 qf[4];
#pragma unroll
            for (int k = 0; k < 4; ++k) qf[k] = *(const bf16x8*)(Q2 + tok * 512 + h * 128 + k * 32 + kg * 8);
            f32x4 sc[16];
#pragma unroll
            for (int mt = 0; mt < 16; ++mt) { sc[mt] = (f32x4){0.f, 0.f, 0.f, 0.f};
#pragma unroll
                for (int k = 0; k < 4; ++k) sc[mt] = MFMA16(*(const LAS bf16x8*)(kl + (mt * 16 + fr) * 256 + (((k * 4 + kg) ^ fr) << 4)), qf[k], sc[mt]);
                if (mt & 1) __builtin_amdgcn_sched_barrier(0); }
            float mx = -3.0e38f;
#pragma unroll
            for (int mt = 0; mt < 16; ++mt)
#pragma unroll
                for (int i = 0; i < 4; ++i) { sc[mt][i] *= scale; mx = fmaxf(mx, sc[mt][i]); }
            mx = fmaxf(mx, __shfl_xor(mx, 16)); mx = fmaxf(mx, __shfl_xor(mx, 32));
            float sum = 0.f;
#pragma unroll
            for (int mt = 0; mt < 16; ++mt)
#pragma unroll
                for (int i = 0; i < 4; ++i) { const float p = __expf(sc[mt][i] - mx); sc[mt][i] = p; sum += p; }
            sum += __shfl_xor(sum, 16); sum += __shfl_xor(sum, 32);
            const float inv = __builtin_amdgcn_rcpf(sum);
            f32x4 o[8];
#pragma unroll
            for (int d = 0; d < 8; ++d) o[d] = (f32x4){0.f, 0.f, 0.f, 0.f};
#pragma unroll
            for (int q = 0; q < 8; ++q) {
                float pv[8];
#pragma unroll
                for (int i = 0; i < 4; ++i) { pv[i] = sc[2 * q][i] * inv; pv[4 + i] = sc[2 * q + 1][i] * inv; }
                const bf16x8 pf = pack8(pv);
#pragma unroll
                for (int d = 0; d < 8; ++d) o[d] = MFMA16(*(const LAS bf16x8*)(vl + (d * 16 + fr) * 512 + (((q * 4 + kg) ^ fr) << 4)), pf, o[d]);
                __builtin_amdgcn_sched_barrier(0);
            }
#pragma unroll
            for (int d = 0; d < 8; ++d) { u32x2 w; w.x = pk2(o[d][0], o[d][1]); w.y = pk2(o[d][2], o[d][3]);
                *(u32x2*)(O2 + tok * 512 + h * 128 + d * 16 + kg * 4) = w; }
        }
    }
    __syncthreads();
}

DI void p_router(const Frame& F) {
    const bf16* HB = WSP(bf16, WS_RA); const bf16* WR = WSP(bf16, WS_WR_T); const float* SSQ2 = WSP(float, WS_SSQ2);
    int* TI = WSP(int, WS_TI); float* TG = WSP(float, WS_TG); unsigned* ecnt = WSP(unsigned, WS_CTL) + CW_ECNT;
    const int lane = F.lane, fr = lane & 15, kg = lane >> 4;
    LAS unsigned char* bl = F.lds; LAS float* lg = (LAS float*)(F.lds + 65536); LAS unsigned* lcnt = (LAS unsigned*)(F.lds + 65536 + 24576);
    for (int task = blockIdx.x; task < T / 128; task += F.G) {
        const size_t tok0 = (size_t)task * 128;
        f32x4 acc[3];
#pragma unroll
        for (int n = 0; n < 3; ++n) acc[n] = (f32x4){0.f, 0.f, 0.f, 0.f};
#pragma unroll 1
        for (int kc = 0; kc < 4; ++kc) {
            __syncthreads();
#pragma unroll
            for (int i = 0; i < 6; ++i) { const int id = F.tid + 512 * i, row = id >> 6, c = id & 63;
                *(LAS u32x4*)(bl + row * 1024 + ((c ^ (row & 15)) << 4)) = *(const u32x4*)(WR + (size_t)row * 2048 + kc * 512 + c * 8); }
            bf16x8 af[16];
            const bf16* ap = HB + (tok0 + F.wave * 16 + fr) * 2048 + kc * 512 + kg * 8;
#pragma unroll
            for (int ks = 0; ks < 16; ++ks) af[ks] = *(const bf16x8*)(ap + ks * 32);
            __syncthreads();
#pragma unroll
            for (int ks = 0; ks < 16; ++ks) {
#pragma unroll
                for (int n = 0; n < 3; ++n) acc[n] = MFMA16(af[ks], *(const LAS bf16x8*)(bl + (n * 16 + fr) * 1024 + (((ks * 4 + kg) ^ fr) << 4)), acc[n]);
                if ((ks & 3) == 3) __builtin_amdgcn_sched_barrier(0); }
        }
        if (F.tid < 64) lcnt[F.tid] = 0u;
#pragma unroll
        for (int i = 0; i < 4; ++i) { const int rl = F.wave * 16 + kg * 4 + i; const float rs = rstd32(SSQ2 + (tok0 + rl) * 32);
#pragma unroll
            for (int n = 0; n < 3; ++n) lg[rl * 48 + n * 16 + fr] = acc[n][i] * rs; }
        __syncthreads();
        unsigned lp1 = 0, lp2 = 0; int ex1 = 0, ex2 = 0; float w1 = 0.f, w2 = 0.f, ggate = 0.f;
        if (F.tid < 128) {
            const LAS float* l = lg + F.tid * 48;
            float gl[4] = {l[0], l[1], l[2], l[3]};
            int gs = 0; float gm = gl[0];
#pragma unroll
            for (int j = 1; j < 4; ++j) if (gl[j] > gm) { gm = gl[j]; gs = j; }
            float den = 0.f;
#pragma unroll
            for (int j = 0; j < 4; ++j) den += expf(gl[j] - gm);
            ggate = 1.0f / den;
            float el[8];
#pragma unroll
            for (int j = 0; j < 8; ++j) el[j] = l[4 + gs * 8 + j];
            int i1 = 0; float v1 = el[0];
#pragma unroll
            for (int j = 1; j < 8; ++j) if (el[j] > v1) { v1 = el[j]; i1 = j; }
            int i2 = -1; float v2 = -3.0e38f;
#pragma unroll
            for (int j = 0; j < 8; ++j) if (j != i1 && el[j] > v2) { v2 = el[j]; i2 = j; }
            const float e2 = expf(v2 - v1); w1 = 1.0f / (1.0f + e2); w2 = e2 / (1.0f + e2);
            ex1 = gs * 8 + i1; ex2 = gs * 8 + i2;
            lp1 = atomicAdd((unsigned*)&lcnt[ex1], 1u); lp2 = atomicAdd((unsigned*)&lcnt[ex2], 1u);
        }
        __syncthreads();
        if (F.tid < 32) lcnt[32 + F.tid] = __hip_atomic_fetch_add(ecnt + F.tid, lcnt[F.tid], __ATOMIC_RELAXED, __HIP_MEMORY_SCOPE_AGENT);
        __syncthreads();
        if (F.tid < 128) { const int t = (int)tok0 + F.tid;
            TI[t * 4 + 0] = ex1; TI[t * 4 + 1] = (int)(lcnt[32 + ex1] + lp1); TI[t * 4 + 2] = ex2; TI[t * 4 + 3] = (int)(lcnt[32 + ex2] + lp2);
            TG[t * 2 + 0] = w1 * ggate; TG[t * 2 + 1] = w2 * ggate; }
    }
    __syncthreads();
}
DI void p_route_b(const Frame& F) {
    const int* TI = WSP(int, WS_TI); int* TSLOT = WSP(int, WS_TSLOT); int* SLOTTOK = WSP(int, WS_SLOTTOK); int* TILEE = WSP(int, WS_TILEE);
    unsigned* ecnt = WSP(unsigned, WS_CTL) + CW_ECNT; const float* SSQ2 = WSP(float, WS_SSQ2); float* SRSTD = WSP(float, WS_SRSTD);
    LAS int* st = (LAS int*)(F.lds);
    if (F.tid < 32) st[64 + F.tid] = (int)__hip_atomic_load(ecnt + F.tid, __ATOMIC_RELAXED, __HIP_MEMORY_SCOPE_AGENT);
    __syncthreads();
    if (F.tid == 0) { int s = 0; for (int e = 0; e < 32; ++e) { st[e] = s; s += (st[64 + e] + 255) / 256 * 256; } st[32] = s; }
    __syncthreads();
    for (int t = blockIdx.x * 512 + F.tid; t < T; t += F.G * 512) {
        const int e1 = TI[t * 4 + 0], p1 = TI[t * 4 + 1], e2 = TI[t * 4 + 2], p2 = TI[t * 4 + 3];
        const int s1 = st[e1] + p1, s2 = st[e2] + p2;
        SLOTTOK[s1] = t; SLOTTOK[s2] = t; TSLOT[t * 2] = s1; TSLOT[t * 2 + 1] = s2;
        const float rs = rstd32(SSQ2 + (size_t)t * 32); SRSTD[s1] = rs; SRSTD[s2] = rs;
    }
    for (int e = blockIdx.x; e < 32; e += F.G) {
        const int a = st[e] + st[64 + e], bnd = st[e + 1];
        for (int s = a + F.tid; s < bnd; s += 512) { SLOTTOK[s] = 0; SRSTD[s] = 0.f; }
        for (int tl = st[e] / 256 + F.tid; tl < bnd / 256; tl += 512) TILEE[tl] = e;
    }
    if (blockIdx.x == 0 && F.tid == 0) TILEE[511] = st[32] / 256;
    __syncthreads();
}

DI void p_final(const Frame& F) {
    const bf16* Y = WSP(bf16, WS_Y); const int* TSLOT = WSP(int, WS_TSLOT); const float* TG = WSP(float, WS_TG); const float* w = F.in[25];
    for (int m = F.gw; m < T; m += F.NGW) {
        const int s1 = TSLOT[m * 2], s2 = TSLOT[m * 2 + 1]; const float g1 = TG[m * 2], g2 = TG[m * 2 + 1];
        f32x4* xr = (f32x4*)(F.out + (size_t)m * 2048) + F.lane; const u32x2* y1 = (const u32x2*)(Y + (size_t)s1 * 2048) + F.lane; const u32x2* y2 = (const u32x2*)(Y + (size_t)s2 * 2048) + F.lane;
        f32x4 v[8]; float s = 0.f;
#pragma unroll
        for (int j = 0; j < 8; ++j) { v[j] = xr[64 * j]; const u32x2 a = y1[64 * j], b = y2[64 * j];
            v[j].x += g1 * __uint_as_float(a.x << 16) + g2 * __uint_as_float(b.x << 16); v[j].y += g1 * __uint_as_float(a.x & 0xffff0000u) + g2 * __uint_as_float(b.x & 0xffff0000u);
            v[j].z += g1 * __uint_as_float(a.y << 16) + g2 * __uint_as_float(b.y << 16); v[j].w += g1 * __uint_as_float(a.y & 0xffff0000u) + g2 * __uint_as_float(b.y & 0xffff0000u);
            s += (v[j].x * v[j].x + v[j].y * v[j].y) + (v[j].z * v[j].z + v[j].w * v[j].w); }
        const float rstd = 1.0f / sqrtf(wave_sum(s) * (1.0f / 2048.0f) + EPS);
        const f32x4* wr4 = (const f32x4*)w + F.lane;
#pragma unroll
        for (int j = 0; j < 8; ++j) { const f32x4 ww = wr4[64 * j]; xr[64 * j] = v[j] * rstd * ww; }
    }
}

constexpr int NPHASE = 20;
struct Args { const float* in[26]; float* out; unsigned char* ws; int ph_lo, ph_hi; };
__global__ void __launch_bounds__(NWAVES * 64, 2) fwd(Args args) {
    extern __shared__ __attribute__((aligned(16))) unsigned char lds[];
    Frame F;
    F.lds = (LAS unsigned char*)lds;
    F.tid = threadIdx.x; F.lane = F.tid & 63; F.wave = __builtin_amdgcn_readfirstlane(F.tid >> 6);
    F.G = gridDim.x; F.gw = blockIdx.x * NWAVES + F.wave; F.NGW = F.G * NWAVES;
#pragma unroll
    for (int i = 0; i < 26; ++i) F.in[i] = args.in[i];
    F.out = args.out; F.ws = args.ws;
    volatile LAS unsigned* MISC = (volatile LAS unsigned*)(F.lds + MISC_OFF);
    for (int u = F.tid; u < (LDS_BYTES - RING_BYTES) / 4; u += NWAVES * 64) ((LAS unsigned*)(F.lds + RING_BYTES))[u] = 0u;
    __syncthreads();
    const int lo = args.ph_lo, hi = args.ph_hi;
    const bool one = (hi - lo) > 1;
    XcdBarrier bar; bar.bar = WSP(unsigned, WS_CTL) + CW_BAR; bar.x = 0; bar.st = nullptr;
    if (one) bar = xcd_barrier_post(WSP(unsigned, WS_CTL) + CW_BAR, MISC + 8);
#define IN(k) (lo <= (k) && (k) < hi)
#define SEAM(k) do { if (lo <= (k) && (k) + 1 < hi) xcd_barrier(bar); } while (0)
    LAS unsigned char* ring = F.lds;
    const int bx = blockIdx.x;
    const int vcu = (F.G % 8 == 0) ? (bx % 8) * (F.G / 8) + bx / 8 : bx;

    if (IN(0)) REP(0) { p0_prologue(F); SEAM(0); }
    if (IN(1)) REP(1) {
        pg8::Gemm g{WSP(bf16, WS_RA), WSP(bf16, WS_WIN_T), 2048, 2048, 2048, nullptr, nullptr, 0};
        pg8::StaticOrder S; S.init(T, IN_PAD, 2048, F.G, bx);
        pg8::EpiInProj E{WSP(bf16, WS_Z), WSP(bf16, WS_XBC), WSP(bf16, WS_QKV), WSP(bf16, WS_GATES), WSP(float, WS_DTRAW)};
        pg8::gemm_phase<pg8::EpiInProj, pg8::StaticOrder, true, false>(ring, g, S, E);
        p_kv_mem(F);
        SEAM(1);
    }
    if (IN(2)) REP(2) { p_conv(F); SEAM(2); }
    if (IN(3)) REP(3) { REP(20) p_ssd_local(F); REP(21) p_sb_attn(F); SEAM(3); }
    if (IN(4)) REP(4) { p_ssd_scan(F); SEAM(4); }
    if (IN(5)) REP(5) { p_ssd_out(F); SEAM(5); }
    if (IN(6)) REP(6) {
        pg8::Gemm g{WSP(bf16, WS_RA), WSP(bf16, WS_WCAT_T), 2048, 2048, 2048, nullptr, nullptr, 0};
        pg8::SplitOrder S; S.so.init(T, 2048, 2048, F.G, bx); S.nt0 = 1536 / 64; S.nt1 = 512 / 64;
        pg8::EpiMerge E{WSP(bf16, WS_MERGED), WSP(bf16, WS_GATES), WSP(float, WS_RSTD)};
        pg8::gemm_phase<pg8::EpiMerge, pg8::SplitOrder, true, false>(ring, g, S, E);
        SEAM(6);
    }
    if (IN(8)) REP(8) {
        pg8::Gemm g{WSP(bf16, WS_MERGED), WSP(bf16, WS_WMIX_T), 2048, 2048, 2048, nullptr, nullptr, 0};
        pg8::StaticOrder S; S.init(T, 2048, 2048, F.G, bx);
        pg8::EpiResStat E{F.in[0], F.out, WSP(bf16, WS_RA), WSP(float, WS_SSQ1)};
        pg8::gemm_phase<pg8::EpiResStat, pg8::StaticOrder, true, false>(ring, g, S, E);
        SEAM(8);
    }
    if (IN(9)) REP(9) { p_expert_weights(F); SEAM(9); }
    if (IN(10)) REP(10) {
        pg8::Gemm g{WSP(bf16, WS_RA), WSP(bf16, WS_WQ_T), 2048, 2048, 2048, nullptr, nullptr, 0};
        pg8::StaticOrder S; S.init(T, 512, 2048, F.G, bx);
        pg8::EpiBf16Rs E{WSP(bf16, WS_Q2), 512, WSP(float, WS_SSQ1)};
        pg8::gemm_phase<pg8::EpiBf16Rs, pg8::StaticOrder, true, false>(ring, g, S, E);
        SEAM(10);
    }
    if (IN(11)) REP(11) { p_xattn(F); SEAM(11); }
    if (IN(12)) REP(12) {
        pg8::Gemm g{WSP(bf16, WS_O2), WSP(bf16, WS_WO_T), 512, 512, 512, nullptr, nullptr, 0};
        pg8::StaticOrder S; S.init(T, 2048, 512, F.G, bx);
        pg8::EpiResStat E{F.out, F.out, WSP(bf16, WS_RA), WSP(float, WS_SSQ2)};
        pg8::gemm_phase<pg8::EpiResStat, pg8::StaticOrder, true, false>(ring, g, S, E);
        SEAM(12);
    }
    if (IN(14)) REP(14) { p_router(F); SEAM(14); }
    if (IN(16)) REP(16) { p_route_b(F); SEAM(16); }
    if (IN(17)) REP(17) {
        const int* TILEE = WSP(int, WS_TILEE);
        pg8::Gemm g{WSP(bf16, WS_RA), WSP(bf16, WS_WGU_T), 2048, 2048, 2048, WSP(int, WS_SLOTTOK), TILEE, (size_t)1024 * 2048};
        pg8::ListOrder S; S.init(TILEE[511], 4, F.G, bx, 2048 / 64);
        pg8::EpiSwiGLU E{WSP(bf16, WS_HID), WSP(float, WS_SRSTD)};
        pg8::gemm_phase<pg8::EpiSwiGLU, pg8::ListOrder, true, true>(ring, g, S, E);
        SEAM(17);
    }
    if (IN(18)) REP(18) {
        const int* TILEE = WSP(int, WS_TILEE);
        pg8::Gemm g{WSP(bf16, WS_HID), WSP(bf16, WS_WD_T), 512, 512, 512, nullptr, TILEE, (size_t)2048 * 512};
        pg8::ListOrder S; S.init(TILEE[511], 8, F.G, bx, 512 / 64);
        pg8::EpiBf16 E{WSP(bf16, WS_Y), 2048};
        pg8::gemm_phase<pg8::EpiBf16, pg8::ListOrder, true, false>(ring, g, S, E);
        SEAM(18);
    }
    if (IN(19)) REP(19) { p_final(F); }
#undef IN
#undef SEAM
}

extern "C" void kernel_launch(void* const* d_in, const int* in_sizes, int n_in, void* d_out, int out_size, void* d_ws, size_t ws_size, hipStream_t stream) {
    static int grid = 0;
    if (grid == 0) {
        if (n_in != 26 || out_size != T * D || ws_size < WS_END) { fprintf(stderr, "kernel_launch: unexpected sizes n_in %d out %d ws %zu\n", n_in, out_size, ws_size); grid = -1; return; }
        int dev = 0, cus = 0, per_cu = 0;
        if (hipGetDevice(&dev) != hipSuccess || hipDeviceGetAttribute(&cus, hipDeviceAttributeMultiprocessorCount, dev) != hipSuccess) { grid = -1; return; }
        if (hipFuncSetAttribute((const void*)fwd, hipFuncAttributeMaxDynamicSharedMemorySize, LDS_BYTES) != hipSuccess) { fprintf(stderr, "kernel_launch: hipFuncSetAttribute failed\n"); grid = -1; return; }
        if (hipOccupancyMaxActiveBlocksPerMultiprocessor(&per_cu, (const void*)fwd, NWAVES * 64, LDS_BYTES) != hipSuccess || per_cu < 1) fprintf(stderr, "kernel_launch: occupancy query reports %d\n", per_cu);
        (void)hipGetLastError();
        grid = cus;
    }
    if (grid < 0) return;
    if (hipMemsetAsync((char*)d_ws + WS_CTL, 0, CTL_ZERO_BYTES, stream) != hipSuccess) return;
    Args a{};
    for (int i = 0; i < 26; ++i) a.in[i] = (const float*)d_in[i];
    a.out = (float*)d_out; a.ws = (unsigned char*)d_ws;
    if (MK_N_LAUNCHES == 1) {
        a.ph_lo = 0; a.ph_hi = NPHASE;
        hipLaunchKernelGGL(fwd, dim3(grid), dim3(NWAVES * 64), LDS_BYTES, stream, a);
    } else {
        for (int p = 0; p < NPHASE; ++p) { a.ph_lo = p; a.ph_hi = p + 1; hipLaunchKernelGGL(fwd, dim3(grid), dim3(NWAVES * 64), LDS_BYTES, stream, a); }
    }
}
```

```cpp
#include <hip/hip_runtime.h>
#include <cstdio>
#include <cstdint>

#define DI __device__ __forceinline__
#define LAS __attribute__((address_space(3)))
#define GAS __attribute__((address_space(1)))
typedef unsigned short bf16;
typedef short bf16x8 __attribute__((ext_vector_type(8)));
typedef short s16x4 __attribute__((ext_vector_type(4)));
typedef float f32x4 __attribute__((ext_vector_type(4)));
typedef float f32x2 __attribute__((ext_vector_type(2)));
typedef unsigned u32x4 __attribute__((ext_vector_type(4)));
typedef unsigned u32x2 __attribute__((ext_vector_type(2)));
typedef __bf16 bf16x2_t __attribute__((ext_vector_type(2)));

#ifndef DUP_MASK
#define DUP_MASK 0
#endif
#define REP(k) for (int rep_ = 0; rep_ < 1 + 2 * ((DUP_MASK >> (k)) & 1); ++rep_)
#ifndef PROBE_PHASE
#define PROBE_PHASE -1
#endif
#define PROBE_MULT 10
#ifndef MK_N_LAUNCHES
#define MK_N_LAUNCHES 1
#endif

constexpr int D = 2048, BATCH = 2, SEQ = 16384, T = BATCH * SEQ;
constexpr int SSD_INNER = 1536, SSD_HEADS = 24, SSD_P = 64, SSD_N = 128, SSD_G = 4, SSD_L = 128, SSD_BC = 512, CONV_DIM = 2560;
constexpr int NCHUNK = T / SSD_L;
constexpr int SB_W = 512, SB_H = 4, SB_D = 128;
constexpr int IN_COLS = 9752, IN_PAD = 9984;
constexpr int XA_W = 512, MEM = 256;
constexpr int NEXP = 32, EFF = 512;
constexpr int NSLOT = 2 * T + NEXP * 256;
constexpr float EPS = 1e-6f;
constexpr float WGU_SCALE = 64.f, HID_SCALE = 16.f, WD_SCALE = 32.f, Y_SCALE = 16.f;

constexpr size_t MiB = 1u << 20;
constexpr size_t WS_CTL = 0, CTL_ZERO_BYTES = 1 * MiB;
constexpr size_t WS_WCAT_T = 1 * MiB;
constexpr size_t WS_WMIX_T = 9 * MiB;
constexpr size_t WS_WQ_T = 17 * MiB;
constexpr size_t WS_WK_T = 19 * MiB;
constexpr size_t WS_WV_T = 21 * MiB;
constexpr size_t WS_WO_T = 23 * MiB;
constexpr size_t WS_WR_T = 25 * MiB;
constexpr size_t WS_MEMN = 26 * MiB;
constexpr size_t WS_KX = 28 * MiB;
constexpr size_t WS_VXT = 28 * MiB + 512 * 1024;
constexpr size_t WS_DTRAW = 29 * MiB;
constexpr size_t WS_DTT = 33 * MiB;
constexpr size_t WS_ACT = 36 * MiB;
constexpr size_t WS_RSTD = 39 * MiB;
constexpr size_t WS_SRSTD = 53 * MiB;
constexpr size_t WS_USC = 62 * MiB;
constexpr size_t WS_WSC = 62 * MiB + 256 * 1024;
constexpr size_t WS_SSQ1 = 54 * MiB, WS_SSQ2 = 58 * MiB;
constexpr size_t WS_WL = 50 * MiB;
constexpr size_t WS_LOGITS = 40 * MiB;
constexpr size_t WS_TI = 48 * MiB;
constexpr size_t WS_TG = 48 * MiB + 512 * 1024;
constexpr size_t WS_TSLOT = 48 * MiB + 768 * 1024;
constexpr size_t WS_SLOTTOK = 49 * MiB;
constexpr size_t WS_TILEE = 49 * MiB + 512 * 1024;
constexpr size_t WS_WIN_T = 64 * MiB;
constexpr size_t WS_BT = 64 * MiB;
constexpr size_t WS_Q2 = 64 * MiB;
constexpr size_t WS_RA = 104 * MiB;
constexpr size_t WS_Z = 232 * MiB;
constexpr size_t WS_HID = 232 * MiB;
constexpr size_t WS_XBC = 328 * MiB;
constexpr size_t WS_MERGED = 328 * MiB;
constexpr size_t WS_HB8 = 328 * MiB;
constexpr size_t WS_QKV = 488 * MiB;
constexpr size_t WS_WGU_T = 488 * MiB;
constexpr size_t WS_GATES = 584 * MiB;
constexpr size_t WS_WD_T = 616 * MiB;
constexpr size_t WS_Y = 680 * MiB;
constexpr size_t WS_BN = 840 * MiB;
constexpr size_t WS_CN = 872 * MiB;
constexpr size_t WS_XT = 904 * MiB;
constexpr size_t WS_O2 = 968 * MiB;
constexpr size_t WS_END = 1000 * MiB;
constexpr size_t OUT_STATE = 0, OUT_VT = 192 * MiB;
constexpr size_t OUT_UQ = 0, OUT_WQI = 64 * MiB;
constexpr size_t OUT_WGU8 = 128 * MiB, OUT_WD8 = 224 * MiB;
constexpr int CW_BAR = 4096;
constexpr int CW_ECNT = 16384;
constexpr int CW_QEXP = 16512;
constexpr int CW_CMAX = 32768;

constexpr int RING_BYTES = 131072;
constexpr int MISC_OFF = RING_BYTES + 320;
constexpr int LDS_BYTES = 147456;
constexpr int NWAVES = 8;

DI float bf2f(bf16 v) { return __uint_as_float(((unsigned)v) << 16); }
DI unsigned pk2(float lo, float hi) { f32x2 v = {lo, hi}; bf16x2_t b = __builtin_convertvector(v, bf16x2_t); return __builtin_bit_cast(unsigned, b); }
DI bf16x8 pack8(const float (&v)[8]) { u32x4 p; p.x = pk2(v[0], v[1]); p.y = pk2(v[2], v[3]); p.z = pk2(v[4], v[5]); p.w = pk2(v[6], v[7]); return __builtin_bit_cast(bf16x8, p); }
DI float wave_sum(float v) {
#pragma unroll
    for (int o = 1; o < 64; o <<= 1) v += __shfl_xor(v, o);
    return v;
}
DI float silu_f(float x) { return x * __builtin_amdgcn_rcpf(1.0f + __expf(-x)); }
DI float sigmoid_f(float x) { return __builtin_amdgcn_rcpf(1.0f + __expf(-x)); }
DI unsigned pk4_fp8(float a, float b, float c, float d) { int w = 0;
    w = __builtin_amdgcn_cvt_pk_fp8_f32(__builtin_amdgcn_fmed3f(a, -448.f, 448.f), __builtin_amdgcn_fmed3f(b, -448.f, 448.f), w, false);
    w = __builtin_amdgcn_cvt_pk_fp8_f32(__builtin_amdgcn_fmed3f(c, -448.f, 448.f), __builtin_amdgcn_fmed3f(d, -448.f, 448.f), w, true); return (unsigned)w; }
DI unsigned pk4_i8(float a, float b, float c, float d) { const int ia = (int)__builtin_rintf(a), ib = (int)__builtin_rintf(b), ic = (int)__builtin_rintf(c), id = (int)__builtin_rintf(d);
    return (unsigned)(ia & 255) | ((unsigned)(ib & 255) << 8) | ((unsigned)(ic & 255) << 16) | ((unsigned)(id & 255) << 24); }
DI float rstd32(const float* p) { f32x4 a = *(const f32x4*)p;
#pragma unroll
    for (int i = 1; i < 8; ++i) a += *(const f32x4*)(p + 4 * i);
    return 1.0f / sqrtf(((a[0] + a[1]) + (a[2] + a[3])) * (1.0f / 2048.0f) + EPS); }
#define SUBPROBE_BEGIN(id) unsigned long long sp_t0_##id = 0; if (PROBE_PHASE == (id)) sp_t0_##id = __builtin_amdgcn_s_memrealtime()
#define SUBPROBE_END(id) do { if (PROBE_PHASE == (id) && F.pacc) *F.pacc += __builtin_amdgcn_s_memrealtime() - sp_t0_##id; } while (0)
#define MFMA16(a, b, c) __builtin_amdgcn_mfma_f32_16x16x32_bf16((a), (b), (c), 0, 0, 0)
#define LDS_WAIT() asm volatile("s_waitcnt lgkmcnt(0)" ::: "memory")
#define VM_WAIT() asm volatile("s_waitcnt vmcnt(0)" ::: "memory")

namespace pg8 {
#define PG8_LAS __attribute__((address_space(3)))
constexpr int BM = 256, BK = 64, HALF = 128, HTB = HALF * BK * 2, STAGE_BYTES = 8 * HTB, NXCD = 8, WGM = 8;
__host__ __device__ __forceinline__ int lds_byte(int r, int c) { const int st = (r >> 4) * 2 + (c >> 5), rr = r & 15, cc = c & 31, ob = rr * 64 + cc * 2; return st * 1024 + (ob ^ (((ob >> 9) & 1) << 5)); }
__host__ __device__ __forceinline__ void stage_rc(int b, int& R, int& C) { const int st = b / 1024, sb = b % 1024, swz = sb ^ (((sb >> 9) & 1) << 5); R = (st >> 1) * 16 + swz / 64; C = (st & 1) * 32 + (swz % 64) / 2; }
__host__ __device__ __forceinline__ int perm32(int rho) { const int n = rho >> 4, i = rho & 15; return 8 * (i >> 2) + 4 * n + (i & 3); }

struct Unit { int pm, pn, k0, nt, fin; };
struct Gemm { const void* A; const void* Bt; int K, lda, ldb; const int* arow; const int* tile_e; size_t b_estride; };

struct StaticOrder {
    int nM, nN, nwg, G, c, nt;
    __device__ void init(int M, int N, int K, int G_, int c_) { nM = M / BM; nN = N / BM; nwg = nM * nN; G = G_; c = c_; nt = K / BK; }
    __device__ bool next(int i, Unit& u) const {
        u.k0 = 0; u.nt = nt; u.fin = 1;
        const long L = (long)i * G + c; if (L >= nwg) return false;
        int wgid = (int)L; { const int q = nwg / NXCD, r = nwg % NXCD, xcd = wgid % NXCD, off = wgid / NXCD; wgid = (xcd < r ? xcd * (q + 1) : r * (q + 1) + (xcd - r) * q) + off; }
        const int nig = WGM * nN, gid = wgid / nig, fm = gid * WGM, gsz = (nM - fm) < WGM ? (nM - fm) : WGM;
        u.pm = fm + ((wgid % nig) % gsz); u.pn = (wgid % nig) / gsz; return true;
    }
};
struct ListOrder {
    int ntile, nN, G, c, nt;
    __device__ void init(int ntile_, int nN_, int G_, int c_, int nt_) { ntile = ntile_; nN = nN_; G = G_; c = c_; nt = nt_; }
    __device__ bool next(int i, Unit& u) const { u.k0 = 0; u.nt = nt; u.fin = 1; const int L = i * G + c; if (L >= ntile * nN) return false; u.pm = L / nN; u.pn = L % nN; return true; }
};
struct GatesOrder {
    int c, nt, G;
    __device__ bool next(int i, Unit& u) const { u.k0 = 0; u.nt = nt; u.fin = 1; int L;
        if (G == 256) { if (c < 128) { if (i >= 7) return false; L = c * 7 + i; } else { if (i >= 9) return false; L = 896 + (c - 128) * 9 + i; } }
        else { L = i * G + c; if (L >= 2048) return false; }
        u.pm = L >> 4; u.pn = L & 15; return true; }
};
struct SplitOrder {
    StaticOrder so; int nt0, nt1;
    __device__ bool next(int i, Unit& u) const { if (!so.next(i >> 1, u)) return false; if (i & 1) { u.k0 = nt0 * BK; u.nt = nt1; u.fin = 1; } else { u.k0 = 0; u.nt = nt0; u.fin = 0; } return true; }
};

typedef int v4i_t __attribute__((ext_vector_type(4)));
typedef int v8i_t __attribute__((ext_vector_type(8)));
template <class Epi, class Sched, bool ALIGN_EPI, bool GATHER, int MODE = 0>
__device__ __forceinline__ void gemm_phase(PG8_LAS unsigned char* lds, const Gemm g, const Sched& S, const Epi& E, unsigned long long* pacc = nullptr) {
    const int tid = threadIdx.x, wid = __builtin_amdgcn_readfirstlane(tid >> 6), lane = tid & 63, wr = wid >> 2, wc = wid & 3, fr = lane & 15, fq = lane >> 4;
    constexpr bool FP8 = (MODE == 1), I8 = (MODE == 2);
    constexpr int ESZ = MODE ? 1 : 2;
    unsigned voffB[2]; int RA[2], CA[2];
#pragma unroll
    for (int i = 0; i < 2; ++i) { int R, C; stage_rc(tid * 16 + i * 8192, R, C); const int Rb = (R & ~31) + perm32(R & 31);
        RA[i] = R; CA[i] = C; voffB[i] = (unsigned)(Rb * g.ldb * ESZ + C * 2); }
    const size_t kstep = (size_t)(BK * 2);
    const size_t hstepB = (size_t)HALF * g.ldb * ESZ;
    const size_t tstepB = 2 * hstepB;
    const unsigned ldsw = (unsigned)wid * 1024u;
    const int aoff = lds_byte(wr * 64 + fr, fq * 8), boff = lds_byte(wc * 32 + fr, fq * 8);
    const char* Ab = (const char*)g.A;
#define PG8_SA(b, h) (((b) * 2 + (h)) * HTB)
#define PG8_SB(b, h) ((4 + (b) * 2 + (h)) * HTB)
#define PG8_STAGE(bufoff, gbase, voff) do { _Pragma("unroll") for (int _i = 0; _i < 2; ++_i) \
        __builtin_amdgcn_global_load_lds((const unsigned*)((const char*)(gbase) + (voff)[_i]), (PG8_LAS unsigned*)(lds + (bufoff) + ldsw + _i * 8192), 16, 0, 0); } while (0)
#define PG8_STAGEA(bufoff, kb, o0, o1) do { \
        __builtin_amdgcn_global_load_lds((const unsigned*)(Ab + (kb) + (o0)), (PG8_LAS unsigned*)(lds + (bufoff) + ldsw), 16, 0, 0); \
        __builtin_amdgcn_global_load_lds((const unsigned*)(Ab + (kb) + (o1)), (PG8_LAS unsigned*)(lds + (bufoff) + ldsw + 8192), 16, 0, 0); } while (0)
#define PG8_LDA(dst, b, h) do { _Pragma("unroll") for (int m = 0; m < 4; ++m) dst[m] = __builtin_shufflevector(*(const PG8_LAS v4i_t*)(lds + PG8_SA(b, h) + aoff + m * 2048), *(const PG8_LAS v4i_t*)(lds + PG8_SA(b, h) + aoff + m * 2048 + 1024), 0, 1, 2, 3, 4, 5, 6, 7); } while (0)
#define PG8_LDB(dst, b, h) do { _Pragma("unroll") for (int n = 0; n < 2; ++n) dst[n] = __builtin_shufflevector(*(const PG8_LAS v4i_t*)(lds + PG8_SB(b, h) + boff + n * 2048), *(const PG8_LAS v4i_t*)(lds + PG8_SB(b, h) + boff + n * 2048 + 1024), 0, 1, 2, 3, 4, 5, 6, 7); } while (0)
#define PG8_LO(v) __builtin_bit_cast(bf16x8, __builtin_shufflevector((v), (v), 0, 1, 2, 3))
#define PG8_HI(v) __builtin_bit_cast(bf16x8, __builtin_shufflevector((v), (v), 4, 5, 6, 7))
#define PG8_MMA(ai, bj, At, Bt) do { __builtin_amdgcn_s_setprio(1); _Pragma("unroll") for (int m = 0; m < 4; ++m) _Pragma("unroll") for (int n = 0; n < 2; ++n) { \
        if constexpr (FP8) asm volatile("v_mfma_scale_f32_16x16x128_f8f6f4 %0, %1, %2, %0, %3, %3 op_sel_hi:[0,0,0]" : "+v"(acc[ai][bj][m][n]) : "v"(Bt[n]), "v"(At[m]), "v"(one_scale)); \
        else if constexpr (I8) { v4i_t c_ = __builtin_bit_cast(v4i_t, acc[ai][bj][m][n]); \
               c_ = __builtin_amdgcn_mfma_i32_16x16x64_i8(__builtin_shufflevector(Bt[n], Bt[n], 0, 1, 2, 3), __builtin_shufflevector(At[m], At[m], 0, 1, 2, 3), c_, 0, 0, 0); \
               c_ = __builtin_amdgcn_mfma_i32_16x16x64_i8(__builtin_shufflevector(Bt[n], Bt[n], 4, 5, 6, 7), __builtin_shufflevector(At[m], At[m], 4, 5, 6, 7), c_, 0, 0, 0); \
               acc[ai][bj][m][n] = __builtin_bit_cast(f32x4, c_); } \
        else { acc[ai][bj][m][n] = __builtin_amdgcn_mfma_f32_16x16x32_bf16(PG8_LO(Bt[n]), PG8_LO(At[m]), acc[ai][bj][m][n], 0, 0, 0); \
               acc[ai][bj][m][n] = __builtin_amdgcn_mfma_f32_16x16x32_bf16(PG8_HI(Bt[n]), PG8_HI(At[m]), acc[ai][bj][m][n], 0, 0, 0); } } \
        __builtin_amdgcn_s_setprio(0); } while (0)
#define PG8_WAIT_V(n) asm volatile("s_waitcnt vmcnt(" #n ")" ::: "memory")
#define PG8_WAIT_L(n) asm volatile("s_waitcnt lgkmcnt(" #n ")" ::: "memory")
#define PG8_BAR __builtin_amdgcn_s_barrier()
#define PG8_SCHED __builtin_amdgcn_sched_barrier(0)
#define PG8_SETA(o, u) do { _Pragma("unroll") for (int _h = 0; _h < 2; ++_h) _Pragma("unroll") for (int _i = 0; _i < 2; ++_i) { \
        int _row = (u).pm * BM + _h * HALF + RA[_i]; if (GATHER) _row = g.arow[_row]; (o)[_h][_i] = (unsigned)((_row * g.lda + (u).k0) * ESZ + CA[_i] * 2); } } while (0)
    Unit cur, nxt; int ui = 0;
    if (!S.next(0, cur)) return;
    f32x4 acc[2][2][4][2];
#pragma unroll
    for (int a = 0; a < 2; ++a)
#pragma unroll
        for (int b = 0; b < 2; ++b)
#pragma unroll
            for (int m = 0; m < 4; ++m)
#pragma unroll
                for (int n = 0; n < 2; ++n) acc[a][b][m][n] = (f32x4){0.f, 0.f, 0.f, 0.f};
    v8i_t At[4], B0[2], B1[2];
    const int one_scale = 0x7F7F7F7F;
    unsigned oc[2][2], on[2][2];
    PG8_SETA(oc, cur);
    const char* cB = (const char*)g.Bt + (g.tile_e ? (size_t)g.tile_e[cur.pm] * g.b_estride * ESZ : (size_t)0) + (size_t)cur.pn * tstepB + (size_t)cur.k0 * ESZ;
    PG8_STAGE(PG8_SB(0, 0), cB, voffB); PG8_STAGE(PG8_SB(0, 1), cB + hstepB, voffB); PG8_STAGEA(PG8_SA(0, 0), 0, oc[0][0], oc[0][1]); PG8_STAGEA(PG8_SA(0, 1), 0, oc[1][0], oc[1][1]);
    if (wr == 1) PG8_BAR;
    PG8_WAIT_V(2); PG8_BAR;
    PG8_STAGE(PG8_SB(1, 0), cB + kstep, voffB); PG8_STAGEA(PG8_SA(1, 0), kstep, oc[0][0], oc[0][1]); PG8_STAGE(PG8_SB(1, 1), cB + hstepB + kstep, voffB);
    PG8_WAIT_V(6); PG8_BAR;
    for (;;) {
        const bool has_next = S.next(ui + 1, nxt);
        const char* nB = cB;
        if (has_next) { nB = (const char*)g.Bt + (g.tile_e ? (size_t)g.tile_e[nxt.pm] * g.b_estride * ESZ : (size_t)0) + (size_t)nxt.pn * tstepB + (size_t)nxt.k0 * ESZ; }
        int nt = cur.nt; asm volatile("" : "+s"(nt));
#pragma unroll
        for (int _h = 0; _h < 2; ++_h)
#pragma unroll
            for (int _i = 0; _i < 2; ++_i) on[_h][_i] = oc[_h][_i];
        for (int t = 0; t < nt; t += 2) {
            const bool last = (t == nt - 2);
            if (last && has_next) { PG8_SETA(on, nxt); }
            const size_t k1 = (size_t)(t + 1) * kstep;
            const size_t k2 = last ? (size_t)0 : (size_t)(t + 2) * kstep, k3 = k2 + kstep;
            const char* b2 = last ? nB : cB + (size_t)(t + 2) * kstep; const char* b3 = b2 + kstep;
            const unsigned s00 = last ? on[0][0] : oc[0][0], s01 = last ? on[0][1] : oc[0][1], s10 = last ? on[1][0] : oc[1][0], s11 = last ? on[1][1] : oc[1][1];
            PG8_LDB(B0, 0, 0); PG8_LDB(B1, 0, 1); PG8_SCHED; PG8_LDA(At, 0, 0); PG8_STAGEA(PG8_SA(1, 1), k1, oc[1][0], oc[1][1]);
            PG8_WAIT_V(8); PG8_WAIT_L(0); PG8_BAR; PG8_MMA(0, 0, At, B0); PG8_MMA(0, 1, At, B1); PG8_BAR; PG8_SCHED;
            PG8_LDA(At, 0, 1); PG8_STAGE(PG8_SB(0, 0), b2, voffB); PG8_STAGE(PG8_SB(0, 1), b2 + hstepB, voffB); PG8_STAGEA(PG8_SA(0, 0), k2, s00, s01);
            PG8_WAIT_V(8); PG8_WAIT_L(0); PG8_BAR; PG8_MMA(1, 0, At, B0); PG8_MMA(1, 1, At, B1); PG8_BAR; PG8_SCHED;
            PG8_LDB(B0, 1, 0); PG8_LDB(B1, 1, 1); PG8_SCHED; PG8_LDA(At, 1, 0); PG8_STAGEA(PG8_SA(0, 1), k2, s10, s11);
            PG8_WAIT_V(8); PG8_WAIT_L(0); PG8_BAR; PG8_MMA(0, 0, At, B0); PG8_MMA(0, 1, At, B1); PG8_BAR; PG8_SCHED;
            PG8_LDA(At, 1, 1); PG8_STAGE(PG8_SB(1, 0), b3, voffB); PG8_STAGE(PG8_SB(1, 1), b3 + hstepB, voffB); PG8_STAGEA(PG8_SA(1, 0), k3, s00, s01);
            PG8_WAIT_V(8); PG8_WAIT_L(0); PG8_BAR; PG8_MMA(1, 0, At, B0); PG8_MMA(1, 1, At, B1); PG8_BAR; PG8_SCHED;
        }
        if constexpr (FP8) asm volatile("s_nop 15\n\ts_nop 15" ::: "memory");
        unsigned long long pt_e0 = 0; if (pacc) pt_e0 = __builtin_amdgcn_s_memrealtime();
        if constexpr (ALIGN_EPI) { if (wr == 0) PG8_BAR; }
        E(acc, cur, wr, wc, fr, fq);
        if (pacc) *pacc += __builtin_amdgcn_s_memrealtime() - pt_e0;
        if (!has_next) break;
        if (cur.fin) {
#pragma unroll
        for (int a = 0; a < 2; ++a)
#pragma unroll
            for (int b = 0; b < 2; ++b)
#pragma unroll
                for (int m = 0; m < 4; ++m)
#pragma unroll
                    for (int n = 0; n < 2; ++n) { acc[a][b][m][n] = (f32x4){0.f, 0.f, 0.f, 0.f}; }
        }
        cur = nxt; cB = nB; ++ui;
#pragma unroll
        for (int _h = 0; _h < 2; ++_h)
#pragma unroll
            for (int _i = 0; _i < 2; ++_i) oc[_h][_i] = on[_h][_i];
        if constexpr (ALIGN_EPI) { if (wr == 1) PG8_BAR; }
    }
    PG8_WAIT_V(0);
    if constexpr (!ALIGN_EPI) { if (wr == 0) PG8_BAR; }
    PG8_BAR;
#undef PG8_SA
#undef PG8_SB
#undef PG8_STAGE
#undef PG8_STAGEA
#undef PG8_LDA
#undef PG8_LDB
#undef PG8_MMA
#undef PG8_LO
#undef PG8_HI
#undef PG8_WAIT_V
#undef PG8_WAIT_L
#undef PG8_BAR
#undef PG8_SCHED
#undef PG8_SETA
}

#define EPI_ROWS(...) _Pragma("unroll") for (int ai = 0; ai < 2; ++ai) _Pragma("unroll") for (int m = 0; m < 4; ++m) { const int row = u.pm * BM + ai * HALF + wr * 64 + m * 16 + fr; \
        _Pragma("unroll") for (int bj = 0; bj < 2; ++bj) { const int col = u.pn * BM + bj * HALF + wc * 32 + 8 * fq; const f32x4 v0 = acc[ai][bj][m][0], v1 = acc[ai][bj][m][1]; __VA_ARGS__ } }
DI void unpack8_u8(u32x2 w, float (&f)[8]) {
#pragma unroll
    for (int j = 0; j < 4; ++j) { f[j] = (float)((w.x >> (8 * j)) & 255u); f[4 + j] = (float)((w.y >> (8 * j)) & 255u); } }
DI u32x4 pack8v(f32x4 v0, f32x4 v1) { u32x4 w; w.x = pk2(v0[0], v0[1]); w.y = pk2(v0[2], v0[3]); w.z = pk2(v1[0], v1[1]); w.w = pk2(v1[2], v1[3]); return w; }
DI void unpack8(u32x4 w, float (&f)[8]) { f[0] = __uint_as_float(w.x << 16); f[1] = __uint_as_float(w.x & 0xffff0000u); f[2] = __uint_as_float(w.y << 16); f[3] = __uint_as_float(w.y & 0xffff0000u);
    f[4] = __uint_as_float(w.z << 16); f[5] = __uint_as_float(w.z & 0xffff0000u); f[6] = __uint_as_float(w.w << 16); f[7] = __uint_as_float(w.w & 0xffff0000u); }

struct EpiF8 {
    unsigned char* O; int ldc; float sc;
    DI void operator()(const f32x4 (&acc)[2][2][4][2], const Unit& u, int wr, int wc, int fr, int fq) const {
        EPI_ROWS({ u32x2 w8; w8.x = pk4_fp8(v0[0] * sc, v0[1] * sc, v0[2] * sc, v0[3] * sc); w8.y = pk4_fp8(v1[0] * sc, v1[1] * sc, v1[2] * sc, v1[3] * sc); *(u32x2*)(O + (size_t)row * ldc + col) = w8; })
    }
};
struct EpiBf16 {
    bf16* O; int ldc; float sc;
    DI void operator()(const f32x4 (&acc)[2][2][4][2], const Unit& u, int wr, int wc, int fr, int fq) const {
        EPI_ROWS({ *(u32x4*)(O + (size_t)row * ldc + col) = pack8v(v0 * sc, v1 * sc); })
    }
};
struct EpiInProj {
    bf16 *Z, *XBC, *QKV; unsigned char* GATES; float* DTRAW; const float* usc; const float* wsc;
    DI void operator()(const f32x4 (&acc)[2][2][4][2], const Unit& u, int wr, int wc, int fr, int fq) const {
        const int pn = u.pn;
        f32x4 cs[2][2];
#pragma unroll
        for (int bj = 0; bj < 2; ++bj) { const int col = u.pn * BM + bj * HALF + wc * 32 + 8 * fq; cs[bj][0] = *(const f32x4*)(wsc + col); cs[bj][1] = *(const f32x4*)(wsc + col + 4); }
#pragma unroll
        for (int ai = 0; ai < 2; ++ai)
#pragma unroll
            for (int m = 0; m < 4; ++m) { const int row = u.pm * BM + ai * HALF + wr * 64 + m * 16 + fr; const float rs = usc[row];
#pragma unroll
                for (int bj = 0; bj < 2; ++bj) { const int col = u.pn * BM + bj * HALF + wc * 32 + 8 * fq;
                    const v4i_t i0 = __builtin_bit_cast(v4i_t, acc[ai][bj][m][0]), i1 = __builtin_bit_cast(v4i_t, acc[ai][bj][m][1]);
                    f32x4 v0, v1;
#pragma unroll
                    for (int j = 0; j < 4; ++j) { v0[j] = (float)i0[j] * rs * cs[bj][0][j]; v1[j] = (float)i1[j] * rs * cs[bj][1][j]; }
                    if (pn < 6) *(u32x4*)(Z + (size_t)row * 1536 + col) = pack8v(v0, v1);
                    else if (pn < 16) *(u32x4*)(XBC + (size_t)row * 2560 + (col - 1536)) = pack8v(v0, v1);
                    else if (pn < 22) *(u32x4*)(QKV + (size_t)row * 1536 + (col - 4096)) = pack8v(v0, v1);
                    else if (pn < 38) { f32x4 a, b;
#pragma unroll
                        for (int j = 0; j < 4; ++j) { a[j] = fmaxf(sigmoid_f(v0[j]) * 255.f, 1.f); b[j] = fmaxf(sigmoid_f(v1[j]) * 255.f, 1.f); }
                        u32x2 q; q.x = pk4_i8(a[0], a[1], a[2], a[3]); q.y = pk4_i8(b[0], b[1], b[2], b[3]);
                        *(u32x2*)(GATES + (size_t)row * 4096 + (col - 5632)) = q; }
                    else { const int c = col - 9728; if (c < 32) { *(f32x4*)(DTRAW + (size_t)row * 32 + c) = v0; *(f32x4*)(DTRAW + (size_t)row * 32 + c + 4) = v1; } } } }
    }
};
struct EpiMerge {
    bf16* MERGED; const unsigned char* GATES; const float* RSTD;
    DI void operator()(f32x4 (&acc)[2][2][4][2], const Unit& u, int wr, int wc, int fr, int fq) const { if (u.fin) fin(acc, u, wr, wc, fr, fq); else mid(acc, u, wr, wc, fr, fq); }
    DI void mid(f32x4 (&acc)[2][2][4][2], const Unit& u, int wr, int wc, int fr, int fq) const {
#pragma unroll
        for (int ai = 0; ai < 2; ++ai) { u32x2 ga[4][2], gb[4][2]; float rs[4];
#pragma unroll
            for (int m = 0; m < 4; ++m) { const int row = u.pm * BM + ai * HALF + wr * 64 + m * 16 + fr; rs[m] = RSTD[row];
#pragma unroll
                for (int bj = 0; bj < 2; ++bj) { const int col = u.pn * BM + bj * HALF + wc * 32 + 8 * fq; ga[m][bj] = *(const u32x2*)(GATES + (size_t)row * 4096 + col); gb[m][bj] = *(const u32x2*)(GATES + (size_t)row * 4096 + 2048 + col); } }
#pragma unroll
            for (int m = 0; m < 4; ++m)
#pragma unroll
                for (int bj = 0; bj < 2; ++bj) { float g1[8], g2[8]; unpack8_u8(ga[m][bj], g1); unpack8_u8(gb[m][bj], g2);
#pragma unroll
                    for (int j = 0; j < 4; ++j) { acc[ai][bj][m][0][j] *= rs[m] * g1[j] * __builtin_amdgcn_rcpf(fmaxf(g2[j], 1e-30f)); acc[ai][bj][m][1][j] *= rs[m] * g1[4 + j] * __builtin_amdgcn_rcpf(fmaxf(g2[4 + j], 1e-30f)); } }
            asm volatile("" ::: "memory"); }
    }
    DI void fin(const f32x4 (&acc)[2][2][4][2], const Unit& u, int wr, int wc, int fr, int fq) const {
        EPI_ROWS({ float g2[8]; unpack8_u8(*(const u32x2*)(GATES + (size_t)row * 4096 + 2048 + col), g2);
            f32x4 a, b;
_Pragma("unroll")
            for (int j = 0; j < 4; ++j) { a[j] = v0[j] * g2[j] * (1.0f / 255.0f); b[j] = v1[j] * g2[4 + j] * (1.0f / 255.0f); }
            *(u32x4*)(MERGED + (size_t)row * 2048 + col) = pack8v(a, b); })
    }
};
struct EpiResF32 {
    const float* base; float* out;
    DI void operator()(const f32x4 (&acc)[2][2][4][2], const Unit& u, int wr, int wc, int fr, int fq) const {
        EPI_ROWS({ const size_t o = (size_t)row * 2048 + col; const f32x4 b0 = *(const f32x4*)(base + o), b1 = *(const f32x4*)(base + o + 4);
            *(f32x4*)(out + o) = b0 + v0; *(f32x4*)(out + o + 4) = b1 + v1; })
    }
};
struct EpiResStatF32 {
    const float* base; bf16* hb; float* ssq;
    DI void operator()(const f32x4 (&acc)[2][2][4][2], const Unit& u, int wr, int wc, int fr, int fq) const {
#pragma unroll
        for (int ai = 0; ai < 2; ++ai) { f32x4 bv[4][2][2];
#pragma unroll
            for (int m = 0; m < 4; ++m)
#pragma unroll
                for (int bj = 0; bj < 2; ++bj) { const size_t o = (size_t)(u.pm * BM + ai * HALF + wr * 64 + m * 16 + fr) * 2048 + u.pn * BM + bj * HALF + wc * 32 + 8 * fq; bv[m][bj][0] = *(const f32x4*)(base + o); bv[m][bj][1] = *(const f32x4*)(base + o + 4); }
#pragma unroll
            for (int m = 0; m < 4; ++m) { const int row = u.pm * BM + ai * HALF + wr * 64 + m * 16 + fr; float sq = 0.f;
#pragma unroll
                for (int bj = 0; bj < 2; ++bj) { const size_t o = (size_t)row * 2048 + u.pn * BM + bj * HALF + wc * 32 + 8 * fq;
                    const f32x4 r0 = bv[m][bj][0] + acc[ai][bj][m][0], r1 = bv[m][bj][1] + acc[ai][bj][m][1];
                    *(u32x4*)(hb + o) = pack8v(r0, r1);
                    sq += (r0[0] * r0[0] + r0[1] * r0[1]) + (r0[2] * r0[2] + r0[3] * r0[3]) + (r1[0] * r1[0] + r1[1] * r1[1]) + (r1[2] * r1[2] + r1[3] * r1[3]); }
                sq += __shfl_xor(sq, 16); sq += __shfl_xor(sq, 32);
                if (fq == 0) ssq[(size_t)row * 32 + u.pn * 4 + wc] = sq; }
            asm volatile("" ::: "memory"); }
    }
};
struct EpiResStatBf {
    bf16* hb; float* ssq; unsigned char* hb8;
    DI void operator()(const f32x4 (&acc)[2][2][4][2], const Unit& u, int wr, int wc, int fr, int fq) const {
        u32x4 bv[2][4][2];
#pragma unroll
        for (int ai = 0; ai < 2; ++ai)
#pragma unroll
            for (int m = 0; m < 4; ++m)
#pragma unroll
                for (int bj = 0; bj < 2; ++bj) bv[ai][m][bj] = *(const u32x4*)(hb + (size_t)(u.pm * BM + ai * HALF + wr * 64 + m * 16 + fr) * 2048 + u.pn * BM + bj * HALF + wc * 32 + 8 * fq);
#pragma unroll
        for (int ai = 0; ai < 2; ++ai)
#pragma unroll
            for (int m = 0; m < 4; ++m) { const int row = u.pm * BM + ai * HALF + wr * 64 + m * 16 + fr; float sq = 0.f;
#pragma unroll
                for (int bj = 0; bj < 2; ++bj) { const size_t o = (size_t)row * 2048 + u.pn * BM + bj * HALF + wc * 32 + 8 * fq; float bf[8]; unpack8(bv[ai][m][bj], bf);
                    f32x4 r0, r1;
#pragma unroll
                    for (int j = 0; j < 4; ++j) { r0[j] = bf[j] + acc[ai][bj][m][0][j]; r1[j] = bf[4 + j] + acc[ai][bj][m][1][j]; }
                    *(u32x4*)(hb + o) = pack8v(r0, r1);
                    { u32x2 w8; w8.x = pk4_fp8(r0[0], r0[1], r0[2], r0[3]); w8.y = pk4_fp8(r1[0], r1[1], r1[2], r1[3]); *(u32x2*)(hb8 + o) = w8; }
                    sq += (r0[0] * r0[0] + r0[1] * r0[1]) + (r0[2] * r0[2] + r0[3] * r0[3]) + (r1[0] * r1[0] + r1[1] * r1[1]) + (r1[2] * r1[2] + r1[3] * r1[3]); }
                sq += __shfl_xor(sq, 16); sq += __shfl_xor(sq, 32);
                if (fq == 0) ssq[(size_t)row * 32 + u.pn * 4 + wc] = sq; }
    }
};
struct EpiBf16Rs {
    bf16* O; int ldc; const float* ssq;
    DI void operator()(const f32x4 (&acc)[2][2][4][2], const Unit& u, int wr, int wc, int fr, int fq) const {
_Pragma("unroll") for (int ai = 0; ai < 2; ++ai) _Pragma("unroll") for (int m = 0; m < 4; ++m) { const int row = u.pm * BM + ai * HALF + wr * 64 + m * 16 + fr; const float rs = rstd32(ssq + (size_t)row * 32);
            _Pragma("unroll") for (int bj = 0; bj < 2; ++bj) { const int col = u.pn * BM + bj * HALF + wc * 32 + 8 * fq; *(u32x4*)(O + (size_t)row * ldc + col) = pack8v(acc[ai][bj][m][0] * rs, acc[ai][bj][m][1] * rs); } }
    }
};
struct EpiSwiGLU {
    unsigned char* HID; const float* srstd; float in_scale, out_scale;
    DI void operator()(const f32x4 (&acc)[2][2][4][2], const Unit& u, int wr, int wc, int fr, int fq) const {
#pragma unroll
        for (int ai = 0; ai < 2; ++ai)
#pragma unroll
            for (int m = 0; m < 4; ++m) { const int row = u.pm * BM + ai * HALF + wr * 64 + m * 16 + fr; const int col = u.pn * 128 + wc * 32 + 8 * fq; const float rs = srstd[row] * in_scale;
                f32x4 a, b;
#pragma unroll
                for (int j = 0; j < 4; ++j) { a[j] = silu_f(acc[ai][0][m][0][j] * rs) * (acc[ai][1][m][0][j] * rs) * out_scale; b[j] = silu_f(acc[ai][0][m][1][j] * rs) * (acc[ai][1][m][1][j] * rs) * out_scale; }
                u32x2 w; w.x = pk4_fp8(a[0], a[1], a[2], a[3]); w.y = pk4_fp8(b[0], b[1], b[2], b[3]);
                *(u32x2*)(HID + (size_t)row * EFF + col) = w; }
    }
};
}

#define XB_TMO      128
#define XB_XCNT(j)  (256  + 64 * (j))
#define XB_XSUB(j)  (1280 + 64 * (j))
#define XB_XGEN(j)  (2304 + 64 * (j))
#define XB_TOP      3328
#define XB_TOPGEN   3392
#define XCD_BAR_WORDS 3456
#define XB_SPIN_CAP (1u << 18)
__device__ __forceinline__ unsigned xb_ld(unsigned* p)              { return __hip_atomic_load(p, __ATOMIC_RELAXED, __HIP_MEMORY_SCOPE_AGENT); }
__device__ __forceinline__ unsigned xb_add(unsigned* p, unsigned v) { return __hip_atomic_fetch_add(p, v, __ATOMIC_RELAXED, __HIP_MEMORY_SCOPE_AGENT); }
__device__ __forceinline__ unsigned xb_xcc_id() { return (unsigned)__builtin_amdgcn_s_getreg((3 << 11) | 20) & 0xFu; }
#define XB_SPIN(cond, bar) do { unsigned _sp = 0; while (cond) { __builtin_amdgcn_s_sleep(1); \
    if ((++_sp & 255u) == 0u) { if (xb_ld(&(bar)[XB_TMO])) break; if (_sp > XB_SPIN_CAP) { atomicAdd(&(bar)[XB_TMO], 1u); break; } } } } while (0)
struct XcdBarrier { unsigned* bar; unsigned x; volatile LAS unsigned* st; };
__device__ __forceinline__ XcdBarrier xcd_barrier_post(unsigned* bar, volatile LAS unsigned* st) {
    XcdBarrier b; b.bar = bar; b.x = xb_xcc_id(); b.st = st;
    if (threadIdx.x == 0) (void)xb_add(&bar[XB_XCNT(b.x)], 1u);
    return b;
}
__device__ __forceinline__ void xcd_barrier_complete(unsigned* bar, unsigned x, unsigned& nloc, unsigned& nx) {
    const unsigned G = gridDim.x * gridDim.y * gridDim.z;
    unsigned sum, cnt, mine, sp = 0u;
    for (;;) {
        sum = 0u; cnt = 0u; mine = 0u;
#pragma unroll
        for (unsigned j = 0; j < 16; ++j) { const unsigned c = xb_ld(&bar[XB_XCNT(j)]); sum += c; cnt += (c > 0u) ? 1u : 0u; mine = (j == x) ? c : mine; }
        if (sum == G) break;
        __builtin_amdgcn_s_sleep(1);
        if ((++sp & 255u) == 0u) { if (xb_ld(&bar[XB_TMO])) break; if (sp > XB_SPIN_CAP) { atomicAdd(&bar[XB_TMO], 1u); break; } }
    }
    nloc = mine > 0u ? mine : 1u; nx = cnt > 0u ? cnt : 1u;
}
__device__ __forceinline__ void xcd_barrier(const XcdBarrier& b) {
    asm volatile("s_waitcnt vmcnt(0)" ::: "memory");
    __syncthreads();
    if (threadIdx.x == 0) {
        unsigned* bar = b.bar;
        __builtin_amdgcn_s_waitcnt(0);
        unsigned nloc = b.st[0], nx = b.st[1];
        if (nloc == 0u) { xcd_barrier_complete(bar, b.x, nloc, nx); b.st[0] = nloc; b.st[1] = nx; }
        const unsigned old = xb_add(&bar[XB_XSUB(b.x)], 1u);
        const unsigned gen = old / nloc;
        if (old + 1u == (gen + 1u) * nloc) {
            __builtin_amdgcn_fence(__ATOMIC_RELEASE, "agent");
            asm volatile("s_waitcnt vmcnt(0)" ::: "memory");
            const unsigned og = xb_add(&bar[XB_TOP], 1u);
            const unsigned tg = og / nx;
            if (og + 1u == (tg + 1u) * nx) xb_add(&bar[XB_TOPGEN], 1u);
            else XB_SPIN(xb_ld(&bar[XB_TOPGEN]) == tg, bar);
            __builtin_amdgcn_fence(__ATOMIC_ACQUIRE, "agent");
            xb_add(&bar[XB_XGEN(b.x)], 1u);
            asm volatile("s_waitcnt vmcnt(0)" ::: "memory");
        } else {
            XB_SPIN(xb_ld(&bar[XB_XGEN(b.x)]) == gen, bar);
            __builtin_amdgcn_fence(__ATOMIC_ACQUIRE, "agent");
            asm volatile("s_waitcnt vmcnt(0)" ::: "memory");
        }
    }
    __syncthreads();
}

struct Frame {
    unsigned long long* pacc;
    LAS unsigned char* lds;
    int tid, lane, wave, G, gw, NGW;
    const float* in[26];
    float* out; unsigned char* ws;
};
#define WSP(type, off) ((type*)(F.ws + (off)))

DI void tr_item(const float* W, int ldw, int k0, int nsrc0, int nvalid, bf16* WT, int ldt, int drow0, const float* kscale, LAS float* scr, int lane) {
    const int nn = lane & 31;
#pragma unroll 8
    for (int i = 0; i < 32; ++i) { const int kk = 2 * i + (lane >> 5); float v = 0.f; if (nn < nvalid) v = W[(size_t)(k0 + kk) * ldw + nsrc0 + nn]; if (kscale) v *= kscale[k0 + kk]; scr[kk * 33 + nn] = v; }
    LDS_WAIT(); asm volatile("" ::: "memory");
    const int c = lane & 7;
#pragma unroll
    for (int j = 0; j < 4; ++j) { const int n = (lane >> 3) + 8 * j; const LAS float* s = scr + (8 * c) * 33 + n;
        u32x4 o; o.x = pk2(s[0 * 33], s[1 * 33]); o.y = pk2(s[2 * 33], s[3 * 33]); o.z = pk2(s[4 * 33], s[5 * 33]); o.w = pk2(s[6 * 33], s[7 * 33]);
        if (n < nvalid) *(u32x4*)(WT + (size_t)(drow0 + n) * ldt + k0 + 8 * c) = o; }
    LDS_WAIT(); asm volatile("" ::: "memory");
}
DI void tr_block(const float* W, int ldw, int K, int ncols, int nsrc0, bf16* WT, int ldt, int drow0, const float* kscale, LAS float* scr, int lane, int it) {
    const int nblk = (ncols + 31) / 32, kb = it / nblk, nb = it % nblk; const int nv = ncols - nb * 32 < 32 ? ncols - nb * 32 : 32;
    tr_item(W, ldw, kb * 64, nsrc0 + nb * 32, nv, WT, ldt, drow0 + nb * 32, kscale, scr, lane);
}
DI void tr64_item(const float* W, int ldw, int k0, int nsrc0, bf16* WT, int ldt, int drow0, const float* kscale, int lane) {
    const int n4 = lane & 15, kq = lane >> 4;
    f32x4 r[2][8];
#pragma unroll
    for (int hf = 0; hf < 2; ++hf)
#pragma unroll
        for (int i = 0; i < 8; ++i) r[hf][i] = *(const f32x4*)(W + (size_t)(k0 + hf * 32 + kq * 8 + i) * ldw + nsrc0 + n4 * 4);
#pragma unroll
    for (int hf = 0; hf < 2; ++hf) { const int kb = k0 + hf * 32 + kq * 8;
        if (kscale) { const f32x4 s0 = *(const f32x4*)(kscale + kb), s1 = *(const f32x4*)(kscale + kb + 4);
#pragma unroll
            for (int i = 0; i < 4; ++i) { r[hf][i] = r[hf][i] * s0[i]; r[hf][4 + i] = r[hf][4 + i] * s1[i]; } }
#pragma unroll
        for (int j = 0; j < 4; ++j) { u32x4 o; o.x = pk2(r[hf][0][j], r[hf][1][j]); o.y = pk2(r[hf][2][j], r[hf][3][j]); o.z = pk2(r[hf][4][j], r[hf][5][j]); o.w = pk2(r[hf][6][j], r[hf][7][j]);
            *(u32x4*)(WT + (size_t)(drow0 + n4 * 4 + j) * ldt + kb) = o; } }
}
DI void tr64_item8(const float* W, int ldw, int k0, int nsrc0, unsigned char* WT, int ldt, int drow0, const float* kscale, float sc, int lane) {
    const int n4 = lane & 15, kq = lane >> 4;
    f32x4 r[2][8];
#pragma unroll
    for (int hf = 0; hf < 2; ++hf)
#pragma unroll
        for (int i = 0; i < 8; ++i) r[hf][i] = *(const f32x4*)(W + (size_t)(k0 + kq * 16 + hf * 8 + i) * ldw + nsrc0 + n4 * 4);
    const int kb = k0 + kq * 16;
#pragma unroll
    for (int hf = 0; hf < 2; ++hf) { f32x4 s0 = (f32x4){sc, sc, sc, sc}, s1 = s0;
        if (kscale) { s0 = *(const f32x4*)(kscale + kb + hf * 8) * sc; s1 = *(const f32x4*)(kscale + kb + hf * 8 + 4) * sc; }
#pragma unroll
        for (int i = 0; i < 4; ++i) { r[hf][i] = r[hf][i] * s0[i]; r[hf][4 + i] = r[hf][4 + i] * s1[i]; } }
#pragma unroll
    for (int j = 0; j < 4; ++j) { u32x4 o; o.x = pk4_fp8(r[0][0][j], r[0][1][j], r[0][2][j], r[0][3][j]); o.y = pk4_fp8(r[0][4][j], r[0][5][j], r[0][6][j], r[0][7][j]);
        o.z = pk4_fp8(r[1][0][j], r[1][1][j], r[1][2][j], r[1][3][j]); o.w = pk4_fp8(r[1][4][j], r[1][5][j], r[1][6][j], r[1][7][j]);
        *(u32x4*)(WT + (size_t)(drow0 + n4 * 4 + j) * ldt + kb) = o; }
}
DI void tr64_block(const float* W, int ldw, int K, int ncols, int nsrc0, bf16* WT, int ldt, int drow0, const float* kscale, int lane, int it) {
    const int nblk = ncols / 64, kb = it / nblk, nb = it % nblk;
    tr64_item(W, ldw, kb * 64, nsrc0 + nb * 64, WT, ldt, drow0 + nb * 64, kscale, lane);
}
DI void tr64_block8(const float* W, int ldw, int K, int ncols, int nsrc0, unsigned char* WT, int ldt, int drow0, const float* kscale, float sc, int lane, int it) {
    const int nblk = ncols / 64, kb = it / nblk, nb = it % nblk;
    tr64_item8(W, ldw, kb * 64, nsrc0 + nb * 64, WT, ldt, drow0 + nb * 64, kscale, sc, lane);
}
DI void rms_row_bf16(const float* xrow, const float* w, bf16* orow, int lane) {
    const f32x4* xr = (const f32x4*)xrow + lane; const f32x4* wr4 = (const f32x4*)w + lane;
    f32x4 v[8]; float s = 0.f;
#pragma unroll
    for (int j = 0; j < 8; ++j) { v[j] = xr[64 * j]; s += (v[j].x * v[j].x + v[j].y * v[j].y) + (v[j].z * v[j].z + v[j].w * v[j].w); }
    const float rstd = 1.0f / sqrtf(wave_sum(s) * (1.0f / 2048.0f) + EPS);
    u32x2* o8 = (u32x2*)orow + lane;
#pragma unroll
    for (int j = 0; j < 8; ++j) { const f32x4 ww = wr4[64 * j]; u32x2 o; o.x = pk2(v[j].x * rstd * ww.x, v[j].y * rstd * ww.y); o.y = pk2(v[j].z * rstd * ww.z, v[j].w * rstd * ww.w); o8[64 * j] = o; }
}
DI void rms_rows(const Frame& F, const float* src, const float* w, bf16* dst, int rows, unsigned char* dst8 = nullptr) {
    const int lane = F.lane;
    int m = F.gw;
    for (; m + F.NGW < rows; m += 2 * F.NGW) {
        const f32x4* xa = (const f32x4*)(src + (size_t)m * 2048) + lane; const f32x4* xb = (const f32x4*)(src + (size_t)(m + F.NGW) * 2048) + lane; const f32x4* wr4 = (const f32x4*)w + lane;
        f32x4 va[8], vb[8]; float sa = 0.f, sb = 0.f;
#pragma unroll
        for (int j = 0; j < 8; ++j) { va[j] = xa[64 * j]; vb[j] = xb[64 * j]; }
#pragma unroll
        for (int j = 0; j < 8; ++j) { sa += (va[j].x * va[j].x + va[j].y * va[j].y) + (va[j].z * va[j].z + va[j].w * va[j].w); sb += (vb[j].x * vb[j].x + vb[j].y * vb[j].y) + (vb[j].z * vb[j].z + vb[j].w * vb[j].w); }
        const float ra = 1.0f / sqrtf(wave_sum(sa) * (1.0f / 2048.0f) + EPS), rb = 1.0f / sqrtf(wave_sum(sb) * (1.0f / 2048.0f) + EPS);
        u32x2* oa = (u32x2*)(dst + (size_t)m * 2048) + lane; u32x2* ob = (u32x2*)(dst + (size_t)(m + F.NGW) * 2048) + lane;
#pragma unroll
        for (int j = 0; j < 8; ++j) { const f32x4 ww = wr4[64 * j]; const f32x4 ya = va[j] * ra * ww, yb = vb[j] * rb * ww;
            u32x2 o; o.x = pk2(ya.x, ya.y); o.y = pk2(ya.z, ya.w); oa[64 * j] = o;
            u32x2 p; p.x = pk2(yb.x, yb.y); p.y = pk2(yb.z, yb.w); ob[64 * j] = p;
            if (dst8) { ((unsigned*)(dst8 + (size_t)m * 2048))[lane + 64 * j] = pk4_fp8(ya.x, ya.y, ya.z, ya.w); ((unsigned*)(dst8 + (size_t)(m + F.NGW) * 2048))[lane + 64 * j] = pk4_fp8(yb.x, yb.y, yb.z, yb.w); } }
    }
    for (; m < rows; m += F.NGW) rms_row_bf16(src + (size_t)m * 2048, w, dst + (size_t)m * 2048, lane);
}

DI void rms_rows_q(const Frame& F, const float* src, const float* w, unsigned char* dstq, float* usc, int rows) {
    const int lane = F.lane;
    for (int m = F.gw; m < rows; m += 2 * F.NGW) {
        const int m2 = m + F.NGW; const bool two = m2 < rows; const int mb = two ? m2 : m;
        const f32x4* xa = (const f32x4*)(src + (size_t)m * 2048) + lane; const f32x4* xb = (const f32x4*)(src + (size_t)mb * 2048) + lane; const f32x4* wr4 = (const f32x4*)w + lane;
        f32x4 va[8], vb[8]; float sa = 0.f, sb = 0.f;
#pragma unroll
        for (int j = 0; j < 8; ++j) { va[j] = xa[64 * j]; vb[j] = xb[64 * j]; }
#pragma unroll
        for (int j = 0; j < 8; ++j) { sa += (va[j].x * va[j].x + va[j].y * va[j].y) + (va[j].z * va[j].z + va[j].w * va[j].w); sb += (vb[j].x * vb[j].x + vb[j].y * vb[j].y) + (vb[j].z * vb[j].z + vb[j].w * vb[j].w); }
        const float ra = 1.0f / sqrtf(wave_sum(sa) * (1.0f / 2048.0f) + EPS), rb = 1.0f / sqrtf(wave_sum(sb) * (1.0f / 2048.0f) + EPS);
        float ma = 0.f, mbx = 0.f;
#pragma unroll
        for (int j = 0; j < 8; ++j) { const f32x4 ww = wr4[64 * j]; va[j] = va[j] * ra * ww; vb[j] = vb[j] * rb * ww;
            ma = fmaxf(ma, fmaxf(fmaxf(fabsf(va[j].x), fabsf(va[j].y)), fmaxf(fabsf(va[j].z), fabsf(va[j].w)))); mbx = fmaxf(mbx, fmaxf(fmaxf(fabsf(vb[j].x), fabsf(vb[j].y)), fmaxf(fabsf(vb[j].z), fabsf(vb[j].w)))); }
#pragma unroll
        for (int o = 1; o < 64; o <<= 1) { ma = fmaxf(ma, __shfl_xor(ma, o)); mbx = fmaxf(mbx, __shfl_xor(mbx, o)); }
        const float ia = ma > 0.f ? 127.0f / ma : 0.f, ib = mbx > 0.f ? 127.0f / mbx : 0.f;
        unsigned* oa = (unsigned*)(dstq + (size_t)m * 2048) + lane; unsigned* ob = (unsigned*)(dstq + (size_t)mb * 2048) + lane;
#pragma unroll
        for (int j = 0; j < 8; ++j) { oa[64 * j] = pk4_i8(va[j].x * ia, va[j].y * ia, va[j].z * ia, va[j].w * ia); if (two) ob[64 * j] = pk4_i8(vb[j].x * ib, vb[j].y * ib, vb[j].z * ib, vb[j].w * ib); }
        if (lane == 0) { usc[m] = ma * (1.0f / 127.0f); if (two) usc[mb] = mbx * (1.0f / 127.0f); }
    }
}
DI void win_item(int it, int& k0, int& nsrc0, int& drow0) {
    constexpr int NB = 153;
    const int kb = it / NB, nb = it % NB; k0 = kb * 64;
    if (nb < 24) { nsrc0 = nb * 64; drow0 = nb * 64; }
    else if (nb < 64) { nsrc0 = 1536 + (nb - 24) * 64; drow0 = 1536 + (nb - 24) * 64; }
    else if (nb < 88) { nsrc0 = 4120 + (nb - 64) * 64; drow0 = 4096 + (nb - 64) * 64; }
    else if (nb < 152) { nsrc0 = 5656 + (nb - 88) * 64; drow0 = 5632 + (nb - 88) * 64; }
    else { nsrc0 = 4096; drow0 = 9728; }
}
constexpr int WIN_ITEMS = 32 * 153;
DI void win_colmax(const Frame& F) {
    const float* W = F.in[3]; unsigned* cmax = WSP(unsigned, WS_CTL) + CW_CMAX;
    const int lane = F.lane, n4 = lane & 15, kq = lane >> 4;
    for (int it = F.gw; it < WIN_ITEMS; it += F.NGW) { int k0, nsrc0, drow0; win_item(it, k0, nsrc0, drow0);
        f32x4 mx = (f32x4){0.f, 0.f, 0.f, 0.f};
#pragma unroll
        for (int i = 0; i < 16; ++i) { const f32x4 v = *(const f32x4*)(W + (size_t)(k0 + kq * 16 + i) * IN_COLS + nsrc0 + n4 * 4);
#pragma unroll
            for (int j = 0; j < 4; ++j) mx[j] = fmaxf(mx[j], fabsf(v[j])); }
#pragma unroll
        for (int j = 0; j < 4; ++j) { float v = mx[j]; v = fmaxf(v, __shfl_xor(v, 16)); v = fmaxf(v, __shfl_xor(v, 32));
            if (kq == 0) atomicMax(cmax + drow0 + n4 * 4 + j, __float_as_uint(v)); }
    }
}
DI void win_quant(const Frame& F) {
    const float* W = F.in[3]; const unsigned* cmax = WSP(unsigned, WS_CTL) + CW_CMAX; unsigned char* WT = (unsigned char*)F.out + OUT_WQI; float* wsc = WSP(float, WS_WSC);
    const int lane = F.lane, n4 = lane & 15, kq = lane >> 4;
    for (int it = F.gw; it < WIN_ITEMS; it += F.NGW) { int k0, nsrc0, drow0; win_item(it, k0, nsrc0, drow0);
        f32x4 r[16];
#pragma unroll
        for (int i = 0; i < 16; ++i) r[i] = *(const f32x4*)(W + (size_t)(k0 + kq * 16 + i) * IN_COLS + nsrc0 + n4 * 4);
#pragma unroll
        for (int j = 0; j < 4; ++j) { const float cm = __uint_as_float(__hip_atomic_load(cmax + drow0 + n4 * 4 + j, __ATOMIC_RELAXED, __HIP_MEMORY_SCOPE_AGENT)); const float inv = cm > 0.f ? 127.0f / cm : 0.f;
            u32x4 o; o.x = pk4_i8(r[0][j] * inv, r[1][j] * inv, r[2][j] * inv, r[3][j] * inv); o.y = pk4_i8(r[4][j] * inv, r[5][j] * inv, r[6][j] * inv, r[7][j] * inv);
            o.z = pk4_i8(r[8][j] * inv, r[9][j] * inv, r[10][j] * inv, r[11][j] * inv); o.w = pk4_i8(r[12][j] * inv, r[13][j] * inv, r[14][j] * inv, r[15][j] * inv);
            *(u32x4*)(WT + (size_t)(drow0 + n4 * 4 + j) * 2048 + k0 + kq * 16) = o;
            if (k0 == 0 && kq == 0) wsc[drow0 + n4 * 4 + j] = cm * (1.0f / 127.0f); }
    }
    { const int gt = F.gw * 64 + F.lane, NT = F.NGW * 64;
      u32x4* z1 = (u32x4*)(WT + (size_t)9792 * 2048); for (int i = gt; i < (IN_PAD - 9792) * 2048 / 16; i += NT) z1[i] = (u32x4){0u, 0u, 0u, 0u};
      for (int i = gt; i < IN_PAD - 9792; i += NT) wsc[9792 + i] = 0.f; }
}
DI void p0_prologue(const Frame& F) {
    LAS float* scr = (LAS float*)(F.lds + F.wave * 16384);
    win_colmax(F);
    constexpr int I_SSD = (1536 / 64) * (2048 / 64), I_SB = (512 / 64) * (2048 / 64), I_MIX = (2048 / 64) * (2048 / 64);
    constexpr int I_XQ = (2048 / 64) * (512 / 64), I_XO = (512 / 64) * (2048 / 64);
    constexpr int NITEMS = I_SSD + I_SB + I_MIX + 3 * I_XQ + I_XO;
    for (int it = F.gw; it < NITEMS; it += F.NGW) {
        int r = it;
        if (r < I_SSD) { tr64_block(F.in[10], 2048, 1536, 2048, 0, WSP(bf16, WS_WCAT_T), 2048, 0, F.in[9], F.lane, r); continue; } r -= I_SSD;
        if (r < I_SB)  { tr64_block(F.in[11], 2048, 512,  2048, 0, WSP(bf16, WS_WCAT_T) + 1536, 2048, 0, nullptr, F.lane, r); continue; } r -= I_SB;
        if (r < I_MIX) { tr64_block(F.in[12], 2048, 2048, 2048, 0, WSP(bf16, WS_WMIX_T), 2048, 0, nullptr, F.lane, r); continue; } r -= I_MIX;
        if (r < I_XQ)  { tr64_block(F.in[15], 512, 2048, 512, 0, WSP(bf16, WS_WQ_T), 2048, 0, F.in[13], F.lane, r); continue; } r -= I_XQ;
        if (r < I_XQ)  { tr64_block(F.in[16], 512, 2048, 512, 0, WSP(bf16, WS_WK_T), 2048, 0, nullptr, F.lane, r); continue; } r -= I_XQ;
        if (r < I_XQ)  { tr64_block(F.in[17], 512, 2048, 512, 0, WSP(bf16, WS_WV_T), 2048, 0, nullptr, F.lane, r); continue; } r -= I_XQ;
        tr64_block(F.in[18], 2048, 512, 2048, 0, WSP(bf16, WS_WO_T), 512, 0, nullptr, F.lane, r);
    }
    constexpr int I_RG = 32, I_RE = 32;
    for (int it = F.gw; it < I_RG + I_RE; it += F.NGW) {
        int r = it;
        if (r < I_RG)  { tr_block(F.in[20], 4, 2048, 4, 0, WSP(bf16, WS_WR_T), 2048, 0, F.in[19], scr, F.lane, r); continue; } r -= I_RG;
        tr_block(F.in[21], 32, 2048, 32, 0, WSP(bf16, WS_WR_T), 2048, 4, F.in[19], scr, F.lane, r);
    }
    { const int gt = F.gw * 64 + F.lane, NT = F.NGW * 64;
      u32x4* z2 = (u32x4*)(WSP(bf16, WS_WR_T) + (size_t)36 * 2048); for (int i = gt; i < 12 * 2048 / 8; i += NT) z2[i] = (u32x4){0u, 0u, 0u, 0u}; }
    rms_rows_q(F, F.in[0], F.in[2], (unsigned char*)F.out + OUT_UQ, WSP(float, WS_USC), T);
    rms_rows(F, F.in[1], F.in[14], WSP(bf16, WS_MEMN), BATCH * MEM);
}
DI void p_expert_weights(const Frame& F, int quota) {
    constexpr int PER = 256, NIT = NEXP * 3 * PER;
    unsigned* qh = WSP(unsigned, WS_CTL) + CW_QEXP;
    unsigned char* WGU8 = (unsigned char*)F.out + OUT_WGU8; unsigned char* WD8 = (unsigned char*)F.out + OUT_WD8;
    for (int n = 0; n < quota; ++n) {
        unsigned itu = 0; if (F.lane == 0) itu = __hip_atomic_fetch_add(qh, 1u, __ATOMIC_RELAXED, __HIP_MEMORY_SCOPE_AGENT);
        const int it = __builtin_amdgcn_readfirstlane((int)itu);
        if (it >= NIT) break;
        const int e = it / (3 * PER), r = it % (3 * PER), which = r / PER, q = r % PER;
        if (which < 2) { const int kb = q / 8, nb = q % 8, n0 = nb * 64; const float* W = (which == 0 ? F.in[22] : F.in[23]) + (size_t)e * 2048 * 512;
            tr64_item8(W, 512, kb * 64, n0, WGU8 + (size_t)e * 1024 * 2048, 2048, (n0 / 128) * 256 + (n0 % 128) + which * 128, F.in[19], WGU_SCALE, F.lane); }
        else { const int kb = q / 32, nb = q % 32; const float* W = F.in[24] + (size_t)e * 512 * 2048;
            tr64_item8(W, 2048, kb * 64, nb * 64, WD8 + (size_t)e * 2048 * 512, 512, nb * 64, nullptr, WD_SCALE, F.lane); }
    }
}

template <int NT>
DI void wave_tile_gemm(const bf16* A, int lda, const bf16* Bt, int ldb, int K, int lane, f32x4 (&acc)[NT]) {
    const int fr = lane & 15, kg = lane >> 4;
#pragma unroll
    for (int n = 0; n < NT; ++n) acc[n] = (f32x4){0.f, 0.f, 0.f, 0.f};
    const bf16* ap = A + (size_t)fr * lda + kg * 8;
    const bf16* bp = Bt + (size_t)fr * ldb + kg * 8;
#pragma unroll 4
    for (int k0 = 0; k0 < K; k0 += 32) {
        const bf16x8 a = *(const bf16x8*)(ap + k0);
#pragma unroll
        for (int n = 0; n < NT; ++n) { const bf16x8 b = *(const bf16x8*)(bp + (size_t)n * 16 * ldb + k0); acc[n] = MFMA16(a, b, acc[n]); }
    }
}

DI void p_kv_mem(const Frame& F) {
    const bf16* MEMN = WSP(bf16, WS_MEMN);
    for (int u = F.gw; u < 512; u += F.NGW) {
        const int which = u >> 8, rt = (u & 255) >> 3, cg = u & 7; f32x4 acc[4];
        const bf16* Aop = which == 0 ? MEMN : WSP(bf16, WS_WV_T); const bf16* Bop = which == 0 ? WSP(bf16, WS_WK_T) : MEMN; bf16* O = which == 0 ? WSP(bf16, WS_KX) : WSP(bf16, WS_VXT);
        wave_tile_gemm<4>(Aop + (size_t)rt * 16 * 2048, 2048, Bop + (size_t)cg * 64 * 2048, 2048, 2048, F.lane, acc);
#pragma unroll
        for (int n = 0; n < 4; ++n)
#pragma unroll
            for (int i = 0; i < 4; ++i) O[(size_t)(rt * 16 + (F.lane >> 4) * 4 + i) * 512 + cg * 64 + n * 16 + (F.lane & 15)] = (bf16)(pk2(acc[n][i], 0.f) & 0xffffu);
    }
}

DI int spos(int s) { return (s & ~31) | (((s >> 2) & 3) << 3) | (((s >> 4) & 1) << 2) | (s & 3); }
template <bool CONV, bool NAT, bool TRN>
DI void conv_slab(const bf16* src, int pitch, int c0, size_t tok0, int s0, bool zero_halo, const float* cw, const float* cb, bf16* nat, bf16* trn, LAS unsigned char* tile, int lane) {
    constexpr int HALO = CONV ? 3 : 0, ROWS = 64 + HALO, TP = 144;
    const int rr = lane >> 3, cq = lane & 7;
#pragma unroll
    for (int i = 0; i < (ROWS + 7) / 8; ++i) { const int ri = 8 * i + rr;
        if (ri < ROWS) { u32x4 v = (u32x4){0u, 0u, 0u, 0u};
            if (!(zero_halo && ri < HALO)) v = *(const u32x4*)(src + (tok0 + s0 - HALO + ri) * (size_t)pitch + c0 + cq * 8);
            *(LAS u32x4*)(tile + ri * TP + cq * 16) = v; } }
    float w0 = 0.f, w1 = 0.f, w2 = 0.f, w3 = 0.f, bias = 0.f;
    if (CONV) { w0 = cw[c0 + lane]; w1 = cw[CONV_DIM + c0 + lane]; w2 = cw[2 * CONV_DIM + c0 + lane]; w3 = cw[3 * CONV_DIM + c0 + lane]; bias = cb[c0 + lane]; }
    LDS_WAIT();
    const LAS unsigned short* col = (const LAS unsigned short*)tile + lane;
    float h1 = 0.f, h2 = 0.f, h3 = 0.f;
    if (CONV) { h3 = bf2f(col[0]); h2 = bf2f(col[72]); h1 = bf2f(col[144]); }
    unsigned pk[32];
#pragma unroll
    for (int s2 = 0; s2 < 64; s2 += 2) {
        float o[2];
#pragma unroll
        for (int e = 0; e < 2; ++e) { const float xin = bf2f(col[(s2 + e + HALO) * 72]);
            if (CONV) { const float a = w3 * xin + w2 * h1 + w1 * h2 + w0 * h3 + bias; o[e] = silu_f(a); h3 = h2; h2 = h1; h1 = xin; }
            else o[e] = xin; }
        const unsigned p2 = pk2(o[0], o[1]);
        pk[spos(s2) >> 1] = p2;
        if (NAT) { nat[(tok0 + s0 + s2) * 512 + lane] = (bf16)(p2 & 0xffffu); nat[(tok0 + s0 + s2 + 1) * 512 + lane] = (bf16)(p2 >> 16); }
    }
    if (TRN) {
        LDS_WAIT();
#pragma unroll
        for (int m = 0; m < 8; ++m) *(LAS u32x4*)(tile + lane * TP + m * 16) = (u32x4){pk[4 * m], pk[4 * m + 1], pk[4 * m + 2], pk[4 * m + 3]};
        LDS_WAIT();
#pragma unroll
        for (int m = 0; m < 8; ++m) { const int cl = rr + 8 * m; *(u32x4*)(trn + (size_t)cl * 128 + s0 + cq * 8) = *(const LAS u32x4*)(tile + cl * TP + cq * 16); }
        LDS_WAIT();
    }
}
DI void p_conv(const Frame& F) {
    const bf16* XBC = WSP(bf16, WS_XBC); const bf16* QKV = WSP(bf16, WS_QKV);
    const float* cw = F.in[4]; const float* cb = F.in[5];
    bf16* XT = WSP(bf16, WS_XT); bf16* BT = WSP(bf16, WS_BT); bf16* BN = WSP(bf16, WS_BN); bf16* CN = WSP(bf16, WS_CN); bf16* VT = (bf16*)((unsigned char*)F.out + OUT_VT);
    LAS unsigned char* tile = F.lds + F.wave * 16384;
    for (int bc = blockIdx.x; bc < NCHUNK; bc += F.G) {
        const size_t tok0 = (size_t)bc * 128; const bool first = (bc % (SEQ / 128)) == 0;
        SUBPROBE_BEGIN(120);
#pragma unroll 1
        for (int task = F.wave; task < 96; task += NWAVES) {
            if (task < 80) { const int slab = task >> 1, hf = task & 1, c0 = slab * 64, s0 = hf * 64; const bool zh = first && hf == 0;
                if (slab < 24) conv_slab<true, false, true>(XBC, CONV_DIM, c0, tok0, s0, zh, cw, cb, nullptr, XT + ((size_t)bc * 1536 + c0) * 128, tile, F.lane);
                else if (slab < 32) conv_slab<true, true, true>(XBC, CONV_DIM, c0, tok0, s0, zh, cw, cb, BN + (c0 - 1536), BT + ((size_t)bc * 512 + (c0 - 1536)) * 128, tile, F.lane);
                else conv_slab<true, true, false>(XBC, CONV_DIM, c0, tok0, s0, zh, cw, cb, CN + (c0 - 2048), nullptr, tile, F.lane); }
            else { const int t2 = task - 80, slab = t2 >> 1, hf = t2 & 1, c0 = slab * 64;
                conv_slab<false, false, true>(QKV + 1024, 1536, c0, tok0, hf * 64, false, nullptr, nullptr, nullptr, VT + ((size_t)bc * 512 + c0) * 128, tile, F.lane); }
        }
        SUBPROBE_END(120);
        SUBPROBE_BEGIN(121);
        const float* DTRAW = WSP(float, WS_DTRAW); float* DTT = WSP(float, WS_DTT); float* ACT = WSP(float, WS_ACT); float* WL = WSP(float, WS_WL);
#pragma unroll 1
        for (int hh = 0; hh < 3; ++hh) { const int h = F.wave + 8 * hh; const float bias = F.in[6][h], a = -expf(F.in[7][h]);
            float dt2[2], c2[2];
#pragma unroll
            for (int j = 0; j < 2; ++j) { const float r = DTRAW[(size_t)(tok0 + 2 * F.lane + j) * 32 + h] + bias; dt2[j] = fmaxf(r, 0.f) + log1pf(expf(-fabsf(r))); }
            c2[0] = dt2[0] * a; c2[1] = c2[0] + dt2[1] * a;
            float sc = c2[1];
#pragma unroll
            for (int o = 1; o < 64; o <<= 1) { const float t = __shfl_up(sc, o); if (F.lane >= o) sc += t; }
            const float ex = sc - c2[1]; const float alast = __shfl(sc, 63);
            const float ac0 = ex + c2[0], ac1 = ex + c2[1];
            *(f32x2*)(DTT + ((size_t)bc * 24 + h) * 128 + 2 * F.lane) = (f32x2){dt2[0], dt2[1]};
            *(f32x2*)(ACT + ((size_t)bc * 24 + h) * 128 + 2 * F.lane) = (f32x2){ac0, ac1};
            *(f32x2*)(WL + ((size_t)bc * 24 + h) * 128 + spos(2 * F.lane)) = (f32x2){dt2[0] * __expf(alast - ac0), dt2[1] * __expf(alast - ac1)};
        }
        SUBPROBE_END(121);
    }
}

DI void p_ssd_local(const Frame& F) {
    const bf16* XT = WSP(bf16, WS_XT); const bf16* BT = WSP(bf16, WS_BT); const float* WL = WSP(float, WS_WL);
    bf16* STATE = (bf16*)((unsigned char*)F.out + OUT_STATE);
    const int lane = F.lane, fr = lane & 15, kg = lane >> 4, w = F.wave, g = w >> 1;
    for (int bc = blockIdx.x; bc < NCHUNK; bc += F.G) {
        __syncthreads();
#pragma unroll
        for (int i = 0; i < 16; ++i) { const int id = F.tid + 512 * i, row = id >> 4, c = id & 15;
            *(LAS u32x4*)(F.lds + row * 256 + ((c ^ (row & 15)) << 4)) = *(const u32x4*)(BT + ((size_t)bc * 512 + row) * 128 + c * 8); }
        __syncthreads();
#pragma unroll 1
        for (int r = 0; r < 3; ++r) {
            const int h = 3 * w + r;
            const float* wlp = WL + ((size_t)bc * 24 + h) * 128 + kg * 8;
            const bf16* xp = XT + ((size_t)bc * 1536 + h * 64 + fr) * 128 + kg * 8;
            u32x4 xr[4][4]; f32x4 wv[4][2];
#pragma unroll
            for (int k = 0; k < 4; ++k) { wv[k][0] = *(const f32x4*)(wlp + k * 32); wv[k][1] = *(const f32x4*)(wlp + k * 32 + 4);
#pragma unroll
                for (int pt = 0; pt < 4; ++pt) xr[pt][k] = *(const u32x4*)(xp + (size_t)pt * 16 * 128 + k * 32); }
            bf16x8 xs[4][4];
#pragma unroll
            for (int k = 0; k < 4; ++k)
#pragma unroll
                for (int pt = 0; pt < 4; ++pt) { float f[8]; pg8::unpack8(xr[pt][k], f);
#pragma unroll
                    for (int j = 0; j < 4; ++j) { f[j] *= wv[k][0][j]; f[4 + j] *= wv[k][1][j]; }
                    xs[pt][k] = pack8(f); }
            bf16* st = STATE + ((size_t)bc * 24 + h) * 8192;
#pragma unroll 1
            for (int nh = 0; nh < 2; ++nh) {
                f32x4 acc[4][4];
#pragma unroll
                for (int a = 0; a < 4; ++a)
#pragma unroll
                    for (int b = 0; b < 4; ++b) acc[a][b] = (f32x4){0.f, 0.f, 0.f, 0.f};
#pragma unroll
                for (int nt = 0; nt < 4; ++nt) {
#pragma unroll
                    for (int k = 0; k < 4; ++k) { const bf16x8 bfr = *(const LAS bf16x8*)(F.lds + (g * 128 + nh * 64 + nt * 16 + fr) * 256 + (((k * 4 + kg) ^ fr) << 4));
#pragma unroll
                        for (int pt = 0; pt < 4; ++pt) acc[nt][pt] = MFMA16(bfr, xs[pt][k], acc[nt][pt]); }
                    __builtin_amdgcn_sched_barrier(0); }
#pragma unroll
                for (int nt = 0; nt < 4; ++nt)
#pragma unroll
                    for (int pt = 0; pt < 4; ++pt) { u32x2 wq; wq.x = pk2(acc[nt][pt][0], acc[nt][pt][1]); wq.y = pk2(acc[nt][pt][2], acc[nt][pt][3]);
                        *(u32x2*)(st + (size_t)(pt * 16 + fr) * 128 + nh * 64 + nt * 16 + kg * 4) = wq; }
            }
        }
    }
    __syncthreads();
}

DI void p_sb_attn(const Frame& F) {
    const bf16* QKV = WSP(bf16, WS_QKV); const bf16* VT = (const bf16*)((const unsigned char*)F.out + OUT_VT); bf16* YSB = WSP(bf16, WS_RA);
    const int lane = F.lane, fr = lane & 15, kg = lane >> 4;
    const float scale = 0.08838834764831845f;
    for (int u = F.gw; u < BATCH * SB_H * (SEQ / 16); u += F.NGW) {
        const int bh = u / (SEQ / 16), strip = u % (SEQ / 16), b = bh / SB_H, h = bh % SB_H;
        const int q0 = strip * 16, t = q0 + fr; const size_t tb = (size_t)b * SEQ;
        bf16x8 qf[4];
#pragma unroll
        for (int k = 0; k < 4; ++k) qf[k] = *(const bf16x8*)(QKV + (tb + t) * 1536 + h * 128 + k * 32 + kg * 8);
        f32x4 o[8];
#pragma unroll
        for (int d = 0; d < 8; ++d) o[d] = (f32x4){0.f, 0.f, 0.f, 0.f};
        float R = 0.f;
#pragma unroll 1
        for (int kb = q0 >> 5; kb >= 0; --kb) {
            const int sb = kb * 32;
            f32x4 z[2];
#pragma unroll
            for (int st = 0; st < 2; ++st) { z[st] = (f32x4){0.f, 0.f, 0.f, 0.f};
                const bf16* kp = QKV + (tb + sb + st * 16 + fr) * 1536 + 512 + h * 128 + kg * 8;
#pragma unroll
                for (int k = 0; k < 4; ++k) z[st] = MFMA16(*(const bf16x8*)(kp + k * 32), qf[k], z[st]); }
            float lb[2][4], lk[2][4], tot[2];
#pragma unroll
            for (int st = 0; st < 2; ++st) { tot[st] = 0.f;
#pragma unroll
                for (int i = 0; i < 4; ++i) { const int s = sb + st * 16 + kg * 4 + i; const float zz = z[st][i] * scale;
                    const float l = fminf(zz, 0.f) - __logf(1.0f + __expf(-fabsf(zz)));
                    lb[st][i] = l; lk[st][i] = (s < t) ? (l - zz) : 0.f; tot[st] += lk[st][i]; } }
            float hi[2], all[2];
#pragma unroll
            for (int st = 0; st < 2; ++st) { const float t1 = __shfl_xor(tot[st], 16), t2 = __shfl_xor(tot[st], 32), t3 = __shfl_xor(tot[st], 48);
                all[st] = tot[st] + t1 + t2 + t3;
                hi[st] = (((kg ^ 1) > kg) ? t1 : 0.f) + (((kg ^ 2) > kg) ? t2 : 0.f) + (((kg ^ 3) > kg) ? t3 : 0.f); }
            float att[8];
#pragma unroll
            for (int st = 0; st < 2; ++st) { const float base = R + hi[st] + (st == 0 ? all[1] : 0.f);
                float suf = 0.f;
#pragma unroll
                for (int i = 3; i >= 0; --i) { const int s = sb + st * 16 + kg * 4 + i; att[st * 4 + i] = (s < t) ? __expf(lb[st][i] + base + suf) : 0.f; suf += lk[st][i]; } }
            R += all[0] + all[1];
            const bf16x8 pf = pack8(att);
            const int bcv = (int)((tb + sb) >> 7), sl = (sb & 127) + kg * 8;
#pragma unroll
            for (int d = 0; d < 8; ++d) { const bf16x8 vf = *(const bf16x8*)(VT + ((size_t)bcv * 512 + h * 128 + d * 16 + fr) * 128 + sl);
                o[d] = MFMA16(vf, pf, o[d]); }
            if (__all(R < -30.0f)) break;
        }
#pragma unroll
        for (int d = 0; d < 8; ++d) { u32x2 w; w.x = pk2(o[d][0], o[d][1]); w.y = pk2(o[d][2], o[d][3]);
            *(u32x2*)(YSB + (tb + t) * 2048 + 1536 + h * 128 + d * 16 + kg * 4) = w; }
    }
}

DI void p_ssd_scan(const Frame& F) {
    bf16* STATE = (bf16*)((unsigned char*)F.out + OUT_STATE); const float* ACT = WSP(float, WS_ACT);
    const int gt = blockIdx.x * 512 + F.tid, NT = F.G * 512;
    for (int e = gt; e < BATCH * SSD_HEADS * 2048; e += NT) {
        const int v4 = e & 2047, bh = e >> 11, b = bh / SSD_HEADS, h = bh % SSD_HEADS;
        f32x4 run = (f32x4){0.f, 0.f, 0.f, 0.f};
        for (int c0 = 0; c0 < 128; c0 += 8) {
            u32x2 tmp[8]; float dec[8];
#pragma unroll
            for (int j = 0; j < 8; ++j) { const size_t bc = (size_t)b * 128 + c0 + j; tmp[j] = *(const u32x2*)(STATE + (bc * 24 + h) * 8192 + v4 * 4); dec[j] = __expf(ACT[(bc * 24 + h) * 128 + 127]); }
#pragma unroll
            for (int j = 0; j < 8; ++j) { const size_t bc = (size_t)b * 128 + c0 + j;
                u32x2 w; w.x = pk2(run[0], run[1]); w.y = pk2(run[2], run[3]); *(u32x2*)(STATE + (bc * 24 + h) * 8192 + v4 * 4) = w;
                const f32x4 t4 = (f32x4){__uint_as_float(tmp[j].x << 16), __uint_as_float(tmp[j].x & 0xffff0000u), __uint_as_float(tmp[j].y << 16), __uint_as_float(tmp[j].y & 0xffff0000u)};
                run = run * dec[j] + t4; }
        }
    }
}

DI int cb_off(int t, int s) { return t * 256 + ((((s >> 2) ^ (2 * (t & 15))) << 3) | ((s & 3) << 1)); }
constexpr int SSQ_OFF = RING_BYTES + 1024, TAB_OFF = RING_BYTES + 5120;
DI void p_ssd_out(const Frame& F) {
    const bf16* XT = WSP(bf16, WS_XT); const bf16* BN = WSP(bf16, WS_BN); const bf16* CN = WSP(bf16, WS_CN); const bf16* Z = WSP(bf16, WS_Z);
    const float* DTT = WSP(float, WS_DTT); const float* ACT = WSP(float, WS_ACT); const bf16* STATE = (const bf16*)((const unsigned char*)F.out + OUT_STATE);
    bf16* YG = WSP(bf16, WS_RA); float* RSTD = WSP(float, WS_RSTD);
    const float* dskip = F.in[8];
    const int lane = F.lane, fr = lane & 15, kg = lane >> 4, w = F.wave, g = w >> 1;
    LAS unsigned char* cbl = F.lds + g * 32768;
    LAS float* tab = (LAS float*)(F.lds + TAB_OFF + w * 1024);
    LAS float* ssqp = (LAS float*)(F.lds + SSQ_OFF);
    for (int bc = blockIdx.x; bc < NCHUNK; bc += F.G) {
        const size_t tok0 = (size_t)bc * 128;
        REP(22)
#pragma unroll 1
        for (int q = 0; q < 4; ++q) { const int tt = (w & 1) + 2 * q;
            bf16x8 cf[4];
#pragma unroll
            for (int k = 0; k < 4; ++k) cf[k] = *(const bf16x8*)(CN + (tok0 + tt * 16 + fr) * 512 + g * 128 + k * 32 + kg * 8);
#pragma unroll 1
            for (int st = 0; st <= tt; ++st) { f32x4 X = (f32x4){0.f, 0.f, 0.f, 0.f}; const bf16* bp = BN + (tok0 + st * 16 + fr) * 512 + g * 128 + kg * 8;
#pragma unroll
                for (int k = 0; k < 4; ++k) X = MFMA16(*(const bf16x8*)(bp + k * 32), cf[k], X);
                u32x2 pw; pw.x = pk2(X[0], X[1]); pw.y = pk2(X[2], X[3]);
                *(LAS u32x2*)(cbl + cb_off(tt * 16 + fr, st * 16 + kg * 4)) = pw; } }
        __syncthreads();
        REP(23) {
        ssqp[w * 128 + lane] = 0.f; ssqp[w * 128 + 64 + lane] = 0.f;
#pragma unroll 1
        for (int r = 0; r < 3; ++r) {
            const int h = 3 * w + r; const float dsk = dskip[h];
            { const f32x2 d2 = *(const f32x2*)(DTT + ((size_t)bc * 24 + h) * 128 + 2 * lane), a2 = *(const f32x2*)(ACT + ((size_t)bc * 24 + h) * 128 + 2 * lane);
              *(LAS f32x2*)(tab + 2 * lane) = d2; *(LAS f32x2*)(tab + 128 + 2 * lane) = a2; }
            bf16x8 sf[4][4], xf0[4], xfA[4];
            const bf16* xbase = XT + ((size_t)bc * 1536 + h * 64) * 128;
            { unsigned so = (unsigned)(fr * 128 + kg * 8); asm volatile("" : "+v"(so));
              const bf16* sp0 = STATE + ((size_t)bc * 24 + h) * 8192;
#pragma unroll
              for (int pt = 0; pt < 4; ++pt) {
#pragma unroll
                  for (int k = 0; k < 4; ++k) sf[pt][k] = *(const bf16x8*)(sp0 + (so + (unsigned)(pt * 2048 + k * 32)));
                  xf0[pt] = *(const bf16x8*)(xbase + (so + (unsigned)(pt * 2048))); } }
            LDS_WAIT();
#define SSD_STEP(SP, XF) do { float mv[8]; \
        _Pragma("unroll") for (int half = 0; half < 2; ++half) { const int sbase = 32 * (SP) + 16 * half + kg * 4; \
            const u32x2 cbv = *(const LAS u32x2*)(cbl + cb_off(tl, sbase)); \
            const f32x4 dv = *(const LAS f32x4*)(tab + sbase), av = *(const LAS f32x4*)(tab + 128 + sbase); \
            const float cbf[4] = {__uint_as_float(cbv.x << 16), __uint_as_float(cbv.x & 0xffff0000u), __uint_as_float(cbv.y << 16), __uint_as_float(cbv.y & 0xffff0000u)}; \
            _Pragma("unroll") for (int i = 0; i < 4; ++i) { const int s_ = sbase + i; float v = 0.f; \
                if (s_ <= tl) v = cbf[i] * dv[i] * __expf(acum_t - av[i]); \
                if (s_ == tl) v += dsk; \
                mv[half * 4 + i] = v; } } \
        const bf16x8 mf = pack8(mv); \
        _Pragma("unroll") for (int pt = 0; pt < 4; ++pt) acc[pt] = MFMA16(XF[pt], mf, acc[pt]); } while (0)
#define SSD_LOADX(XF, SP) do { unsigned xo_ = (unsigned)(fr * 128 + kg * 8 + 32 * (SP)); asm volatile("" : "+v"(xo_)); \
        _Pragma("unroll") for (int pt = 0; pt < 4; ++pt) XF[pt] = *(const bf16x8*)(xbase + (xo_ + (unsigned)(pt * 2048))); } while (0)
#pragma unroll 1
            for (int tt = 0; tt < 8; ++tt) {
                int frx = fr; asm volatile("" : "+v"(frx));
                const int tl = tt * 16 + frx; const size_t tok = tok0 + tl; float ssq = 0.f;
                bf16x8 cf[4]; u32x2 zr[4];
                if (tt >= 2) SSD_LOADX(xfA, 1);
                const float acum_t = tab[128 + tl];
                f32x4 acc[4];
#pragma unroll
                for (int pt = 0; pt < 4; ++pt) acc[pt] = (f32x4){0.f, 0.f, 0.f, 0.f};
                SSD_STEP(0, xf0);
#pragma unroll
                for (int k = 0; k < 4; ++k) cf[k] = *(const bf16x8*)(CN + tok * 512 + g * 128 + k * 32 + kg * 8);
                if (tt >= 2) { SSD_STEP(1, xfA); if (tt >= 4) SSD_LOADX(xfA, 2); }
                if (tt >= 4) { SSD_STEP(2, xfA); if (tt >= 6) SSD_LOADX(xfA, 3); }
                if (tt >= 6) { SSD_STEP(3, xfA); }
#pragma unroll
                for (int pt = 0; pt < 4; ++pt) zr[pt] = *(const u32x2*)(Z + tok * 1536 + h * 64 + pt * 16 + kg * 4);
                { f32x4 ao[4];
#pragma unroll
                  for (int pt = 0; pt < 4; ++pt) ao[pt] = (f32x4){0.f, 0.f, 0.f, 0.f};
#pragma unroll
                  for (int k = 0; k < 4; ++k)
#pragma unroll
                      for (int pt = 0; pt < 4; ++pt) ao[pt] = MFMA16(sf[pt][k], cf[k], ao[pt]);
                  const float e = __expf(acum_t);
#pragma unroll
                  for (int pt = 0; pt < 4; ++pt) acc[pt] = ao[pt] * e + acc[pt]; }
#pragma unroll
                for (int pt = 0; pt < 4; ++pt) { const int col = h * 64 + pt * 16 + kg * 4;
                    const float z0 = __uint_as_float(zr[pt].x << 16), z1 = __uint_as_float(zr[pt].x & 0xffff0000u), z2 = __uint_as_float(zr[pt].y << 16), z3 = __uint_as_float(zr[pt].y & 0xffff0000u);
                    const float y0 = acc[pt][0] * silu_f(z0), y1 = acc[pt][1] * silu_f(z1), y2 = acc[pt][2] * silu_f(z2), y3 = acc[pt][3] * silu_f(z3);
                    ssq += (y0 * y0 + y1 * y1) + (y2 * y2 + y3 * y3);
                    u32x2 wv; wv.x = pk2(y0, y1); wv.y = pk2(y2, y3); *(u32x2*)(YG + tok * 2048 + col) = wv; }
                ssq += __shfl_xor(ssq, 16); ssq += __shfl_xor(ssq, 32);
                if (kg == 0) ssqp[w * 128 + tl] += ssq;
            }
            LDS_WAIT();
        }
        }
#undef SSD_STEP
#undef SSD_LOADX
        __syncthreads();
        if (F.tid < 128) { float v = 0.f;
#pragma unroll
            for (int ww = 0; ww < 8; ++ww) v += ssqp[ww * 128 + F.tid];
            RSTD[tok0 + F.tid] = 1.0f / sqrtf(v * (1.0f / 1536.0f) + EPS); }
        __syncthreads();
    }
}

DI void p_xattn(const Frame& F) {
    const bf16* Q2 = WSP(bf16, WS_Q2); const bf16* KX = WSP(bf16, WS_KX); const bf16* VXT = WSP(bf16, WS_VXT); bf16* O2 = WSP(bf16, WS_O2);
    const int lane = F.lane, fr = lane & 15, kg = lane >> 4;
    const float scale = 0.08838834764831845f;
    LAS unsigned char* kl = F.lds; LAS unsigned char* vl = F.lds + 65536;
    for (int task = blockIdx.x; task < 256; task += F.G) {
        const int bh = task >> 5, b = bh >> 2, h = bh & 3;
        __syncthreads();
#pragma unroll
        for (int i = 0; i < 8; ++i) { const int id = F.tid + 512 * i;
            { const int m = id >> 4, c = id & 15; *(LAS u32x4*)(kl + m * 256 + ((c ^ (m & 15)) << 4)) = *(const u32x4*)(KX + ((size_t)b * 256 + m) * 512 + h * 128 + c * 8); }
            { const int d = id >> 5, mc = id & 31, blk = mc >> 2, h2 = (mc >> 1) & 1, q = 2 * (mc & 1);
              const u32x4 v = *(const u32x4*)(VXT + ((size_t)h * 128 + d) * 512 + b * 256 + mc * 8);
              *(LAS u32x2*)(vl + d * 512 + (((blk * 4 + q) ^ (d & 15)) << 4) + 8 * h2) = (u32x2){v.x, v.y};
              *(LAS u32x2*)(vl + d * 512 + (((blk * 4 + q + 1) ^ (d & 15)) << 4) + 8 * h2) = (u32x2){v.z, v.w}; } }
        __syncthreads();
#pragma unroll 1
        for (int si = 0; si < 4; ++si) {
            const int strip = (task & 31) * 32 + F.wave * 4 + si;
            const size_t tok = (size_t)b * SEQ + strip * 16 + fr;
            bf16x8 qf[4];
#pragma unroll
            for (int k = 0; k < 4; ++k) qf[k] = *(const bf16x8*)(Q2 + tok * 512 + h * 128 + k * 32 + kg * 8);
            f32x4 sc[16];
#pragma unroll
            for (int mt = 0; mt < 16; ++mt) { sc[mt] = (f32x4){0.f, 0.f, 0.f, 0.f};
#pragma unroll
                for (int k = 0; k < 4; ++k) sc[mt] = MFMA16(*(const LAS bf16x8*)(kl + (mt * 16 + fr) * 256 + (((k * 4 + kg) ^ fr) << 4)), qf[k], sc[mt]);
                if (mt & 1) __builtin_amdgcn_sched_barrier(0); }
            float mx = -3.0e38f;
#pragma unroll
            for (int mt = 0; mt < 16; ++mt)
#pragma unroll
                for (int i = 0; i < 4; ++i) { sc[mt][i] *= scale; mx = fmaxf(mx, sc[mt][i]); }
            mx = fmaxf(mx, __shfl_xor(mx, 16)); mx = fmaxf(mx, __shfl_xor(mx, 32));
            float sum = 0.f;
#pragma unroll
            for (int mt = 0; mt < 16; ++mt)
#pragma unroll
                for (int i = 0; i < 4; ++i) { const float p = __expf(sc[mt][i] - mx); sc[mt][i] = p; sum += p; }
            sum += __shfl_xor(sum, 16); sum += __shfl_xor(sum, 32);
            const float inv = __builtin_amdgcn_rcpf(sum);
            f32x4 o[8];
#pragma unroll
            for (int d = 0; d < 8; ++d) o[d] = (f32x4){0.f, 0.f, 0.f, 0.f};
#pragma unroll
            for (int q = 0; q < 8; ++q) {
                float pv[8];
#pragma unroll
                for (int i = 0; i < 4; ++i) { pv[i] = sc[2 * q][i] * inv; pv[4 + i] = sc[2 * q + 1][i] * inv; }
                const bf16x8 pf = pack8(pv);
#pragma unroll
                for (int d = 0; d < 8; ++d) o[d] = MFMA16(*(const LAS bf16x8*)(vl + (d * 16 + fr) * 512 + (((q * 4 + kg) ^ fr) << 4)), pf, o[d]);
                __builtin_amdgcn_sched_barrier(0);
            }
#pragma unroll
            for (int d = 0; d < 8; ++d) { u32x2 w; w.x = pk2(o[d][0], o[d][1]); w.y = pk2(o[d][2], o[d][3]);
                *(u32x2*)(O2 + tok * 512 + h * 128 + d * 16 + kg * 4) = w; }
        }
    }
    __syncthreads();
}

DI void p_router(const Frame& F) {
    const bf16* HB = WSP(bf16, WS_RA); const bf16* WR = WSP(bf16, WS_WR_T); const float* SSQ2 = WSP(float, WS_SSQ2);
    int* TI = WSP(int, WS_TI); float* TG = WSP(float, WS_TG); unsigned* ecnt = WSP(unsigned, WS_CTL) + CW_ECNT;
    const int lane = F.lane, fr = lane & 15, kg = lane >> 4;
    LAS unsigned char* bl = F.lds; LAS float* lg = (LAS float*)(F.lds + 65536); LAS unsigned* lcnt = (LAS unsigned*)(F.lds + 65536 + 24576);
    for (int task = blockIdx.x; task < T / 128; task += F.G) {
        const size_t tok0 = (size_t)task * 128;
        f32x4 acc[3];
#pragma unroll
        for (int n = 0; n < 3; ++n) acc[n] = (f32x4){0.f, 0.f, 0.f, 0.f};
#pragma unroll 1
        for (int kc = 0; kc < 4; ++kc) {
            __syncthreads();
#pragma unroll
            for (int i = 0; i < 6; ++i) { const int id = F.tid + 512 * i, row = id >> 6, c = id & 63;
                *(LAS u32x4*)(bl + row * 1024 + ((c ^ (row & 15)) << 4)) = *(const u32x4*)(WR + (size_t)row * 2048 + kc * 512 + c * 8); }
            bf16x8 af[16];
            const bf16* ap = HB + (tok0 + F.wave * 16 + fr) * 2048 + kc * 512 + kg * 8;
#pragma unroll
            for (int ks = 0; ks < 16; ++ks) af[ks] = *(const bf16x8*)(ap + ks * 32);
            __syncthreads();
#pragma unroll
            for (int ks = 0; ks < 16; ++ks) {
#pragma unroll
                for (int n = 0; n < 3; ++n) acc[n] = MFMA16(af[ks], *(const LAS bf16x8*)(bl + (n * 16 + fr) * 1024 + (((ks * 4 + kg) ^ fr) << 4)), acc[n]);
                if ((ks & 3) == 3) __builtin_amdgcn_sched_barrier(0); }
        }
        if (F.tid < 64) lcnt[F.tid] = 0u;
#pragma unroll
        for (int i = 0; i < 4; ++i) { const int rl = F.wave * 16 + kg * 4 + i; const float rs = rstd32(SSQ2 + (tok0 + rl) * 32);
#pragma unroll
            for (int n = 0; n < 3; ++n) lg[rl * 48 + n * 16 + fr] = acc[n][i] * rs; }
        __syncthreads();
        unsigned lp1 = 0, lp2 = 0; int ex1 = 0, ex2 = 0; float w1 = 0.f, w2 = 0.f, ggate = 0.f;
        if (F.tid < 128) {
            const LAS float* l = lg + F.tid * 48;
            float gl[4] = {l[0], l[1], l[2], l[3]};
            int gs = 0; float gm = gl[0];
#pragma unroll
            for (int j = 1; j < 4; ++j) if (gl[j] > gm) { gm = gl[j]; gs = j; }
            float den = 0.f;
#pragma unroll
            for (int j = 0; j < 4; ++j) den += expf(gl[j] - gm);
            ggate = 1.0f / den;
            float el[8];
#pragma unroll
            for (int j = 0; j < 8; ++j) el[j] = l[4 + gs * 8 + j];
            int i1 = 0; float v1 = el[0];
#pragma unroll
            for (int j = 1; j < 8; ++j) if (el[j] > v1) { v1 = el[j]; i1 = j; }
            int i2 = -1; float v2 = -3.0e38f;
#pragma unroll
            for (int j = 0; j < 8; ++j) if (j != i1 && el[j] > v2) { v2 = el[j]; i2 = j; }
            const float e2 = expf(v2 - v1); w1 = 1.0f / (1.0f + e2); w2 = e2 / (1.0f + e2);
            ex1 = gs * 8 + i1; ex2 = gs * 8 + i2;
            lp1 = atomicAdd((unsigned*)&lcnt[ex1], 1u); lp2 = atomicAdd((unsigned*)&lcnt[ex2], 1u);
        }
        __syncthreads();
        if (F.tid < 32) lcnt[32 + F.tid] = __hip_atomic_fetch_add(ecnt + F.tid, lcnt[F.tid], __ATOMIC_RELAXED, __HIP_MEMORY_SCOPE_AGENT);
        __syncthreads();
        if (F.tid < 128) { const int t = (int)tok0 + F.tid;
            TI[t * 4 + 0] = ex1; TI[t * 4 + 1] = (int)(lcnt[32 + ex1] + lp1); TI[t * 4 + 2] = ex2; TI[t * 4 + 3] = (int)(lcnt[32 + ex2] + lp2);
            TG[t * 2 + 0] = w1 * ggate; TG[t * 2 + 1] = w2 * ggate; }
    }
    __syncthreads();
}
DI void p_route_b(const Frame& F) {
    const int* TI = WSP(int, WS_TI); int* TSLOT = WSP(int, WS_TSLOT); int* SLOTTOK = WSP(int, WS_SLOTTOK); int* TILEE = WSP(int, WS_TILEE);
    unsigned* ecnt = WSP(unsigned, WS_CTL) + CW_ECNT; const float* SSQ2 = WSP(float, WS_SSQ2); float* SRSTD = WSP(float, WS_SRSTD);
    LAS int* st = (LAS int*)(F.lds);
    if (F.tid < 32) st[64 + F.tid] = (int)__hip_atomic_load(ecnt + F.tid, __ATOMIC_RELAXED, __HIP_MEMORY_SCOPE_AGENT);
    __syncthreads();
    if (F.tid == 0) { int s = 0; for (int e = 0; e < 32; ++e) { st[e] = s; s += (st[64 + e] + 255) / 256 * 256; } st[32] = s; }
    __syncthreads();
    for (int t = blockIdx.x * 512 + F.tid; t < T; t += F.G * 512) {
        const int e1 = TI[t * 4 + 0], p1 = TI[t * 4 + 1], e2 = TI[t * 4 + 2], p2 = TI[t * 4 + 3];
        const int s1 = st[e1] + p1, s2 = st[e2] + p2;
        SLOTTOK[s1] = t; SLOTTOK[s2] = t; TSLOT[t * 2] = s1; TSLOT[t * 2 + 1] = s2;
        const float rs = rstd32(SSQ2 + (size_t)t * 32); SRSTD[s1] = rs; SRSTD[s2] = rs;
    }
    for (int e = blockIdx.x; e < 32; e += F.G) {
        const int a = st[e] + st[64 + e], bnd = st[e + 1];
        for (int s = a + F.tid; s < bnd; s += 512) { SLOTTOK[s] = 0; SRSTD[s] = 0.f; }
        for (int tl = st[e] / 256 + F.tid; tl < bnd / 256; tl += 512) TILEE[tl] = e;
    }
    if (blockIdx.x == 0 && F.tid == 0) TILEE[511] = st[32] / 256;
    __syncthreads();
}

DI void p_final(const Frame& F) {
    const unsigned char* Y = WSP(unsigned char, WS_Y); const bf16* HB = WSP(bf16, WS_RA); const int* TSLOT = WSP(int, WS_TSLOT); const float* TG = WSP(float, WS_TG); const float* w = F.in[25];
    for (int m = F.gw; m < T; m += F.NGW) {
        const int s1 = TSLOT[m * 2], s2 = TSLOT[m * 2 + 1]; const float g1 = TG[m * 2] * (1.0f / Y_SCALE), g2 = TG[m * 2 + 1] * (1.0f / Y_SCALE);
        const u32x2* hr = (const u32x2*)(HB + (size_t)m * 2048) + F.lane; const unsigned* y1 = (const unsigned*)(Y + (size_t)s1 * 2048) + F.lane; const unsigned* y2 = (const unsigned*)(Y + (size_t)s2 * 2048) + F.lane;
        f32x4 v[8]; float s = 0.f;
#pragma unroll
        for (int j = 0; j < 8; ++j) { const u32x2 hh = hr[64 * j]; const unsigned a = y1[64 * j], b = y2[64 * j];
            const f32x2 a01 = __builtin_amdgcn_cvt_pk_f32_fp8((int)a, false), a23 = __builtin_amdgcn_cvt_pk_f32_fp8((int)a, true), b01 = __builtin_amdgcn_cvt_pk_f32_fp8((int)b, false), b23 = __builtin_amdgcn_cvt_pk_f32_fp8((int)b, true);
            v[j].x = __uint_as_float(hh.x << 16) + g1 * a01[0] + g2 * b01[0]; v[j].y = __uint_as_float(hh.x & 0xffff0000u) + g1 * a01[1] + g2 * b01[1];
            v[j].z = __uint_as_float(hh.y << 16) + g1 * a23[0] + g2 * b23[0]; v[j].w = __uint_as_float(hh.y & 0xffff0000u) + g1 * a23[1] + g2 * b23[1];
            s += (v[j].x * v[j].x + v[j].y * v[j].y) + (v[j].z * v[j].z + v[j].w * v[j].w); }
        const float rstd = 1.0f / sqrtf(wave_sum(s) * (1.0f / 2048.0f) + EPS);
        const f32x4* wr4 = (const f32x4*)w + F.lane; f32x4* xr = (f32x4*)(F.out + (size_t)m * 2048) + F.lane;
#pragma unroll
        for (int j = 0; j < 8; ++j) { const f32x4 ww = wr4[64 * j]; xr[64 * j] = v[j] * rstd * ww; }
    }
}

constexpr int NPHASE = 20;
struct Args { const float* in[26]; float* out; unsigned char* ws; int ph_lo, ph_hi; };
__global__ void __launch_bounds__(NWAVES * 64, 2) fwd(Args args) {
    extern __shared__ __attribute__((aligned(16))) unsigned char lds[];
    Frame F;
    F.lds = (LAS unsigned char*)lds;
    F.tid = threadIdx.x; F.lane = F.tid & 63; F.wave = __builtin_amdgcn_readfirstlane(F.tid >> 6);
    F.G = gridDim.x; F.gw = blockIdx.x * NWAVES + F.wave; F.NGW = F.G * NWAVES;
#pragma unroll
    for (int i = 0; i < 26; ++i) F.in[i] = args.in[i];
    F.out = args.out; F.ws = args.ws; F.pacc = nullptr;
    volatile LAS unsigned* MISC = (volatile LAS unsigned*)(F.lds + MISC_OFF);
    for (int u = F.tid; u < (LDS_BYTES - RING_BYTES) / 4; u += NWAVES * 64) ((LAS unsigned*)(F.lds + RING_BYTES))[u] = 0u;
    __syncthreads();
    const int lo = args.ph_lo, hi = args.ph_hi;
    const bool one = (hi - lo) > 1;
    XcdBarrier bar; bar.bar = WSP(unsigned, WS_CTL) + CW_BAR; bar.x = 0; bar.st = nullptr;
    if (one) bar = xcd_barrier_post(WSP(unsigned, WS_CTL) + CW_BAR, MISC + 8);
#define IN(k) (lo <= (k) && (k) < hi)
#define SEAM(k) do { if (lo <= (k) && (k) + 1 < hi) xcd_barrier(bar); } while (0)
    LAS unsigned char* ring = F.lds;
    const int bx = blockIdx.x;
    unsigned long long pt0 = 0, pt1 = 0, psub = 0;
    if (PROBE_PHASE >= 120) F.pacc = &psub;
#define PB(k) do { if ((k) == PROBE_PHASE) pt0 = __builtin_amdgcn_s_memrealtime(); } while (0)
#define PE(k) do { if ((k) == PROBE_PHASE) pt1 = __builtin_amdgcn_s_memrealtime(); } while (0)
    const int vcu = (F.G % 8 == 0) ? (bx % 8) * (F.G / 8) + bx / 8 : bx;

    if (IN(0)) REP(0) { PB(0); p0_prologue(F); SEAM(0); PE(0); }
    if (IN(7)) REP(7) { PB(7); win_quant(F); SEAM(7); PE(7); }
    if (IN(1)) REP(1) { PB(1);
        pg8::Gemm g{(const unsigned char*)F.out + OUT_UQ, (const unsigned char*)F.out + OUT_WQI, 2048, 2048, 2048, nullptr, nullptr, 0};
        pg8::StaticOrder S; S.init(T, IN_PAD, 2048, F.G, bx); S.nt = 2048 / 128;
        pg8::EpiInProj E{WSP(bf16, WS_Z), WSP(bf16, WS_XBC), WSP(bf16, WS_QKV), WSP(unsigned char, WS_GATES), WSP(float, WS_DTRAW), WSP(float, WS_USC), WSP(float, WS_WSC)};
        pg8::gemm_phase<pg8::EpiInProj, pg8::StaticOrder, true, false, 2>(ring, g, S, E);
        p_kv_mem(F);
        if (F.G == 256 && bx >= 128) p_expert_weights(F, 10);
        SEAM(1); PE(1);
    }
    if (IN(2)) REP(2) { PB(2); p_conv(F); SEAM(2); PE(2); }
    if (IN(3)) REP(3) { PB(3); REP(20) p_ssd_local(F); REP(21) p_sb_attn(F); SEAM(3); PE(3); }
    if (IN(4)) REP(4) { PB(4); p_ssd_scan(F); SEAM(4); PE(4); }
    if (IN(5)) REP(5) { PB(5); p_ssd_out(F); SEAM(5); PE(5); }
    if (IN(6)) REP(6) { PB(6);
        pg8::Gemm g{WSP(bf16, WS_RA), WSP(bf16, WS_WCAT_T), 2048, 2048, 2048, nullptr, nullptr, 0};
        pg8::SplitOrder S; S.so.init(T, 2048, 2048, F.G, bx); S.nt0 = 1536 / 64; S.nt1 = 512 / 64;
        pg8::EpiMerge E{WSP(bf16, WS_MERGED), WSP(unsigned char, WS_GATES), WSP(float, WS_RSTD)};
        unsigned long long pepi6 = 0;
        pg8::gemm_phase<pg8::EpiMerge, pg8::SplitOrder, true, false>(ring, g, S, E, (PROBE_PHASE == 106) ? &pepi6 : nullptr);
        if (PROBE_PHASE == 106) { pt0 = 0; pt1 = pepi6; }
        SEAM(6); PE(6);
    }
    if (IN(8)) REP(8) { PB(8);
        pg8::Gemm g{WSP(bf16, WS_MERGED), WSP(bf16, WS_WMIX_T), 2048, 2048, 2048, nullptr, nullptr, 0};
        pg8::StaticOrder S; S.init(T, 2048, 2048, F.G, bx);
        pg8::EpiResStatF32 E{F.in[0], WSP(bf16, WS_RA), WSP(float, WS_SSQ1)};
        unsigned long long pepi = 0;
        pg8::gemm_phase<pg8::EpiResStatF32, pg8::StaticOrder, true, false>(ring, g, S, E, (PROBE_PHASE == 108) ? &pepi : nullptr);
        if (PROBE_PHASE == 108) { pt0 = 0; pt1 = pepi; }
        SEAM(8); PE(8);
    }
    if (IN(9)) { PB(9); p_expert_weights(F, 1 << 30); SEAM(9); PE(9); }
    if (IN(10)) REP(10) { PB(10);
        pg8::Gemm g{WSP(bf16, WS_RA), WSP(bf16, WS_WQ_T), 2048, 2048, 2048, nullptr, nullptr, 0};
        pg8::StaticOrder S; S.init(T, 512, 2048, F.G, bx);
        pg8::EpiBf16Rs E{WSP(bf16, WS_Q2), 512, WSP(float, WS_SSQ1)};
        pg8::gemm_phase<pg8::EpiBf16Rs, pg8::StaticOrder, true, false>(ring, g, S, E);
        SEAM(10); PE(10);
    }
    if (IN(11)) REP(11) { PB(11); p_xattn(F); SEAM(11); PE(11); }
    if (IN(12)) REP(12) { PB(12);
        pg8::Gemm g{WSP(bf16, WS_O2), WSP(bf16, WS_WO_T), 512, 512, 512, nullptr, nullptr, 0};
        pg8::StaticOrder S; S.init(T, 2048, 512, F.G, bx);
        pg8::EpiResStatBf E{WSP(bf16, WS_RA), WSP(float, WS_SSQ2), WSP(unsigned char, WS_HB8)};
        pg8::gemm_phase<pg8::EpiResStatBf, pg8::StaticOrder, true, false>(ring, g, S, E);
        SEAM(12); PE(12);
    }
    if (IN(14)) REP(14) { PB(14); p_router(F); SEAM(14); PE(14); }
    if (IN(16)) REP(16) { PB(16); p_route_b(F); SEAM(16); PE(16); }
    if (IN(17)) REP(17) { PB(17);
        const int* TILEE = WSP(int, WS_TILEE);
        pg8::Gemm g{WSP(unsigned char, WS_HB8), (const unsigned char*)F.out + OUT_WGU8, 2048, 2048, 2048, WSP(int, WS_SLOTTOK), TILEE, (size_t)1024 * 2048};
        pg8::ListOrder S; S.init(TILEE[511], 4, F.G, bx, 2048 / 128);
        pg8::EpiSwiGLU E{WSP(unsigned char, WS_HID), WSP(float, WS_SRSTD), 1.0f / WGU_SCALE, HID_SCALE};
        pg8::gemm_phase<pg8::EpiSwiGLU, pg8::ListOrder, true, true, 1>(ring, g, S, E);
        SEAM(17); PE(17);
    }
    if (IN(18)) REP(18) { PB(18);
        const int* TILEE = WSP(int, WS_TILEE);
        pg8::Gemm g{WSP(unsigned char, WS_HID), (const unsigned char*)F.out + OUT_WD8, 512, 512, 512, nullptr, TILEE, (size_t)2048 * 512};
        pg8::ListOrder S; S.init(TILEE[511], 8, F.G, bx, 512 / 128);
        pg8::EpiF8 E{WSP(unsigned char, WS_Y), 2048, Y_SCALE / (HID_SCALE * WD_SCALE)};
        pg8::gemm_phase<pg8::EpiF8, pg8::ListOrder, true, false, 1>(ring, g, S, E);
        SEAM(18); PE(18);
    }
    if (IN(19)) REP(19) { PB(19); p_final(F); PE(19); }
    if (PROBE_PHASE >= 120) { pt0 = 0; pt1 = psub; }
    if (PROBE_PHASE >= 0 && blockIdx.x == 0 && threadIdx.x == 0) { const unsigned long long te = __builtin_amdgcn_s_memrealtime(), d = (pt1 - pt0) * PROBE_MULT;
        while (__builtin_amdgcn_s_memrealtime() - te < d) __builtin_amdgcn_s_sleep(8); }
#undef IN
#undef SEAM
}

extern "C" void kernel_launch(void* const* d_in, const int* in_sizes, int n_in, void* d_out, int out_size, void* d_ws, size_t ws_size, hipStream_t stream) {
    static int grid = 0;
    if (grid == 0) {
        if (n_in != 26 || out_size != T * D || ws_size < WS_END) { fprintf(stderr, "kernel_launch: unexpected sizes n_in %d out %d ws %zu\n", n_in, out_size, ws_size); grid = -1; return; }
        int dev = 0, cus = 0, per_cu = 0;
        if (hipGetDevice(&dev) != hipSuccess || hipDeviceGetAttribute(&cus, hipDeviceAttributeMultiprocessorCount, dev) != hipSuccess) { grid = -1; return; }
        if (hipFuncSetAttribute((const void*)fwd, hipFuncAttributeMaxDynamicSharedMemorySize, LDS_BYTES) != hipSuccess) { fprintf(stderr, "kernel_launch: hipFuncSetAttribute failed\n"); grid = -1; return; }
        if (hipOccupancyMaxActiveBlocksPerMultiprocessor(&per_cu, (const void*)fwd, NWAVES * 64, LDS_BYTES) != hipSuccess || per_cu < 1) fprintf(stderr, "kernel_launch: occupancy query reports %d\n", per_cu);
        (void)hipGetLastError();
        grid = cus;
    }
    if (grid < 0) return;
    if (hipMemsetAsync((char*)d_ws + WS_CTL, 0, CTL_ZERO_BYTES, stream) != hipSuccess) return;
    Args a{};
    for (int i = 0; i < 26; ++i) a.in[i] = (const float*)d_in[i];
    a.out = (float*)d_out; a.ws = (unsigned char*)d_ws;
    if (MK_N_LAUNCHES == 1) {
        a.ph_lo = 0; a.ph_hi = NPHASE;
        hipLaunchKernelGGL(fwd, dim3(grid), dim3(NWAVES * 64), LDS_BYTES, stream, a);
    } else {
        for (int p = 0; p < NPHASE; ++p) { a.ph_lo = p; a.ph_hi = p + 1; hipLaunchKernelGGL(fwd, dim3(grid), dim3(NWAVES * 64), LDS_BYTES, stream, a); }
    }
}
```

```cpp
#include <hip/hip_runtime.h>
#include <cstdio>
#include <cstdint>

#define DI __device__ __forceinline__
#define LAS __attribute__((address_space(3)))
#define GAS __attribute__((address_space(1)))
typedef unsigned short bf16;
typedef short bf16x8 __attribute__((ext_vector_type(8)));
typedef short s16x4 __attribute__((ext_vector_type(4)));
typedef float f32x4 __attribute__((ext_vector_type(4)));
typedef float f32x2 __attribute__((ext_vector_type(2)));
typedef unsigned u32x4 __attribute__((ext_vector_type(4)));
typedef unsigned u32x2 __attribute__((ext_vector_type(2)));
typedef __bf16 bf16x2_t __attribute__((ext_vector_type(2)));

#ifndef DUP_MASK
#define DUP_MASK 0
#endif
#define REP(k) for (int rep_ = 0; rep_ < 1 + 2 * ((DUP_MASK >> (k)) & 1); ++rep_)
#ifndef PROBE_PHASE
#define PROBE_PHASE -1
#endif
#define PROBE_MULT 10
#ifndef MK_N_LAUNCHES
#define MK_N_LAUNCHES 1
#endif

constexpr int D = 2048, BATCH = 2, SEQ = 16384, T = BATCH * SEQ;
constexpr int SSD_INNER = 1536, SSD_HEADS = 24, SSD_P = 64, SSD_N = 128, SSD_G = 4, SSD_L = 128, SSD_BC = 512, CONV_DIM = 2560;
constexpr int NCHUNK = T / SSD_L;
constexpr int SB_W = 512, SB_H = 4, SB_D = 128;
constexpr int IN_COLS = 9752, IN_PAD = 9984;
constexpr int XA_W = 512, MEM = 256;
constexpr int NEXP = 32, EFF = 512;
constexpr int NSLOT = 2 * T + NEXP * 256;
constexpr float EPS = 1e-6f;
constexpr float WGU_SCALE = 64.f, HID_SCALE = 16.f, WD_SCALE = 32.f, Y_SCALE = 16.f;

constexpr size_t MiB = 1u << 20;
constexpr size_t WS_CTL = 0, CTL_ZERO_BYTES = 1 * MiB;
constexpr size_t WS_WCAT_T = 1 * MiB;
constexpr size_t WS_WMIX_T = 9 * MiB;
constexpr size_t WS_WQ_T = 17 * MiB;
constexpr size_t WS_WK_T = 19 * MiB;
constexpr size_t WS_WV_T = 21 * MiB;
constexpr size_t WS_WO_T = 23 * MiB;
constexpr size_t WS_WR_T = 25 * MiB;
constexpr size_t WS_MEMN = 26 * MiB;
constexpr size_t WS_KX = 28 * MiB;
constexpr size_t WS_VXT = 28 * MiB + 512 * 1024;
constexpr size_t WS_DTRAW = 29 * MiB;
constexpr size_t WS_DTT = 33 * MiB;
constexpr size_t WS_ACT = 36 * MiB;
constexpr size_t WS_RSTD = 39 * MiB;
constexpr size_t WS_SRSTD = 53 * MiB;
constexpr size_t WS_USC = 62 * MiB;
constexpr size_t WS_WSC = 62 * MiB + 256 * 1024;
constexpr size_t WS_SSQ1 = 54 * MiB, WS_SSQ2 = 58 * MiB;
constexpr size_t WS_WL = 50 * MiB;
constexpr size_t WS_LOGITS = 40 * MiB;
constexpr size_t WS_TI = 48 * MiB;
constexpr size_t WS_TG = 48 * MiB + 512 * 1024;
constexpr size_t WS_TSLOT = 48 * MiB + 768 * 1024;
constexpr size_t WS_SLOTTOK = 49 * MiB;
constexpr size_t WS_TILEE = 49 * MiB + 512 * 1024;
constexpr size_t WS_WIN_T = 64 * MiB;
constexpr size_t WS_BT = 64 * MiB;
constexpr size_t WS_Q2 = 64 * MiB;
constexpr size_t WS_RA = 104 * MiB;
constexpr size_t WS_Z = 232 * MiB;
constexpr size_t WS_HID = 232 * MiB;
constexpr size_t WS_XBC = 328 * MiB;
constexpr size_t WS_MERGED = 328 * MiB;
constexpr size_t WS_HB8 = 328 * MiB;
constexpr size_t WS_QKV = 488 * MiB;
constexpr size_t WS_WGU_T = 488 * MiB;
constexpr size_t WS_GATES = 584 * MiB;
constexpr size_t WS_WD_T = 616 * MiB;
constexpr size_t WS_Y = 680 * MiB;
constexpr size_t WS_BN = 840 * MiB;
constexpr size_t WS_CN = 872 * MiB;
constexpr size_t WS_XT = 904 * MiB;
constexpr size_t WS_O2 = 968 * MiB;
constexpr size_t WS_END = 1000 * MiB;
constexpr size_t OUT_STATE = 0, OUT_VT = 192 * MiB;
constexpr size_t OUT_UQ = 0, OUT_WQI = 64 * MiB;
constexpr int CW_BAR = 4096;
constexpr int CW_ECNT = 16384;
constexpr int CW_CMAX = 32768;

constexpr int RING_BYTES = 131072;
constexpr int MISC_OFF = RING_BYTES + 320;
constexpr int LDS_BYTES = 147456;
constexpr int NWAVES = 8;

DI float bf2f(bf16 v) { return __uint_as_float(((unsigned)v) << 16); }
DI unsigned pk2(float lo, float hi) { f32x2 v = {lo, hi}; bf16x2_t b = __builtin_convertvector(v, bf16x2_t); return __builtin_bit_cast(unsigned, b); }
DI bf16x8 pack8(const float (&v)[8]) { u32x4 p; p.x = pk2(v[0], v[1]); p.y = pk2(v[2], v[3]); p.z = pk2(v[4], v[5]); p.w = pk2(v[6], v[7]); return __builtin_bit_cast(bf16x8, p); }
DI float wave_sum(float v) {
#pragma unroll
    for (int o = 1; o < 64; o <<= 1) v += __shfl_xor(v, o);
    return v;
}
DI float silu_f(float x) { return x * __builtin_amdgcn_rcpf(1.0f + __expf(-x)); }
DI float sigmoid_f(float x) { return __builtin_amdgcn_rcpf(1.0f + __expf(-x)); }
DI unsigned pk4_fp8(float a, float b, float c, float d) { int w = 0;
    w = __builtin_amdgcn_cvt_pk_fp8_f32(__builtin_amdgcn_fmed3f(a, -448.f, 448.f), __builtin_amdgcn_fmed3f(b, -448.f, 448.f), w, false);
    w = __builtin_amdgcn_cvt_pk_fp8_f32(__builtin_amdgcn_fmed3f(c, -448.f, 448.f), __builtin_amdgcn_fmed3f(d, -448.f, 448.f), w, true); return (unsigned)w; }
DI unsigned pk4_i8(float a, float b, float c, float d) { const int ia = (int)__builtin_rintf(a), ib = (int)__builtin_rintf(b), ic = (int)__builtin_rintf(c), id = (int)__builtin_rintf(d);
    return (unsigned)(ia & 255) | ((unsigned)(ib & 255) << 8) | ((unsigned)(ic & 255) << 16) | ((unsigned)(id & 255) << 24); }
DI float rstd32(const float* p) { f32x4 a = *(const f32x4*)p;
#pragma unroll
    for (int i = 1; i < 8; ++i) a += *(const f32x4*)(p + 4 * i);
    return 1.0f / sqrtf(((a[0] + a[1]) + (a[2] + a[3])) * (1.0f / 2048.0f) + EPS); }
#define SUBPROBE_BEGIN(id) unsigned long long sp_t0_##id = 0; if (PROBE_PHASE == (id)) sp_t0_##id = __builtin_amdgcn_s_memrealtime()
#define SUBPROBE_END(id) do { if (PROBE_PHASE == (id) && F.pacc) *F.pacc += __builtin_amdgcn_s_memrealtime() - sp_t0_##id; } while (0)
#define MFMA16(a, b, c) __builtin_amdgcn_mfma_f32_16x16x32_bf16((a), (b), (c), 0, 0, 0)
#define LDS_WAIT() asm volatile("s_waitcnt lgkmcnt(0)" ::: "memory")
#define VM_WAIT() asm volatile("s_waitcnt vmcnt(0)" ::: "memory")

namespace pg8 {
#define PG8_LAS __attribute__((address_space(3)))
constexpr int BM = 256, BK = 64, HALF = 128, HTB = HALF * BK * 2, STAGE_BYTES = 8 * HTB, NXCD = 8, WGM = 8;
__host__ __device__ __forceinline__ int lds_byte(int r, int c) { const int st = (r >> 4) * 2 + (c >> 5), rr = r & 15, cc = c & 31, ob = rr * 64 + cc * 2; return st * 1024 + (ob ^ (((ob >> 9) & 1) << 5)); }
__host__ __device__ __forceinline__ void stage_rc(int b, int& R, int& C) { const int st = b / 1024, sb = b % 1024, swz = sb ^ (((sb >> 9) & 1) << 5); R = (st >> 1) * 16 + swz / 64; C = (st & 1) * 32 + (swz % 64) / 2; }
__host__ __device__ __forceinline__ int perm32(int rho) { const int n = rho >> 4, i = rho & 15; return 8 * (i >> 2) + 4 * n + (i & 3); }

struct Unit { int pm, pn, k0, nt, fin; };
struct Gemm { const void* A; const void* Bt; int K, lda, ldb; const int* arow; const int* tile_e; size_t b_estride; };

struct StaticOrder {
    int nM, nN, nwg, G, c, nt;
    __device__ void init(int M, int N, int K, int G_, int c_) { nM = M / BM; nN = N / BM; nwg = nM * nN; G = G_; c = c_; nt = K / BK; }
    __device__ bool next(int i, Unit& u) const {
        u.k0 = 0; u.nt = nt; u.fin = 1;
        const long L = (long)i * G + c; if (L >= nwg) return false;
        int wgid = (int)L; { const int q = nwg / NXCD, r = nwg % NXCD, xcd = wgid % NXCD, off = wgid / NXCD; wgid = (xcd < r ? xcd * (q + 1) : r * (q + 1) + (xcd - r) * q) + off; }
        const int nig = WGM * nN, gid = wgid / nig, fm = gid * WGM, gsz = (nM - fm) < WGM ? (nM - fm) : WGM;
        u.pm = fm + ((wgid % nig) % gsz); u.pn = (wgid % nig) / gsz; return true;
    }
};
struct ListOrder {
    int ntile, nN, G, c, nt;
    __device__ void init(int ntile_, int nN_, int G_, int c_, int nt_) { ntile = ntile_; nN = nN_; G = G_; c = c_; nt = nt_; }
    __device__ bool next(int i, Unit& u) const { u.k0 = 0; u.nt = nt; u.fin = 1; const int L = i * G + c; if (L >= ntile * nN) return false; u.pm = L / nN; u.pn = L % nN; return true; }
};
struct GatesOrder {
    int c, nt, G;
    __device__ bool next(int i, Unit& u) const { u.k0 = 0; u.nt = nt; u.fin = 1; int L;
        if (G == 256) { if (c < 128) { if (i >= 7) return false; L = c * 7 + i; } else { if (i >= 9) return false; L = 896 + (c - 128) * 9 + i; } }
        else { L = i * G + c; if (L >= 2048) return false; }
        u.pm = L >> 4; u.pn = L & 15; return true; }
};
struct SplitOrder {
    StaticOrder so; int nt0, nt1;
    __device__ bool next(int i, Unit& u) const { if (!so.next(i >> 1, u)) return false; if (i & 1) { u.k0 = nt0 * BK; u.nt = nt1; u.fin = 1; } else { u.k0 = 0; u.nt = nt0; u.fin = 0; } return true; }
};

typedef int v4i_t __attribute__((ext_vector_type(4)));
typedef int v8i_t __attribute__((ext_vector_type(8)));
template <class Epi, class Sched, bool ALIGN_EPI, bool GATHER, int MODE = 0>
__device__ __forceinline__ void gemm_phase(PG8_LAS unsigned char* lds, const Gemm g, const Sched& S, const Epi& E, unsigned long long* pacc = nullptr) {
    const int tid = threadIdx.x, wid = __builtin_amdgcn_readfirstlane(tid >> 6), lane = tid & 63, wr = wid >> 2, wc = wid & 3, fr = lane & 15, fq = lane >> 4;
    constexpr bool FP8 = (MODE == 1), I8 = (MODE == 2);
    constexpr int ESZ = MODE ? 1 : 2;
    unsigned voffB[2]; int RA[2], CA[2];
#pragma unroll
    for (int i = 0; i < 2; ++i) { int R, C; stage_rc(tid * 16 + i * 8192, R, C); const int Rb = (R & ~31) + perm32(R & 31);
        RA[i] = R; CA[i] = C; voffB[i] = (unsigned)(Rb * g.ldb * ESZ + C * 2); }
    const size_t kstep = (size_t)(BK * 2);
    const size_t hstepB = (size_t)HALF * g.ldb * ESZ;
    const size_t tstepB = 2 * hstepB;
    const unsigned ldsw = (unsigned)wid * 1024u;
    const int aoff = lds_byte(wr * 64 + fr, fq * 8), boff = lds_byte(wc * 32 + fr, fq * 8);
    const char* Ab = (const char*)g.A;
#define PG8_SA(b, h) (((b) * 2 + (h)) * HTB)
#define PG8_SB(b, h) ((4 + (b) * 2 + (h)) * HTB)
#define PG8_STAGE(bufoff, gbase, voff) do { _Pragma("unroll") for (int _i = 0; _i < 2; ++_i) \
        __builtin_amdgcn_global_load_lds((const unsigned*)((const char*)(gbase) + (voff)[_i]), (PG8_LAS unsigned*)(lds + (bufoff) + ldsw + _i * 8192), 16, 0, 0); } while (0)
#define PG8_STAGEA(bufoff, kb, o0, o1) do { \
        __builtin_amdgcn_global_load_lds((const unsigned*)(Ab + (kb) + (o0)), (PG8_LAS unsigned*)(lds + (bufoff) + ldsw), 16, 0, 0); \
        __builtin_amdgcn_global_load_lds((const unsigned*)(Ab + (kb) + (o1)), (PG8_LAS unsigned*)(lds + (bufoff) + ldsw + 8192), 16, 0, 0); } while (0)
#define PG8_LDA(dst, b, h) do { _Pragma("unroll") for (int m = 0; m < 4; ++m) dst[m] = __builtin_shufflevector(*(const PG8_LAS v4i_t*)(lds + PG8_SA(b, h) + aoff + m * 2048), *(const PG8_LAS v4i_t*)(lds + PG8_SA(b, h) + aoff + m * 2048 + 1024), 0, 1, 2, 3, 4, 5, 6, 7); } while (0)
#define PG8_LDB(dst, b, h) do { _Pragma("unroll") for (int n = 0; n < 2; ++n) dst[n] = __builtin_shufflevector(*(const PG8_LAS v4i_t*)(lds + PG8_SB(b, h) + boff + n * 2048), *(const PG8_LAS v4i_t*)(lds + PG8_SB(b, h) + boff + n * 2048 + 1024), 0, 1, 2, 3, 4, 5, 6, 7); } while (0)
#define PG8_LO(v) __builtin_bit_cast(bf16x8, __builtin_shufflevector((v), (v), 0, 1, 2, 3))
#define PG8_HI(v) __builtin_bit_cast(bf16x8, __builtin_shufflevector((v), (v), 4, 5, 6, 7))
#define PG8_MMA(ai, bj, At, Bt) do { __builtin_amdgcn_s_setprio(1); _Pragma("unroll") for (int m = 0; m < 4; ++m) _Pragma("unroll") for (int n = 0; n < 2; ++n) { \
        if constexpr (FP8) asm volatile("v_mfma_scale_f32_16x16x128_f8f6f4 %0, %1, %2, %0, %3, %3 op_sel_hi:[0,0,0]" : "+v"(acc[ai][bj][m][n]) : "v"(Bt[n]), "v"(At[m]), "v"(one_scale)); \
        else if constexpr (I8) { v4i_t c_ = __builtin_bit_cast(v4i_t, acc[ai][bj][m][n]); \
               c_ = __builtin_amdgcn_mfma_i32_16x16x64_i8(__builtin_shufflevector(Bt[n], Bt[n], 0, 1, 2, 3), __builtin_shufflevector(At[m], At[m], 0, 1, 2, 3), c_, 0, 0, 0); \
               c_ = __builtin_amdgcn_mfma_i32_16x16x64_i8(__builtin_shufflevector(Bt[n], Bt[n], 4, 5, 6, 7), __builtin_shufflevector(At[m], At[m], 4, 5, 6, 7), c_, 0, 0, 0); \
               acc[ai][bj][m][n] = __builtin_bit_cast(f32x4, c_); } \
        else { acc[ai][bj][m][n] = __builtin_amdgcn_mfma_f32_16x16x32_bf16(PG8_LO(Bt[n]), PG8_LO(At[m]), acc[ai][bj][m][n], 0, 0, 0); \
               acc[ai][bj][m][n] = __builtin_amdgcn_mfma_f32_16x16x32_bf16(PG8_HI(Bt[n]), PG8_HI(At[m]), acc[ai][bj][m][n], 0, 0, 0); } } \
        __builtin_amdgcn_s_setprio(0); } while (0)
#define PG8_WAIT_V(n) asm volatile("s_waitcnt vmcnt(" #n ")" ::: "memory")
#define PG8_WAIT_L(n) asm volatile("s_waitcnt lgkmcnt(" #n ")" ::: "memory")
#define PG8_BAR __builtin_amdgcn_s_barrier()
#define PG8_SCHED __builtin_amdgcn_sched_barrier(0)
#define PG8_SETA(o, u) do { _Pragma("unroll") for (int _h = 0; _h < 2; ++_h) _Pragma("unroll") for (int _i = 0; _i < 2; ++_i) { \
        int _row = (u).pm * BM + _h * HALF + RA[_i]; if (GATHER) _row = g.arow[_row]; (o)[_h][_i] = (unsigned)((_row * g.lda + (u).k0) * ESZ + CA[_i] * 2); } } while (0)
    Unit cur, nxt; int ui = 0;
    if (!S.next(0, cur)) return;
    f32x4 acc[2][2][4][2];
#pragma unroll
    for (int a = 0; a < 2; ++a)
#pragma unroll
        for (int b = 0; b < 2; ++b)
#pragma unroll
            for (int m = 0; m < 4; ++m)
#pragma unroll
                for (int n = 0; n < 2; ++n) acc[a][b][m][n] = (f32x4){0.f, 0.f, 0.f, 0.f};
    v8i_t At[4], B0[2], B1[2];
    const int one_scale = 0x7F7F7F7F;
    unsigned oc[2][2], on[2][2];
    PG8_SETA(oc, cur);
    const char* cB = (const char*)g.Bt + (g.tile_e ? (size_t)g.tile_e[cur.pm] * g.b_estride * ESZ : (size_t)0) + (size_t)cur.pn * tstepB + (size_t)cur.k0 * ESZ;
    PG8_STAGE(PG8_SB(0, 0), cB, voffB); PG8_STAGE(PG8_SB(0, 1), cB + hstepB, voffB); PG8_STAGEA(PG8_SA(0, 0), 0, oc[0][0], oc[0][1]); PG8_STAGEA(PG8_SA(0, 1), 0, oc[1][0], oc[1][1]);
    if (wr == 1) PG8_BAR;
    PG8_WAIT_V(2); PG8_BAR;
    PG8_STAGE(PG8_SB(1, 0), cB + kstep, voffB); PG8_STAGEA(PG8_SA(1, 0), kstep, oc[0][0], oc[0][1]); PG8_STAGE(PG8_SB(1, 1), cB + hstepB + kstep, voffB);
    PG8_WAIT_V(6); PG8_BAR;
    for (;;) {
        const bool has_next = S.next(ui + 1, nxt);
        const char* nB = cB;
        if (has_next) { nB = (const char*)g.Bt + (g.tile_e ? (size_t)g.tile_e[nxt.pm] * g.b_estride * ESZ : (size_t)0) + (size_t)nxt.pn * tstepB + (size_t)nxt.k0 * ESZ; }
        int nt = cur.nt; asm volatile("" : "+s"(nt));
#pragma unroll
        for (int _h = 0; _h < 2; ++_h)
#pragma unroll
            for (int _i = 0; _i < 2; ++_i) on[_h][_i] = oc[_h][_i];
        for (int t = 0; t < nt; t += 2) {
            const bool last = (t == nt - 2);
            if (last && has_next) { PG8_SETA(on, nxt); }
            const size_t k1 = (size_t)(t + 1) * kstep;
            const size_t k2 = last ? (size_t)0 : (size_t)(t + 2) * kstep, k3 = k2 + kstep;
            const char* b2 = last ? nB : cB + (size_t)(t + 2) * kstep; const char* b3 = b2 + kstep;
            const unsigned s00 = last ? on[0][0] : oc[0][0], s01 = last ? on[0][1] : oc[0][1], s10 = last ? on[1][0] : oc[1][0], s11 = last ? on[1][1] : oc[1][1];
            PG8_LDB(B0, 0, 0); PG8_LDB(B1, 0, 1); PG8_SCHED; PG8_LDA(At, 0, 0); PG8_STAGEA(PG8_SA(1, 1), k1, oc[1][0], oc[1][1]);
            PG8_WAIT_V(8); PG8_WAIT_L(0); PG8_BAR; PG8_MMA(0, 0, At, B0); PG8_MMA(0, 1, At, B1); PG8_BAR; PG8_SCHED;
            PG8_LDA(At, 0, 1); PG8_STAGE(PG8_SB(0, 0), b2, voffB); PG8_STAGE(PG8_SB(0, 1), b2 + hstepB, voffB); PG8_STAGEA(PG8_SA(0, 0), k2, s00, s01);
            PG8_WAIT_V(8); PG8_WAIT_L(0); PG8_BAR; PG8_MMA(1, 0, At, B0); PG8_MMA(1, 1, At, B1); PG8_BAR; PG8_SCHED;
            PG8_LDB(B0, 1, 0); PG8_LDB(B1, 1, 1); PG8_SCHED; PG8_LDA(At, 1, 0); PG8_STAGEA(PG8_SA(0, 1), k2, s10, s11);
            PG8_WAIT_V(8); PG8_WAIT_L(0); PG8_BAR; PG8_MMA(0, 0, At, B0); PG8_MMA(0, 1, At, B1); PG8_BAR; PG8_SCHED;
            PG8_LDA(At, 1, 1); PG8_STAGE(PG8_SB(1, 0), b3, voffB); PG8_STAGE(PG8_SB(1, 1), b3 + hstepB, voffB); PG8_STAGEA(PG8_SA(1, 0), k3, s00, s01);
            PG8_WAIT_V(8); PG8_WAIT_L(0); PG8_BAR; PG8_MMA(1, 0, At, B0); PG8_MMA(1, 1, At, B1); PG8_BAR; PG8_SCHED;
        }
        if constexpr (FP8) asm volatile("s_nop 15\n\ts_nop 15" ::: "memory");
        unsigned long long pt_e0 = 0; if (pacc) pt_e0 = __builtin_amdgcn_s_memrealtime();
        if constexpr (ALIGN_EPI) { if (wr == 0) PG8_BAR; }
        E(acc, cur, wr, wc, fr, fq);
        if (pacc) *pacc += __builtin_amdgcn_s_memrealtime() - pt_e0;
        if (!has_next) break;
        if (cur.fin) {
#pragma unroll
        for (int a = 0; a < 2; ++a)
#pragma unroll
            for (int b = 0; b < 2; ++b)
#pragma unroll
                for (int m = 0; m < 4; ++m)
#pragma unroll
                    for (int n = 0; n < 2; ++n) { acc[a][b][m][n] = (f32x4){0.f, 0.f, 0.f, 0.f}; }
        }
        cur = nxt; cB = nB; ++ui;
#pragma unroll
        for (int _h = 0; _h < 2; ++_h)
#pragma unroll
            for (int _i = 0; _i < 2; ++_i) oc[_h][_i] = on[_h][_i];
        if constexpr (ALIGN_EPI) { if (wr == 1) PG8_BAR; }
    }
    PG8_WAIT_V(0);
    if constexpr (!ALIGN_EPI) { if (wr == 0) PG8_BAR; }
    PG8_BAR;
#undef PG8_SA
#undef PG8_SB
#undef PG8_STAGE
#undef PG8_STAGEA
#undef PG8_LDA
#undef PG8_LDB
#undef PG8_MMA
#undef PG8_LO
#undef PG8_HI
#undef PG8_WAIT_V
#undef PG8_WAIT_L
#undef PG8_BAR
#undef PG8_SCHED
#undef PG8_SETA
}

#define EPI_ROWS(...) _Pragma("unroll") for (int ai = 0; ai < 2; ++ai) _Pragma("unroll") for (int m = 0; m < 4; ++m) { const int row = u.pm * BM + ai * HALF + wr * 64 + m * 16 + fr; \
        _Pragma("unroll") for (int bj = 0; bj < 2; ++bj) { const int col = u.pn * BM + bj * HALF + wc * 32 + 8 * fq; const f32x4 v0 = acc[ai][bj][m][0], v1 = acc[ai][bj][m][1]; __VA_ARGS__ } }
DI void unpack8_u8(u32x2 w, float (&f)[8]) {
#pragma unroll
    for (int j = 0; j < 4; ++j) { f[j] = (float)((w.x >> (8 * j)) & 255u); f[4 + j] = (float)((w.y >> (8 * j)) & 255u); } }
DI u32x4 pack8v(f32x4 v0, f32x4 v1) { u32x4 w; w.x = pk2(v0[0], v0[1]); w.y = pk2(v0[2], v0[3]); w.z = pk2(v1[0], v1[1]); w.w = pk2(v1[2], v1[3]); return w; }
DI void unpack8(u32x4 w, float (&f)[8]) { f[0] = __uint_as_float(w.x << 16); f[1] = __uint_as_float(w.x & 0xffff0000u); f[2] = __uint_as_float(w.y << 16); f[3] = __uint_as_float(w.y & 0xffff0000u);
    f[4] = __uint_as_float(w.z << 16); f[5] = __uint_as_float(w.z & 0xffff0000u); f[6] = __uint_as_float(w.w << 16); f[7] = __uint_as_float(w.w & 0xffff0000u); }

struct EpiF8 {
    unsigned char* O; int ldc; float sc;
    DI void operator()(const f32x4 (&acc)[2][2][4][2], const Unit& u, int wr, int wc, int fr, int fq) const {
        EPI_ROWS({ u32x2 w8; w8.x = pk4_fp8(v0[0] * sc, v0[1] * sc, v0[2] * sc, v0[3] * sc); w8.y = pk4_fp8(v1[0] * sc, v1[1] * sc, v1[2] * sc, v1[3] * sc); *(u32x2*)(O + (size_t)row * ldc + col) = w8; })
    }
};
struct EpiBf16 {
    bf16* O; int ldc; float sc;
    DI void operator()(const f32x4 (&acc)[2][2][4][2], const Unit& u, int wr, int wc, int fr, int fq) const {
        EPI_ROWS({ *(u32x4*)(O + (size_t)row * ldc + col) = pack8v(v0 * sc, v1 * sc); })
    }
};
struct EpiInProj {
    bf16 *Z, *XBC, *QKV; unsigned char* GATES; float* DTRAW; const float* usc; const float* wsc;
    DI void operator()(const f32x4 (&acc)[2][2][4][2], const Unit& u, int wr, int wc, int fr, int fq) const {
        const int pn = u.pn;
        f32x4 cs[2][2];
#pragma unroll
        for (int bj = 0; bj < 2; ++bj) { const int col = u.pn * BM + bj * HALF + wc * 32 + 8 * fq; cs[bj][0] = *(const f32x4*)(wsc + col); cs[bj][1] = *(const f32x4*)(wsc + col + 4); }
#pragma unroll
        for (int ai = 0; ai < 2; ++ai)
#pragma unroll
            for (int m = 0; m < 4; ++m) { const int row = u.pm * BM + ai * HALF + wr * 64 + m * 16 + fr; const float rs = usc[row];
#pragma unroll
                for (int bj = 0; bj < 2; ++bj) { const int col = u.pn * BM + bj * HALF + wc * 32 + 8 * fq;
                    const v4i_t i0 = __builtin_bit_cast(v4i_t, acc[ai][bj][m][0]), i1 = __builtin_bit_cast(v4i_t, acc[ai][bj][m][1]);
                    f32x4 v0, v1;
#pragma unroll
                    for (int j = 0; j < 4; ++j) { v0[j] = (float)i0[j] * rs * cs[bj][0][j]; v1[j] = (float)i1[j] * rs * cs[bj][1][j]; }
                    if (pn < 6) *(u32x4*)(Z + (size_t)row * 1536 + col) = pack8v(v0, v1);
                    else if (pn < 16) *(u32x4*)(XBC + (size_t)row * 2560 + (col - 1536)) = pack8v(v0, v1);
                    else if (pn < 22) *(u32x4*)(QKV + (size_t)row * 1536 + (col - 4096)) = pack8v(v0, v1);
                    else if (pn < 38) { f32x4 a, b;
#pragma unroll
                        for (int j = 0; j < 4; ++j) { a[j] = fmaxf(sigmoid_f(v0[j]) * 255.f, 1.f); b[j] = fmaxf(sigmoid_f(v1[j]) * 255.f, 1.f); }
                        u32x2 q; q.x = pk4_i8(a[0], a[1], a[2], a[3]); q.y = pk4_i8(b[0], b[1], b[2], b[3]);
                        *(u32x2*)(GATES + (size_t)row * 4096 + (col - 5632)) = q; }
                    else { const int c = col - 9728; if (c < 32) { *(f32x4*)(DTRAW + (size_t)row * 32 + c) = v0; *(f32x4*)(DTRAW + (size_t)row * 32 + c + 4) = v1; } } } }
    }
};
struct EpiMerge {
    bf16* MERGED; const unsigned char* GATES; const float* RSTD;
    DI void operator()(f32x4 (&acc)[2][2][4][2], const Unit& u, int wr, int wc, int fr, int fq) const { if (u.fin) fin(acc, u, wr, wc, fr, fq); else mid(acc, u, wr, wc, fr, fq); }
    DI void mid(f32x4 (&acc)[2][2][4][2], const Unit& u, int wr, int wc, int fr, int fq) const {
#pragma unroll
        for (int ai = 0; ai < 2; ++ai) { u32x2 ga[4][2], gb[4][2]; float rs[4];
#pragma unroll
            for (int m = 0; m < 4; ++m) { const int row = u.pm * BM + ai * HALF + wr * 64 + m * 16 + fr; rs[m] = RSTD[row];
#pragma unroll
                for (int bj = 0; bj < 2; ++bj) { const int col = u.pn * BM + bj * HALF + wc * 32 + 8 * fq; ga[m][bj] = *(const u32x2*)(GATES + (size_t)row * 4096 + col); gb[m][bj] = *(const u32x2*)(GATES + (size_t)row * 4096 + 2048 + col); } }
#pragma unroll
            for (int m = 0; m < 4; ++m)
#pragma unroll
                for (int bj = 0; bj < 2; ++bj) { float g1[8], g2[8]; unpack8_u8(ga[m][bj], g1); unpack8_u8(gb[m][bj], g2);
#pragma unroll
                    for (int j = 0; j < 4; ++j) { acc[ai][bj][m][0][j] *= rs[m] * g1[j] * __builtin_amdgcn_rcpf(fmaxf(g2[j], 1e-30f)); acc[ai][bj][m][1][j] *= rs[m] * g1[4 + j] * __builtin_amdgcn_rcpf(fmaxf(g2[4 + j], 1e-30f)); } }
            asm volatile("" ::: "memory"); }
    }
    DI void fin(const f32x4 (&acc)[2][2][4][2], const Unit& u, int wr, int wc, int fr, int fq) const {
        EPI_ROWS({ float g2[8]; unpack8_u8(*(const u32x2*)(GATES + (size_t)row * 4096 + 2048 + col), g2);
            f32x4 a, b;
_Pragma("unroll")
            for (int j = 0; j < 4; ++j) { a[j] = v0[j] * g2[j] * (1.0f / 255.0f); b[j] = v1[j] * g2[4 + j] * (1.0f / 255.0f); }
            *(u32x4*)(MERGED + (size_t)row * 2048 + col) = pack8v(a, b); })
    }
};
struct EpiResF32 {
    const float* base; float* out;
    DI void operator()(const f32x4 (&acc)[2][2][4][2], const Unit& u, int wr, int wc, int fr, int fq) const {
        EPI_ROWS({ const size_t o = (size_t)row * 2048 + col; const f32x4 b0 = *(const f32x4*)(base + o), b1 = *(const f32x4*)(base + o + 4);
            *(f32x4*)(out + o) = b0 + v0; *(f32x4*)(out + o + 4) = b1 + v1; })
    }
};
struct EpiResStatF32 {
    const float* base; bf16* hb; float* ssq;
    DI void operator()(const f32x4 (&acc)[2][2][4][2], const Unit& u, int wr, int wc, int fr, int fq) const {
#pragma unroll
        for (int ai = 0; ai < 2; ++ai) { f32x4 bv[4][2][2];
#pragma unroll
            for (int m = 0; m < 4; ++m)
#pragma unroll
                for (int bj = 0; bj < 2; ++bj) { const size_t o = (size_t)(u.pm * BM + ai * HALF + wr * 64 + m * 16 + fr) * 2048 + u.pn * BM + bj * HALF + wc * 32 + 8 * fq; bv[m][bj][0] = *(const f32x4*)(base + o); bv[m][bj][1] = *(const f32x4*)(base + o + 4); }
#pragma unroll
            for (int m = 0; m < 4; ++m) { const int row = u.pm * BM + ai * HALF + wr * 64 + m * 16 + fr; float sq = 0.f;
#pragma unroll
                for (int bj = 0; bj < 2; ++bj) { const size_t o = (size_t)row * 2048 + u.pn * BM + bj * HALF + wc * 32 + 8 * fq;
                    const f32x4 r0 = bv[m][bj][0] + acc[ai][bj][m][0], r1 = bv[m][bj][1] + acc[ai][bj][m][1];
                    *(u32x4*)(hb + o) = pack8v(r0, r1);
                    sq += (r0[0] * r0[0] + r0[1] * r0[1]) + (r0[2] * r0[2] + r0[3] * r0[3]) + (r1[0] * r1[0] + r1[1] * r1[1]) + (r1[2] * r1[2] + r1[3] * r1[3]); }
                sq += __shfl_xor(sq, 16); sq += __shfl_xor(sq, 32);
                if (fq == 0) ssq[(size_t)row * 32 + u.pn * 4 + wc] = sq; }
            asm volatile("" ::: "memory"); }
    }
};
struct EpiResStatBf {
    bf16* hb; float* ssq; unsigned char* hb8;
    DI void operator()(const f32x4 (&acc)[2][2][4][2], const Unit& u, int wr, int wc, int fr, int fq) const {
        u32x4 bv[2][4][2];
#pragma unroll
        for (int ai = 0; ai < 2; ++ai)
#pragma unroll
            for (int m = 0; m < 4; ++m)
#pragma unroll
                for (int bj = 0; bj < 2; ++bj) bv[ai][m][bj] = *(const u32x4*)(hb + (size_t)(u.pm * BM + ai * HALF + wr * 64 + m * 16 + fr) * 2048 + u.pn * BM + bj * HALF + wc * 32 + 8 * fq);
#pragma unroll
        for (int ai = 0; ai < 2; ++ai)
#pragma unroll
            for (int m = 0; m < 4; ++m) { const int row = u.pm * BM + ai * HALF + wr * 64 + m * 16 + fr; float sq = 0.f;
#pragma unroll
                for (int bj = 0; bj < 2; ++bj) { const size_t o = (size_t)row * 2048 + u.pn * BM + bj * HALF + wc * 32 + 8 * fq; float bf[8]; unpack8(bv[ai][m][bj], bf);
                    f32x4 r0, r1;
#pragma unroll
                    for (int j = 0; j < 4; ++j) { r0[j] = bf[j] + acc[ai][bj][m][0][j]; r1[j] = bf[4 + j] + acc[ai][bj][m][1][j]; }
                    *(u32x4*)(hb + o) = pack8v(r0, r1);
                    { u32x2 w8; w8.x = pk4_fp8(r0[0], r0[1], r0[2], r0[3]); w8.y = pk4_fp8(r1[0], r1[1], r1[2], r1[3]); *(u32x2*)(hb8 + o) = w8; }
                    sq += (r0[0] * r0[0] + r0[1] * r0[1]) + (r0[2] * r0[2] + r0[3] * r0[3]) + (r1[0] * r1[0] + r1[1] * r1[1]) + (r1[2] * r1[2] + r1[3] * r1[3]); }
                sq += __shfl_xor(sq, 16); sq += __shfl_xor(sq, 32);
                if (fq == 0) ssq[(size_t)row * 32 + u.pn * 4 + wc] = sq; }
    }
};
struct EpiBf16Rs {
    bf16* O; int ldc; const float* ssq;
    DI void operator()(const f32x4 (&acc)[2][2][4][2], const Unit& u, int wr, int wc, int fr, int fq) const {
_Pragma("unroll") for (int ai = 0; ai < 2; ++ai) _Pragma("unroll") for (int m = 0; m < 4; ++m) { const int row = u.pm * BM + ai * HALF + wr * 64 + m * 16 + fr; const float rs = rstd32(ssq + (size_t)row * 32);
            _Pragma("unroll") for (int bj = 0; bj < 2; ++bj) { const int col = u.pn * BM + bj * HALF + wc * 32 + 8 * fq; *(u32x4*)(O + (size_t)row * ldc + col) = pack8v(acc[ai][bj][m][0] * rs, acc[ai][bj][m][1] * rs); } }
    }
};
struct EpiSwiGLU {
    unsigned char* HID; const float* srstd; float in_scale, out_scale;
    DI void operator()(const f32x4 (&acc)[2][2][4][2], const Unit& u, int wr, int wc, int fr, int fq) const {
#pragma unroll
        for (int ai = 0; ai < 2; ++ai)
#pragma unroll
            for (int m = 0; m < 4; ++m) { const int row = u.pm * BM + ai * HALF + wr * 64 + m * 16 + fr; const int col = u.pn * 128 + wc * 32 + 8 * fq; const float rs = srstd[row] * in_scale;
                f32x4 a, b;
#pragma unroll
                for (int j = 0; j < 4; ++j) { a[j] = silu_f(acc[ai][0][m][0][j] * rs) * (acc[ai][1][m][0][j] * rs) * out_scale; b[j] = silu_f(acc[ai][0][m][1][j] * rs) * (acc[ai][1][m][1][j] * rs) * out_scale; }
                u32x2 w; w.x = pk4_fp8(a[0], a[1], a[2], a[3]); w.y = pk4_fp8(b[0], b[1], b[2], b[3]);
                *(u32x2*)(HID + (size_t)row * EFF + col) = w; }
    }
};
}

#define XB_TMO      128
#define XB_XCNT(j)  (256  + 64 * (j))
#define XB_XSUB(j)  (1280 + 64 * (j))
#define XB_XGEN(j)  (2304 + 64 * (j))
#define XB_TOP      3328
#define XB_TOPGEN   3392
#define XCD_BAR_WORDS 3456
#define XB_SPIN_CAP (1u << 18)
__device__ __forceinline__ unsigned xb_ld(unsigned* p)              { return __hip_atomic_load(p, __ATOMIC_RELAXED, __HIP_MEMORY_SCOPE_AGENT); }
__device__ __forceinline__ unsigned xb_add(unsigned* p, unsigned v) { return __hip_atomic_fetch_add(p, v, __ATOMIC_RELAXED, __HIP_MEMORY_SCOPE_AGENT); }
__device__ __forceinline__ unsigned xb_xcc_id() { return (unsigned)__builtin_amdgcn_s_getreg((3 << 11) | 20) & 0xFu; }
#define XB_SPIN(cond, bar) do { unsigned _sp = 0; while (cond) { __builtin_amdgcn_s_sleep(1); \
    if ((++_sp & 255u) == 0u) { if (xb_ld(&(bar)[XB_TMO])) break; if (_sp > XB_SPIN_CAP) { atomicAdd(&(bar)[XB_TMO], 1u); break; } } } } while (0)
struct XcdBarrier { unsigned* bar; unsigned x; volatile LAS unsigned* st; };
__device__ __forceinline__ XcdBarrier xcd_barrier_post(unsigned* bar, volatile LAS unsigned* st) {
    XcdBarrier b; b.bar = bar; b.x = xb_xcc_id(); b.st = st;
    if (threadIdx.x == 0) (void)xb_add(&bar[XB_XCNT(b.x)], 1u);
    return b;
}
__device__ __forceinline__ void xcd_barrier_complete(unsigned* bar, unsigned x, unsigned& nloc, unsigned& nx) {
    const unsigned G = gridDim.x * gridDim.y * gridDim.z;
    unsigned sum, cnt, mine, sp = 0u;
    for (;;) {
        sum = 0u; cnt = 0u; mine = 0u;
#pragma unroll
        for (unsigned j = 0; j < 16; ++j) { const unsigned c = xb_ld(&bar[XB_XCNT(j)]); sum += c; cnt += (c > 0u) ? 1u : 0u; mine = (j == x) ? c : mine; }
        if (sum == G) break;
        __builtin_amdgcn_s_sleep(1);
        if ((++sp & 255u) == 0u) { if (xb_ld(&bar[XB_TMO])) break; if (sp > XB_SPIN_CAP) { atomicAdd(&bar[XB_TMO], 1u); break; } }
    }
    nloc = mine > 0u ? mine : 1u; nx = cnt > 0u ? cnt : 1u;
}
__device__ __forceinline__ void xcd_barrier(const XcdBarrier& b) {
    asm volatile("s_waitcnt vmcnt(0)" ::: "memory");
    __syncthreads();
    if (threadIdx.x == 0) {
        unsigned* bar = b.bar;
        __builtin_amdgcn_s_waitcnt(0);
        unsigned nloc = b.st[0], nx = b.st[1];
        if (nloc == 0u) { xcd_barrier_complete(bar, b.x, nloc, nx); b.st[0] = nloc; b.st[1] = nx; }
        const unsigned old = xb_add(&bar[XB_XSUB(b.x)], 1u);
        const unsigned gen = old / nloc;
        if (old + 1u == (gen + 1u) * nloc) {
            __builtin_amdgcn_fence(__ATOMIC_RELEASE, "agent");
            asm volatile("s_waitcnt vmcnt(0)" ::: "memory");
            const unsigned og = xb_add(&bar[XB_TOP], 1u);
            const unsigned tg = og / nx;
            if (og + 1u == (tg + 1u) * nx) xb_add(&bar[XB_TOPGEN], 1u);
            else XB_SPIN(xb_ld(&bar[XB_TOPGEN]) == tg, bar);
            __builtin_amdgcn_fence(__ATOMIC_ACQUIRE, "agent");
            xb_add(&bar[XB_XGEN(b.x)], 1u);
            asm volatile("s_waitcnt vmcnt(0)" ::: "memory");
        } else {
            XB_SPIN(xb_ld(&bar[XB_XGEN(b.x)]) == gen, bar);
            __builtin_amdgcn_fence(__ATOMIC_ACQUIRE, "agent");
            asm volatile("s_waitcnt vmcnt(0)" ::: "memory");
        }
    }
    __syncthreads();
}

struct Frame {
    unsigned long long* pacc;
    LAS unsigned char* lds;
    int tid, lane, wave, G, gw, NGW;
    const float* in[26];
    float* out; unsigned char* ws;
};
#define WSP(type, off) ((type*)(F.ws + (off)))

DI void tr_item(const float* W, int ldw, int k0, int nsrc0, int nvalid, bf16* WT, int ldt, int drow0, const float* kscale, LAS float* scr, int lane) {
    const int nn = lane & 31;
#pragma unroll 8
    for (int i = 0; i < 32; ++i) { const int kk = 2 * i + (lane >> 5); float v = 0.f; if (nn < nvalid) v = W[(size_t)(k0 + kk) * ldw + nsrc0 + nn]; if (kscale) v *= kscale[k0 + kk]; scr[kk * 33 + nn] = v; }
    LDS_WAIT(); asm volatile("" ::: "memory");
    const int c = lane & 7;
#pragma unroll
    for (int j = 0; j < 4; ++j) { const int n = (lane >> 3) + 8 * j; const LAS float* s = scr + (8 * c) * 33 + n;
        u32x4 o; o.x = pk2(s[0 * 33], s[1 * 33]); o.y = pk2(s[2 * 33], s[3 * 33]); o.z = pk2(s[4 * 33], s[5 * 33]); o.w = pk2(s[6 * 33], s[7 * 33]);
        if (n < nvalid) *(u32x4*)(WT + (size_t)(drow0 + n) * ldt + k0 + 8 * c) = o; }
    LDS_WAIT(); asm volatile("" ::: "memory");
}
DI void tr_block(const float* W, int ldw, int K, int ncols, int nsrc0, bf16* WT, int ldt, int drow0, const float* kscale, LAS float* scr, int lane, int it) {
    const int nblk = (ncols + 31) / 32, kb = it / nblk, nb = it % nblk; const int nv = ncols - nb * 32 < 32 ? ncols - nb * 32 : 32;
    tr_item(W, ldw, kb * 64, nsrc0 + nb * 32, nv, WT, ldt, drow0 + nb * 32, kscale, scr, lane);
}
DI void tr64_item(const float* W, int ldw, int k0, int nsrc0, bf16* WT, int ldt, int drow0, const float* kscale, int lane) {
    const int n4 = lane & 15, kq = lane >> 4;
    f32x4 r[2][8];
#pragma unroll
    for (int hf = 0; hf < 2; ++hf)
#pragma unroll
        for (int i = 0; i < 8; ++i) r[hf][i] = *(const f32x4*)(W + (size_t)(k0 + hf * 32 + kq * 8 + i) * ldw + nsrc0 + n4 * 4);
#pragma unroll
    for (int hf = 0; hf < 2; ++hf) { const int kb = k0 + hf * 32 + kq * 8;
        if (kscale) { const f32x4 s0 = *(const f32x4*)(kscale + kb), s1 = *(const f32x4*)(kscale + kb + 4);
#pragma unroll
            for (int i = 0; i < 4; ++i) { r[hf][i] = r[hf][i] * s0[i]; r[hf][4 + i] = r[hf][4 + i] * s1[i]; } }
#pragma unroll
        for (int j = 0; j < 4; ++j) { u32x4 o; o.x = pk2(r[hf][0][j], r[hf][1][j]); o.y = pk2(r[hf][2][j], r[hf][3][j]); o.z = pk2(r[hf][4][j], r[hf][5][j]); o.w = pk2(r[hf][6][j], r[hf][7][j]);
            *(u32x4*)(WT + (size_t)(drow0 + n4 * 4 + j) * ldt + kb) = o; } }
}
DI void tr64_item8(const float* W, int ldw, int k0, int nsrc0, unsigned char* WT, int ldt, int drow0, const float* kscale, float sc, int lane) {
    const int n4 = lane & 15, kq = lane >> 4;
    f32x4 r[2][8];
#pragma unroll
    for (int hf = 0; hf < 2; ++hf)
#pragma unroll
        for (int i = 0; i < 8; ++i) r[hf][i] = *(const f32x4*)(W + (size_t)(k0 + kq * 16 + hf * 8 + i) * ldw + nsrc0 + n4 * 4);
    const int kb = k0 + kq * 16;
#pragma unroll
    for (int hf = 0; hf < 2; ++hf) { f32x4 s0 = (f32x4){sc, sc, sc, sc}, s1 = s0;
        if (kscale) { s0 = *(const f32x4*)(kscale + kb + hf * 8) * sc; s1 = *(const f32x4*)(kscale + kb + hf * 8 + 4) * sc; }
#pragma unroll
        for (int i = 0; i < 4; ++i) { r[hf][i] = r[hf][i] * s0[i]; r[hf][4 + i] = r[hf][4 + i] * s1[i]; } }
#pragma unroll
    for (int j = 0; j < 4; ++j) { u32x4 o; o.x = pk4_fp8(r[0][0][j], r[0][1][j], r[0][2][j], r[0][3][j]); o.y = pk4_fp8(r[0][4][j], r[0][5][j], r[0][6][j], r[0][7][j]);
        o.z = pk4_fp8(r[1][0][j], r[1][1][j], r[1][2][j], r[1][3][j]); o.w = pk4_fp8(r[1][4][j], r[1][5][j], r[1][6][j], r[1][7][j]);
        *(u32x4*)(WT + (size_t)(drow0 + n4 * 4 + j) * ldt + kb) = o; }
}
DI void tr64_block(const float* W, int ldw, int K, int ncols, int nsrc0, bf16* WT, int ldt, int drow0, const float* kscale, int lane, int it) {
    const int nblk = ncols / 64, kb = it / nblk, nb = it % nblk;
    tr64_item(W, ldw, kb * 64, nsrc0 + nb * 64, WT, ldt, drow0 + nb * 64, kscale, lane);
}
DI void tr64_block8(const float* W, int ldw, int K, int ncols, int nsrc0, unsigned char* WT, int ldt, int drow0, const float* kscale, float sc, int lane, int it) {
    const int nblk = ncols / 64, kb = it / nblk, nb = it % nblk;
    tr64_item8(W, ldw, kb * 64, nsrc0 + nb * 64, WT, ldt, drow0 + nb * 64, kscale, sc, lane);
}
DI void rms_row_bf16(const float* xrow, const float* w, bf16* orow, int lane) {
    const f32x4* xr = (const f32x4*)xrow + lane; const f32x4* wr4 = (const f32x4*)w + lane;
    f32x4 v[8]; float s = 0.f;
#pragma unroll
    for (int j = 0; j < 8; ++j) { v[j] = xr[64 * j]; s += (v[j].x * v[j].x + v[j].y * v[j].y) + (v[j].z * v[j].z + v[j].w * v[j].w); }
    const float rstd = 1.0f / sqrtf(wave_sum(s) * (1.0f / 2048.0f) + EPS);
    u32x2* o8 = (u32x2*)orow + lane;
#pragma unroll
    for (int j = 0; j < 8; ++j) { const f32x4 ww = wr4[64 * j]; u32x2 o; o.x = pk2(v[j].x * rstd * ww.x, v[j].y * rstd * ww.y); o.y = pk2(v[j].z * rstd * ww.z, v[j].w * rstd * ww.w); o8[64 * j] = o; }
}
DI void rms_rows(const Frame& F, const float* src, const float* w, bf16* dst, int rows, unsigned char* dst8 = nullptr) {
    const int lane = F.lane;
    int m = F.gw;
    for (; m + F.NGW < rows; m += 2 * F.NGW) {
        const f32x4* xa = (const f32x4*)(src + (size_t)m * 2048) + lane; const f32x4* xb = (const f32x4*)(src + (size_t)(m + F.NGW) * 2048) + lane; const f32x4* wr4 = (const f32x4*)w + lane;
        f32x4 va[8], vb[8]; float sa = 0.f, sb = 0.f;
#pragma unroll
        for (int j = 0; j < 8; ++j) { va[j] = xa[64 * j]; vb[j] = xb[64 * j]; }
#pragma unroll
        for (int j = 0; j < 8; ++j) { sa += (va[j].x * va[j].x + va[j].y * va[j].y) + (va[j].z * va[j].z + va[j].w * va[j].w); sb += (vb[j].x * vb[j].x + vb[j].y * vb[j].y) + (vb[j].z * vb[j].z + vb[j].w * vb[j].w); }
        const float ra = 1.0f / sqrtf(wave_sum(sa) * (1.0f / 2048.0f) + EPS), rb = 1.0f / sqrtf(wave_sum(sb) * (1.0f / 2048.0f) + EPS);
        u32x2* oa = (u32x2*)(dst + (size_t)m * 2048) + lane; u32x2* ob = (u32x2*)(dst + (size_t)(m + F.NGW) * 2048) + lane;
#pragma unroll
        for (int j = 0; j < 8; ++j) { const f32x4 ww = wr4[64 * j]; const f32x4 ya = va[j] * ra * ww, yb = vb[j] * rb * ww;
            u32x2 o; o.x = pk2(ya.x, ya.y); o.y = pk2(ya.z, ya.w); oa[64 * j] = o;
            u32x2 p; p.x = pk2(yb.x, yb.y); p.y = pk2(yb.z, yb.w); ob[64 * j] = p;
            if (dst8) { ((unsigned*)(dst8 + (size_t)m * 2048))[lane + 64 * j] = pk4_fp8(ya.x, ya.y, ya.z, ya.w); ((unsigned*)(dst8 + (size_t)(m + F.NGW) * 2048))[lane + 64 * j] = pk4_fp8(yb.x, yb.y, yb.z, yb.w); } }
    }
    for (; m < rows; m += F.NGW) rms_row_bf16(src + (size_t)m * 2048, w, dst + (size_t)m * 2048, lane);
}

DI void rms_rows_q(const Frame& F, const float* src, const float* w, unsigned char* dstq, float* usc, int rows) {
    const int lane = F.lane;
    for (int m = F.gw; m < rows; m += 2 * F.NGW) {
        const int m2 = m + F.NGW; const bool two = m2 < rows; const int mb = two ? m2 : m;
        const f32x4* xa = (const f32x4*)(src + (size_t)m * 2048) + lane; const f32x4* xb = (const f32x4*)(src + (size_t)mb * 2048) + lane; const f32x4* wr4 = (const f32x4*)w + lane;
        f32x4 va[8], vb[8]; float sa = 0.f, sb = 0.f;
#pragma unroll
        for (int j = 0; j < 8; ++j) { va[j] = xa[64 * j]; vb[j] = xb[64 * j]; }
#pragma unroll
        for (int j = 0; j < 8; ++j) { sa += (va[j].x * va[j].x + va[j].y * va[j].y) + (va[j].z * va[j].z + va[j].w * va[j].w); sb += (vb[j].x * vb[j].x + vb[j].y * vb[j].y) + (vb[j].z * vb[j].z + vb[j].w * vb[j].w); }
        const float ra = 1.0f / sqrtf(wave_sum(sa) * (1.0f / 2048.0f) + EPS), rb = 1.0f / sqrtf(wave_sum(sb) * (1.0f / 2048.0f) + EPS);
        float ma = 0.f, mbx = 0.f;
#pragma unroll
        for (int j = 0; j < 8; ++j) { const f32x4 ww = wr4[64 * j]; va[j] = va[j] * ra * ww; vb[j] = vb[j] * rb * ww;
            ma = fmaxf(ma, fmaxf(fmaxf(fabsf(va[j].x), fabsf(va[j].y)), fmaxf(fabsf(va[j].z), fabsf(va[j].w)))); mbx = fmaxf(mbx, fmaxf(fmaxf(fabsf(vb[j].x), fabsf(vb[j].y)), fmaxf(fabsf(vb[j].z), fabsf(vb[j].w)))); }
#pragma unroll
        for (int o = 1; o < 64; o <<= 1) { ma = fmaxf(ma, __shfl_xor(ma, o)); mbx = fmaxf(mbx, __shfl_xor(mbx, o)); }
        const float ia = ma > 0.f ? 127.0f / ma : 0.f, ib = mbx > 0.f ? 127.0f / mbx : 0.f;
        unsigned* oa = (unsigned*)(dstq + (size_t)m * 2048) + lane; unsigned* ob = (unsigned*)(dstq + (size_t)mb * 2048) + lane;
#pragma unroll
        for (int j = 0; j < 8; ++j) { oa[64 * j] = pk4_i8(va[j].x * ia, va[j].y * ia, va[j].z * ia, va[j].w * ia); if (two) ob[64 * j] = pk4_i8(vb[j].x * ib, vb[j].y * ib, vb[j].z * ib, vb[j].w * ib); }
        if (lane == 0) { usc[m] = ma * (1.0f / 127.0f); if (two) usc[mb] = mbx * (1.0f / 127.0f); }
    }
}
DI void win_item(int it, int& k0, int& nsrc0, int& drow0) {
    constexpr int NB = 153;
    const int kb = it / NB, nb = it % NB; k0 = kb * 64;
    if (nb < 24) { nsrc0 = nb * 64; drow0 = nb * 64; }
    else if (nb < 64) { nsrc0 = 1536 + (nb - 24) * 64; drow0 = 1536 + (nb - 24) * 64; }
    else if (nb < 88) { nsrc0 = 4120 + (nb - 64) * 64; drow0 = 4096 + (nb - 64) * 64; }
    else if (nb < 152) { nsrc0 = 5656 + (nb - 88) * 64; drow0 = 5632 + (nb - 88) * 64; }
    else { nsrc0 = 4096; drow0 = 9728; }
}
constexpr int WIN_ITEMS = 32 * 153;
DI void win_colmax(const Frame& F) {
    const float* W = F.in[3]; unsigned* cmax = WSP(unsigned, WS_CTL) + CW_CMAX;
    const int lane = F.lane, n4 = lane & 15, kq = lane >> 4;
    for (int it = F.gw; it < WIN_ITEMS; it += F.NGW) { int k0, nsrc0, drow0; win_item(it, k0, nsrc0, drow0);
        f32x4 mx = (f32x4){0.f, 0.f, 0.f, 0.f};
#pragma unroll
        for (int i = 0; i < 16; ++i) { const f32x4 v = *(const f32x4*)(W + (size_t)(k0 + kq * 16 + i) * IN_COLS + nsrc0 + n4 * 4);
#pragma unroll
            for (int j = 0; j < 4; ++j) mx[j] = fmaxf(mx[j], fabsf(v[j])); }
#pragma unroll
        for (int j = 0; j < 4; ++j) { float v = mx[j]; v = fmaxf(v, __shfl_xor(v, 16)); v = fmaxf(v, __shfl_xor(v, 32));
            if (kq == 0) atomicMax(cmax + drow0 + n4 * 4 + j, __float_as_uint(v)); }
    }
}
DI void win_quant(const Frame& F) {
    const float* W = F.in[3]; const unsigned* cmax = WSP(unsigned, WS_CTL) + CW_CMAX; unsigned char* WT = (unsigned char*)F.out + OUT_WQI; float* wsc = WSP(float, WS_WSC);
    const int lane = F.lane, n4 = lane & 15, kq = lane >> 4;
    for (int it = F.gw; it < WIN_ITEMS; it += F.NGW) { int k0, nsrc0, drow0; win_item(it, k0, nsrc0, drow0);
        f32x4 r[16];
#pragma unroll
        for (int i = 0; i < 16; ++i) r[i] = *(const f32x4*)(W + (size_t)(k0 + kq * 16 + i) * IN_COLS + nsrc0 + n4 * 4);
#pragma unroll
        for (int j = 0; j < 4; ++j) { const float cm = __uint_as_float(__hip_atomic_load(cmax + drow0 + n4 * 4 + j, __ATOMIC_RELAXED, __HIP_MEMORY_SCOPE_AGENT)); const float inv = cm > 0.f ? 127.0f / cm : 0.f;
            u32x4 o; o.x = pk4_i8(r[0][j] * inv, r[1][j] * inv, r[2][j] * inv, r[3][j] * inv); o.y = pk4_i8(r[4][j] * inv, r[5][j] * inv, r[6][j] * inv, r[7][j] * inv);
            o.z = pk4_i8(r[8][j] * inv, r[9][j] * inv, r[10][j] * inv, r[11][j] * inv); o.w = pk4_i8(r[12][j] * inv, r[13][j] * inv, r[14][j] * inv, r[15][j] * inv);
            *(u32x4*)(WT + (size_t)(drow0 + n4 * 4 + j) * 2048 + k0 + kq * 16) = o;
            if (k0 == 0 && kq == 0) wsc[drow0 + n4 * 4 + j] = cm * (1.0f / 127.0f); }
    }
    { const int gt = F.gw * 64 + F.lane, NT = F.NGW * 64;
      u32x4* z1 = (u32x4*)(WT + (size_t)9792 * 2048); for (int i = gt; i < (IN_PAD - 9792) * 2048 / 16; i += NT) z1[i] = (u32x4){0u, 0u, 0u, 0u};
      for (int i = gt; i < IN_PAD - 9792; i += NT) wsc[9792 + i] = 0.f; }
}
DI void p0_prologue(const Frame& F) {
    LAS float* scr = (LAS float*)(F.lds + F.wave * 16384);
    win_colmax(F);
    constexpr int I_SSD = (1536 / 64) * (2048 / 64), I_SB = (512 / 64) * (2048 / 64), I_MIX = (2048 / 64) * (2048 / 64);
    constexpr int I_XQ = (2048 / 64) * (512 / 64), I_XO = (512 / 64) * (2048 / 64);
    constexpr int NITEMS = I_SSD + I_SB + I_MIX + 3 * I_XQ + I_XO;
    for (int it = F.gw; it < NITEMS; it += F.NGW) {
        int r = it;
        if (r < I_SSD) { tr64_block(F.in[10], 2048, 1536, 2048, 0, WSP(bf16, WS_WCAT_T), 2048, 0, F.in[9], F.lane, r); continue; } r -= I_SSD;
        if (r < I_SB)  { tr64_block(F.in[11], 2048, 512,  2048, 0, WSP(bf16, WS_WCAT_T) + 1536, 2048, 0, nullptr, F.lane, r); continue; } r -= I_SB;
        if (r < I_MIX) { tr64_block(F.in[12], 2048, 2048, 2048, 0, WSP(bf16, WS_WMIX_T), 2048, 0, nullptr, F.lane, r); continue; } r -= I_MIX;
        if (r < I_XQ)  { tr64_block(F.in[15], 512, 2048, 512, 0, WSP(bf16, WS_WQ_T), 2048, 0, F.in[13], F.lane, r); continue; } r -= I_XQ;
        if (r < I_XQ)  { tr64_block(F.in[16], 512, 2048, 512, 0, WSP(bf16, WS_WK_T), 2048, 0, nullptr, F.lane, r); continue; } r -= I_XQ;
        if (r < I_XQ)  { tr64_block(F.in[17], 512, 2048, 512, 0, WSP(bf16, WS_WV_T), 2048, 0, nullptr, F.lane, r); continue; } r -= I_XQ;
        tr64_block(F.in[18], 2048, 512, 2048, 0, WSP(bf16, WS_WO_T), 512, 0, nullptr, F.lane, r);
    }
    constexpr int I_RG = 32, I_RE = 32;
    for (int it = F.gw; it < I_RG + I_RE; it += F.NGW) {
        int r = it;
        if (r < I_RG)  { tr_block(F.in[20], 4, 2048, 4, 0, WSP(bf16, WS_WR_T), 2048, 0, F.in[19], scr, F.lane, r); continue; } r -= I_RG;
        tr_block(F.in[21], 32, 2048, 32, 0, WSP(bf16, WS_WR_T), 2048, 4, F.in[19], scr, F.lane, r);
    }
    { const int gt = F.gw * 64 + F.lane, NT = F.NGW * 64;
      u32x4* z2 = (u32x4*)(WSP(bf16, WS_WR_T) + (size_t)36 * 2048); for (int i = gt; i < 12 * 2048 / 8; i += NT) z2[i] = (u32x4){0u, 0u, 0u, 0u}; }
    rms_rows_q(F, F.in[0], F.in[2], (unsigned char*)F.out + OUT_UQ, WSP(float, WS_USC), T);
    rms_rows(F, F.in[1], F.in[14], WSP(bf16, WS_MEMN), BATCH * MEM);
}
DI void p_expert_weights(const Frame& F) {
    constexpr int PER = 256;
    for (int it = F.gw; it < NEXP * 3 * PER; it += F.NGW) {
        const int e = it / (3 * PER), r = it % (3 * PER), which = r / PER, q = r % PER;
        if (which < 2) { const int kb = q / 8, nb = q % 8, n0 = nb * 64; const float* W = (which == 0 ? F.in[22] : F.in[23]) + (size_t)e * 2048 * 512;
            tr64_item8(W, 512, kb * 64, n0, WSP(unsigned char, WS_WGU_T) + (size_t)e * 1024 * 2048, 2048, (n0 / 128) * 256 + (n0 % 128) + which * 128, F.in[19], WGU_SCALE, F.lane); }
        else { const int kb = q / 32, nb = q % 32; const float* W = F.in[24] + (size_t)e * 512 * 2048;
            tr64_item8(W, 2048, kb * 64, nb * 64, WSP(unsigned char, WS_WD_T) + (size_t)e * 2048 * 512, 512, nb * 64, nullptr, WD_SCALE, F.lane); }
    }
}

template <int NT>
DI void wave_tile_gemm(const bf16* A, int lda, const bf16* Bt, int ldb, int K, int lane, f32x4 (&acc)[NT]) {
    const int fr = lane & 15, kg = lane >> 4;
#pragma unroll
    for (int n = 0; n < NT; ++n) acc[n] = (f32x4){0.f, 0.f, 0.f, 0.f};
    const bf16* ap = A + (size_t)fr * lda + kg * 8;
    const bf16* bp = Bt + (size_t)fr * ldb + kg * 8;
#pragma unroll 4
    for (int k0 = 0; k0 < K; k0 += 32) {
        const bf16x8 a = *(const bf16x8*)(ap + k0);
#pragma unroll
        for (int n = 0; n < NT; ++n) { const bf16x8 b = *(const bf16x8*)(bp + (size_t)n * 16 * ldb + k0); acc[n] = MFMA16(a, b, acc[n]); }
    }
}

DI void p_kv_mem(const Frame& F) {
    const bf16* MEMN = WSP(bf16, WS_MEMN);
    for (int u = F.gw; u < 512; u += F.NGW) {
        const int which = u >> 8, rt = (u & 255) >> 3, cg = u & 7; f32x4 acc[4];
        const bf16* Aop = which == 0 ? MEMN : WSP(bf16, WS_WV_T); const bf16* Bop = which == 0 ? WSP(bf16, WS_WK_T) : MEMN; bf16* O = which == 0 ? WSP(bf16, WS_KX) : WSP(bf16, WS_VXT);
        wave_tile_gemm<4>(Aop + (size_t)rt * 16 * 2048, 2048, Bop + (size_t)cg * 64 * 2048, 2048, 2048, F.lane, acc);
#pragma unroll
        for (int n = 0; n < 4; ++n)
#pragma unroll
            for (int i = 0; i < 4; ++i) O[(size_t)(rt * 16 + (F.lane >> 4) * 4 + i) * 512 + cg * 64 + n * 16 + (F.lane & 15)] = (bf16)(pk2(acc[n][i], 0.f) & 0xffffu);
    }
}

DI int spos(int s) { return (s & ~31) | (((s >> 2) & 3) << 3) | (((s >> 4) & 1) << 2) | (s & 3); }
DI void slab_issue(const bf16* src, int pitch, int c0, size_t tok0, int s0, int halo, bool zero_halo, u32x4 (&buf)[9], int lane) {
    const int rr = lane >> 3, cq = lane & 7, rows = 64 + halo;
#pragma unroll
    for (int i = 0; i < 9; ++i) { const int ri = 8 * i + rr; buf[i] = (u32x4){0u, 0u, 0u, 0u};
        if (ri < rows && !(zero_halo && ri < halo)) buf[i] = *(const u32x4*)(src + (tok0 + s0 - halo + ri) * (size_t)pitch + c0 + cq * 8); }
}
template <bool CONV, bool NAT, bool TRN>
DI void conv_slab(const u32x4 (&buf)[9], int c0, size_t tok0, int s0, const float* cw, const float* cb, bf16* nat, bf16* trn, LAS unsigned char* tile, int lane) {
    constexpr int HALO = CONV ? 3 : 0, ROWS = 64 + HALO, TP = 144;
    const int rr = lane >> 3, cq = lane & 7;
#pragma unroll
    for (int i = 0; i < (ROWS + 7) / 8; ++i) { const int ri = 8 * i + rr; if (ri < ROWS) *(LAS u32x4*)(tile + ri * TP + cq * 16) = buf[i]; }
    float w0 = 0.f, w1 = 0.f, w2 = 0.f, w3 = 0.f, bias = 0.f;
    if (CONV) { w0 = cw[c0 + lane]; w1 = cw[CONV_DIM + c0 + lane]; w2 = cw[2 * CONV_DIM + c0 + lane]; w3 = cw[3 * CONV_DIM + c0 + lane]; bias = cb[c0 + lane]; }
    LDS_WAIT();
    const LAS unsigned short* col = (const LAS unsigned short*)tile + lane;
    float h1 = 0.f, h2 = 0.f, h3 = 0.f;
    if (CONV) { h3 = bf2f(col[0]); h2 = bf2f(col[72]); h1 = bf2f(col[144]); }
    unsigned pk[32];
#pragma unroll
    for (int s2 = 0; s2 < 64; s2 += 2) {
        float o[2];
#pragma unroll
        for (int e = 0; e < 2; ++e) { const float xin = bf2f(col[(s2 + e + HALO) * 72]);
            if (CONV) { const float a = w3 * xin + w2 * h1 + w1 * h2 + w0 * h3 + bias; o[e] = silu_f(a); h3 = h2; h2 = h1; h1 = xin; }
            else o[e] = xin; }
        const unsigned p2 = pk2(o[0], o[1]);
        pk[spos(s2) >> 1] = p2;
        if (NAT) { nat[(tok0 + s0 + s2) * 512 + lane] = (bf16)(p2 & 0xffffu); nat[(tok0 + s0 + s2 + 1) * 512 + lane] = (bf16)(p2 >> 16); }
    }
    if (TRN) {
        LDS_WAIT();
#pragma unroll
        for (int m = 0; m < 8; ++m) *(LAS u32x4*)(tile + lane * TP + m * 16) = (u32x4){pk[4 * m], pk[4 * m + 1], pk[4 * m + 2], pk[4 * m + 3]};
        LDS_WAIT();
#pragma unroll
        for (int m = 0; m < 8; ++m) { const int cl = rr + 8 * m; *(u32x4*)(trn + (size_t)cl * 128 + s0 + cq * 8) = *(const LAS u32x4*)(tile + cl * TP + cq * 16); }
        LDS_WAIT();
    }
}
DI void p_conv(const Frame& F) {
    const bf16* XBC = WSP(bf16, WS_XBC); const bf16* QKV = WSP(bf16, WS_QKV);
    const float* cw = F.in[4]; const float* cb = F.in[5];
    bf16* XT = WSP(bf16, WS_XT); bf16* BT = WSP(bf16, WS_BT); bf16* BN = WSP(bf16, WS_BN); bf16* CN = WSP(bf16, WS_CN); bf16* VT = (bf16*)((unsigned char*)F.out + OUT_VT);
    LAS unsigned char* tile = F.lds + F.wave * 16384;
    for (int bc = blockIdx.x; bc < NCHUNK; bc += F.G) {
        const size_t tok0 = (size_t)bc * 128; const bool first = (bc % (SEQ / 128)) == 0;
#define CONV_ISSUE(task_, dst_) do { const int tk_ = (task_); \
            if (tk_ < 80) slab_issue(XBC, CONV_DIM, (tk_ >> 1) * 64, tok0, (tk_ & 1) * 64, 3, first && (tk_ & 1) == 0, dst_, F.lane); \
            else slab_issue(QKV + 1024, 1536, ((tk_ - 80) >> 1) * 64, tok0, ((tk_ - 80) & 1) * 64, 0, false, dst_, F.lane); } while (0)
        u32x4 cur[9], nxt[9];
        CONV_ISSUE(F.wave, cur);
#pragma unroll 1
        for (int task = F.wave; task < 96; task += NWAVES) {
            if (task + NWAVES < 96) CONV_ISSUE(task + NWAVES, nxt);
            if (task < 80) { const int slab = task >> 1, hf = task & 1, c0 = slab * 64, s0 = hf * 64;
                if (slab < 24) conv_slab<true, false, true>(cur, c0, tok0, s0, cw, cb, nullptr, XT + ((size_t)bc * 1536 + c0) * 128, tile, F.lane);
                else if (slab < 32) conv_slab<true, true, true>(cur, c0, tok0, s0, cw, cb, BN + (c0 - 1536), BT + ((size_t)bc * 512 + (c0 - 1536)) * 128, tile, F.lane);
                else conv_slab<true, true, false>(cur, c0, tok0, s0, cw, cb, CN + (c0 - 2048), nullptr, tile, F.lane); }
            else { const int t2 = task - 80, slab = t2 >> 1, hf = t2 & 1, c0 = slab * 64;
                conv_slab<false, false, true>(cur, c0, tok0, hf * 64, nullptr, nullptr, nullptr, VT + ((size_t)bc * 512 + c0) * 128, tile, F.lane); }
#pragma unroll
            for (int i = 0; i < 9; ++i) cur[i] = nxt[i];
        }
#undef CONV_ISSUE
        const float* DTRAW = WSP(float, WS_DTRAW); float* DTT = WSP(float, WS_DTT); float* ACT = WSP(float, WS_ACT); float* WL = WSP(float, WS_WL);
#pragma unroll 1
        for (int hh = 0; hh < 3; ++hh) { const int h = F.wave + 8 * hh; const float bias = F.in[6][h], a = -expf(F.in[7][h]);
            float dt2[2], c2[2];
#pragma unroll
            for (int j = 0; j < 2; ++j) { const float r = DTRAW[(size_t)(tok0 + 2 * F.lane + j) * 32 + h] + bias; dt2[j] = fmaxf(r, 0.f) + log1pf(expf(-fabsf(r))); }
            c2[0] = dt2[0] * a; c2[1] = c2[0] + dt2[1] * a;
            float sc = c2[1];
#pragma unroll
            for (int o = 1; o < 64; o <<= 1) { const float t = __shfl_up(sc, o); if (F.lane >= o) sc += t; }
            const float ex = sc - c2[1]; const float alast = __shfl(sc, 63);
            const float ac0 = ex + c2[0], ac1 = ex + c2[1];
            *(f32x2*)(DTT + ((size_t)bc * 24 + h) * 128 + 2 * F.lane) = (f32x2){dt2[0], dt2[1]};
            *(f32x2*)(ACT + ((size_t)bc * 24 + h) * 128 + 2 * F.lane) = (f32x2){ac0, ac1};
            *(f32x2*)(WL + ((size_t)bc * 24 + h) * 128 + spos(2 * F.lane)) = (f32x2){dt2[0] * __expf(alast - ac0), dt2[1] * __expf(alast - ac1)};
        }
    }
}

DI void p_ssd_local(const Frame& F) {
    const bf16* XT = WSP(bf16, WS_XT); const bf16* BT = WSP(bf16, WS_BT); const float* WL = WSP(float, WS_WL);
    bf16* STATE = (bf16*)((unsigned char*)F.out + OUT_STATE);
    const int lane = F.lane, fr = lane & 15, kg = lane >> 4, w = F.wave, g = w >> 1;
    for (int bc = blockIdx.x; bc < NCHUNK; bc += F.G) {
        __syncthreads();
#pragma unroll
        for (int i = 0; i < 16; ++i) { const int id = F.tid + 512 * i, row = id >> 4, c = id & 15;
            *(LAS u32x4*)(F.lds + row * 256 + ((c ^ (row & 15)) << 4)) = *(const u32x4*)(BT + ((size_t)bc * 512 + row) * 128 + c * 8); }
        __syncthreads();
#pragma unroll 1
        for (int r = 0; r < 3; ++r) {
            const int h = 3 * w + r;
            const float* wlp = WL + ((size_t)bc * 24 + h) * 128 + kg * 8;
            const bf16* xp = XT + ((size_t)bc * 1536 + h * 64 + fr) * 128 + kg * 8;
            u32x4 xr[4][4]; f32x4 wv[4][2];
#pragma unroll
            for (int k = 0; k < 4; ++k) { wv[k][0] = *(const f32x4*)(wlp + k * 32); wv[k][1] = *(const f32x4*)(wlp + k * 32 + 4);
#pragma unroll
                for (int pt = 0; pt < 4; ++pt) xr[pt][k] = *(const u32x4*)(xp + (size_t)pt * 16 * 128 + k * 32); }
            bf16x8 xs[4][4];
#pragma unroll
            for (int k = 0; k < 4; ++k)
#pragma unroll
                for (int pt = 0; pt < 4; ++pt) { float f[8]; pg8::unpack8(xr[pt][k], f);
#pragma unroll
                    for (int j = 0; j < 4; ++j) { f[j] *= wv[k][0][j]; f[4 + j] *= wv[k][1][j]; }
                    xs[pt][k] = pack8(f); }
            bf16* st = STATE + ((size_t)bc * 24 + h) * 8192;
#pragma unroll 1
            for (int nh = 0; nh < 2; ++nh) {
                f32x4 acc[4][4];
#pragma unroll
                for (int a = 0; a < 4; ++a)
#pragma unroll
                    for (int b = 0; b < 4; ++b) acc[a][b] = (f32x4){0.f, 0.f, 0.f, 0.f};
#pragma unroll
                for (int nt = 0; nt < 4; ++nt) {
#pragma unroll
                    for (int k = 0; k < 4; ++k) { const bf16x8 bfr = *(const LAS bf16x8*)(F.lds + (g * 128 + nh * 64 + nt * 16 + fr) * 256 + (((k * 4 + kg) ^ fr) << 4));
#pragma unroll
                        for (int pt = 0; pt < 4; ++pt) acc[nt][pt] = MFMA16(bfr, xs[pt][k], acc[nt][pt]); }
                    __builtin_amdgcn_sched_barrier(0); }
#pragma unroll
                for (int nt = 0; nt < 4; ++nt)
#pragma unroll
                    for (int pt = 0; pt < 4; ++pt) { u32x2 wq; wq.x = pk2(acc[nt][pt][0], acc[nt][pt][1]); wq.y = pk2(acc[nt][pt][2], acc[nt][pt][3]);
                        *(u32x2*)(st + (size_t)(pt * 16 + fr) * 128 + nh * 64 + nt * 16 + kg * 4) = wq; }
            }
        }
    }
    __syncthreads();
}

DI void p_sb_attn(const Frame& F) {
    const bf16* QKV = WSP(bf16, WS_QKV); const bf16* VT = (const bf16*)((const unsigned char*)F.out + OUT_VT); bf16* YSB = WSP(bf16, WS_RA);
    const int lane = F.lane, fr = lane & 15, kg = lane >> 4;
    const float scale = 0.08838834764831845f;
    for (int u = F.gw; u < BATCH * SB_H * (SEQ / 16); u += F.NGW) {
        const int bh = u / (SEQ / 16), strip = u % (SEQ / 16), b = bh / SB_H, h = bh % SB_H;
        const int q0 = strip * 16, t = q0 + fr; const size_t tb = (size_t)b * SEQ;
        bf16x8 qf[4];
#pragma unroll
        for (int k = 0; k < 4; ++k) qf[k] = *(const bf16x8*)(QKV + (tb + t) * 1536 + h * 128 + k * 32 + kg * 8);
        f32x4 o[8];
#pragma unroll
        for (int d = 0; d < 8; ++d) o[d] = (f32x4){0.f, 0.f, 0.f, 0.f};
        float R = 0.f;
#pragma unroll 1
        for (int kb = q0 >> 5; kb >= 0; --kb) {
            const int sb = kb * 32;
            f32x4 z[2];
#pragma unroll
            for (int st = 0; st < 2; ++st) { z[st] = (f32x4){0.f, 0.f, 0.f, 0.f};
                const bf16* kp = QKV + (tb + sb + st * 16 + fr) * 1536 + 512 + h * 128 + kg * 8;
#pragma unroll
                for (int k = 0; k < 4; ++k) z[st] = MFMA16(*(const bf16x8*)(kp + k * 32), qf[k], z[st]); }
            float lb[2][4], lk[2][4], tot[2];
#pragma unroll
            for (int st = 0; st < 2; ++st) { tot[st] = 0.f;
#pragma unroll
                for (int i = 0; i < 4; ++i) { const int s = sb + st * 16 + kg * 4 + i; const float zz = z[st][i] * scale;
                    const float l = fminf(zz, 0.f) - __logf(1.0f + __expf(-fabsf(zz)));
                    lb[st][i] = l; lk[st][i] = (s < t) ? (l - zz) : 0.f; tot[st] += lk[st][i]; } }
            float hi[2], all[2];
#pragma unroll
            for (int st = 0; st < 2; ++st) { const float t1 = __shfl_xor(tot[st], 16), t2 = __shfl_xor(tot[st], 32), t3 = __shfl_xor(tot[st], 48);
                all[st] = tot[st] + t1 + t2 + t3;
                hi[st] = (((kg ^ 1) > kg) ? t1 : 0.f) + (((kg ^ 2) > kg) ? t2 : 0.f) + (((kg ^ 3) > kg) ? t3 : 0.f); }
            float att[8];
#pragma unroll
            for (int st = 0; st < 2; ++st) { const float base = R + hi[st] + (st == 0 ? all[1] : 0.f);
                float suf = 0.f;
#pragma unroll
                for (int i = 3; i >= 0; --i) { const int s = sb + st * 16 + kg * 4 + i; att[st * 4 + i] = (s < t) ? __expf(lb[st][i] + base + suf) : 0.f; suf += lk[st][i]; } }
            R += all[0] + all[1];
            const bf16x8 pf = pack8(att);
            const int bcv = (int)((tb + sb) >> 7), sl = (sb & 127) + kg * 8;
#pragma unroll
            for (int d = 0; d < 8; ++d) { const bf16x8 vf = *(const bf16x8*)(VT + ((size_t)bcv * 512 + h * 128 + d * 16 + fr) * 128 + sl);
                o[d] = MFMA16(vf, pf, o[d]); }
            if (__all(R < -30.0f)) break;
        }
#pragma unroll
        for (int d = 0; d < 8; ++d) { u32x2 w; w.x = pk2(o[d][0], o[d][1]); w.y = pk2(o[d][2], o[d][3]);
            *(u32x2*)(YSB + (tb + t) * 2048 + 1536 + h * 128 + d * 16 + kg * 4) = w; }
    }
}

DI void p_ssd_scan(const Frame& F) {
    bf16* STATE = (bf16*)((unsigned char*)F.out + OUT_STATE); const float* ACT = WSP(float, WS_ACT);
    const int gt = blockIdx.x * 512 + F.tid, NT = F.G * 512;
    for (int e = gt; e < BATCH * SSD_HEADS * 2048; e += NT) {
        const int v4 = e & 2047, bh = e >> 11, b = bh / SSD_HEADS, h = bh % SSD_HEADS;
        f32x4 run = (f32x4){0.f, 0.f, 0.f, 0.f};
        for (int c0 = 0; c0 < 128; c0 += 8) {
            u32x2 tmp[8]; float dec[8];
#pragma unroll
            for (int j = 0; j < 8; ++j) { const size_t bc = (size_t)b * 128 + c0 + j; tmp[j] = *(const u32x2*)(STATE + (bc * 24 + h) * 8192 + v4 * 4); dec[j] = __expf(ACT[(bc * 24 + h) * 128 + 127]); }
#pragma unroll
            for (int j = 0; j < 8; ++j) { const size_t bc = (size_t)b * 128 + c0 + j;
                u32x2 w; w.x = pk2(run[0], run[1]); w.y = pk2(run[2], run[3]); *(u32x2*)(STATE + (bc * 24 + h) * 8192 + v4 * 4) = w;
                const f32x4 t4 = (f32x4){__uint_as_float(tmp[j].x << 16), __uint_as_float(tmp[j].x & 0xffff0000u), __uint_as_float(tmp[j].y << 16), __uint_as_float(tmp[j].y & 0xffff0000u)};
                run = run * dec[j] + t4; }
        }
    }
}

DI int cb_off(int t, int s) { return t * 256 + ((((s >> 2) ^ (2 * (t & 15))) << 3) | ((s & 3) << 1)); }
constexpr int SSQ_OFF = RING_BYTES + 1024, TAB_OFF = RING_BYTES + 5120;
DI void p_ssd_out(const Frame& F) {
    const bf16* XT = WSP(bf16, WS_XT); const bf16* BN = WSP(bf16, WS_BN); const bf16* CN = WSP(bf16, WS_CN); const bf16* Z = WSP(bf16, WS_Z);
    const float* DTT = WSP(float, WS_DTT); const float* ACT = WSP(float, WS_ACT); const bf16* STATE = (const bf16*)((const unsigned char*)F.out + OUT_STATE);
    bf16* YG = WSP(bf16, WS_RA); float* RSTD = WSP(float, WS_RSTD);
    const float* dskip = F.in[8];
    const int lane = F.lane, fr = lane & 15, kg = lane >> 4, w = F.wave, g = w >> 1;
    LAS unsigned char* cbl = F.lds + g * 32768;
    LAS float* tab = (LAS float*)(F.lds + TAB_OFF + w * 1024);
    LAS float* ssqp = (LAS float*)(F.lds + SSQ_OFF);
    for (int bc = blockIdx.x; bc < NCHUNK; bc += F.G) {
        const size_t tok0 = (size_t)bc * 128;
        REP(22)
#pragma unroll 1
        for (int q = 0; q < 4; ++q) { const int tt = (w & 1) + 2 * q;
            bf16x8 cf[4];
#pragma unroll
            for (int k = 0; k < 4; ++k) cf[k] = *(const bf16x8*)(CN + (tok0 + tt * 16 + fr) * 512 + g * 128 + k * 32 + kg * 8);
#pragma unroll 1
            for (int st = 0; st <= tt; ++st) { f32x4 X = (f32x4){0.f, 0.f, 0.f, 0.f}; const bf16* bp = BN + (tok0 + st * 16 + fr) * 512 + g * 128 + kg * 8;
#pragma unroll
                for (int k = 0; k < 4; ++k) X = MFMA16(*(const bf16x8*)(bp + k * 32), cf[k], X);
                u32x2 pw; pw.x = pk2(X[0], X[1]); pw.y = pk2(X[2], X[3]);
                *(LAS u32x2*)(cbl + cb_off(tt * 16 + fr, st * 16 + kg * 4)) = pw; } }
        __syncthreads();
        REP(23) {
        ssqp[w * 128 + lane] = 0.f; ssqp[w * 128 + 64 + lane] = 0.f;
#pragma unroll 1
        for (int r = 0; r < 3; ++r) {
            const int h = 3 * w + r; const float dsk = dskip[h];
            { const f32x2 d2 = *(const f32x2*)(DTT + ((size_t)bc * 24 + h) * 128 + 2 * lane), a2 = *(const f32x2*)(ACT + ((size_t)bc * 24 + h) * 128 + 2 * lane);
              *(LAS f32x2*)(tab + 2 * lane) = d2; *(LAS f32x2*)(tab + 128 + 2 * lane) = a2; }
            bf16x8 sf[4][4], xf0[4], xfA[4];
            const bf16* xbase = XT + ((size_t)bc * 1536 + h * 64) * 128;
            { unsigned so = (unsigned)(fr * 128 + kg * 8); asm volatile("" : "+v"(so));
              const bf16* sp0 = STATE + ((size_t)bc * 24 + h) * 8192;
#pragma unroll
              for (int pt = 0; pt < 4; ++pt) {
#pragma unroll
                  for (int k = 0; k < 4; ++k) sf[pt][k] = *(const bf16x8*)(sp0 + (so + (unsigned)(pt * 2048 + k * 32)));
                  xf0[pt] = *(const bf16x8*)(xbase + (so + (unsigned)(pt * 2048))); } }
            LDS_WAIT();
#define SSD_STEP(SP, XF) do { float mv[8]; \
        _Pragma("unroll") for (int half = 0; half < 2; ++half) { const int sbase = 32 * (SP) + 16 * half + kg * 4; \
            const u32x2 cbv = *(const LAS u32x2*)(cbl + cb_off(tl, sbase)); \
            const f32x4 dv = *(const LAS f32x4*)(tab + sbase), av = *(const LAS f32x4*)(tab + 128 + sbase); \
            const float cbf[4] = {__uint_as_float(cbv.x << 16), __uint_as_float(cbv.x & 0xffff0000u), __uint_as_float(cbv.y << 16), __uint_as_float(cbv.y & 0xffff0000u)}; \
            _Pragma("unroll") for (int i = 0; i < 4; ++i) { const int s_ = sbase + i; float v = 0.f; \
                if (s_ <= tl) v = cbf[i] * dv[i] * __expf(acum_t - av[i]); \
                if (s_ == tl) v += dsk; \
                mv[half * 4 + i] = v; } } \
        const bf16x8 mf = pack8(mv); \
        _Pragma("unroll") for (int pt = 0; pt < 4; ++pt) acc[pt] = MFMA16(XF[pt], mf, acc[pt]); } while (0)
#define SSD_LOADX(XF, SP) do { unsigned xo_ = (unsigned)(fr * 128 + kg * 8 + 32 * (SP)); asm volatile("" : "+v"(xo_)); \
        _Pragma("unroll") for (int pt = 0; pt < 4; ++pt) XF[pt] = *(const bf16x8*)(xbase + (xo_ + (unsigned)(pt * 2048))); } while (0)
#pragma unroll 1
            for (int tt = 0; tt < 8; ++tt) {
                int frx = fr; asm volatile("" : "+v"(frx));
                const int tl = tt * 16 + frx; const size_t tok = tok0 + tl; float ssq = 0.f;
                bf16x8 cf[4]; u32x2 zr[4];
                if (tt >= 2) SSD_LOADX(xfA, 1);
                const float acum_t = tab[128 + tl];
                f32x4 acc[4];
#pragma unroll
                for (int pt = 0; pt < 4; ++pt) acc[pt] = (f32x4){0.f, 0.f, 0.f, 0.f};
                SSD_STEP(0, xf0);
#pragma unroll
                for (int k = 0; k < 4; ++k) cf[k] = *(const bf16x8*)(CN + tok * 512 + g * 128 + k * 32 + kg * 8);
                if (tt >= 2) { SSD_STEP(1, xfA); if (tt >= 4) SSD_LOADX(xfA, 2); }
                if (tt >= 4) { SSD_STEP(2, xfA); if (tt >= 6) SSD_LOADX(xfA, 3); }
                if (tt >= 6) { SSD_STEP(3, xfA); }
#pragma unroll
                for (int pt = 0; pt < 4; ++pt) zr[pt] = *(const u32x2*)(Z + tok * 1536 + h * 64 + pt * 16 + kg * 4);
                { f32x4 ao[4];
#pragma unroll
                  for (int pt = 0; pt < 4; ++pt) ao[pt] = (f32x4){0.f, 0.f, 0.f, 0.f};
#pragma unroll
                  for (int k = 0; k < 4; ++k)
#pragma unroll
                      for (int pt = 0; pt < 4; ++pt) ao[pt] = MFMA16(sf[pt][k], cf[k], ao[pt]);
                  const float e = __expf(acum_t);
#pragma unroll
                  for (int pt = 0; pt < 4; ++pt) acc[pt] = ao[pt] * e + acc[pt]; }
#pragma unroll
                for (int pt = 0; pt < 4; ++pt) { const int col = h * 64 + pt * 16 + kg * 4;
                    const float z0 = __uint_as_float(zr[pt].x << 16), z1 = __uint_as_float(zr[pt].x & 0xffff0000u), z2 = __uint_as_float(zr[pt].y << 16), z3 = __uint_as_float(zr[pt].y & 0xffff0000u);
                    const float y0 = acc[pt][0] * silu_f(z0), y1 = acc[pt][1] * silu_f(z1), y2 = acc[pt][2] * silu_f(z2), y3 = acc[pt][3] * silu_f(z3);
                    ssq += (y0 * y0 + y1 * y1) + (y2 * y2 + y3 * y3);
                    u32x2 wv; wv.x = pk2(y0, y1); wv.y = pk2(y2, y3); *(u32x2*)(YG + tok * 2048 + col) = wv; }
                ssq += __shfl_xor(ssq, 16); ssq += __shfl_xor(ssq, 32);
                if (kg == 0) ssqp[w * 128 + tl] += ssq;
            }
            LDS_WAIT();
        }
        }
#undef SSD_STEP
#undef SSD_LOADX
        __syncthreads();
        if (F.tid < 128) { float v = 0.f;
#pragma unroll
            for (int ww = 0; ww < 8; ++ww) v += ssqp[ww * 128 + F.tid];
            RSTD[tok0 + F.tid] = 1.0f / sqrtf(v * (1.0f / 1536.0f) + EPS); }
        __syncthreads();
    }
}

DI void p_xattn(const Frame& F) {
    const bf16* Q2 = WSP(bf16, WS_Q2); const bf16* KX = WSP(bf16, WS_KX); const bf16* VXT = WSP(bf16, WS_VXT); bf16* O2 = WSP(bf16, WS_O2);
    const int lane = F.lane, fr = lane & 15, kg = lane >> 4;
    const float scale = 0.08838834764831845f;
    LAS unsigned char* kl = F.lds; LAS unsigned char* vl = F.lds + 65536;
    for (int task = blockIdx.x; task < 256; task += F.G) {
        const int bh = task >> 5, b = bh >> 2, h = bh & 3;
        __syncthreads();
#pragma unroll
        for (int i = 0; i < 8; ++i) { const int id = F.tid + 512 * i;
            { const int m = id >> 4, c = id & 15; *(LAS u32x4*)(kl + m * 256 + ((c ^ (m & 15)) << 4)) = *(const u32x4*)(KX + ((size_t)b * 256 + m) * 512 + h * 128 + c * 8); }
            { const int d = id >> 5, mc = id & 31, blk = mc >> 2, h2 = (mc >> 1) & 1, q = 2 * (mc & 1);
              const u32x4 v = *(const u32x4*)(VXT + ((size_t)h * 128 + d) * 512 + b * 256 + mc * 8);
              *(LAS u32x2*)(vl + d * 512 + (((blk * 4 + q) ^ (d & 15)) << 4) + 8 * h2) = (u32x2){v.x, v.y};
              *(LAS u32x2*)(vl + d * 512 + (((blk * 4 + q + 1) ^ (d & 15)) << 4) + 8 * h2) = (u32x2){v.z, v.w}; } }
        __syncthreads();
#pragma unroll 1
        for (int si = 0; si < 4; ++si) {
            const int strip = (task & 31) * 32 + F.wave * 4 + si;
            const size_t tok = (size_t)b * SEQ + strip * 16 + fr;
            bf16x8 qf[4];
#pragma unroll
            for (int k = 0; k < 4; ++k) qf[k] = *(const bf16x8*)(Q2 + tok * 512 + h * 128 + k * 32 + kg * 8);
            f32x4 sc[16];
#pragma unroll
            for (int mt = 0; mt < 16; ++mt) { sc[mt] = (f32x4){0.f, 0.f, 0.f, 0.f};
#pragma unroll
                for (int k = 0; k < 4; ++k) sc[mt] = MFMA16(*(const LAS bf16x8*)(kl + (mt * 16 + fr) * 256 + (((k * 4 + kg) ^ fr) << 4)), qf[k], sc[mt]);
                if (mt & 1) __builtin_amdgcn_sched_barrier(0); }
            float mx = -3.0e38f;
#pragma unroll
            for (int mt = 0; mt < 16; ++mt)
#pragma unroll
                for (int i = 0; i < 4; ++i) { sc[mt][i] *= scale; mx = fmaxf(mx, sc[mt][i]); }
            mx = fmaxf(mx, __shfl_xor(mx, 16)); mx = fmaxf(mx, __shfl_xor(mx, 32));
            float sum = 0.f;
#pragma unroll
            for (int mt = 0; mt < 16; ++mt)
#pragma unroll
                for (int i = 0; i < 4; ++i) { const float p = __expf(sc[mt][i] - mx); sc[mt][i] = p; sum += p; }
            sum += __shfl_xor(sum, 16); sum += __shfl_xor(sum, 32);
            const float inv = __builtin_amdgcn_rcpf(sum);
            f32x4 o[8];
#pragma unroll
            for (int d = 0; d < 8; ++d) o[d] = (f32x4){0.f, 0.f, 0.f, 0.f};
#pragma unroll
            for (int q = 0; q < 8; ++q) {
                float pv[8];
#pragma unroll
                for (int i = 0; i < 4; ++i) { pv[i] = sc[2 * q][i] * inv; pv[4 + i] = sc[2 * q + 1][i] * inv; }
                const bf16x8 pf = pack8(pv);
#pragma unroll
                for (int d = 0; d < 8; ++d) o[d] = MFMA16(*(const LAS bf16x8*)(vl + (d * 16 + fr) * 512 + (((q * 4 + kg) ^ fr) << 4)), pf, o[d]);
                __builtin_amdgcn_sched_barrier(0);
            }
#pragma unroll
            for (int d = 0; d < 8; ++d) { u32x2 w; w.x = pk2(o[d][0], o[d][1]); w.y = pk2(o[d][2], o[d][3]);
                *(u32x2*)(O2 + tok * 512 + h * 128 + d * 16 + kg * 4) = w; }
        }
    }
    __syncthreads();
}

DI void p_router(const Frame& F) {
    const bf16* HB = WSP(bf16, WS_RA); const bf16* WR = WSP(bf16, WS_WR_T); const float* SSQ2 = WSP(float, WS_SSQ2);
    int* TI = WSP(int, WS_TI); float* TG = WSP(float, WS_TG); unsigned* ecnt = WSP(unsigned, WS_CTL) + CW_ECNT;
    const int lane = F.lane, fr = lane & 15, kg = lane >> 4;
    LAS unsigned char* bl = F.lds; LAS float* lg = (LAS float*)(F.lds + 65536); LAS unsigned* lcnt = (LAS unsigned*)(F.lds + 65536 + 24576);
    for (int task = blockIdx.x; task < T / 128; task += F.G) {
        const size_t tok0 = (size_t)task * 128;
        f32x4 acc[3];
#pragma unroll
        for (int n = 0; n < 3; ++n) acc[n] = (f32x4){0.f, 0.f, 0.f, 0.f};
#pragma unroll 1
        for (int kc = 0; kc < 4; ++kc) {
            __syncthreads();
#pragma unroll
            for (int i = 0; i < 6; ++i) { const int id = F.tid + 512 * i, row = id >> 6, c = id & 63;
                *(LAS u32x4*)(bl + row * 1024 + ((c ^ (row & 15)) << 4)) = *(const u32x4*)(WR + (size_t)row * 2048 + kc * 512 + c * 8); }
            bf16x8 af[16];
            const bf16* ap = HB + (tok0 + F.wave * 16 + fr) * 2048 + kc * 512 + kg * 8;
#pragma unroll
            for (int ks = 0; ks < 16; ++ks) af[ks] = *(const bf16x8*)(ap + ks * 32);
            __syncthreads();
#pragma unroll
            for (int ks = 0; ks < 16; ++ks) {
#pragma unroll
                for (int n = 0; n < 3; ++n) acc[n] = MFMA16(af[ks], *(const LAS bf16x8*)(bl + (n * 16 + fr) * 1024 + (((ks * 4 + kg) ^ fr) << 4)), acc[n]);
                if ((ks & 3) == 3) __builtin_amdgcn_sched_barrier(0); }
        }
        if (F.tid < 64) lcnt[F.tid] = 0u;
#pragma unroll
        for (int i = 0; i < 4; ++i) { const int rl = F.wave * 16 + kg * 4 + i; const float rs = rstd32(SSQ2 + (tok0 + rl) * 32);
#pragma unroll
            for (int n = 0; n < 3; ++n) lg[rl * 48 + n * 16 + fr] = acc[n][i] * rs; }
        __syncthreads();
        unsigned lp1 = 0, lp2 = 0; int ex1 = 0, ex2 = 0; float w1 = 0.f, w2 = 0.f, ggate = 0.f;
        if (F.tid < 128) {
            const LAS float* l = lg + F.tid * 48;
            float gl[4] = {l[0], l[1], l[2], l[3]};
            int gs = 0; float gm = gl[0];
#pragma unroll
            for (int j = 1; j < 4; ++j) if (gl[j] > gm) { gm = gl[j]; gs = j; }
            float den = 0.f;
#pragma unroll
            for (int j = 0; j < 4; ++j) den += expf(gl[j] - gm);
            ggate = 1.0f / den;
            float el[8];
#pragma unroll
            for (int j = 0; j < 8; ++j) el[j] = l[4 + gs * 8 + j];
            int i1 = 0; float v1 = el[0];
#pragma unroll
            for (int j = 1; j < 8; ++j) if (el[j] > v1) { v1 = el[j]; i1 = j; }
            int i2 = -1; float v2 = -3.0e38f;
#pragma unroll
            for (int j = 0; j < 8; ++j) if (j != i1 && el[j] > v2) { v2 = el[j]; i2 = j; }
            const float e2 = expf(v2 - v1); w1 = 1.0f / (1.0f + e2); w2 = e2 / (1.0f + e2);
            ex1 = gs * 8 + i1; ex2 = gs * 8 + i2;
            lp1 = atomicAdd((unsigned*)&lcnt[ex1], 1u); lp2 = atomicAdd((unsigned*)&lcnt[ex2], 1u);
        }
        __syncthreads();
        if (F.tid < 32) lcnt[32 + F.tid] = __hip_atomic_fetch_add(ecnt + F.tid, lcnt[F.tid], __ATOMIC_RELAXED, __HIP_MEMORY_SCOPE_AGENT);
        __syncthreads();
        if (F.tid < 128) { const int t = (int)tok0 + F.tid;
            TI[t * 4 + 0] = ex1; TI[t * 4 + 1] = (int)(lcnt[32 + ex1] + lp1); TI[t * 4 + 2] = ex2; TI[t * 4 + 3] = (int)(lcnt[32 + ex2] + lp2);
            TG[t * 2 + 0] = w1 * ggate; TG[t * 2 + 1] = w2 * ggate; }
    }
    __syncthreads();
}
DI void p_route_b(const Frame& F) {
    const int* TI = WSP(int, WS_TI); int* TSLOT = WSP(int, WS_TSLOT); int* SLOTTOK = WSP(int, WS_SLOTTOK); int* TILEE = WSP(int, WS_TILEE);
    unsigned* ecnt = WSP(unsigned, WS_CTL) + CW_ECNT; const float* SSQ2 = WSP(float, WS_SSQ2); float* SRSTD = WSP(float, WS_SRSTD);
    LAS int* st = (LAS int*)(F.lds);
    if (F.tid < 32) st[64 + F.tid] = (int)__hip_atomic_load(ecnt + F.tid, __ATOMIC_RELAXED, __HIP_MEMORY_SCOPE_AGENT);
    __syncthreads();
    if (F.tid == 0) { int s = 0; for (int e = 0; e < 32; ++e) { st[e] = s; s += (st[64 + e] + 255) / 256 * 256; } st[32] = s; }
    __syncthreads();
    for (int t = blockIdx.x * 512 + F.tid; t < T; t += F.G * 512) {
        const int e1 = TI[t * 4 + 0], p1 = TI[t * 4 + 1], e2 = TI[t * 4 + 2], p2 = TI[t * 4 + 3];
        const int s1 = st[e1] + p1, s2 = st[e2] + p2;
        SLOTTOK[s1] = t; SLOTTOK[s2] = t; TSLOT[t * 2] = s1; TSLOT[t * 2 + 1] = s2;
        const float rs = rstd32(SSQ2 + (size_t)t * 32); SRSTD[s1] = rs; SRSTD[s2] = rs;
    }
    for (int e = blockIdx.x; e < 32; e += F.G) {
        const int a = st[e] + st[64 + e], bnd = st[e + 1];
        for (int s = a + F.tid; s < bnd; s += 512) { SLOTTOK[s] = 0; SRSTD[s] = 0.f; }
        for (int tl = st[e] / 256 + F.tid; tl < bnd / 256; tl += 512) TILEE[tl] = e;
    }
    if (blockIdx.x == 0 && F.tid == 0) TILEE[511] = st[32] / 256;
    __syncthreads();
}

DI void p_final(const Frame& F) {
    const unsigned char* Y = WSP(unsigned char, WS_Y); const bf16* HB = WSP(bf16, WS_RA); const int* TSLOT = WSP(int, WS_TSLOT); const float* TG = WSP(float, WS_TG); const float* w = F.in[25];
    for (int m = F.gw; m < T; m += F.NGW) {
        const int s1 = TSLOT[m * 2], s2 = TSLOT[m * 2 + 1]; const float g1 = TG[m * 2] * (1.0f / Y_SCALE), g2 = TG[m * 2 + 1] * (1.0f / Y_SCALE);
        const u32x2* hr = (const u32x2*)(HB + (size_t)m * 2048) + F.lane; const unsigned* y1 = (const unsigned*)(Y + (size_t)s1 * 2048) + F.lane; const unsigned* y2 = (const unsigned*)(Y + (size_t)s2 * 2048) + F.lane;
        f32x4 v[8]; float s = 0.f;
#pragma unroll
        for (int j = 0; j < 8; ++j) { const u32x2 hh = hr[64 * j]; const unsigned a = y1[64 * j], b = y2[64 * j];
            const f32x2 a01 = __builtin_amdgcn_cvt_pk_f32_fp8((int)a, false), a23 = __builtin_amdgcn_cvt_pk_f32_fp8((int)a, true), b01 = __builtin_amdgcn_cvt_pk_f32_fp8((int)b, false), b23 = __builtin_amdgcn_cvt_pk_f32_fp8((int)b, true);
            v[j].x = __uint_as_float(hh.x << 16) + g1 * a01[0] + g2 * b01[0]; v[j].y = __uint_as_float(hh.x & 0xffff0000u) + g1 * a01[1] + g2 * b01[1];
            v[j].z = __uint_as_float(hh.y << 16) + g1 * a23[0] + g2 * b23[0]; v[j].w = __uint_as_float(hh.y & 0xffff0000u) + g1 * a23[1] + g2 * b23[1];
            s += (v[j].x * v[j].x + v[j].y * v[j].y) + (v[j].z * v[j].z + v[j].w * v[j].w); }
        const float rstd = 1.0f / sqrtf(wave_sum(s) * (1.0f / 2048.0f) + EPS);
        const f32x4* wr4 = (const f32x4*)w + F.lane; f32x4* xr = (f32x4*)(F.out + (size_t)m * 2048) + F.lane;
#pragma unroll
        for (int j = 0; j < 8; ++j) { const f32x4 ww = wr4[64 * j]; xr[64 * j] = v[j] * rstd * ww; }
    }
}

constexpr int NPHASE = 20;
struct Args { const float* in[26]; float* out; unsigned char* ws; int ph_lo, ph_hi; };
__global__ void __launch_bounds__(NWAVES * 64, 2) fwd(Args args) {
    extern __shared__ __attribute__((aligned(16))) unsigned char lds[];
    Frame F;
    F.lds = (LAS unsigned char*)lds;
    F.tid = threadIdx.x; F.lane = F.tid & 63; F.wave = __builtin_amdgcn_readfirstlane(F.tid >> 6);
    F.G = gridDim.x; F.gw = blockIdx.x * NWAVES + F.wave; F.NGW = F.G * NWAVES;
#pragma unroll
    for (int i = 0; i < 26; ++i) F.in[i] = args.in[i];
    F.out = args.out; F.ws = args.ws; F.pacc = nullptr;
    volatile LAS unsigned* MISC = (volatile LAS unsigned*)(F.lds + MISC_OFF);
    for (int u = F.tid; u < (LDS_BYTES - RING_BYTES) / 4; u += NWAVES * 64) ((LAS unsigned*)(F.lds + RING_BYTES))[u] = 0u;
    __syncthreads();
    const int lo = args.ph_lo, hi = args.ph_hi;
    const bool one = (hi - lo) > 1;
    XcdBarrier bar; bar.bar = WSP(unsigned, WS_CTL) + CW_BAR; bar.x = 0; bar.st = nullptr;
    if (one) bar = xcd_barrier_post(WSP(unsigned, WS_CTL) + CW_BAR, MISC + 8);
#define IN(k) (lo <= (k) && (k) < hi)
#define SEAM(k) do { if (lo <= (k) && (k) + 1 < hi) xcd_barrier(bar); } while (0)
    LAS unsigned char* ring = F.lds;
    const int bx = blockIdx.x;
    unsigned long long pt0 = 0, pt1 = 0, psub = 0;
    if (PROBE_PHASE >= 120) F.pacc = &psub;
#define PB(k) do { if ((k) == PROBE_PHASE) pt0 = __builtin_amdgcn_s_memrealtime(); } while (0)
#define PE(k) do { if ((k) == PROBE_PHASE) pt1 = __builtin_amdgcn_s_memrealtime(); } while (0)
    const int vcu = (F.G % 8 == 0) ? (bx % 8) * (F.G / 8) + bx / 8 : bx;

    if (IN(0)) REP(0) { PB(0); p0_prologue(F); SEAM(0); PE(0); }
    if (IN(7)) REP(7) { PB(7); win_quant(F); SEAM(7); PE(7); }
    if (IN(1)) REP(1) { PB(1);
        pg8::Gemm g{(const unsigned char*)F.out + OUT_UQ, (const unsigned char*)F.out + OUT_WQI, 2048, 2048, 2048, nullptr, nullptr, 0};
        pg8::StaticOrder S; S.init(T, IN_PAD, 2048, F.G, bx); S.nt = 2048 / 128;
        pg8::EpiInProj E{WSP(bf16, WS_Z), WSP(bf16, WS_XBC), WSP(bf16, WS_QKV), WSP(unsigned char, WS_GATES), WSP(float, WS_DTRAW), WSP(float, WS_USC), WSP(float, WS_WSC)};
        pg8::gemm_phase<pg8::EpiInProj, pg8::StaticOrder, true, false, 2>(ring, g, S, E);
        p_kv_mem(F);
        SEAM(1); PE(1);
    }
    if (IN(2)) REP(2) { PB(2); p_conv(F); SEAM(2); PE(2); }
    if (IN(3)) REP(3) { PB(3); REP(20) p_ssd_local(F); REP(21) p_sb_attn(F); SEAM(3); PE(3); }
    if (IN(4)) REP(4) { PB(4); p_ssd_scan(F); SEAM(4); PE(4); }
    if (IN(5)) REP(5) { PB(5); p_ssd_out(F); SEAM(5); PE(5); }
    if (IN(6)) REP(6) { PB(6);
        pg8::Gemm g{WSP(bf16, WS_RA), WSP(bf16, WS_WCAT_T), 2048, 2048, 2048, nullptr, nullptr, 0};
        pg8::SplitOrder S; S.so.init(T, 2048, 2048, F.G, bx); S.nt0 = 1536 / 64; S.nt1 = 512 / 64;
        pg8::EpiMerge E{WSP(bf16, WS_MERGED), WSP(unsigned char, WS_GATES), WSP(float, WS_RSTD)};
        unsigned long long pepi6 = 0;
        pg8::gemm_phase<pg8::EpiMerge, pg8::SplitOrder, true, false>(ring, g, S, E, (PROBE_PHASE == 106) ? &pepi6 : nullptr);
        if (PROBE_PHASE == 106) { pt0 = 0; pt1 = pepi6; }
        SEAM(6); PE(6);
    }
    if (IN(8)) REP(8) { PB(8);
        pg8::Gemm g{WSP(bf16, WS_MERGED), WSP(bf16, WS_WMIX_T), 2048, 2048, 2048, nullptr, nullptr, 0};
        pg8::StaticOrder S; S.init(T, 2048, 2048, F.G, bx);
        pg8::EpiResStatF32 E{F.in[0], WSP(bf16, WS_RA), WSP(float, WS_SSQ1)};
        unsigned long long pepi = 0;
        pg8::gemm_phase<pg8::EpiResStatF32, pg8::StaticOrder, true, false>(ring, g, S, E, (PROBE_PHASE == 108) ? &pepi : nullptr);
        if (PROBE_PHASE == 108) { pt0 = 0; pt1 = pepi; }
        SEAM(8); PE(8);
    }
    if (IN(9)) REP(9) { PB(9); p_expert_weights(F); SEAM(9); PE(9); }
    if (IN(10)) REP(10) { PB(10);
        pg8::Gemm g{WSP(bf16, WS_RA), WSP(bf16, WS_WQ_T), 2048, 2048, 2048, nullptr, nullptr, 0};
        pg8::StaticOrder S; S.init(T, 512, 2048, F.G, bx);
        pg8::EpiBf16Rs E{WSP(bf16, WS_Q2), 512, WSP(float, WS_SSQ1)};
        pg8::gemm_phase<pg8::EpiBf16Rs, pg8::StaticOrder, true, false>(ring, g, S, E);
        SEAM(10); PE(10);
    }
    if (IN(11)) REP(11) { PB(11); p_xattn(F); SEAM(11); PE(11); }
    if (IN(12)) REP(12) { PB(12);
        pg8::Gemm g{WSP(bf16, WS_O2), WSP(bf16, WS_WO_T), 512, 512, 512, nullptr, nullptr, 0};
        pg8::StaticOrder S; S.init(T, 2048, 512, F.G, bx);
        pg8::EpiResStatBf E{WSP(bf16, WS_RA), WSP(float, WS_SSQ2), WSP(unsigned char, WS_HB8)};
        pg8::gemm_phase<pg8::EpiResStatBf, pg8::StaticOrder, true, false>(ring, g, S, E);
        SEAM(12); PE(12);
    }
    if (IN(14)) REP(14) { PB(14); p_router(F); SEAM(14); PE(14); }
    if (IN(16)) REP(16) { PB(16); p_route_b(F); SEAM(16); PE(16); }
    if (IN(17)) REP(17) { PB(17);
        const int* TILEE = WSP(int, WS_TILEE);
        pg8::Gemm g{WSP(unsigned char, WS_HB8), WSP(unsigned char, WS_WGU_T), 2048, 2048, 2048, WSP(int, WS_SLOTTOK), TILEE, (size_t)1024 * 2048};
        pg8::ListOrder S; S.init(TILEE[511], 4, F.G, bx, 2048 / 128);
        pg8::EpiSwiGLU E{WSP(unsigned char, WS_HID), WSP(float, WS_SRSTD), 1.0f / WGU_SCALE, HID_SCALE};
        pg8::gemm_phase<pg8::EpiSwiGLU, pg8::ListOrder, true, true, 1>(ring, g, S, E);
        SEAM(17); PE(17);
    }
    if (IN(18)) REP(18) { PB(18);
        const int* TILEE = WSP(int, WS_TILEE);
        pg8::Gemm g{WSP(unsigned char, WS_HID), WSP(unsigned char, WS_WD_T), 512, 512, 512, nullptr, TILEE, (size_t)2048 * 512};
        pg8::ListOrder S; S.init(TILEE[511], 8, F.G, bx, 512 / 128);
        pg8::EpiF8 E{WSP(unsigned char, WS_Y), 2048, Y_SCALE / (HID_SCALE * WD_SCALE)};
        pg8::gemm_phase<pg8::EpiF8, pg8::ListOrder, true, false, 1>(ring, g, S, E);
        SEAM(18); PE(18);
    }
    if (IN(19)) REP(19) { PB(19); p_final(F); PE(19); }
    if (PROBE_PHASE >= 120) { pt0 = 0; pt1 = psub; }
    if (PROBE_PHASE >= 0 && blockIdx.x == 0 && threadIdx.x == 0) { const unsigned long long te = __builtin_amdgcn_s_memrealtime(), d = (pt1 - pt0) * PROBE_MULT;
        while (__builtin_amdgcn_s_memrealtime() - te < d) __builtin_amdgcn_s_sleep(8); }
#undef IN
#undef SEAM
}

extern "C" void kernel_launch(void* const* d_in, const int* in_sizes, int n_in, void* d_out, int out_size, void* d_ws, size_t ws_size, hipStream_t stream) {
    static int grid = 0;
    if (grid == 0) {
        if (n_in != 26 || out_size != T * D || ws_size < WS_END) { fprintf(stderr, "kernel_launch: unexpected sizes n_in %d out %d ws %zu\n", n_in, out_size, ws_size); grid = -1; return; }
        int dev = 0, cus = 0, per_cu = 0;
        if (hipGetDevice(&dev) != hipSuccess || hipDeviceGetAttribute(&cus, hipDeviceAttributeMultiprocessorCount, dev) != hipSuccess) { grid = -1; return; }
        if (hipFuncSetAttribute((const void*)fwd, hipFuncAttributeMaxDynamicSharedMemorySize, LDS_BYTES) != hipSuccess) { fprintf(stderr, "kernel_launch: hipFuncSetAttribute failed\n"); grid = -1; return; }
        if (hipOccupancyMaxActiveBlocksPerMultiprocessor(&per_cu, (const void*)fwd, NWAVES * 64, LDS_BYTES) != hipSuccess || per_cu < 1) fprintf(stderr, "kernel_launch: occupancy query reports %d\n", per_cu);
        (void)hipGetLastError();
        grid = cus;
    }
    if (grid < 0) return;
    if (hipMemsetAsync((char*)d_ws + WS_CTL, 0, CTL_ZERO_BYTES, stream) != hipSuccess) return;
    Args a{};
    for (int i = 0; i < 26; ++i) a.in[i] = (const float*)d_in[i];
    a.out = (float*)d_out; a.ws = (unsigned char*)d_ws;
    if (MK_N_LAUNCHES == 1) {
        a.ph_lo = 0; a.ph_hi = NPHASE;
        hipLaunchKernelGGL(fwd, dim3(grid), dim3(NWAVES * 64), LDS_BYTES, stream, a);
    } else {
        for (int p = 0; p < NPHASE; ++p) { a.ph_lo = p; a.ph_hi = p + 1; hipLaunchKernelGGL(fwd, dim3(grid), dim3(NWAVES * 64), LDS_BYTES, stream, a); }
    }
}
```

```cpp
#include <hip/hip_runtime.h>
#include <cstdio>
#include <cstdint>

#define DI __device__ __forceinline__
#define LAS __attribute__((address_space(3)))
#define GAS __attribute__((address_space(1)))
typedef unsigned short bf16;
typedef short bf16x8 __attribute__((ext_vector_type(8)));
typedef short s16x4 __attribute__((ext_vector_type(4)));
typedef float f32x4 __attribute__((ext_vector_type(4)));
typedef float f32x2 __attribute__((ext_vector_type(2)));
typedef unsigned u32x4 __attribute__((ext_vector_type(4)));
typedef unsigned u32x2 __attribute__((ext_vector_type(2)));
typedef __bf16 bf16x2_t __attribute__((ext_vector_type(2)));

#ifndef DUP_MASK
#define DUP_MASK 0
#endif
#define REP(k) for (int rep_ = 0; rep_ < 1 + 2 * ((DUP_MASK >> (k)) & 1); ++rep_)
#ifndef PROBE_PHASE
#define PROBE_PHASE -1
#endif
#define PROBE_MULT 10
#define WGM_P1 4
#define WGM_P6 4
#define WGM_P8 4
#define WGM_P10 4
#define WGM_P12 4
#define WGM_P17 8
#define WGM_P18 4
#ifndef MK_N_LAUNCHES
#define MK_N_LAUNCHES 1
#endif

constexpr int D = 2048, BATCH = 2, SEQ = 16384, T = BATCH * SEQ;
constexpr int SSD_INNER = 1536, SSD_HEADS = 24, SSD_P = 64, SSD_N = 128, SSD_G = 4, SSD_L = 128, SSD_BC = 512, CONV_DIM = 2560;
constexpr int NCHUNK = T / SSD_L;
constexpr int SB_W = 512, SB_H = 4, SB_D = 128;
constexpr int IN_COLS = 9752, IN_PAD = 9984;
constexpr int XA_W = 512, MEM = 256;
constexpr int NEXP = 32, EFF = 512;
constexpr int NSLOT = 2 * T + NEXP * 256;
constexpr float EPS = 1e-6f;
constexpr float WGU_SCALE = 64.f, HID_SCALE = 16.f, WD_SCALE = 32.f, Y_SCALE = 16.f;

constexpr size_t MiB = 1u << 20;
constexpr size_t WS_CTL = 0, CTL_ZERO_BYTES = 1 * MiB;
constexpr size_t WS_WCAT_T = 1 * MiB;
constexpr size_t WS_WMIX_T = 9 * MiB;
constexpr size_t WS_WQ_T = 17 * MiB;
constexpr size_t WS_WK_T = 19 * MiB;
constexpr size_t WS_WV_T = 21 * MiB;
constexpr size_t WS_WO_T = 23 * MiB;
constexpr size_t WS_WR_T = 25 * MiB;
constexpr size_t WS_MEMN = 26 * MiB;
constexpr size_t WS_KX = 28 * MiB;
constexpr size_t WS_VXT = 28 * MiB + 512 * 1024;
constexpr size_t WS_DTRAW = 29 * MiB;
constexpr size_t WS_DTT = 33 * MiB;
constexpr size_t WS_ACT = 36 * MiB;
constexpr size_t WS_RSTD = 39 * MiB;
constexpr size_t WS_SRSTD = 53 * MiB;
constexpr size_t WS_USC = 62 * MiB;
constexpr size_t WS_WMS = 62 * MiB + 512 * 1024;
constexpr size_t WS_MSC = 63 * MiB;
constexpr size_t WS_MQ = 488 * MiB;
constexpr size_t WS_WSC = 62 * MiB + 256 * 1024;
constexpr size_t WS_SSQ1 = 54 * MiB, WS_SSQ2 = 58 * MiB;
constexpr size_t WS_WL = 50 * MiB;
constexpr size_t WS_LOGITS = 40 * MiB;
constexpr size_t WS_TI = 48 * MiB;
constexpr size_t WS_TG = 48 * MiB + 512 * 1024;
constexpr size_t WS_TSLOT = 48 * MiB + 768 * 1024;
constexpr size_t WS_SLOTTOK = 49 * MiB;
constexpr size_t WS_TILEE = 49 * MiB + 512 * 1024;
constexpr size_t WS_WIN_T = 64 * MiB;
constexpr size_t WS_BT = 64 * MiB;
constexpr size_t WS_Q2 = 64 * MiB;
constexpr size_t WS_RA = 104 * MiB;
constexpr size_t WS_Z = 232 * MiB;
constexpr size_t WS_HID = 232 * MiB;
constexpr size_t WS_XBC = 328 * MiB;
constexpr size_t WS_MERGED = 328 * MiB;
constexpr size_t WS_HB8 = 328 * MiB;
constexpr size_t WS_QKV = 488 * MiB;
constexpr size_t WS_WGU_T = 488 * MiB;
constexpr size_t WS_GATES = 584 * MiB;
constexpr size_t WS_WD_T = 616 * MiB;
constexpr size_t WS_Y = 680 * MiB;
constexpr size_t WS_BN = 840 * MiB;
constexpr size_t WS_CN = 872 * MiB;
constexpr size_t WS_XT = 904 * MiB;
constexpr size_t WS_O2 = 968 * MiB;
constexpr size_t WS_END = 1000 * MiB;
constexpr size_t OUT_STATE = 96 * MiB, OUT_VT = 192 * MiB;
constexpr size_t OUT_UQ = 0, OUT_WQI = 64 * MiB;
constexpr size_t OUT_WGU = 0, OUT_WD = 64 * MiB;
constexpr int CW_BAR = 4096;
constexpr int CW_ECNT = 16384;
constexpr int CW_CMAXM = 49152;
constexpr int CW_CMAX = 32768;

constexpr int RING_BYTES = 131072;
constexpr int MISC_OFF = RING_BYTES + 320;
constexpr int LDS_BYTES = 147456;
constexpr int NWAVES = 8;

DI float bf2f(bf16 v) { return __uint_as_float(((unsigned)v) << 16); }
DI unsigned pk2(float lo, float hi) { f32x2 v = {lo, hi}; bf16x2_t b = __builtin_convertvector(v, bf16x2_t); return __builtin_bit_cast(unsigned, b); }
DI bf16x8 pack8(const float (&v)[8]) { u32x4 p; p.x = pk2(v[0], v[1]); p.y = pk2(v[2], v[3]); p.z = pk2(v[4], v[5]); p.w = pk2(v[6], v[7]); return __builtin_bit_cast(bf16x8, p); }
DI float wave_sum(float v) {
#pragma unroll
    for (int o = 1; o < 64; o <<= 1) v += __shfl_xor(v, o);
    return v;
}
DI float silu_f(float x) { return x * __builtin_amdgcn_rcpf(1.0f + __expf(-x)); }
DI float sigmoid_f(float x) { return __builtin_amdgcn_rcpf(1.0f + __expf(-x)); }
DI unsigned pk4_fp8(float a, float b, float c, float d) { int w = 0;
    w = __builtin_amdgcn_cvt_pk_fp8_f32(__builtin_amdgcn_fmed3f(a, -448.f, 448.f), __builtin_amdgcn_fmed3f(b, -448.f, 448.f), w, false);
    w = __builtin_amdgcn_cvt_pk_fp8_f32(__builtin_amdgcn_fmed3f(c, -448.f, 448.f), __builtin_amdgcn_fmed3f(d, -448.f, 448.f), w, true); return (unsigned)w; }
DI unsigned pk4_i8(float a, float b, float c, float d) { const int ia = (int)__builtin_rintf(a), ib = (int)__builtin_rintf(b), ic = (int)__builtin_rintf(c), id = (int)__builtin_rintf(d);
    return (unsigned)(ia & 255) | ((unsigned)(ib & 255) << 8) | ((unsigned)(ic & 255) << 16) | ((unsigned)(id & 255) << 24); }
DI float rstd32(const float* p) { f32x4 a = *(const f32x4*)p;
#pragma unroll
    for (int i = 1; i < 8; ++i) a += *(const f32x4*)(p + 4 * i);
    return 1.0f / sqrtf(((a[0] + a[1]) + (a[2] + a[3])) * (1.0f / 2048.0f) + EPS); }
#define SUBPROBE_BEGIN(id) unsigned long long sp_t0_##id = 0; if (PROBE_PHASE == (id)) sp_t0_##id = __builtin_amdgcn_s_memrealtime()
#define SUBPROBE_END(id) do { if (PROBE_PHASE == (id) && F.pacc) *F.pacc += __builtin_amdgcn_s_memrealtime() - sp_t0_##id; } while (0)
#define MFMA16(a, b, c) __builtin_amdgcn_mfma_f32_16x16x32_bf16((a), (b), (c), 0, 0, 0)
#define LDS_WAIT() asm volatile("s_waitcnt lgkmcnt(0)" ::: "memory")
#define VM_WAIT() asm volatile("s_waitcnt vmcnt(0)" ::: "memory")

namespace pg8 {
#define PG8_LAS __attribute__((address_space(3)))
constexpr int BM = 256, BK = 64, HALF = 128, HTB = HALF * BK * 2, STAGE_BYTES = 8 * HTB, NXCD = 8;
__host__ __device__ __forceinline__ int lds_byte(int r, int c) { const int st = (r >> 4) * 2 + (c >> 5), rr = r & 15, cc = c & 31, ob = rr * 64 + cc * 2; return st * 1024 + (ob ^ (((ob >> 9) & 1) << 5)); }
__host__ __device__ __forceinline__ void stage_rc(int b, int& R, int& C) { const int st = b / 1024, sb = b % 1024, swz = sb ^ (((sb >> 9) & 1) << 5); R = (st >> 1) * 16 + swz / 64; C = (st & 1) * 32 + (swz % 64) / 2; }
__host__ __device__ __forceinline__ int perm32(int rho) { const int n = rho >> 4, i = rho & 15; return 8 * (i >> 2) + 4 * n + (i & 3); }

struct Unit { int pm, pn, k0, nt, fin; };
struct Gemm { const void* A; const void* Bt; int K, lda, ldb; const int* arow; const int* tile_e; size_t b_estride; };

struct StaticOrder {
    int nM, nN, nwg, G, c, nt, WGM;
    __device__ void init(int M, int N, int K, int G_, int c_, int wgm = 4) { nM = M / BM; nN = N / BM; nwg = nM * nN; G = G_; c = c_; nt = K / BK; WGM = wgm; }
    __device__ bool next(int i, Unit& u) const {
        u.k0 = 0; u.nt = nt; u.fin = 1;
        const long L = (long)i * G + c; if (L >= nwg) return false;
        int wgid = (int)L; { const int q = nwg / NXCD, r = nwg % NXCD, xcd = wgid % NXCD, off = wgid / NXCD; wgid = (xcd < r ? xcd * (q + 1) : r * (q + 1) + (xcd - r) * q) + off; }
        const int nig = WGM * nN, gid = wgid / nig, fm = gid * WGM, gsz = (nM - fm) < WGM ? (nM - fm) : WGM;
        u.pm = fm + ((wgid % nig) % gsz); u.pn = (wgid % nig) / gsz; return true;
    }
};
struct ListOrder {
    int ntile, nN, G, c, nt, WGM;
    __device__ void init(int ntile_, int nN_, int G_, int c_, int nt_, int wgm = 0) { ntile = ntile_; nN = nN_; G = G_; c = c_; nt = nt_; WGM = wgm; }
    __device__ bool next(int i, Unit& u) const { u.k0 = 0; u.nt = nt; u.fin = 1; const int nwg = ntile * nN; const int L = i * G + c; if (L >= nwg) return false;
        if (WGM == 0) { u.pm = L / nN; u.pn = L % nN; return true; }
        int wgid = L; { const int q = nwg / NXCD, r = nwg % NXCD, xcd = wgid % NXCD, off = wgid / NXCD; wgid = (xcd < r ? xcd * (q + 1) : r * (q + 1) + (xcd - r) * q) + off; }
        const int nig = WGM * nN, gid = wgid / nig, fm = gid * WGM, gsz = (ntile - fm) < WGM ? (ntile - fm) : WGM;
        u.pm = fm + ((wgid % nig) % gsz); u.pn = (wgid % nig) / gsz; return true; }
};
struct GatesOrder {
    int c, nt, G;
    __device__ bool next(int i, Unit& u) const { u.k0 = 0; u.nt = nt; u.fin = 1; int L;
        if (G == 256) { if (c < 128) { if (i >= 7) return false; L = c * 7 + i; } else { if (i >= 9) return false; L = 896 + (c - 128) * 9 + i; } }
        else { L = i * G + c; if (L >= 2048) return false; }
        u.pm = L >> 4; u.pn = L & 15; return true; }
};
struct SplitOrder {
    StaticOrder so; int nt0, nt1;
    __device__ bool next(int i, Unit& u) const { if (!so.next(i >> 1, u)) return false; if (i & 1) { u.k0 = nt0 * BK; u.nt = nt1; u.fin = 1; } else { u.k0 = 0; u.nt = nt0; u.fin = 0; } return true; }
};

template <class S> struct RangeOrder { S s; int i0, i1; __device__ bool next(int i, Unit& u) const { return (i0 + i < i1) && s.next(i0 + i, u); } };

typedef int v4i_t __attribute__((ext_vector_type(4)));
typedef int v8i_t __attribute__((ext_vector_type(8)));
template <class Epi, class Sched, bool ALIGN_EPI, bool GATHER, int MODE = 0>
__device__ __forceinline__ void gemm_phase(PG8_LAS unsigned char* lds, const Gemm g, const Sched& S, const Epi& E, unsigned long long* pacc = nullptr) {
    const int tid = threadIdx.x, wid = __builtin_amdgcn_readfirstlane(tid >> 6), lane = tid & 63, wr = wid >> 2, wc = wid & 3, fr = lane & 15, fq = lane >> 4;
    constexpr bool FP8 = (MODE == 1), I8 = (MODE == 2);
    constexpr int ESZ = MODE ? 1 : 2;
    unsigned voffB[2]; int RA[2], CA[2];
#pragma unroll
    for (int i = 0; i < 2; ++i) { int R, C; stage_rc(tid * 16 + i * 8192, R, C); const int Rb = (R & ~31) + perm32(R & 31);
        RA[i] = R; CA[i] = C; voffB[i] = (unsigned)(Rb * g.ldb * ESZ + C * 2); }
    const size_t kstep = (size_t)(BK * 2);
    const size_t hstepB = (size_t)HALF * g.ldb * ESZ;
    const size_t tstepB = 2 * hstepB;
    const unsigned ldsw = (unsigned)wid * 1024u;
    const int aoff = lds_byte(wr * 64 + fr, fq * 8), boff = lds_byte(wc * 32 + fr, fq * 8);
    const char* Ab = (const char*)g.A;
#define PG8_SA(b, h) (((b) * 2 + (h)) * HTB)
#define PG8_SB(b, h) ((4 + (b) * 2 + (h)) * HTB)
#define PG8_STAGE(bufoff, gbase, voff) do { _Pragma("unroll") for (int _i = 0; _i < 2; ++_i) \
        __builtin_amdgcn_global_load_lds((const unsigned*)((const char*)(gbase) + (voff)[_i]), (PG8_LAS unsigned*)(lds + (bufoff) + ldsw + _i * 8192), 16, 0, 0); } while (0)
#define PG8_STAGEA(bufoff, kb, o0, o1) do { \
        __builtin_amdgcn_global_load_lds((const unsigned*)(Ab + (kb) + (o0)), (PG8_LAS unsigned*)(lds + (bufoff) + ldsw), 16, 0, 0); \
        __builtin_amdgcn_global_load_lds((const unsigned*)(Ab + (kb) + (o1)), (PG8_LAS unsigned*)(lds + (bufoff) + ldsw + 8192), 16, 0, 0); } while (0)
#define PG8_LDA(dst, b, h) do { _Pragma("unroll") for (int m = 0; m < 4; ++m) dst[m] = __builtin_shufflevector(*(const PG8_LAS v4i_t*)(lds + PG8_SA(b, h) + aoff + m * 2048), *(const PG8_LAS v4i_t*)(lds + PG8_SA(b, h) + aoff + m * 2048 + 1024), 0, 1, 2, 3, 4, 5, 6, 7); } while (0)
#define PG8_LDB(dst, b, h) do { _Pragma("unroll") for (int n = 0; n < 2; ++n) dst[n] = __builtin_shufflevector(*(const PG8_LAS v4i_t*)(lds + PG8_SB(b, h) + boff + n * 2048), *(const PG8_LAS v4i_t*)(lds + PG8_SB(b, h) + boff + n * 2048 + 1024), 0, 1, 2, 3, 4, 5, 6, 7); } while (0)
#define PG8_LO(v) __builtin_bit_cast(bf16x8, __builtin_shufflevector((v), (v), 0, 1, 2, 3))
#define PG8_HI(v) __builtin_bit_cast(bf16x8, __builtin_shufflevector((v), (v), 4, 5, 6, 7))
#define PG8_MMA(ai, bj, At, Bt) do { __builtin_amdgcn_s_setprio(1); _Pragma("unroll") for (int m = 0; m < 4; ++m) _Pragma("unroll") for (int n = 0; n < 2; ++n) { \
        if constexpr (FP8) asm volatile("v_mfma_scale_f32_16x16x128_f8f6f4 %0, %1, %2, %0, %3, %3 op_sel_hi:[0,0,0]" : "+v"(acc[ai][bj][m][n]) : "v"(Bt[n]), "v"(At[m]), "v"(one_scale)); \
        else if constexpr (I8) { v4i_t c_ = __builtin_bit_cast(v4i_t, acc[ai][bj][m][n]); \
               c_ = __builtin_amdgcn_mfma_i32_16x16x64_i8(__builtin_shufflevector(Bt[n], Bt[n], 0, 1, 2, 3), __builtin_shufflevector(At[m], At[m], 0, 1, 2, 3), c_, 0, 0, 0); \
               c_ = __builtin_amdgcn_mfma_i32_16x16x64_i8(__builtin_shufflevector(Bt[n], Bt[n], 4, 5, 6, 7), __builtin_shufflevector(At[m], At[m], 4, 5, 6, 7), c_, 0, 0, 0); \
               acc[ai][bj][m][n] = __builtin_bit_cast(f32x4, c_); } \
        else { acc[ai][bj][m][n] = __builtin_amdgcn_mfma_f32_16x16x32_bf16(PG8_LO(Bt[n]), PG8_LO(At[m]), acc[ai][bj][m][n], 0, 0, 0); \
               acc[ai][bj][m][n] = __builtin_amdgcn_mfma_f32_16x16x32_bf16(PG8_HI(Bt[n]), PG8_HI(At[m]), acc[ai][bj][m][n], 0, 0, 0); } } \
        __builtin_amdgcn_s_setprio(0); } while (0)
#define PG8_WAIT_V(n) asm volatile("s_waitcnt vmcnt(" #n ")" ::: "memory")
#define PG8_WAIT_L(n) asm volatile("s_waitcnt lgkmcnt(" #n ")" ::: "memory")
#define PG8_BAR __builtin_amdgcn_s_barrier()
#define PG8_SCHED __builtin_amdgcn_sched_barrier(0)
#define PG8_SETA(o, u) do { _Pragma("unroll") for (int _h = 0; _h < 2; ++_h) _Pragma("unroll") for (int _i = 0; _i < 2; ++_i) { \
        int _row = (u).pm * BM + _h * HALF + RA[_i]; if (GATHER) _row = g.arow[_row]; (o)[_h][_i] = (unsigned)((_row * g.lda + (u).k0) * ESZ + CA[_i] * 2); } } while (0)
    Unit cur, nxt; int ui = 0;
    if (!S.next(0, cur)) return;
    f32x4 acc[2][2][4][2];
#pragma unroll
    for (int a = 0; a < 2; ++a)
#pragma unroll
        for (int b = 0; b < 2; ++b)
#pragma unroll
            for (int m = 0; m < 4; ++m)
#pragma unroll
                for (int n = 0; n < 2; ++n) acc[a][b][m][n] = (f32x4){0.f, 0.f, 0.f, 0.f};
    v8i_t At[4], B0[2], B1[2];
    const int one_scale = 0x7F7F7F7F;
    unsigned oc[2][2], on[2][2];
    PG8_SETA(oc, cur);
    const char* cB = (const char*)g.Bt + (g.tile_e ? (size_t)g.tile_e[cur.pm] * g.b_estride * ESZ : (size_t)0) + (size_t)cur.pn * tstepB + (size_t)cur.k0 * ESZ;
    PG8_STAGE(PG8_SB(0, 0), cB, voffB); PG8_STAGE(PG8_SB(0, 1), cB + hstepB, voffB); PG8_STAGEA(PG8_SA(0, 0), 0, oc[0][0], oc[0][1]); PG8_STAGEA(PG8_SA(0, 1), 0, oc[1][0], oc[1][1]);
    if (wr == 1) PG8_BAR;
    PG8_WAIT_V(2); PG8_BAR;
    PG8_STAGE(PG8_SB(1, 0), cB + kstep, voffB); PG8_STAGEA(PG8_SA(1, 0), kstep, oc[0][0], oc[0][1]); PG8_STAGE(PG8_SB(1, 1), cB + hstepB + kstep, voffB);
    PG8_WAIT_V(6); PG8_BAR;
    for (;;) {
        const bool has_next = S.next(ui + 1, nxt);
        const char* nB = cB;
        if (has_next) { nB = (const char*)g.Bt + (g.tile_e ? (size_t)g.tile_e[nxt.pm] * g.b_estride * ESZ : (size_t)0) + (size_t)nxt.pn * tstepB + (size_t)nxt.k0 * ESZ; }
        int nt = cur.nt; asm volatile("" : "+s"(nt));
#pragma unroll
        for (int _h = 0; _h < 2; ++_h)
#pragma unroll
            for (int _i = 0; _i < 2; ++_i) on[_h][_i] = oc[_h][_i];
        for (int t = 0; t < nt; t += 2) {
            const bool last = (t == nt - 2);
            if (last && has_next) { PG8_SETA(on, nxt); }
            const size_t k1 = (size_t)(t + 1) * kstep;
            const size_t k2 = last ? (size_t)0 : (size_t)(t + 2) * kstep, k3 = k2 + kstep;
            const char* b2 = last ? nB : cB + (size_t)(t + 2) * kstep; const char* b3 = b2 + kstep;
            const unsigned s00 = last ? on[0][0] : oc[0][0], s01 = last ? on[0][1] : oc[0][1], s10 = last ? on[1][0] : oc[1][0], s11 = last ? on[1][1] : oc[1][1];
            PG8_LDB(B0, 0, 0); PG8_LDB(B1, 0, 1); PG8_SCHED; PG8_LDA(At, 0, 0); PG8_STAGEA(PG8_SA(1, 1), k1, oc[1][0], oc[1][1]);
            PG8_WAIT_V(8); PG8_WAIT_L(0); PG8_BAR; PG8_MMA(0, 0, At, B0); PG8_MMA(0, 1, At, B1); PG8_BAR; PG8_SCHED;
            PG8_LDA(At, 0, 1); PG8_STAGE(PG8_SB(0, 0), b2, voffB); PG8_STAGE(PG8_SB(0, 1), b2 + hstepB, voffB); PG8_STAGEA(PG8_SA(0, 0), k2, s00, s01);
            PG8_WAIT_V(8); PG8_WAIT_L(0); PG8_BAR; PG8_MMA(1, 0, At, B0); PG8_MMA(1, 1, At, B1); PG8_BAR; PG8_SCHED;
            PG8_LDB(B0, 1, 0); PG8_LDB(B1, 1, 1); PG8_SCHED; PG8_LDA(At, 1, 0); PG8_STAGEA(PG8_SA(0, 1), k2, s10, s11);
            PG8_WAIT_V(8); PG8_WAIT_L(0); PG8_BAR; PG8_MMA(0, 0, At, B0); PG8_MMA(0, 1, At, B1); PG8_BAR; PG8_SCHED;
            PG8_LDA(At, 1, 1); PG8_STAGE(PG8_SB(1, 0), b3, voffB); PG8_STAGE(PG8_SB(1, 1), b3 + hstepB, voffB); PG8_STAGEA(PG8_SA(1, 0), k3, s00, s01);
            PG8_WAIT_V(8); PG8_WAIT_L(0); PG8_BAR; PG8_MMA(1, 0, At, B0); PG8_MMA(1, 1, At, B1); PG8_BAR; PG8_SCHED;
        }
        if constexpr (FP8) asm volatile("s_nop 15\n\ts_nop 15" ::: "memory");
        unsigned long long pt_e0 = 0; if (pacc) pt_e0 = __builtin_amdgcn_s_memrealtime();
        if constexpr (ALIGN_EPI) { if (wr == 0) PG8_BAR; }
        E(acc, cur, wr, wc, fr, fq);
        if (pacc) *pacc += __builtin_amdgcn_s_memrealtime() - pt_e0;
        if (!has_next) break;
        if (cur.fin) {
#pragma unroll
        for (int a = 0; a < 2; ++a)
#pragma unroll
            for (int b = 0; b < 2; ++b)
#pragma unroll
                for (int m = 0; m < 4; ++m)
#pragma unroll
                    for (int n = 0; n < 2; ++n) { acc[a][b][m][n] = (f32x4){0.f, 0.f, 0.f, 0.f}; }
        }
        cur = nxt; cB = nB; ++ui;
#pragma unroll
        for (int _h = 0; _h < 2; ++_h)
#pragma unroll
            for (int _i = 0; _i < 2; ++_i) oc[_h][_i] = on[_h][_i];
        if constexpr (ALIGN_EPI) { if (wr == 1) PG8_BAR; }
    }
    PG8_WAIT_V(0);
    if constexpr (!ALIGN_EPI) { if (wr == 0) PG8_BAR; }
    PG8_BAR;
#undef PG8_SA
#undef PG8_SB
#undef PG8_STAGE
#undef PG8_STAGEA
#undef PG8_LDA
#undef PG8_LDB
#undef PG8_MMA
#undef PG8_LO
#undef PG8_HI
#undef PG8_WAIT_V
#undef PG8_WAIT_L
#undef PG8_BAR
#undef PG8_SCHED
#undef PG8_SETA
}

#define EPI_ROWS(...) _Pragma("unroll") for (int ai = 0; ai < 2; ++ai) _Pragma("unroll") for (int m = 0; m < 4; ++m) { const int row = u.pm * BM + ai * HALF + wr * 64 + m * 16 + fr; \
        _Pragma("unroll") for (int bj = 0; bj < 2; ++bj) { const int col = u.pn * BM + bj * HALF + wc * 32 + 8 * fq; const f32x4 v0 = acc[ai][bj][m][0], v1 = acc[ai][bj][m][1]; __VA_ARGS__ } }
DI void unpack8_u8(u32x2 w, float (&f)[8]) {
#pragma unroll
    for (int j = 0; j < 4; ++j) { f[j] = (float)((w.x >> (8 * j)) & 255u); f[4 + j] = (float)((w.y >> (8 * j)) & 255u); } }
DI u32x4 pack8v(f32x4 v0, f32x4 v1) { u32x4 w; w.x = pk2(v0[0], v0[1]); w.y = pk2(v0[2], v0[3]); w.z = pk2(v1[0], v1[1]); w.w = pk2(v1[2], v1[3]); return w; }
DI void unpack8(u32x4 w, float (&f)[8]) { f[0] = __uint_as_float(w.x << 16); f[1] = __uint_as_float(w.x & 0xffff0000u); f[2] = __uint_as_float(w.y << 16); f[3] = __uint_as_float(w.y & 0xffff0000u);
    f[4] = __uint_as_float(w.z << 16); f[5] = __uint_as_float(w.z & 0xffff0000u); f[6] = __uint_as_float(w.w << 16); f[7] = __uint_as_float(w.w & 0xffff0000u); }

struct EpiF8 {
    unsigned char* O; int ldc; float sc;
    DI void operator()(const f32x4 (&acc)[2][2][4][2], const Unit& u, int wr, int wc, int fr, int fq) const {
        EPI_ROWS({ u32x2 w8; w8.x = pk4_fp8(v0[0] * sc, v0[1] * sc, v0[2] * sc, v0[3] * sc); w8.y = pk4_fp8(v1[0] * sc, v1[1] * sc, v1[2] * sc, v1[3] * sc); *(u32x2*)(O + (size_t)row * ldc + col) = w8; })
    }
};
struct EpiBf16 {
    bf16* O; int ldc; float sc;
    DI void operator()(const f32x4 (&acc)[2][2][4][2], const Unit& u, int wr, int wc, int fr, int fq) const {
        EPI_ROWS({ *(u32x4*)(O + (size_t)row * ldc + col) = pack8v(v0 * sc, v1 * sc); })
    }
};
struct EpiInProj {
    bf16 *Z, *XBC, *QKV; unsigned char* GATES; float* DTRAW; const float* usc; const float* wsc; const LAS unsigned char* sgt;
    DI void operator()(const f32x4 (&acc)[2][2][4][2], const Unit& u, int wr, int wc, int fr, int fq) const {
        const int pn = u.pn; const bool gate = (pn >= 22 && pn < 38);
        f32x4 cs[2][2];
#pragma unroll
        for (int bj = 0; bj < 2; ++bj) { const int col = u.pn * BM + bj * HALF + wc * 32 + 8 * fq; const float k = gate ? 256.0f : 1.0f; cs[bj][0] = *(const f32x4*)(wsc + col) * k; cs[bj][1] = *(const f32x4*)(wsc + col + 4) * k; }
#pragma unroll
        for (int ai = 0; ai < 2; ++ai)
#pragma unroll
            for (int m = 0; m < 4; ++m) { const int row = u.pm * BM + ai * HALF + wr * 64 + m * 16 + fr; const float rs = usc[row];
#pragma unroll
                for (int bj = 0; bj < 2; ++bj) { const int col = u.pn * BM + bj * HALF + wc * 32 + 8 * fq;
                    const v4i_t i0 = __builtin_bit_cast(v4i_t, acc[ai][bj][m][0]), i1 = __builtin_bit_cast(v4i_t, acc[ai][bj][m][1]);
                    const f32x4 r0 = cs[bj][0] * rs, r1 = cs[bj][1] * rs;
                    f32x4 v0, v1;
#pragma unroll
                    for (int j = 0; j < 4; ++j) { v0[j] = (float)i0[j] * r0[j]; v1[j] = (float)i1[j] * r1[j]; }
                    if (pn < 6) *(u32x4*)(Z + (size_t)row * 1536 + col) = pack8v(v0, v1);
                    else if (pn < 16) *(u32x4*)(XBC + (size_t)row * 2560 + (col - 1536)) = pack8v(v0, v1);
                    else if (pn < 22) *(u32x4*)(QKV + (size_t)row * 1536 + (col - 4096)) = pack8v(v0, v1);
                    else if (pn < 38) { u32x2 q = (u32x2){0u, 0u};
#pragma unroll
                        for (int j = 0; j < 4; ++j) { const int i0_ = (int)__builtin_amdgcn_fmed3f(v0[j] + 2048.5f, 0.f, 4095.f), i1_ = (int)__builtin_amdgcn_fmed3f(v1[j] + 2048.5f, 0.f, 4095.f);
                                                      q.x |= (unsigned)sgt[i0_] << (8 * j); q.y |= (unsigned)sgt[i1_] << (8 * j); }
                        *(u32x2*)(GATES + (size_t)row * 4096 + (col - 5632)) = q; }
                    else { const int c = col - 9728; if (c < 32) { *(f32x4*)(DTRAW + (size_t)row * 32 + c) = v0; *(f32x4*)(DTRAW + (size_t)row * 32 + c + 4) = v1; } } } }
    }
};
struct EpiMerge {
    bf16* MERGED; const unsigned char* GATES; const float* RSTD;
    DI void operator()(f32x4 (&acc)[2][2][4][2], const Unit& u, int wr, int wc, int fr, int fq) const { if (u.fin) fin(acc, u, wr, wc, fr, fq); else mid(acc, u, wr, wc, fr, fq); }
    DI void mid(f32x4 (&acc)[2][2][4][2], const Unit& u, int wr, int wc, int fr, int fq) const {
#pragma unroll
        for (int ai = 0; ai < 2; ++ai) { u32x2 ga[4][2], gb[4][2]; float rs[4];
#pragma unroll
            for (int m = 0; m < 4; ++m) { const int row = u.pm * BM + ai * HALF + wr * 64 + m * 16 + fr; rs[m] = RSTD[row];
#pragma unroll
                for (int bj = 0; bj < 2; ++bj) { const int col = u.pn * BM + bj * HALF + wc * 32 + 8 * fq; ga[m][bj] = *(const u32x2*)(GATES + (size_t)row * 4096 + col); gb[m][bj] = *(const u32x2*)(GATES + (size_t)row * 4096 + 2048 + col); } }
#pragma unroll
            for (int m = 0; m < 4; ++m)
#pragma unroll
                for (int bj = 0; bj < 2; ++bj) { float g1[8], g2[8]; unpack8_u8(ga[m][bj], g1); unpack8_u8(gb[m][bj], g2);
#pragma unroll
                    for (int j = 0; j < 4; ++j) { acc[ai][bj][m][0][j] *= rs[m] * g1[j] * __builtin_amdgcn_rcpf(fmaxf(g2[j], 1e-30f)); acc[ai][bj][m][1][j] *= rs[m] * g1[4 + j] * __builtin_amdgcn_rcpf(fmaxf(g2[4 + j], 1e-30f)); } }
            asm volatile("" ::: "memory"); }
    }
    DI void fin(const f32x4 (&acc)[2][2][4][2], const Unit& u, int wr, int wc, int fr, int fq) const {
        EPI_ROWS({ float g2[8]; unpack8_u8(*(const u32x2*)(GATES + (size_t)row * 4096 + 2048 + col), g2);
            f32x4 a, b;
_Pragma("unroll")
            for (int j = 0; j < 4; ++j) { a[j] = v0[j] * g2[j] * (1.0f / 255.0f); b[j] = v1[j] * g2[4 + j] * (1.0f / 255.0f); }
            *(u32x4*)(MERGED + (size_t)row * 2048 + col) = pack8v(a, b); })
    }
};
struct EpiResF32 {
    const float* base; float* out;
    DI void operator()(const f32x4 (&acc)[2][2][4][2], const Unit& u, int wr, int wc, int fr, int fq) const {
        EPI_ROWS({ const size_t o = (size_t)row * 2048 + col; const f32x4 b0 = *(const f32x4*)(base + o), b1 = *(const f32x4*)(base + o + 4);
            *(f32x4*)(out + o) = b0 + v0; *(f32x4*)(out + o + 4) = b1 + v1; })
    }
};
struct EpiResStatF32 {
    const float* base; bf16* hb; float* ssq; const float* rsc; const float* csc;
    DI void operator()(const f32x4 (&acc)[2][2][4][2], const Unit& u, int wr, int wc, int fr, int fq) const {
#pragma unroll
        for (int ai = 0; ai < 2; ++ai) { f32x4 bv[4][2][2];
#pragma unroll
            for (int m = 0; m < 4; ++m)
#pragma unroll
                for (int bj = 0; bj < 2; ++bj) { const size_t o = (size_t)(u.pm * BM + ai * HALF + wr * 64 + m * 16 + fr) * 2048 + u.pn * BM + bj * HALF + wc * 32 + 8 * fq; bv[m][bj][0] = *(const f32x4*)(base + o); bv[m][bj][1] = *(const f32x4*)(base + o + 4); }
#pragma unroll
            for (int m = 0; m < 4; ++m) { const int row = u.pm * BM + ai * HALF + wr * 64 + m * 16 + fr; float sq = 0.f;
#pragma unroll
                for (int bj = 0; bj < 2; ++bj) { const size_t o = (size_t)row * 2048 + u.pn * BM + bj * HALF + wc * 32 + 8 * fq;
                    const v4i_t i0 = __builtin_bit_cast(v4i_t, acc[ai][bj][m][0]), i1 = __builtin_bit_cast(v4i_t, acc[ai][bj][m][1]);
                    const f32x4 c0 = *(const f32x4*)(csc + u.pn * BM + bj * HALF + wc * 32 + 8 * fq) * rsc[row], c1 = *(const f32x4*)(csc + u.pn * BM + bj * HALF + wc * 32 + 8 * fq + 4) * rsc[row];
                    f32x4 r0, r1;
#pragma unroll
                    for (int j = 0; j < 4; ++j) { r0[j] = bv[m][bj][0][j] + (float)i0[j] * c0[j]; r1[j] = bv[m][bj][1][j] + (float)i1[j] * c1[j]; }
                    *(u32x4*)(hb + o) = pack8v(r0, r1);
                    sq += (r0[0] * r0[0] + r0[1] * r0[1]) + (r0[2] * r0[2] + r0[3] * r0[3]) + (r1[0] * r1[0] + r1[1] * r1[1]) + (r1[2] * r1[2] + r1[3] * r1[3]); }
                sq += __shfl_xor(sq, 16); sq += __shfl_xor(sq, 32);
                if (fq == 0) ssq[(size_t)row * 32 + u.pn * 4 + wc] = sq; }
            asm volatile("" ::: "memory"); }
    }
};
struct EpiResStatBf {
    bf16* hb; float* ssq; unsigned char* hb8;
    DI void operator()(const f32x4 (&acc)[2][2][4][2], const Unit& u, int wr, int wc, int fr, int fq) const {
        u32x4 bv[2][4][2];
#pragma unroll
        for (int ai = 0; ai < 2; ++ai)
#pragma unroll
            for (int m = 0; m < 4; ++m)
#pragma unroll
                for (int bj = 0; bj < 2; ++bj) bv[ai][m][bj] = *(const u32x4*)(hb + (size_t)(u.pm * BM + ai * HALF + wr * 64 + m * 16 + fr) * 2048 + u.pn * BM + bj * HALF + wc * 32 + 8 * fq);
#pragma unroll
        for (int ai = 0; ai < 2; ++ai)
#pragma unroll
            for (int m = 0; m < 4; ++m) { const int row = u.pm * BM + ai * HALF + wr * 64 + m * 16 + fr; float sq = 0.f;
#pragma unroll
                for (int bj = 0; bj < 2; ++bj) { const size_t o = (size_t)row * 2048 + u.pn * BM + bj * HALF + wc * 32 + 8 * fq; float bf[8]; unpack8(bv[ai][m][bj], bf);
                    f32x4 r0, r1;
#pragma unroll
                    for (int j = 0; j < 4; ++j) { r0[j] = bf[j] + acc[ai][bj][m][0][j]; r1[j] = bf[4 + j] + acc[ai][bj][m][1][j]; }
                    *(u32x4*)(hb + o) = pack8v(r0, r1);
                    { u32x2 w8; w8.x = pk4_fp8(r0[0], r0[1], r0[2], r0[3]); w8.y = pk4_fp8(r1[0], r1[1], r1[2], r1[3]); *(u32x2*)(hb8 + o) = w8; }
                    sq += (r0[0] * r0[0] + r0[1] * r0[1]) + (r0[2] * r0[2] + r0[3] * r0[3]) + (r1[0] * r1[0] + r1[1] * r1[1]) + (r1[2] * r1[2] + r1[3] * r1[3]); }
                sq += __shfl_xor(sq, 16); sq += __shfl_xor(sq, 32);
                if (fq == 0) ssq[(size_t)row * 32 + u.pn * 4 + wc] = sq; }
    }
};
struct EpiBf16Rs {
    bf16* O; int ldc; const float* ssq;
    DI void operator()(const f32x4 (&acc)[2][2][4][2], const Unit& u, int wr, int wc, int fr, int fq) const {
_Pragma("unroll") for (int ai = 0; ai < 2; ++ai) _Pragma("unroll") for (int m = 0; m < 4; ++m) { const int row = u.pm * BM + ai * HALF + wr * 64 + m * 16 + fr; const float rs = rstd32(ssq + (size_t)row * 32);
            _Pragma("unroll") for (int bj = 0; bj < 2; ++bj) { const int col = u.pn * BM + bj * HALF + wc * 32 + 8 * fq; *(u32x4*)(O + (size_t)row * ldc + col) = pack8v(acc[ai][bj][m][0] * rs, acc[ai][bj][m][1] * rs); } }
    }
};
struct EpiSwiGLU {
    unsigned char* HID; const float* srstd; float in_scale, out_scale;
    DI void operator()(const f32x4 (&acc)[2][2][4][2], const Unit& u, int wr, int wc, int fr, int fq) const {
#pragma unroll
        for (int ai = 0; ai < 2; ++ai)
#pragma unroll
            for (int m = 0; m < 4; ++m) { const int row = u.pm * BM + ai * HALF + wr * 64 + m * 16 + fr; const int col = u.pn * 128 + wc * 32 + 8 * fq; const float rs = srstd[row] * in_scale;
                f32x4 a, b;
#pragma unroll
                for (int j = 0; j < 4; ++j) { a[j] = silu_f(acc[ai][0][m][0][j] * rs) * (acc[ai][1][m][0][j] * rs) * out_scale; b[j] = silu_f(acc[ai][0][m][1][j] * rs) * (acc[ai][1][m][1][j] * rs) * out_scale; }
                u32x2 w; w.x = pk4_fp8(a[0], a[1], a[2], a[3]); w.y = pk4_fp8(b[0], b[1], b[2], b[3]);
                *(u32x2*)(HID + (size_t)row * EFF + col) = w; }
    }
};
}

#define XB_TMO      128
#define XB_XCNT(j)  (256  + 64 * (j))
#define XB_XSUB(j)  (1280 + 64 * (j))
#define XB_XGEN(j)  (2304 + 64 * (j))
#define XB_TOP      3328
#define XB_TOPGEN   3392
#define XCD_BAR_WORDS 3456
#define XB_SPIN_CAP (1u << 18)
__device__ __forceinline__ unsigned xb_ld(unsigned* p)              { return __hip_atomic_load(p, __ATOMIC_RELAXED, __HIP_MEMORY_SCOPE_AGENT); }
__device__ __forceinline__ unsigned xb_add(unsigned* p, unsigned v) { return __hip_atomic_fetch_add(p, v, __ATOMIC_RELAXED, __HIP_MEMORY_SCOPE_AGENT); }
__device__ __forceinline__ unsigned xb_xcc_id() { return (unsigned)__builtin_amdgcn_s_getreg((3 << 11) | 20) & 0xFu; }
#define XB_SPIN(cond, bar) do { unsigned _sp = 0; while (cond) { __builtin_amdgcn_s_sleep(1); \
    if ((++_sp & 255u) == 0u) { if (xb_ld(&(bar)[XB_TMO])) break; if (_sp > XB_SPIN_CAP) { atomicAdd(&(bar)[XB_TMO], 1u); break; } } } } while (0)
struct XcdBarrier { unsigned* bar; unsigned x; volatile LAS unsigned* st; };
__device__ __forceinline__ XcdBarrier xcd_barrier_post(unsigned* bar, volatile LAS unsigned* st) {
    XcdBarrier b; b.bar = bar; b.x = xb_xcc_id(); b.st = st;
    if (threadIdx.x == 0) (void)xb_add(&bar[XB_XCNT(b.x)], 1u);
    return b;
}
__device__ __forceinline__ void xcd_barrier_complete(unsigned* bar, unsigned x, unsigned& nloc, unsigned& nx) {
    const unsigned G = gridDim.x * gridDim.y * gridDim.z;
    unsigned sum, cnt, mine, sp = 0u;
    for (;;) {
        sum = 0u; cnt = 0u; mine = 0u;
#pragma unroll
        for (unsigned j = 0; j < 16; ++j) { const unsigned c = xb_ld(&bar[XB_XCNT(j)]); sum += c; cnt += (c > 0u) ? 1u : 0u; mine = (j == x) ? c : mine; }
        if (sum == G) break;
        __builtin_amdgcn_s_sleep(1);
        if ((++sp & 255u) == 0u) { if (xb_ld(&bar[XB_TMO])) break; if (sp > XB_SPIN_CAP) { atomicAdd(&bar[XB_TMO], 1u); break; } }
    }
    nloc = mine > 0u ? mine : 1u; nx = cnt > 0u ? cnt : 1u;
}
__device__ __forceinline__ void xcd_barrier(const XcdBarrier& b) {
    asm volatile("s_waitcnt vmcnt(0)" ::: "memory");
    __syncthreads();
    if (threadIdx.x == 0) {
        unsigned* bar = b.bar;
        __builtin_amdgcn_s_waitcnt(0);
        unsigned nloc = b.st[0], nx = b.st[1];
        if (nloc == 0u) { xcd_barrier_complete(bar, b.x, nloc, nx); b.st[0] = nloc; b.st[1] = nx; }
        const unsigned old = xb_add(&bar[XB_XSUB(b.x)], 1u);
        const unsigned gen = old / nloc;
        if (old + 1u == (gen + 1u) * nloc) {
            __builtin_amdgcn_fence(__ATOMIC_RELEASE, "agent");
            asm volatile("s_waitcnt vmcnt(0)" ::: "memory");
            const unsigned og = xb_add(&bar[XB_TOP], 1u);
            const unsigned tg = og / nx;
            if (og + 1u == (tg + 1u) * nx) xb_add(&bar[XB_TOPGEN], 1u);
            else XB_SPIN(xb_ld(&bar[XB_TOPGEN]) == tg, bar);
            __builtin_amdgcn_fence(__ATOMIC_ACQUIRE, "agent");
            xb_add(&bar[XB_XGEN(b.x)], 1u);
            asm volatile("s_waitcnt vmcnt(0)" ::: "memory");
        } else {
            XB_SPIN(xb_ld(&bar[XB_XGEN(b.x)]) == gen, bar);
            __builtin_amdgcn_fence(__ATOMIC_ACQUIRE, "agent");
            asm volatile("s_waitcnt vmcnt(0)" ::: "memory");
        }
    }
    __syncthreads();
}

struct Frame {
    unsigned long long* pacc;
    LAS unsigned char* lds;
    int tid, lane, wave, G, gw, NGW;
    const float* in[26];
    float* out; unsigned char* ws;
};
#define WSP(type, off) ((type*)(F.ws + (off)))

DI void tr_item(const float* W, int ldw, int k0, int nsrc0, int nvalid, bf16* WT, int ldt, int drow0, const float* kscale, LAS float* scr, int lane) {
    const int nn = lane & 31;
#pragma unroll 8
    for (int i = 0; i < 32; ++i) { const int kk = 2 * i + (lane >> 5); float v = 0.f; if (nn < nvalid) v = W[(size_t)(k0 + kk) * ldw + nsrc0 + nn]; if (kscale) v *= kscale[k0 + kk]; scr[kk * 33 + nn] = v; }
    LDS_WAIT(); asm volatile("" ::: "memory");
    const int c = lane & 7;
#pragma unroll
    for (int j = 0; j < 4; ++j) { const int n = (lane >> 3) + 8 * j; const LAS float* s = scr + (8 * c) * 33 + n;
        u32x4 o; o.x = pk2(s[0 * 33], s[1 * 33]); o.y = pk2(s[2 * 33], s[3 * 33]); o.z = pk2(s[4 * 33], s[5 * 33]); o.w = pk2(s[6 * 33], s[7 * 33]);
        if (n < nvalid) *(u32x4*)(WT + (size_t)(drow0 + n) * ldt + k0 + 8 * c) = o; }
    LDS_WAIT(); asm volatile("" ::: "memory");
}
DI void tr_block(const float* W, int ldw, int K, int ncols, int nsrc0, bf16* WT, int ldt, int drow0, const float* kscale, LAS float* scr, int lane, int it) {
    const int nblk = (ncols + 31) / 32, kb = it / nblk, nb = it % nblk; const int nv = ncols - nb * 32 < 32 ? ncols - nb * 32 : 32;
    tr_item(W, ldw, kb * 64, nsrc0 + nb * 32, nv, WT, ldt, drow0 + nb * 32, kscale, scr, lane);
}
DI void tr64_item(const float* W, int ldw, int k0, int nsrc0, bf16* WT, int ldt, int drow0, const float* kscale, int lane) {
    const int n4 = lane & 15, kq = lane >> 4;
    f32x4 r[2][8];
#pragma unroll
    for (int hf = 0; hf < 2; ++hf)
#pragma unroll
        for (int i = 0; i < 8; ++i) r[hf][i] = *(const f32x4*)(W + (size_t)(k0 + hf * 32 + kq * 8 + i) * ldw + nsrc0 + n4 * 4);
#pragma unroll
    for (int hf = 0; hf < 2; ++hf) { const int kb = k0 + hf * 32 + kq * 8;
        if (kscale) { const f32x4 s0 = *(const f32x4*)(kscale + kb), s1 = *(const f32x4*)(kscale + kb + 4);
#pragma unroll
            for (int i = 0; i < 4; ++i) { r[hf][i] = r[hf][i] * s0[i]; r[hf][4 + i] = r[hf][4 + i] * s1[i]; } }
#pragma unroll
        for (int j = 0; j < 4; ++j) { u32x4 o; o.x = pk2(r[hf][0][j], r[hf][1][j]); o.y = pk2(r[hf][2][j], r[hf][3][j]); o.z = pk2(r[hf][4][j], r[hf][5][j]); o.w = pk2(r[hf][6][j], r[hf][7][j]);
            *(u32x4*)(WT + (size_t)(drow0 + n4 * 4 + j) * ldt + kb) = o; } }
}
DI void tr64_item8(const float* W, int ldw, int k0, int nsrc0, unsigned char* WT, int ldt, int drow0, const float* kscale, float sc, int lane) {
    const int n4 = lane & 15, kq = lane >> 4;
    f32x4 r[2][8];
#pragma unroll
    for (int hf = 0; hf < 2; ++hf)
#pragma unroll
        for (int i = 0; i < 8; ++i) r[hf][i] = *(const f32x4*)(W + (size_t)(k0 + kq * 16 + hf * 8 + i) * ldw + nsrc0 + n4 * 4);
    const int kb = k0 + kq * 16;
#pragma unroll
    for (int hf = 0; hf < 2; ++hf) { f32x4 s0 = (f32x4){sc, sc, sc, sc}, s1 = s0;
        if (kscale) { s0 = *(const f32x4*)(kscale + kb + hf * 8) * sc; s1 = *(const f32x4*)(kscale + kb + hf * 8 + 4) * sc; }
#pragma unroll
        for (int i = 0; i < 4; ++i) { r[hf][i] = r[hf][i] * s0[i]; r[hf][4 + i] = r[hf][4 + i] * s1[i]; } }
#pragma unroll
    for (int j = 0; j < 4; ++j) { u32x4 o; o.x = pk4_fp8(r[0][0][j], r[0][1][j], r[0][2][j], r[0][3][j]); o.y = pk4_fp8(r[0][4][j], r[0][5][j], r[0][6][j], r[0][7][j]);
        o.z = pk4_fp8(r[1][0][j], r[1][1][j], r[1][2][j], r[1][3][j]); o.w = pk4_fp8(r[1][4][j], r[1][5][j], r[1][6][j], r[1][7][j]);
        *(u32x4*)(WT + (size_t)(drow0 + n4 * 4 + j) * ldt + kb) = o; }
}
DI void tr64_block(const float* W, int ldw, int K, int ncols, int nsrc0, bf16* WT, int ldt, int drow0, const float* kscale, int lane, int it) {
    const int nblk = ncols / 64, kb = it / nblk, nb = it % nblk;
    tr64_item(W, ldw, kb * 64, nsrc0 + nb * 64, WT, ldt, drow0 + nb * 64, kscale, lane);
}
DI void tr64_block8(const float* W, int ldw, int K, int ncols, int nsrc0, unsigned char* WT, int ldt, int drow0, const float* kscale, float sc, int lane, int it) {
    const int nblk = ncols / 64, kb = it / nblk, nb = it % nblk;
    tr64_item8(W, ldw, kb * 64, nsrc0 + nb * 64, WT, ldt, drow0 + nb * 64, kscale, sc, lane);
}
DI void rms_row_bf16(const float* xrow, const float* w, bf16* orow, int lane) {
    const f32x4* xr = (const f32x4*)xrow + lane; const f32x4* wr4 = (const f32x4*)w + lane;
    f32x4 v[8]; float s = 0.f;
#pragma unroll
    for (int j = 0; j < 8; ++j) { v[j] = xr[64 * j]; s += (v[j].x * v[j].x + v[j].y * v[j].y) + (v[j].z * v[j].z + v[j].w * v[j].w); }
    const float rstd = 1.0f / sqrtf(wave_sum(s) * (1.0f / 2048.0f) + EPS);
    u32x2* o8 = (u32x2*)orow + lane;
#pragma unroll
    for (int j = 0; j < 8; ++j) { const f32x4 ww = wr4[64 * j]; u32x2 o; o.x = pk2(v[j].x * rstd * ww.x, v[j].y * rstd * ww.y); o.y = pk2(v[j].z * rstd * ww.z, v[j].w * rstd * ww.w); o8[64 * j] = o; }
}
DI void rms_rows(const Frame& F, const float* src, const float* w, bf16* dst, int rows, unsigned char* dst8 = nullptr) {
    const int lane = F.lane;
    int m = F.gw;
    for (; m + F.NGW < rows; m += 2 * F.NGW) {
        const f32x4* xa = (const f32x4*)(src + (size_t)m * 2048) + lane; const f32x4* xb = (const f32x4*)(src + (size_t)(m + F.NGW) * 2048) + lane; const f32x4* wr4 = (const f32x4*)w + lane;
        f32x4 va[8], vb[8]; float sa = 0.f, sb = 0.f;
#pragma unroll
        for (int j = 0; j < 8; ++j) { va[j] = xa[64 * j]; vb[j] = xb[64 * j]; }
#pragma unroll
        for (int j = 0; j < 8; ++j) { sa += (va[j].x * va[j].x + va[j].y * va[j].y) + (va[j].z * va[j].z + va[j].w * va[j].w); sb += (vb[j].x * vb[j].x + vb[j].y * vb[j].y) + (vb[j].z * vb[j].z + vb[j].w * vb[j].w); }
        const float ra = 1.0f / sqrtf(wave_sum(sa) * (1.0f / 2048.0f) + EPS), rb = 1.0f / sqrtf(wave_sum(sb) * (1.0f / 2048.0f) + EPS);
        u32x2* oa = (u32x2*)(dst + (size_t)m * 2048) + lane; u32x2* ob = (u32x2*)(dst + (size_t)(m + F.NGW) * 2048) + lane;
#pragma unroll
        for (int j = 0; j < 8; ++j) { const f32x4 ww = wr4[64 * j]; const f32x4 ya = va[j] * ra * ww, yb = vb[j] * rb * ww;
            u32x2 o; o.x = pk2(ya.x, ya.y); o.y = pk2(ya.z, ya.w); oa[64 * j] = o;
            u32x2 p; p.x = pk2(yb.x, yb.y); p.y = pk2(yb.z, yb.w); ob[64 * j] = p;
            if (dst8) { ((unsigned*)(dst8 + (size_t)m * 2048))[lane + 64 * j] = pk4_fp8(ya.x, ya.y, ya.z, ya.w); ((unsigned*)(dst8 + (size_t)(m + F.NGW) * 2048))[lane + 64 * j] = pk4_fp8(yb.x, yb.y, yb.z, yb.w); } }
    }
    for (; m < rows; m += F.NGW) rms_row_bf16(src + (size_t)m * 2048, w, dst + (size_t)m * 2048, lane);
}

DI void rms_rows_q(const Frame& F, const float* src, const float* w, unsigned char* dstq, float* usc, int rows) {
    const int lane = F.lane;
    for (int m = F.gw; m < rows; m += 2 * F.NGW) {
        const int m2 = m + F.NGW; const bool two = m2 < rows; const int mb = two ? m2 : m;
        const f32x4* xa = (const f32x4*)(src + (size_t)m * 2048) + lane; const f32x4* xb = (const f32x4*)(src + (size_t)mb * 2048) + lane; const f32x4* wr4 = (const f32x4*)w + lane;
        f32x4 va[8], vb[8]; float sa = 0.f, sb = 0.f;
#pragma unroll
        for (int j = 0; j < 8; ++j) { va[j] = xa[64 * j]; vb[j] = xb[64 * j]; }
#pragma unroll
        for (int j = 0; j < 8; ++j) { sa += (va[j].x * va[j].x + va[j].y * va[j].y) + (va[j].z * va[j].z + va[j].w * va[j].w); sb += (vb[j].x * vb[j].x + vb[j].y * vb[j].y) + (vb[j].z * vb[j].z + vb[j].w * vb[j].w); }
        const float ra = 1.0f / sqrtf(wave_sum(sa) * (1.0f / 2048.0f) + EPS), rb = 1.0f / sqrtf(wave_sum(sb) * (1.0f / 2048.0f) + EPS);
        float ma = 0.f, mbx = 0.f;
#pragma unroll
        for (int j = 0; j < 8; ++j) { const f32x4 ww = wr4[64 * j]; va[j] = va[j] * ra * ww; vb[j] = vb[j] * rb * ww;
            ma = fmaxf(ma, fmaxf(fmaxf(fabsf(va[j].x), fabsf(va[j].y)), fmaxf(fabsf(va[j].z), fabsf(va[j].w)))); mbx = fmaxf(mbx, fmaxf(fmaxf(fabsf(vb[j].x), fabsf(vb[j].y)), fmaxf(fabsf(vb[j].z), fabsf(vb[j].w)))); }
#pragma unroll
        for (int o = 1; o < 64; o <<= 1) { ma = fmaxf(ma, __shfl_xor(ma, o)); mbx = fmaxf(mbx, __shfl_xor(mbx, o)); }
        const float ia = ma > 0.f ? 127.0f / ma : 0.f, ib = mbx > 0.f ? 127.0f / mbx : 0.f;
        unsigned* oa = (unsigned*)(dstq + (size_t)m * 2048) + lane; unsigned* ob = (unsigned*)(dstq + (size_t)mb * 2048) + lane;
#pragma unroll
        for (int j = 0; j < 8; ++j) { oa[64 * j] = pk4_i8(va[j].x * ia, va[j].y * ia, va[j].z * ia, va[j].w * ia); if (two) ob[64 * j] = pk4_i8(vb[j].x * ib, vb[j].y * ib, vb[j].z * ib, vb[j].w * ib); }
        if (lane == 0) { usc[m] = ma * (1.0f / 127.0f); if (two) usc[mb] = mbx * (1.0f / 127.0f); }
    }
}
DI void gen_colmax(const Frame& F, const float* W, int ldw, int K, int N, const float* kscale, unsigned* cmax, int it) {
    const int lane = F.lane, n4 = lane & 15, kq = lane >> 4, nblk = N / 64, kb = it / nblk, nb = it % nblk, k0 = kb * 64;
    f32x4 mx = (f32x4){0.f, 0.f, 0.f, 0.f};
#pragma unroll
    for (int i = 0; i < 16; ++i) { const int k = k0 + kq * 16 + i; f32x4 v = *(const f32x4*)(W + (size_t)k * ldw + nb * 64 + n4 * 4); if (kscale) v = v * kscale[k];
#pragma unroll
        for (int j = 0; j < 4; ++j) mx[j] = fmaxf(mx[j], fabsf(v[j])); }
#pragma unroll
    for (int j = 0; j < 4; ++j) { float v = mx[j]; v = fmaxf(v, __shfl_xor(v, 16)); v = fmaxf(v, __shfl_xor(v, 32)); if (kq == 0) atomicMax(cmax + nb * 64 + n4 * 4 + j, __float_as_uint(v)); }
}
DI void gen_quant(const Frame& F, const float* W, int ldw, int K, int N, const float* kscale, const unsigned* cmax, unsigned char* WT, int ldt, int koff, float* wsc, int it) {
    const int lane = F.lane, n4 = lane & 15, kq = lane >> 4, nblk = N / 64, kb = it / nblk, nb = it % nblk, k0 = kb * 64;
    f32x4 r[16];
#pragma unroll
    for (int i = 0; i < 16; ++i) { const int k = k0 + kq * 16 + i; r[i] = *(const f32x4*)(W + (size_t)k * ldw + nb * 64 + n4 * 4); if (kscale) r[i] = r[i] * kscale[k]; }
#pragma unroll
    for (int j = 0; j < 4; ++j) { const int n = nb * 64 + n4 * 4 + j; const float cm = __uint_as_float(__hip_atomic_load(cmax + n, __ATOMIC_RELAXED, __HIP_MEMORY_SCOPE_AGENT)); const float inv = cm > 0.f ? 127.0f / cm : 0.f;
        u32x4 o; o.x = pk4_i8(r[0][j] * inv, r[1][j] * inv, r[2][j] * inv, r[3][j] * inv); o.y = pk4_i8(r[4][j] * inv, r[5][j] * inv, r[6][j] * inv, r[7][j] * inv);
        o.z = pk4_i8(r[8][j] * inv, r[9][j] * inv, r[10][j] * inv, r[11][j] * inv); o.w = pk4_i8(r[12][j] * inv, r[13][j] * inv, r[14][j] * inv, r[15][j] * inv);
        *(u32x4*)(WT + (size_t)n * ldt + koff + k0 + kq * 16) = o;
        if (k0 == 0 && kq == 0) wsc[n] = cm * (1.0f / 127.0f); }
}
constexpr int WC_I1 = (1536 / 64) * (2048 / 64), WC_I2 = (512 / 64) * (2048 / 64);
DI void win_item(int it, int& k0, int& nsrc0, int& drow0) {
    constexpr int NB = 153;
    const int kb = it / NB, nb = it % NB; k0 = kb * 64;
    if (nb < 24) { nsrc0 = nb * 64; drow0 = nb * 64; }
    else if (nb < 64) { nsrc0 = 1536 + (nb - 24) * 64; drow0 = 1536 + (nb - 24) * 64; }
    else if (nb < 88) { nsrc0 = 4120 + (nb - 64) * 64; drow0 = 4096 + (nb - 64) * 64; }
    else if (nb < 152) { nsrc0 = 5656 + (nb - 88) * 64; drow0 = 5632 + (nb - 88) * 64; }
    else { nsrc0 = 4096; drow0 = 9728; }
}
constexpr int WIN_ITEMS = 32 * 153;
DI void win_colmax(const Frame& F) {
    const float* W = F.in[3]; unsigned* cmax = WSP(unsigned, WS_CTL) + CW_CMAX;
    const int lane = F.lane, n4 = lane & 15, kq = lane >> 4;
    for (int it = F.gw; it < WIN_ITEMS; it += F.NGW) { int k0, nsrc0, drow0; win_item(it, k0, nsrc0, drow0);
        f32x4 mx = (f32x4){0.f, 0.f, 0.f, 0.f};
#pragma unroll
        for (int i = 0; i < 16; ++i) { const f32x4 v = *(const f32x4*)(W + (size_t)(k0 + kq * 16 + i) * IN_COLS + nsrc0 + n4 * 4);
#pragma unroll
            for (int j = 0; j < 4; ++j) mx[j] = fmaxf(mx[j], fabsf(v[j])); }
#pragma unroll
        for (int j = 0; j < 4; ++j) { float v = mx[j]; v = fmaxf(v, __shfl_xor(v, 16)); v = fmaxf(v, __shfl_xor(v, 32));
            if (kq == 0) atomicMax(cmax + drow0 + n4 * 4 + j, __float_as_uint(v)); }
    }
}
DI void win_quant(const Frame& F) {
    const float* W = F.in[3]; const unsigned* cmax = WSP(unsigned, WS_CTL) + CW_CMAX; unsigned char* WT = (unsigned char*)F.out + OUT_WQI; float* wsc = WSP(float, WS_WSC);
    const int lane = F.lane, n4 = lane & 15, kq = lane >> 4;
    for (int it = F.gw; it < WIN_ITEMS; it += F.NGW) { int k0, nsrc0, drow0; win_item(it, k0, nsrc0, drow0);
        f32x4 r[16];
#pragma unroll
        for (int i = 0; i < 16; ++i) r[i] = *(const f32x4*)(W + (size_t)(k0 + kq * 16 + i) * IN_COLS + nsrc0 + n4 * 4);
#pragma unroll
        for (int j = 0; j < 4; ++j) { const float cm = __uint_as_float(__hip_atomic_load(cmax + drow0 + n4 * 4 + j, __ATOMIC_RELAXED, __HIP_MEMORY_SCOPE_AGENT)); const float inv = cm > 0.f ? 127.0f / cm : 0.f;
            u32x4 o; o.x = pk4_i8(r[0][j] * inv, r[1][j] * inv, r[2][j] * inv, r[3][j] * inv); o.y = pk4_i8(r[4][j] * inv, r[5][j] * inv, r[6][j] * inv, r[7][j] * inv);
            o.z = pk4_i8(r[8][j] * inv, r[9][j] * inv, r[10][j] * inv, r[11][j] * inv); o.w = pk4_i8(r[12][j] * inv, r[13][j] * inv, r[14][j] * inv, r[15][j] * inv);
            *(u32x4*)(WT + (size_t)(drow0 + n4 * 4 + j) * 2048 + k0 + kq * 16) = o;
            if (k0 == 0 && kq == 0) wsc[drow0 + n4 * 4 + j] = cm * (1.0f / 127.0f); }
    }
    { const unsigned* cm = WSP(unsigned, WS_CTL) + CW_CMAXM; for (int it = F.gw; it < 32 * 32; it += F.NGW) gen_quant(F, F.in[12], 2048, 2048, 2048, nullptr, cm, WSP(unsigned char, WS_WMIX_T), 2048, 0, WSP(float, WS_WMS), it); }
    { const int gt = F.gw * 64 + F.lane, NT = F.NGW * 64;
      u32x4* z1 = (u32x4*)(WT + (size_t)9792 * 2048); for (int i = gt; i < (IN_PAD - 9792) * 2048 / 16; i += NT) z1[i] = (u32x4){0u, 0u, 0u, 0u};
      for (int i = gt; i < IN_PAD - 9792; i += NT) wsc[9792 + i] = 0.f; }
}
DI void p0_prologue(const Frame& F) {
    LAS float* scr = (LAS float*)(F.lds + F.wave * 16384);
    win_colmax(F);
    { unsigned* cm = WSP(unsigned, WS_CTL) + CW_CMAXM; for (int it = F.gw; it < 32 * 32; it += F.NGW) gen_colmax(F, F.in[12], 2048, 2048, 2048, nullptr, cm, it); }
    constexpr int I_SSD = (1536 / 64) * (2048 / 64), I_SB = (512 / 64) * (2048 / 64), I_MIX = (2048 / 64) * (2048 / 64);
    constexpr int I_XQ = (2048 / 64) * (512 / 64), I_XO = (512 / 64) * (2048 / 64);
    constexpr int NITEMS = I_SSD + I_SB + 3 * I_XQ + I_XO;
    for (int it = F.gw; it < NITEMS; it += F.NGW) {
        int r = it;
        if (r < I_SSD) { tr64_block(F.in[10], 2048, 1536, 2048, 0, WSP(bf16, WS_WCAT_T), 2048, 0, F.in[9], F.lane, r); continue; } r -= I_SSD;
        if (r < I_SB)  { tr64_block(F.in[11], 2048, 512,  2048, 0, WSP(bf16, WS_WCAT_T) + 1536, 2048, 0, nullptr, F.lane, r); continue; } r -= I_SB;
        if (r < I_XQ)  { tr64_block(F.in[15], 512, 2048, 512, 0, WSP(bf16, WS_WQ_T), 2048, 0, F.in[13], F.lane, r); continue; } r -= I_XQ;
        if (r < I_XQ)  { tr64_block(F.in[16], 512, 2048, 512, 0, WSP(bf16, WS_WK_T), 2048, 0, nullptr, F.lane, r); continue; } r -= I_XQ;
        if (r < I_XQ)  { tr64_block(F.in[17], 512, 2048, 512, 0, WSP(bf16, WS_WV_T), 2048, 0, nullptr, F.lane, r); continue; } r -= I_XQ;
        tr64_block(F.in[18], 2048, 512, 2048, 0, WSP(bf16, WS_WO_T), 512, 0, nullptr, F.lane, r);
    }
    constexpr int I_RG = 32, I_RE = 32;
    for (int it = F.gw; it < I_RG + I_RE; it += F.NGW) {
        int r = it;
        if (r < I_RG)  { tr_block(F.in[20], 4, 2048, 4, 0, WSP(bf16, WS_WR_T), 2048, 0, F.in[19], scr, F.lane, r); continue; } r -= I_RG;
        tr_block(F.in[21], 32, 2048, 32, 0, WSP(bf16, WS_WR_T), 2048, 4, F.in[19], scr, F.lane, r);
    }
    { const int gt = F.gw * 64 + F.lane, NT = F.NGW * 64;
      u32x4* z2 = (u32x4*)(WSP(bf16, WS_WR_T) + (size_t)36 * 2048); for (int i = gt; i < 12 * 2048 / 8; i += NT) z2[i] = (u32x4){0u, 0u, 0u, 0u}; }
    rms_rows_q(F, F.in[0], F.in[2], (unsigned char*)F.out + OUT_UQ, WSP(float, WS_USC), T);
    rms_rows(F, F.in[1], F.in[14], WSP(bf16, WS_MEMN), BATCH * MEM);
}
DI void p_expert_weights(const Frame& F, bool down, int part, int nparts, int lw, int nlw) {
    constexpr int PER = 256;
    const int nm = down ? 1 : 2, per = NEXP * nm * PER / nparts;
    for (int it = part * per + lw; it < (part + 1) * per; it += nlw) {
        const int e = it / (nm * PER), r = it % (nm * PER), which = down ? 2 : r / PER, q = r % PER;
        if (which < 2) { const int kb = q / 8, nb = q % 8, n0 = nb * 64; const float* W = (which == 0 ? F.in[22] : F.in[23]) + (size_t)e * 2048 * 512;
            tr64_item8(W, 512, kb * 64, n0, (unsigned char*)F.out + OUT_WGU + (size_t)e * 1024 * 2048, 2048, (n0 / 128) * 256 + (n0 % 128) + which * 128, F.in[19], WGU_SCALE, F.lane); }
        else { const int kb = q / 32, nb = q % 32; const float* W = F.in[24] + (size_t)e * 512 * 2048;
            tr64_item8(W, 2048, kb * 64, nb * 64, (unsigned char*)F.out + OUT_WD + (size_t)e * 2048 * 512, 512, nb * 64, nullptr, WD_SCALE, F.lane); }
    }
}

template <int NT>
DI void wave_tile_gemm(const bf16* A, int lda, const bf16* Bt, int ldb, int K, int lane, f32x4 (&acc)[NT]) {
    const int fr = lane & 15, kg = lane >> 4;
#pragma unroll
    for (int n = 0; n < NT; ++n) acc[n] = (f32x4){0.f, 0.f, 0.f, 0.f};
    const bf16* ap = A + (size_t)fr * lda + kg * 8;
    const bf16* bp = Bt + (size_t)fr * ldb + kg * 8;
#pragma unroll 4
    for (int k0 = 0; k0 < K; k0 += 32) {
        const bf16x8 a = *(const bf16x8*)(ap + k0);
#pragma unroll
        for (int n = 0; n < NT; ++n) { const bf16x8 b = *(const bf16x8*)(bp + (size_t)n * 16 * ldb + k0); acc[n] = MFMA16(a, b, acc[n]); }
    }
}

DI void p_kv_mem(const Frame& F) {
    const bf16* MEMN = WSP(bf16, WS_MEMN);
    const int lane = F.lane, fr = lane & 15, kg = lane >> 4, w = F.wave;
    LAS f32x4* red = (LAS f32x4*)F.lds;
    for (int u = blockIdx.x; u < 512; u += F.G) {
        const int which = u >> 8, rt = (u & 255) >> 3, cg = u & 7;
        const bf16* Aop = which == 0 ? MEMN : WSP(bf16, WS_WV_T); const bf16* Bop = which == 0 ? WSP(bf16, WS_WK_T) : MEMN; bf16* O = which == 0 ? WSP(bf16, WS_KX) : WSP(bf16, WS_VXT);
        const bf16* ap = Aop + (size_t)(rt * 16 + fr) * 2048 + w * 256 + kg * 8;
        const bf16* bp = Bop + (size_t)(cg * 64 + fr) * 2048 + w * 256 + kg * 8;
        f32x4 acc[4];
#pragma unroll
        for (int n = 0; n < 4; ++n) acc[n] = (f32x4){0.f, 0.f, 0.f, 0.f};
#pragma unroll
        for (int hf = 0; hf < 2; ++hf) { bf16x8 a[4], b[4][4];
#pragma unroll
            for (int k = 0; k < 4; ++k) { a[k] = *(const bf16x8*)(ap + (hf * 4 + k) * 32);
#pragma unroll
                for (int n = 0; n < 4; ++n) b[k][n] = *(const bf16x8*)(bp + (size_t)n * 16 * 2048 + (hf * 4 + k) * 32); }
#pragma unroll
            for (int k = 0; k < 4; ++k)
#pragma unroll
                for (int n = 0; n < 4; ++n) acc[n] = MFMA16(a[k], b[k][n], acc[n]); }
        __syncthreads();
#pragma unroll
        for (int n = 0; n < 4; ++n) red[(w * 4 + n) * 64 + lane] = acc[n];
        __syncthreads();
        if (F.tid < 256) { const int n = F.tid >> 6, l = F.tid & 63; f32x4 sacc = red[n * 64 + l];
#pragma unroll
            for (int ww = 1; ww < 8; ++ww) sacc += red[(ww * 4 + n) * 64 + l];
#pragma unroll
            for (int i = 0; i < 4; ++i) O[(size_t)(rt * 16 + (l >> 4) * 4 + i) * 512 + cg * 64 + n * 16 + (l & 15)] = (bf16)(pk2(sacc[i], 0.f) & 0xffffu); }
    }
    __syncthreads();
}

DI int spos(int s) { return (s & ~31) | (((s >> 2) & 3) << 3) | (((s >> 4) & 1) << 2) | (s & 3); }
DI void slab_issue(const bf16* src, int pitch, int c0, size_t tok0, int s0, int halo, bool zero_halo, u32x4 (&buf)[9], int lane) {
    const int rr = lane >> 3, cq = lane & 7, rows = 64 + halo;
#pragma unroll
    for (int i = 0; i < 9; ++i) { const int ri = 8 * i + rr; buf[i] = (u32x4){0u, 0u, 0u, 0u};
        if (ri < rows && !(zero_halo && ri < halo)) buf[i] = *(const u32x4*)(src + (tok0 + s0 - halo + ri) * (size_t)pitch + c0 + cq * 8); }
}
template <bool CONV, bool NAT, bool TRN>
DI void conv_slab(const Frame& F, const u32x4 (&buf)[9], int c0, size_t tok0, int s0, const float* cw, const float* cb, bf16* nat, bf16* trn, LAS unsigned char* tile, int lane) {
    constexpr int HALO = CONV ? 3 : 0, ROWS = 64 + HALO, TP = 144;
    const int rr = lane >> 3, cq = lane & 7;
    SUBPROBE_BEGIN(140);
#pragma unroll
    for (int i = 0; i < (ROWS + 7) / 8; ++i) { const int ri = 8 * i + rr; if (ri < ROWS) *(LAS u32x4*)(tile + ri * TP + cq * 16) = buf[i]; }
    float w0 = 0.f, w1 = 0.f, w2 = 0.f, w3 = 0.f, bias = 0.f;
    if (CONV) { w0 = cw[c0 + lane]; w1 = cw[CONV_DIM + c0 + lane]; w2 = cw[2 * CONV_DIM + c0 + lane]; w3 = cw[3 * CONV_DIM + c0 + lane]; bias = cb[c0 + lane]; }
    LDS_WAIT();
    SUBPROBE_END(140);
    SUBPROBE_BEGIN(141);
    const LAS unsigned short* col = (const LAS unsigned short*)tile + lane;
    float h1 = 0.f, h2 = 0.f, h3 = 0.f;
    if (CONV) { h3 = bf2f(col[0]); h2 = bf2f(col[72]); h1 = bf2f(col[144]); }
    unsigned pk[32];
#pragma unroll
    for (int s2 = 0; s2 < 64; s2 += 2) {
        float o[2];
#pragma unroll
        for (int e = 0; e < 2; ++e) { const float xin = bf2f(col[(s2 + e + HALO) * 72]);
            if (CONV) { const float a = w3 * xin + w2 * h1 + w1 * h2 + w0 * h3 + bias; o[e] = silu_f(a); h3 = h2; h2 = h1; h1 = xin; }
            else o[e] = xin; }
        const unsigned p2 = pk2(o[0], o[1]);
        pk[spos(s2) >> 1] = p2;
        if (NAT) { nat[(tok0 + s0 + s2) * 512 + lane] = (bf16)(p2 & 0xffffu); nat[(tok0 + s0 + s2 + 1) * 512 + lane] = (bf16)(p2 >> 16); }
    }
    SUBPROBE_END(141);
    SUBPROBE_BEGIN(142);
    if (TRN) {
        LDS_WAIT();
#pragma unroll
        for (int m = 0; m < 8; ++m) *(LAS u32x4*)(tile + lane * TP + m * 16) = (u32x4){pk[4 * m], pk[4 * m + 1], pk[4 * m + 2], pk[4 * m + 3]};
        LDS_WAIT();
#pragma unroll
        for (int m = 0; m < 8; ++m) { const int cl = rr + 8 * m; *(u32x4*)(trn + (size_t)cl * 128 + s0 + cq * 8) = *(const LAS u32x4*)(tile + cl * TP + cq * 16); }
        LDS_WAIT();
    }
    SUBPROBE_END(142);
}
DI void p_conv(const Frame& F) {
    const bf16* XBC = WSP(bf16, WS_XBC); const bf16* QKV = WSP(bf16, WS_QKV);
    const float* cw = F.in[4]; const float* cb = F.in[5];
    bf16* XT = WSP(bf16, WS_XT); bf16* BT = WSP(bf16, WS_BT); bf16* BN = WSP(bf16, WS_BN); bf16* CN = WSP(bf16, WS_CN); bf16* VT = (bf16*)((unsigned char*)F.out + OUT_VT);
    LAS unsigned char* tile = F.lds + F.wave * 16384;
    for (int bc = blockIdx.x; bc < NCHUNK; bc += F.G) {
        const size_t tok0 = (size_t)bc * 128; const bool first = (bc % (SEQ / 128)) == 0;
#define CONV_ISSUE(task_, dst_) do { const int tk_ = (task_); \
            if (tk_ < 80) slab_issue(XBC, CONV_DIM, (tk_ >> 1) * 64, tok0, (tk_ & 1) * 64, 3, first && (tk_ & 1) == 0, dst_, F.lane); \
            else slab_issue(QKV + 1024, 1536, ((tk_ - 80) >> 1) * 64, tok0, ((tk_ - 80) & 1) * 64, 0, false, dst_, F.lane); } while (0)
        u32x4 cur[9], nxt[9];
        CONV_ISSUE(F.wave, cur);
#pragma unroll 1
        for (int task = F.wave; task < 96; task += NWAVES) {
            if (task + NWAVES < 96) CONV_ISSUE(task + NWAVES, nxt);
            if (task < 80) { const int slab = task >> 1, hf = task & 1, c0 = slab * 64, s0 = hf * 64;
                if (slab < 24) conv_slab<true, false, true>(F, cur, c0, tok0, s0, cw, cb, nullptr, XT + ((size_t)bc * 1536 + c0) * 128, tile, F.lane);
                else if (slab < 32) conv_slab<true, true, true>(F, cur, c0, tok0, s0, cw, cb, BN + (c0 - 1536), BT + ((size_t)bc * 512 + (c0 - 1536)) * 128, tile, F.lane);
                else conv_slab<true, true, false>(F, cur, c0, tok0, s0, cw, cb, CN + (c0 - 2048), nullptr, tile, F.lane); }
            else { const int t2 = task - 80, slab = t2 >> 1, hf = t2 & 1, c0 = slab * 64;
                conv_slab<false, false, true>(F, cur, c0, tok0, hf * 64, nullptr, nullptr, nullptr, VT + ((size_t)bc * 512 + c0) * 128, tile, F.lane); }
#pragma unroll
            for (int i = 0; i < 9; ++i) cur[i] = nxt[i];
        }
#undef CONV_ISSUE
        float* DTT = WSP(float, WS_DTT); float* ACT = WSP(float, WS_ACT); float* WL = WSP(float, WS_WL);
        LAS float* dtl = (LAS float*)F.lds;
        __syncthreads();
        { const unsigned char* UQ = (const unsigned char*)F.out + OUT_UQ; const unsigned char* WQ = (const unsigned char*)F.out + OUT_WQI + (size_t)9728 * 2048;
          const float* usc = WSP(float, WS_USC); const float* wsc = WSP(float, WS_WSC) + 9728;
          const int fr = F.lane & 15, kg = F.lane >> 4;
          const unsigned char* ap = UQ + (tok0 + F.wave * 16 + fr) * 2048 + kg * 16; const unsigned char* bp = WQ + (size_t)fr * 2048 + kg * 16;
          pg8::v4i_t a0 = (pg8::v4i_t){0, 0, 0, 0}, a1 = a0;
#pragma unroll 8
          for (int ks = 0; ks < 32; ++ks) { const pg8::v4i_t av = *(const pg8::v4i_t*)(ap + ks * 64), b0 = *(const pg8::v4i_t*)(bp + ks * 64), b1 = *(const pg8::v4i_t*)(bp + 16 * 2048 + ks * 64);
              a0 = __builtin_amdgcn_mfma_i32_16x16x64_i8(av, b0, a0, 0, 0, 0); a1 = __builtin_amdgcn_mfma_i32_16x16x64_i8(av, b1, a1, 0, 0, 0); }
          const float c0 = wsc[fr], c1 = wsc[16 + fr];
#pragma unroll
          for (int i = 0; i < 4; ++i) { const int tl = F.wave * 16 + kg * 4 + i; const float rs = usc[tok0 + tl]; dtl[tl * 32 + fr] = (float)a0[i] * rs * c0; dtl[tl * 32 + 16 + fr] = (float)a1[i] * rs * c1; } }
        __syncthreads();
#pragma unroll 1
        for (int hh = 0; hh < 3; ++hh) { const int h = F.wave + 8 * hh; const float bias = F.in[6][h], a = -expf(F.in[7][h]);
            float dt2[2], c2[2];
#pragma unroll
            for (int j = 0; j < 2; ++j) { const float r = dtl[(2 * F.lane + j) * 32 + h] + bias; dt2[j] = fmaxf(r, 0.f) + log1pf(expf(-fabsf(r))); }
            c2[0] = dt2[0] * a; c2[1] = c2[0] + dt2[1] * a;
            float sc = c2[1];
#pragma unroll
            for (int o = 1; o < 64; o <<= 1) { const float t = __shfl_up(sc, o); if (F.lane >= o) sc += t; }
            const float ex = sc - c2[1]; const float alast = __shfl(sc, 63);
            const float ac0 = ex + c2[0], ac1 = ex + c2[1];
            *(f32x2*)(DTT + ((size_t)bc * 24 + h) * 128 + 2 * F.lane) = (f32x2){dt2[0], dt2[1]};
            *(f32x2*)(ACT + ((size_t)bc * 24 + h) * 128 + 2 * F.lane) = (f32x2){ac0, ac1};
            *(f32x2*)(WL + ((size_t)bc * 24 + h) * 128 + spos(2 * F.lane)) = (f32x2){dt2[0] * __expf(alast - ac0), dt2[1] * __expf(alast - ac1)};
        }
        __syncthreads();
    }
}

DI void p_ssd_local(const Frame& F) {
    const bf16* XT = WSP(bf16, WS_XT); const bf16* BT = WSP(bf16, WS_BT); const float* WL = WSP(float, WS_WL);
    bf16* STATE = (bf16*)((unsigned char*)F.out + OUT_STATE);
    const int lane = F.lane, fr = lane & 15, kg = lane >> 4, w = F.wave, g = w >> 1;
    for (int bc = blockIdx.x; bc < NCHUNK; bc += F.G) {
        __syncthreads();
#pragma unroll
        for (int i = 0; i < 16; ++i) { const int id = F.tid + 512 * i, row = id >> 4, c = id & 15;
            *(LAS u32x4*)(F.lds + row * 256 + ((c ^ (row & 15)) << 4)) = *(const u32x4*)(BT + ((size_t)bc * 512 + row) * 128 + c * 8); }
        __syncthreads();
#pragma unroll 1
        for (int r = 0; r < 3; ++r) {
            const int h = 3 * w + r;
            const float* wlp = WL + ((size_t)bc * 24 + h) * 128 + kg * 8;
            const bf16* xp = XT + ((size_t)bc * 1536 + h * 64 + fr) * 128 + kg * 8;
            u32x4 xr[4][4]; f32x4 wv[4][2];
#pragma unroll
            for (int k = 0; k < 4; ++k) { wv[k][0] = *(const f32x4*)(wlp + k * 32); wv[k][1] = *(const f32x4*)(wlp + k * 32 + 4);
#pragma unroll
                for (int pt = 0; pt < 4; ++pt) xr[pt][k] = *(const u32x4*)(xp + (size_t)pt * 16 * 128 + k * 32); }
            bf16x8 xs[4][4];
#pragma unroll
            for (int k = 0; k < 4; ++k)
#pragma unroll
                for (int pt = 0; pt < 4; ++pt) { float f[8]; pg8::unpack8(xr[pt][k], f);
#pragma unroll
                    for (int j = 0; j < 4; ++j) { f[j] *= wv[k][0][j]; f[4 + j] *= wv[k][1][j]; }
                    xs[pt][k] = pack8(f); }
            bf16* st = STATE + ((size_t)bc * 24 + h) * 8192;
#pragma unroll 1
            for (int nh = 0; nh < 2; ++nh) {
                f32x4 acc[4][4];
#pragma unroll
                for (int a = 0; a < 4; ++a)
#pragma unroll
                    for (int b = 0; b < 4; ++b) acc[a][b] = (f32x4){0.f, 0.f, 0.f, 0.f};
#pragma unroll
                for (int nt = 0; nt < 4; ++nt) {
#pragma unroll
                    for (int k = 0; k < 4; ++k) { const bf16x8 bfr = *(const LAS bf16x8*)(F.lds + (g * 128 + nh * 64 + nt * 16 + fr) * 256 + (((k * 4 + kg) ^ fr) << 4));
#pragma unroll
                        for (int pt = 0; pt < 4; ++pt) acc[nt][pt] = MFMA16(bfr, xs[pt][k], acc[nt][pt]); }
                    __builtin_amdgcn_sched_barrier(0); }
#pragma unroll
                for (int nt = 0; nt < 4; ++nt)
#pragma unroll
                    for (int pt = 0; pt < 4; ++pt) { u32x2 wq; wq.x = pk2(acc[nt][pt][0], acc[nt][pt][1]); wq.y = pk2(acc[nt][pt][2], acc[nt][pt][3]);
                        *(u32x2*)(st + (size_t)(pt * 16 + fr) * 128 + nh * 64 + nt * 16 + kg * 4) = wq; }
            }
        }
    }
    __syncthreads();
}

DI void p_sb_attn(const Frame& F) {
    const bf16* QKV = WSP(bf16, WS_QKV); const bf16* VT = (const bf16*)((const unsigned char*)F.out + OUT_VT); bf16* YSB = WSP(bf16, WS_RA);
    const int lane = F.lane, fr = lane & 15, kg = lane >> 4;
    const float scale = 0.08838834764831845f;
    for (int u = F.gw; u < BATCH * SB_H * (SEQ / 16); u += F.NGW) {
        const int bh = u / (SEQ / 16), strip = u % (SEQ / 16), b = bh / SB_H, h = bh % SB_H;
        const int q0 = strip * 16, t = q0 + fr; const size_t tb = (size_t)b * SEQ;
        bf16x8 qf[4];
#pragma unroll
        for (int k = 0; k < 4; ++k) qf[k] = *(const bf16x8*)(QKV + (tb + t) * 1536 + h * 128 + k * 32 + kg * 8);
        f32x4 o[8];
#pragma unroll
        for (int d = 0; d < 8; ++d) o[d] = (f32x4){0.f, 0.f, 0.f, 0.f};
        float R = 0.f;
        bf16x8 kc[2][4];
#pragma unroll
        for (int st = 0; st < 2; ++st)
#pragma unroll
            for (int k = 0; k < 4; ++k) kc[st][k] = *(const bf16x8*)(QKV + (tb + (q0 >> 5) * 32 + st * 16 + fr) * 1536 + 512 + h * 128 + kg * 8 + k * 32);
#pragma unroll 1
        for (int kb = q0 >> 5; kb >= 0; --kb) {
            const int sb = kb * 32;
            bf16x8 vfr[8], kn[2][4];
            { const int bcv = (int)((tb + sb) >> 7), sl = (sb & 127) + kg * 8;
#pragma unroll
              for (int d = 0; d < 8; ++d) vfr[d] = *(const bf16x8*)(VT + ((size_t)bcv * 512 + h * 128 + d * 16 + fr) * 128 + sl); }
            { const int sbn = kb > 0 ? sb - 32 : sb;
#pragma unroll
              for (int st = 0; st < 2; ++st)
#pragma unroll
                  for (int k = 0; k < 4; ++k) kn[st][k] = *(const bf16x8*)(QKV + (tb + sbn + st * 16 + fr) * 1536 + 512 + h * 128 + kg * 8 + k * 32); }
            f32x4 z[2];
#pragma unroll
            for (int st = 0; st < 2; ++st) { z[st] = (f32x4){0.f, 0.f, 0.f, 0.f};
#pragma unroll
                for (int k = 0; k < 4; ++k) z[st] = MFMA16(kc[st][k], qf[k], z[st]); }
            float lb[2][4], lk[2][4], tot[2];
#pragma unroll
            for (int st = 0; st < 2; ++st) { tot[st] = 0.f;
#pragma unroll
                for (int i = 0; i < 4; ++i) { const int s = sb + st * 16 + kg * 4 + i; const float zz = z[st][i] * scale;
                    const float l = fminf(zz, 0.f) - __logf(1.0f + __expf(-fabsf(zz)));
                    lb[st][i] = l; lk[st][i] = (s < t) ? (l - zz) : 0.f; tot[st] += lk[st][i]; } }
            float hi[2], all[2];
#pragma unroll
            for (int st = 0; st < 2; ++st) { const float t1 = __shfl_xor(tot[st], 16), t2 = __shfl_xor(tot[st], 32), t3 = __shfl_xor(tot[st], 48);
                all[st] = tot[st] + t1 + t2 + t3;
                hi[st] = (((kg ^ 1) > kg) ? t1 : 0.f) + (((kg ^ 2) > kg) ? t2 : 0.f) + (((kg ^ 3) > kg) ? t3 : 0.f); }
            float att[8];
#pragma unroll
            for (int st = 0; st < 2; ++st) { const float base = R + hi[st] + (st == 0 ? all[1] : 0.f);
                float suf = 0.f;
#pragma unroll
                for (int i = 3; i >= 0; --i) { const int s = sb + st * 16 + kg * 4 + i; att[st * 4 + i] = (s < t) ? __expf(lb[st][i] + base + suf) : 0.f; suf += lk[st][i]; } }
            R += all[0] + all[1];
            const bf16x8 pf = pack8(att);
#pragma unroll
            for (int d = 0; d < 8; ++d) o[d] = MFMA16(vfr[d], pf, o[d]);
            if (__all(R < -30.0f)) break;
#pragma unroll
            for (int st = 0; st < 2; ++st)
#pragma unroll
                for (int k = 0; k < 4; ++k) kc[st][k] = kn[st][k];
        }
#pragma unroll
        for (int d = 0; d < 8; ++d) { u32x2 w; w.x = pk2(o[d][0], o[d][1]); w.y = pk2(o[d][2], o[d][3]);
            *(u32x2*)(YSB + (tb + t) * 2048 + 1536 + h * 128 + d * 16 + kg * 4) = w; }
    }
}

DI void p_ssd_scan(const Frame& F) {
    bf16* STATE = (bf16*)((unsigned char*)F.out + OUT_STATE); const float* ACT = WSP(float, WS_ACT);
    const int gt = blockIdx.x * 512 + F.tid, NT = F.G * 512;
    for (int e = gt; e < BATCH * SSD_HEADS * 2048; e += NT) {
        const int v4 = e & 2047, bh = e >> 11, b = bh / SSD_HEADS, h = bh % SSD_HEADS;
        f32x4 run = (f32x4){0.f, 0.f, 0.f, 0.f};
        for (int c0 = 0; c0 < 128; c0 += 8) {
            u32x2 tmp[8]; float dec[8];
#pragma unroll
            for (int j = 0; j < 8; ++j) { const size_t bc = (size_t)b * 128 + c0 + j; tmp[j] = *(const u32x2*)(STATE + (bc * 24 + h) * 8192 + v4 * 4); dec[j] = __expf(ACT[(bc * 24 + h) * 128 + 127]); }
#pragma unroll
            for (int j = 0; j < 8; ++j) { const size_t bc = (size_t)b * 128 + c0 + j;
                u32x2 w; w.x = pk2(run[0], run[1]); w.y = pk2(run[2], run[3]); *(u32x2*)(STATE + (bc * 24 + h) * 8192 + v4 * 4) = w;
                const f32x4 t4 = (f32x4){__uint_as_float(tmp[j].x << 16), __uint_as_float(tmp[j].x & 0xffff0000u), __uint_as_float(tmp[j].y << 16), __uint_as_float(tmp[j].y & 0xffff0000u)};
                run = run * dec[j] + t4; }
        }
    }
}

DI int cb_off(int t, int s) { return t * 256 + ((((s >> 2) ^ (2 * (t & 15))) << 3) | ((s & 3) << 1)); }
constexpr int SSQ_OFF = RING_BYTES + 1024, TAB_OFF = RING_BYTES + 5120;
DI void p_ssd_out(const Frame& F) {
    const bf16* XT = WSP(bf16, WS_XT); const bf16* BN = WSP(bf16, WS_BN); const bf16* CN = WSP(bf16, WS_CN); const bf16* Z = WSP(bf16, WS_Z);
    const float* DTT = WSP(float, WS_DTT); const float* ACT = WSP(float, WS_ACT); const bf16* STATE = (const bf16*)((const unsigned char*)F.out + OUT_STATE);
    bf16* YG = WSP(bf16, WS_RA); float* RSTD = WSP(float, WS_RSTD);
    const float* dskip = F.in[8];
    const int lane = F.lane, fr = lane & 15, kg = lane >> 4, w = F.wave, g = w >> 1;
    LAS unsigned char* cbl = F.lds + g * 32768;
    LAS float* tab = (LAS float*)(F.lds + TAB_OFF + w * 1024);
    LAS float* ssqp = (LAS float*)(F.lds + SSQ_OFF);
    for (int bc = blockIdx.x; bc < NCHUNK; bc += F.G) {
        const size_t tok0 = (size_t)bc * 128;
        REP(22)
#pragma unroll 1
        for (int q = 0; q < 4; ++q) { const int tt = (w & 1) + 2 * q;
            bf16x8 cf[4];
#pragma unroll
            for (int k = 0; k < 4; ++k) cf[k] = *(const bf16x8*)(CN + (tok0 + tt * 16 + fr) * 512 + g * 128 + k * 32 + kg * 8);
#pragma unroll 1
            for (int st = 0; st <= tt; ++st) { f32x4 X = (f32x4){0.f, 0.f, 0.f, 0.f}; const bf16* bp = BN + (tok0 + st * 16 + fr) * 512 + g * 128 + kg * 8;
#pragma unroll
                for (int k = 0; k < 4; ++k) X = MFMA16(*(const bf16x8*)(bp + k * 32), cf[k], X);
                u32x2 pw; pw.x = pk2(X[0], X[1]); pw.y = pk2(X[2], X[3]);
                *(LAS u32x2*)(cbl + cb_off(tt * 16 + fr, st * 16 + kg * 4)) = pw; } }
        __syncthreads();
        REP(23) {
        ssqp[w * 128 + lane] = 0.f; ssqp[w * 128 + 64 + lane] = 0.f;
#pragma unroll 1
        for (int r = 0; r < 3; ++r) {
            const int h = 3 * w + r; const float dsk = dskip[h];
            { const f32x2 d2 = *(const f32x2*)(DTT + ((size_t)bc * 24 + h) * 128 + 2 * lane), a2 = *(const f32x2*)(ACT + ((size_t)bc * 24 + h) * 128 + 2 * lane);
              *(LAS f32x2*)(tab + 2 * lane) = d2; *(LAS f32x2*)(tab + 128 + 2 * lane) = a2; }
            bf16x8 sf[4][4], xf0[4], xfA[4];
            const bf16* xbase = XT + ((size_t)bc * 1536 + h * 64) * 128;
            { unsigned so = (unsigned)(fr * 128 + kg * 8); asm volatile("" : "+v"(so));
              const bf16* sp0 = STATE + ((size_t)bc * 24 + h) * 8192;
#pragma unroll
              for (int pt = 0; pt < 4; ++pt) {
#pragma unroll
                  for (int k = 0; k < 4; ++k) sf[pt][k] = *(const bf16x8*)(sp0 + (so + (unsigned)(pt * 2048 + k * 32)));
                  xf0[pt] = *(const bf16x8*)(xbase + (so + (unsigned)(pt * 2048))); } }
            LDS_WAIT();
#define SSD_STEP(SP, XF) do { float mv[8]; \
        _Pragma("unroll") for (int half = 0; half < 2; ++half) { const int sbase = 32 * (SP) + 16 * half + kg * 4; \
            const u32x2 cbv = *(const LAS u32x2*)(cbl + cb_off(tl, sbase)); \
            const f32x4 dv = *(const LAS f32x4*)(tab + sbase), av = *(const LAS f32x4*)(tab + 128 + sbase); \
            const float cbf[4] = {__uint_as_float(cbv.x << 16), __uint_as_float(cbv.x & 0xffff0000u), __uint_as_float(cbv.y << 16), __uint_as_float(cbv.y & 0xffff0000u)}; \
            _Pragma("unroll") for (int i = 0; i < 4; ++i) { const int s_ = sbase + i; float v = 0.f; \
                if (s_ <= tl) v = cbf[i] * dv[i] * __expf(acum_t - av[i]); \
                if (s_ == tl) v += dsk; \
                mv[half * 4 + i] = v; } } \
        const bf16x8 mf = pack8(mv); \
        _Pragma("unroll") for (int pt = 0; pt < 4; ++pt) acc[pt] = MFMA16(XF[pt], mf, acc[pt]); } while (0)
#define SSD_LOADX(XF, SP) do { unsigned xo_ = (unsigned)(fr * 128 + kg * 8 + 32 * (SP)); asm volatile("" : "+v"(xo_)); \
        _Pragma("unroll") for (int pt = 0; pt < 4; ++pt) XF[pt] = *(const bf16x8*)(xbase + (xo_ + (unsigned)(pt * 2048))); } while (0)
#pragma unroll 1
            for (int tt = 0; tt < 8; ++tt) {
                int frx = fr; asm volatile("" : "+v"(frx));
                const int tl = tt * 16 + frx; const size_t tok = tok0 + tl; float ssq = 0.f;
                bf16x8 cf[4]; u32x2 zr[4];
                if (tt >= 2) SSD_LOADX(xfA, 1);
                const float acum_t = tab[128 + tl];
                f32x4 acc[4];
#pragma unroll
                for (int pt = 0; pt < 4; ++pt) acc[pt] = (f32x4){0.f, 0.f, 0.f, 0.f};
                SSD_STEP(0, xf0);
#pragma unroll
                for (int k = 0; k < 4; ++k) cf[k] = *(const bf16x8*)(CN + tok * 512 + g * 128 + k * 32 + kg * 8);
                if (tt >= 2) { SSD_STEP(1, xfA); if (tt >= 4) SSD_LOADX(xfA, 2); }
                if (tt >= 4) { SSD_STEP(2, xfA); if (tt >= 6) SSD_LOADX(xfA, 3); }
                if (tt >= 6) { SSD_STEP(3, xfA); }
#pragma unroll
                for (int pt = 0; pt < 4; ++pt) zr[pt] = *(const u32x2*)(Z + tok * 1536 + h * 64 + pt * 16 + kg * 4);
                { f32x4 ao[4];
#pragma unroll
                  for (int pt = 0; pt < 4; ++pt) ao[pt] = (f32x4){0.f, 0.f, 0.f, 0.f};
#pragma unroll
                  for (int k = 0; k < 4; ++k)
#pragma unroll
                      for (int pt = 0; pt < 4; ++pt) ao[pt] = MFMA16(sf[pt][k], cf[k], ao[pt]);
                  const float e = __expf(acum_t);
#pragma unroll
                  for (int pt = 0; pt < 4; ++pt) acc[pt] = ao[pt] * e + acc[pt]; }
#pragma unroll
                for (int pt = 0; pt < 4; ++pt) { const int col = h * 64 + pt * 16 + kg * 4;
                    const float z0 = __uint_as_float(zr[pt].x << 16), z1 = __uint_as_float(zr[pt].x & 0xffff0000u), z2 = __uint_as_float(zr[pt].y << 16), z3 = __uint_as_float(zr[pt].y & 0xffff0000u);
                    const float y0 = acc[pt][0] * silu_f(z0), y1 = acc[pt][1] * silu_f(z1), y2 = acc[pt][2] * silu_f(z2), y3 = acc[pt][3] * silu_f(z3);
                    ssq += (y0 * y0 + y1 * y1) + (y2 * y2 + y3 * y3);
                    u32x2 wv; wv.x = pk2(y0, y1); wv.y = pk2(y2, y3); *(u32x2*)(YG + tok * 2048 + col) = wv; }
                ssq += __shfl_xor(ssq, 16); ssq += __shfl_xor(ssq, 32);
                if (kg == 0) ssqp[w * 128 + tl] += ssq;
            }
            LDS_WAIT();
        }
        }
#undef SSD_STEP
#undef SSD_LOADX
        __syncthreads();
        if (F.tid < 128) { float v = 0.f;
#pragma unroll
            for (int ww = 0; ww < 8; ++ww) v += ssqp[ww * 128 + F.tid];
            RSTD[tok0 + F.tid] = 1.0f / sqrtf(v * (1.0f / 1536.0f) + EPS); }
        __syncthreads();
    }
}

DI void p_quant_rows(const Frame& F, const bf16* src, unsigned char* dst, float* sc, int rows) {
    const int lane = F.lane;
    for (int m = F.gw; m < rows; m += F.NGW) {
        const u32x4* sr = (const u32x4*)(src + (size_t)m * 2048) + lane; u32x4 v[4]; float f[4][8]; float mx = 0.f;
#pragma unroll
        for (int j = 0; j < 4; ++j) v[j] = sr[64 * j];
#pragma unroll
        for (int j = 0; j < 4; ++j) { pg8::unpack8(v[j], f[j]);
#pragma unroll
            for (int e = 0; e < 8; ++e) mx = fmaxf(mx, fabsf(f[j][e])); }
#pragma unroll
        for (int o = 1; o < 64; o <<= 1) mx = fmaxf(mx, __shfl_xor(mx, o));
        const float inv = mx > 0.f ? 127.0f / mx : 0.f;
        u32x2* dr = (u32x2*)(dst + (size_t)m * 2048) + lane;
#pragma unroll
        for (int j = 0; j < 4; ++j) { u32x2 q; q.x = pk4_i8(f[j][0] * inv, f[j][1] * inv, f[j][2] * inv, f[j][3] * inv); q.y = pk4_i8(f[j][4] * inv, f[j][5] * inv, f[j][6] * inv, f[j][7] * inv); dr[64 * j] = q; }
        if (lane == 0) sc[m] = mx * (1.0f / 127.0f);
    }
}
DI void p_xattn(const Frame& F) {
    const bf16* Q2 = WSP(bf16, WS_Q2); const bf16* KX = WSP(bf16, WS_KX); const bf16* VXT = WSP(bf16, WS_VXT); bf16* O2 = WSP(bf16, WS_O2);
    const int lane = F.lane, fr = lane & 15, kg = lane >> 4;
    const float scale = 0.08838834764831845f;
    LAS unsigned char* kl = F.lds; LAS unsigned char* vl = F.lds + 65536;
    for (int task = blockIdx.x; task < 256; task += F.G) {
        const int bh = task >> 5, b = bh >> 2, h = bh & 3;
        __syncthreads();
#pragma unroll
        for (int i = 0; i < 8; ++i) { const int id = F.tid + 512 * i;
            { const int m = id >> 4, c = id & 15; *(LAS u32x4*)(kl + m * 256 + ((c ^ (m & 15)) << 4)) = *(const u32x4*)(KX + ((size_t)b * 256 + m) * 512 + h * 128 + c * 8); }
            { const int d = id >> 5, mc = id & 31, blk = mc >> 2, h2 = (mc >> 1) & 1, q = 2 * (mc & 1);
              const u32x4 v = *(const u32x4*)(VXT + ((size_t)h * 128 + d) * 512 + b * 256 + mc * 8);
              *(LAS u32x2*)(vl + d * 512 + (((blk * 4 + q) ^ (d & 15)) << 4) + 8 * h2) = (u32x2){v.x, v.y};
              *(LAS u32x2*)(vl + d * 512 + (((blk * 4 + q + 1) ^ (d & 15)) << 4) + 8 * h2) = (u32x2){v.z, v.w}; } }
        __syncthreads();
#pragma unroll 1
        for (int si = 0; si < 4; ++si) {
            const int strip = (task & 31) * 32 + F.wave * 4 + si;
            const size_t tok = (size_t)b * SEQ + strip * 16 + fr;
            bf16x8 qf[4];
#pragma unroll
            for (int k = 0; k < 4; ++k) qf[k] = *(const bf16x8*)(Q2 + tok * 512 + h * 128 + k * 32 + kg * 8);
            f32x4 sc[16];
#pragma unroll
            for (int mt = 0; mt < 16; ++mt) { sc[mt] = (f32x4){0.f, 0.f, 0.f, 0.f};
#pragma unroll
                for (int k = 0; k < 4; ++k) sc[mt] = MFMA16(*(const LAS bf16x8*)(kl + (mt * 16 + fr) * 256 + (((k * 4 + kg) ^ fr) << 4)), qf[k], sc[mt]);
                if (mt & 1) __builtin_amdgcn_sched_barrier(0); }
            float mx = -3.0e38f;
#pragma unroll
            for (int mt = 0; mt < 16; ++mt)
#pragma unroll
                for (int i = 0; i < 4; ++i) { sc[mt][i] *= scale; mx = fmaxf(mx, sc[mt][i]); }
            mx = fmaxf(mx, __shfl_xor(mx, 16)); mx = fmaxf(mx, __shfl_xor(mx, 32));
            float sum = 0.f;
#pragma unroll
            for (int mt = 0; mt < 16; ++mt)
#pragma unroll
                for (int i = 0; i < 4; ++i) { const float p = __expf(sc[mt][i] - mx); sc[mt][i] = p; sum += p; }
            sum += __shfl_xor(sum, 16); sum += __shfl_xor(sum, 32);
            const float inv = __builtin_amdgcn_rcpf(sum);
            f32x4 o[8];
#pragma unroll
            for (int d = 0; d < 8; ++d) o[d] = (f32x4){0.f, 0.f, 0.f, 0.f};
#pragma unroll
            for (int q = 0; q < 8; ++q) {
                float pv[8];
#pragma unroll
                for (int i = 0; i < 4; ++i) { pv[i] = sc[2 * q][i] * inv; pv[4 + i] = sc[2 * q + 1][i] * inv; }
                const bf16x8 pf = pack8(pv);
#pragma unroll
                for (int d = 0; d < 8; ++d) o[d] = MFMA16(*(const LAS bf16x8*)(vl + (d * 16 + fr) * 512 + (((q * 4 + kg) ^ fr) << 4)), pf, o[d]);
                __builtin_amdgcn_sched_barrier(0);
            }
#pragma unroll
            for (int d = 0; d < 8; ++d) { u32x2 w; w.x = pk2(o[d][0], o[d][1]); w.y = pk2(o[d][2], o[d][3]);
                *(u32x2*)(O2 + tok * 512 + h * 128 + d * 16 + kg * 4) = w; }
        }
    }
    __syncthreads();
}

DI void p_router(const Frame& F) {
    const bf16* HB = WSP(bf16, WS_RA); const bf16* WR = WSP(bf16, WS_WR_T); const float* SSQ2 = WSP(float, WS_SSQ2);
    int* TI = WSP(int, WS_TI); float* TG = WSP(float, WS_TG); unsigned* ecnt = WSP(unsigned, WS_CTL) + CW_ECNT;
    const int lane = F.lane, fr = lane & 15, kg = lane >> 4;
    LAS unsigned char* bl = F.lds; LAS float* lg = (LAS float*)(F.lds + 65536); LAS unsigned* lcnt = (LAS unsigned*)(F.lds + 65536 + 24576);
    for (int task = blockIdx.x; task < T / 128; task += F.G) {
        const size_t tok0 = (size_t)task * 128;
        f32x4 acc[3];
#pragma unroll
        for (int n = 0; n < 3; ++n) acc[n] = (f32x4){0.f, 0.f, 0.f, 0.f};
#pragma unroll 1
        for (int kc = 0; kc < 4; ++kc) {
            __syncthreads();
#pragma unroll
            for (int i = 0; i < 6; ++i) { const int id = F.tid + 512 * i, row = id >> 6, c = id & 63;
                *(LAS u32x4*)(bl + row * 1024 + ((c ^ (row & 15)) << 4)) = *(const u32x4*)(WR + (size_t)row * 2048 + kc * 512 + c * 8); }
            bf16x8 af[16];
            const bf16* ap = HB + (tok0 + F.wave * 16 + fr) * 2048 + kc * 512 + kg * 8;
#pragma unroll
            for (int ks = 0; ks < 16; ++ks) af[ks] = *(const bf16x8*)(ap + ks * 32);
            __syncthreads();
#pragma unroll
            for (int ks = 0; ks < 16; ++ks) {
#pragma unroll
                for (int n = 0; n < 3; ++n) acc[n] = MFMA16(af[ks], *(const LAS bf16x8*)(bl + (n * 16 + fr) * 1024 + (((ks * 4 + kg) ^ fr) << 4)), acc[n]);
                if ((ks & 3) == 3) __builtin_amdgcn_sched_barrier(0); }
        }
        if (F.tid < 64) lcnt[F.tid] = 0u;
#pragma unroll
        for (int i = 0; i < 4; ++i) { const int rl = F.wave * 16 + kg * 4 + i; const float rs = rstd32(SSQ2 + (tok0 + rl) * 32);
#pragma unroll
            for (int n = 0; n < 3; ++n) lg[rl * 48 + n * 16 + fr] = acc[n][i] * rs; }
        __syncthreads();
        unsigned lp1 = 0, lp2 = 0; int ex1 = 0, ex2 = 0; float w1 = 0.f, w2 = 0.f, ggate = 0.f;
        if (F.tid < 128) {
            const LAS float* l = lg + F.tid * 48;
            float gl[4] = {l[0], l[1], l[2], l[3]};
            int gs = 0; float gm = gl[0];
#pragma unroll
            for (int j = 1; j < 4; ++j) if (gl[j] > gm) { gm = gl[j]; gs = j; }
            float den = 0.f;
#pragma unroll
            for (int j = 0; j < 4; ++j) den += expf(gl[j] - gm);
            ggate = 1.0f / den;
            float el[8];
#pragma unroll
            for (int j = 0; j < 8; ++j) el[j] = l[4 + gs * 8 + j];
            int i1 = 0; float v1 = el[0];
#pragma unroll
            for (int j = 1; j < 8; ++j) if (el[j] > v1) { v1 = el[j]; i1 = j; }
            int i2 = -1; float v2 = -3.0e38f;
#pragma unroll
            for (int j = 0; j < 8; ++j) if (j != i1 && el[j] > v2) { v2 = el[j]; i2 = j; }
            const float e2 = expf(v2 - v1); w1 = 1.0f / (1.0f + e2); w2 = e2 / (1.0f + e2);
            ex1 = gs * 8 + i1; ex2 = gs * 8 + i2;
            lp1 = atomicAdd((unsigned*)&lcnt[ex1], 1u); lp2 = atomicAdd((unsigned*)&lcnt[ex2], 1u);
        }
        __syncthreads();
        if (F.tid < 32) lcnt[32 + F.tid] = __hip_atomic_fetch_add(ecnt + F.tid, lcnt[F.tid], __ATOMIC_RELAXED, __HIP_MEMORY_SCOPE_AGENT);
        __syncthreads();
        if (F.tid < 128) { const int t = (int)tok0 + F.tid;
            TI[t * 4 + 0] = ex1; TI[t * 4 + 1] = (int)(lcnt[32 + ex1] + lp1); TI[t * 4 + 2] = ex2; TI[t * 4 + 3] = (int)(lcnt[32 + ex2] + lp2);
            TG[t * 2 + 0] = w1 * ggate; TG[t * 2 + 1] = w2 * ggate; }
    }
    __syncthreads();
}
DI void p_route_b(const Frame& F) {
    const int* TI = WSP(int, WS_TI); int* TSLOT = WSP(int, WS_TSLOT); int* SLOTTOK = WSP(int, WS_SLOTTOK); int* TILEE = WSP(int, WS_TILEE);
    unsigned* ecnt = WSP(unsigned, WS_CTL) + CW_ECNT; const float* SSQ2 = WSP(float, WS_SSQ2); float* SRSTD = WSP(float, WS_SRSTD);
    LAS int* st = (LAS int*)(F.lds);
    if (F.tid < 32) st[64 + F.tid] = (int)__hip_atomic_load(ecnt + F.tid, __ATOMIC_RELAXED, __HIP_MEMORY_SCOPE_AGENT);
    __syncthreads();
    if (F.tid == 0) { int s = 0; for (int e = 0; e < 32; ++e) { st[e] = s; s += (st[64 + e] + 255) / 256 * 256; } st[32] = s; }
    __syncthreads();
    for (int t = blockIdx.x * 512 + F.tid; t < T; t += F.G * 512) {
        const int e1 = TI[t * 4 + 0], p1 = TI[t * 4 + 1], e2 = TI[t * 4 + 2], p2 = TI[t * 4 + 3];
        const int s1 = st[e1] + p1, s2 = st[e2] + p2;
        SLOTTOK[s1] = t; SLOTTOK[s2] = t; TSLOT[t * 2] = s1; TSLOT[t * 2 + 1] = s2;
        const float rs = rstd32(SSQ2 + (size_t)t * 32); SRSTD[s1] = rs; SRSTD[s2] = rs;
    }
    for (int e = blockIdx.x; e < 32; e += F.G) {
        const int a = st[e] + st[64 + e], bnd = st[e + 1];
        for (int s = a + F.tid; s < bnd; s += 512) { SLOTTOK[s] = 0; SRSTD[s] = 0.f; }
        for (int tl = st[e] / 256 + F.tid; tl < bnd / 256; tl += 512) TILEE[tl] = e;
    }
    if (blockIdx.x == 0 && F.tid == 0) TILEE[511] = st[32] / 256;
    __syncthreads();
}

DI void p_final(const Frame& F) {
    const unsigned char* Y = WSP(unsigned char, WS_Y); const bf16* HB = WSP(bf16, WS_RA); const int* TSLOT = WSP(int, WS_TSLOT); const float* TG = WSP(float, WS_TG); const float* w = F.in[25];
    for (int m = F.gw; m < T; m += F.NGW) {
        const int s1 = TSLOT[m * 2], s2 = TSLOT[m * 2 + 1]; const float g1 = TG[m * 2] * (1.0f / Y_SCALE), g2 = TG[m * 2 + 1] * (1.0f / Y_SCALE);
        const u32x2* hr = (const u32x2*)(HB + (size_t)m * 2048) + F.lane; const unsigned* y1 = (const unsigned*)(Y + (size_t)s1 * 2048) + F.lane; const unsigned* y2 = (const unsigned*)(Y + (size_t)s2 * 2048) + F.lane;
        f32x4 v[8]; float s = 0.f;
#pragma unroll
        for (int j = 0; j < 8; ++j) { const u32x2 hh = hr[64 * j]; const unsigned a = y1[64 * j], b = y2[64 * j];
            const f32x2 a01 = __builtin_amdgcn_cvt_pk_f32_fp8((int)a, false), a23 = __builtin_amdgcn_cvt_pk_f32_fp8((int)a, true), b01 = __builtin_amdgcn_cvt_pk_f32_fp8((int)b, false), b23 = __builtin_amdgcn_cvt_pk_f32_fp8((int)b, true);
            v[j].x = __uint_as_float(hh.x << 16) + g1 * a01[0] + g2 * b01[0]; v[j].y = __uint_as_float(hh.x & 0xffff0000u) + g1 * a01[1] + g2 * b01[1];
            v[j].z = __uint_as_float(hh.y << 16) + g1 * a23[0] + g2 * b23[0]; v[j].w = __uint_as_float(hh.y & 0xffff0000u) + g1 * a23[1] + g2 * b23[1];
            s += (v[j].x * v[j].x + v[j].y * v[j].y) + (v[j].z * v[j].z + v[j].w * v[j].w); }
        const float rstd = 1.0f / sqrtf(wave_sum(s) * (1.0f / 2048.0f) + EPS);
        const f32x4* wr4 = (const f32x4*)w + F.lane; f32x4* xr = (f32x4*)(F.out + (size_t)m * 2048) + F.lane;
#pragma unroll
        for (int j = 0; j < 8; ++j) { const f32x4 ww = wr4[64 * j]; xr[64 * j] = v[j] * rstd * ww; }
    }
}

constexpr int NPHASE = 20;
struct Args { const float* in[26]; float* out; unsigned char* ws; int ph_lo, ph_hi; };
__global__ void __launch_bounds__(NWAVES * 64, 2) fwd(Args args) {
    extern __shared__ __attribute__((aligned(16))) unsigned char lds[];
    Frame F;
    F.lds = (LAS unsigned char*)lds;
    F.tid = threadIdx.x; F.lane = F.tid & 63; F.wave = __builtin_amdgcn_readfirstlane(F.tid >> 6);
    F.G = gridDim.x; F.gw = blockIdx.x * NWAVES + F.wave; F.NGW = F.G * NWAVES;
#pragma unroll
    for (int i = 0; i < 26; ++i) F.in[i] = args.in[i];
    F.out = args.out; F.ws = args.ws; F.pacc = nullptr;
    volatile LAS unsigned* MISC = (volatile LAS unsigned*)(F.lds + MISC_OFF);
    for (int u = F.tid; u < (LDS_BYTES - RING_BYTES) / 4; u += NWAVES * 64) ((LAS unsigned*)(F.lds + RING_BYTES))[u] = 0u;
    __syncthreads();
    const int lo = args.ph_lo, hi = args.ph_hi;
    const bool one = (hi - lo) > 1;
    XcdBarrier bar; bar.bar = WSP(unsigned, WS_CTL) + CW_BAR; bar.x = 0; bar.st = nullptr;
    if (one) bar = xcd_barrier_post(WSP(unsigned, WS_CTL) + CW_BAR, MISC + 8);
#define IN(k) (lo <= (k) && (k) < hi)
#define SEAM(k) do { if (lo <= (k) && (k) + 1 < hi) xcd_barrier(bar); } while (0)
    LAS unsigned char* ring = F.lds;
    const int bx = blockIdx.x;
    unsigned long long pt0 = 0, pt1 = 0, psub = 0;
    if (PROBE_PHASE >= 120) F.pacc = &psub;
#define PB(k) do { if ((k) == PROBE_PHASE) pt0 = __builtin_amdgcn_s_memrealtime(); } while (0)
#define PE(k) do { if ((k) == PROBE_PHASE) pt1 = __builtin_amdgcn_s_memrealtime(); } while (0)
    const int vcu = (F.G % 8 == 0) ? (bx % 8) * (F.G / 8) + bx / 8 : bx;

    if (IN(0)) REP(0) { PB(0); p0_prologue(F); SEAM(0); PE(0); }
    if (IN(7)) REP(7) { PB(7); win_quant(F); SEAM(7); PE(7); }
    if (IN(1)) REP(1) { PB(1);
        pg8::Gemm g{(const unsigned char*)F.out + OUT_UQ, (const unsigned char*)F.out + OUT_WQI, 2048, 2048, 2048, nullptr, nullptr, 0};
        pg8::StaticOrder S; S.init(T, IN_PAD - 256, 2048, F.G, bx, WGM_P1); S.nt = 2048 / 128;
        LAS unsigned char* sgt = F.lds + RING_BYTES + 1024;
        for (int i = F.tid; i < 4096; i += NWAVES * 64) sgt[i] = (unsigned char)fmaxf(__builtin_rintf(255.f / (1.f + __expf(-(float)(i - 2048) * (1.0f / 256.0f)))), 1.f);
        __syncthreads();
        pg8::EpiInProj E{WSP(bf16, WS_Z), WSP(bf16, WS_XBC), WSP(bf16, WS_QKV), WSP(unsigned char, WS_GATES), WSP(float, WS_DTRAW), WSP(float, WS_USC), WSP(float, WS_WSC), sgt};
        pg8::gemm_phase<pg8::EpiInProj, pg8::StaticOrder, true, false, 2>(ring, g, S, E);
        p_kv_mem(F);
        SEAM(1); PE(1);
    }
    if (IN(2)) REP(2) { PB(2); p_conv(F); if (!IN(3)) SEAM(2); PE(2); }
    if (IN(3)) REP(3) { PB(3); REP(20) p_ssd_local(F); SEAM(3); PE(3); }
    if (IN(4)) REP(4) { PB(4); p_ssd_scan(F); REP(21) p_sb_attn(F); SEAM(4); PE(4); }
    if (IN(5)) REP(5) { PB(5); p_ssd_out(F); SEAM(5); PE(5); }
    if (IN(6)) REP(6) { PB(6);
        pg8::Gemm g{WSP(bf16, WS_RA), WSP(bf16, WS_WCAT_T), 2048, 2048, 2048, nullptr, nullptr, 0};
        pg8::SplitOrder S; S.so.init(T, 2048, 2048, F.G, bx, WGM_P6); S.nt0 = 1536 / 64; S.nt1 = 512 / 64;
        pg8::EpiMerge E{WSP(bf16, WS_MERGED), WSP(unsigned char, WS_GATES), WSP(float, WS_RSTD)};
        unsigned long long pepi6 = 0;
        const bool xs = (F.G % 8 == 0); const int slot = xs ? (bx & 7) >> 1 : 0;
        pg8::RangeOrder<pg8::SplitOrder> R; R.s = S;
        for (int part = 0; part < 2; ++part) {
            if (part == 1) { if (xs) p_expert_weights(F, false, slot, 4, ((bx >> 3) * 2 + (bx & 1)) * NWAVES + F.wave, F.G * 2); else p_expert_weights(F, false, 0, 1, F.gw, F.NGW); }
            R.i0 = part ? 2 * slot : 0; R.i1 = part ? (1 << 30) : 2 * slot;
            pg8::gemm_phase<pg8::EpiMerge, pg8::RangeOrder<pg8::SplitOrder>, true, false>(ring, g, R, E, (PROBE_PHASE == 106) ? &pepi6 : nullptr);
        }
        if (PROBE_PHASE == 106) { pt0 = 0; pt1 = pepi6; }
        SEAM(6); PE(6);
    }
    if (IN(13)) REP(13) { PB(13); p_quant_rows(F, WSP(bf16, WS_MERGED), WSP(unsigned char, WS_MQ), WSP(float, WS_MSC), T); SEAM(13); PE(13); }
    if (IN(8)) REP(8) { PB(8);
        pg8::Gemm g{WSP(unsigned char, WS_MQ), WSP(unsigned char, WS_WMIX_T), 2048, 2048, 2048, nullptr, nullptr, 0};
        pg8::StaticOrder S; S.init(T, 2048, 2048, F.G, bx, WGM_P8); S.nt = 2048 / 128;
        pg8::EpiResStatF32 E{F.in[0], WSP(bf16, WS_RA), WSP(float, WS_SSQ1), WSP(float, WS_MSC), WSP(float, WS_WMS)};
        unsigned long long pepi = 0;
        pg8::gemm_phase<pg8::EpiResStatF32, pg8::StaticOrder, true, false, 2>(ring, g, S, E, (PROBE_PHASE == 108) ? &pepi : nullptr);
        if (PROBE_PHASE == 108) { pt0 = 0; pt1 = pepi; }
        SEAM(8); PE(8);
    }
    if (IN(10)) REP(10) { PB(10);
        pg8::Gemm g{WSP(bf16, WS_RA), WSP(bf16, WS_WQ_T), 2048, 2048, 2048, nullptr, nullptr, 0};
        pg8::StaticOrder S; S.init(T, 512, 2048, F.G, bx, WGM_P10);
        pg8::EpiBf16Rs E{WSP(bf16, WS_Q2), 512, WSP(float, WS_SSQ1)};
        pg8::gemm_phase<pg8::EpiBf16Rs, pg8::StaticOrder, true, false>(ring, g, S, E);
        SEAM(10); PE(10);
    }
    if (IN(11)) REP(11) { PB(11); p_xattn(F); SEAM(11); PE(11); }
    if (IN(12)) REP(12) { PB(12);
        pg8::Gemm g{WSP(bf16, WS_O2), WSP(bf16, WS_WO_T), 512, 512, 512, nullptr, nullptr, 0};
        pg8::StaticOrder S; S.init(T, 2048, 512, F.G, bx, WGM_P12);
        pg8::EpiResStatBf E{WSP(bf16, WS_RA), WSP(float, WS_SSQ2), WSP(unsigned char, WS_HB8)};
        pg8::gemm_phase<pg8::EpiResStatBf, pg8::StaticOrder, true, false>(ring, g, S, E);
        SEAM(12); PE(12);
    }
    if (IN(14)) REP(14) { PB(14); p_router(F); SEAM(14); PE(14); }
    if (IN(16)) REP(16) { PB(16); p_route_b(F); SEAM(16); PE(16); }
    if (IN(17)) REP(17) { PB(17);
        const int* TILEE = WSP(int, WS_TILEE);
        pg8::Gemm g{WSP(unsigned char, WS_HB8), (unsigned char*)F.out + OUT_WGU, 2048, 2048, 2048, WSP(int, WS_SLOTTOK), TILEE, (size_t)1024 * 2048};
        pg8::ListOrder S; S.init(TILEE[511], 4, F.G, bx, 2048 / 128, WGM_P17);
        pg8::EpiSwiGLU E{WSP(unsigned char, WS_HID), WSP(float, WS_SRSTD), 1.0f / WGU_SCALE, HID_SCALE};
        pg8::gemm_phase<pg8::EpiSwiGLU, pg8::ListOrder, true, true, 1>(ring, g, S, E);
        { const int nun = TILEE[511] * 4, rem = nun % F.G;
          if (rem != 0 && F.G - rem >= F.G / 2) { if (bx >= rem) p_expert_weights(F, true, 0, 1, (bx - rem) * NWAVES + F.wave, (F.G - rem) * NWAVES); }
          else p_expert_weights(F, true, 0, 1, F.gw, F.NGW); }
        SEAM(17); PE(17);
    }
    if (IN(18)) REP(18) { PB(18);
        const int* TILEE = WSP(int, WS_TILEE);
        pg8::Gemm g{WSP(unsigned char, WS_HID), (unsigned char*)F.out + OUT_WD, 512, 512, 512, nullptr, TILEE, (size_t)2048 * 512};
        pg8::ListOrder S; S.init(TILEE[511], 8, F.G, bx, 512 / 128, WGM_P18);
        pg8::EpiF8 E{WSP(unsigned char, WS_Y), 2048, Y_SCALE / (HID_SCALE * WD_SCALE)};
        pg8::gemm_phase<pg8::EpiF8, pg8::ListOrder, true, false, 1>(ring, g, S, E);
        SEAM(18); PE(18);
    }
    if (IN(19)) REP(19) { PB(19); p_final(F); PE(19); }
    if (PROBE_PHASE >= 120) { pt0 = 0; pt1 = psub; }
    if (PROBE_PHASE >= 0 && blockIdx.x == 0 && threadIdx.x == 0) { const unsigned long long te = __builtin_amdgcn_s_memrealtime(), d = (pt1 - pt0) * PROBE_MULT;
        while (__builtin_amdgcn_s_memrealtime() - te < d) __builtin_amdgcn_s_sleep(8); }
#undef IN
#undef SEAM
}

extern "C" void kernel_launch(void* const* d_in, const int* in_sizes, int n_in, void* d_out, int out_size, void* d_ws, size_t ws_size, hipStream_t stream) {
    static int grid = 0;
    if (grid == 0) {
        if (n_in != 26 || out_size != T * D || ws_size < WS_END) { fprintf(stderr, "kernel_launch: unexpected sizes n_in %d out %d ws %zu\n", n_in, out_size, ws_size); grid = -1; return; }
        int dev = 0, cus = 0, per_cu = 0;
        if (hipGetDevice(&dev) != hipSuccess || hipDeviceGetAttribute(&cus, hipDeviceAttributeMultiprocessorCount, dev) != hipSuccess) { grid = -1; return; }
        if (hipFuncSetAttribute((const void*)fwd, hipFuncAttributeMaxDynamicSharedMemorySize, LDS_BYTES) != hipSuccess) { fprintf(stderr, "kernel_launch: hipFuncSetAttribute failed\n"); grid = -1; return; }
        if (hipOccupancyMaxActiveBlocksPerMultiprocessor(&per_cu, (const void*)fwd, NWAVES * 64, LDS_BYTES) != hipSuccess || per_cu < 1) fprintf(stderr, "kernel_launch: occupancy query reports %d\n", per_cu);
        (void)hipGetLastError();
        grid = cus;
    }
    if (grid < 0) return;
    if (hipMemsetAsync((char*)d_ws + WS_CTL, 0, CTL_ZERO_BYTES, stream) != hipSuccess) return;
    Args a{};
    for (int i = 0; i < 26; ++i) a.in[i] = (const float*)d_in[i];
    a.out = (float*)d_out; a.ws = (unsigned char*)d_ws;
    if (MK_N_LAUNCHES == 1) {
        a.ph_lo = 0; a.ph_hi = NPHASE;
        hipLaunchKernelGGL(fwd, dim3(grid), dim3(NWAVES * 64), LDS_BYTES, stream, a);
    } else {
        for (int p = 0; p < NPHASE; ++p) { a.ph_lo = p; a.ph_hi = p + 1; hipLaunchKernelGGL(fwd, dim3(grid), dim3(NWAVES * 64), LDS_BYTES, stream, a); }
    }
}
```
